# Optimizing an MI355X kernel written in HIP

```python
import jax, jax.numpy as jnp
from jax import lax
import numpy as np

D_MODEL = 1024
BATCH = 8
SEQ = 2048
DEPTH = 2

GRID_W = 64
CTX_LEN = 256
Q_BLOCK = 128
ROPE_THETA = 10000.0
EPS = 1e-6

GQA_HEADS = 8
GQA_KV_HEADS = 2
GQA_GROUP = GQA_HEADS // GQA_KV_HEADS
GQA_HEAD_DIM = 64
GQA_SCALE = GQA_HEAD_DIM ** -0.5
MLA_HEADS = 8
MLA_Q_RANK = 384
MLA_KV_RANK = 256
MLA_NOPE_DIM = 64
MLA_ROPE_DIM = 32
MLA_V_DIM = 64
MLA_SCALE = (MLA_NOPE_DIM + MLA_ROPE_DIM) ** -0.5
MLA_UQ_WIDTH = MLA_HEADS * (MLA_NOPE_DIM + MLA_ROPE_DIM)
MLA_UKV_WIDTH = MLA_HEADS * (MLA_NOPE_DIM + MLA_V_DIM)
FOURIER_GROUPS = 4
FOURIER_GROUP_DIM = 128
FOURIER_WIDTH = FOURIER_GROUPS * FOURIER_GROUP_DIM
N_BRANCH = 3
FFN_HIDDEN = -(-8 * D_MODEL // (3 * 256)) * 256

IN_WIDTHS = (
    GQA_HEADS * GQA_HEAD_DIM,
    GQA_KV_HEADS * GQA_HEAD_DIM,
    GQA_KV_HEADS * GQA_HEAD_DIM,
    MLA_Q_RANK,
    MLA_KV_RANK,
    MLA_ROPE_DIM,
    FOURIER_WIDTH,
    N_BRANCH * D_MODEL,
)
IN_WIDTH = sum(IN_WIDTHS)

kernel_name = "hybrid_gqa_mla_fnet_prefix_dit"


def rms_norm(x, g):
    xf = x.astype(jnp.float32)
    y = xf * lax.rsqrt(jnp.mean(xf * xf, axis=-1, keepdims=True) + EPS)
    return (y * g.astype(jnp.float32)).astype(x.dtype)


def modulate(x, g, shift, scale):
    return rms_norm(x, g) * (1 + scale) + shift


def split_in(p):
    idx, acc = [], 0
    for w in IN_WIDTHS[:-1]:
        acc += w
        idx.append(acc)
    return jnp.split(p, idx, axis=-1)


def axial_rope_tables(rows, dim):
    row_id = jnp.repeat(jnp.arange(rows), GRID_W)
    col_id = jnp.tile(jnp.arange(GRID_W), rows)
    half = dim // 2
    freqs = ROPE_THETA ** (-jnp.arange(0, half, 2, dtype=jnp.float32) / half)

    def axis_angles(pos):
        ang = pos.astype(jnp.float32)[:, None] * freqs[None, :]
        return jnp.concatenate([ang, ang], axis=-1)

    ang = jnp.concatenate([axis_angles(row_id), axis_angles(col_id)], axis=-1)
    return jnp.cos(ang), jnp.sin(ang)


def apply_rope(x, cos, sin):
    dim = x.shape[-1]
    q = dim // 4
    xr = x.reshape(*x.shape[:-1], 2, 2, q)
    rot = jnp.concatenate([-xr[..., 1:2, :], xr[..., 0:1, :]], axis=-2).reshape(x.shape)
    out = x.astype(jnp.float32) * cos[None, :, None, :] + rot.astype(jnp.float32) * sin[None, :, None, :]
    return out.astype(x.dtype)


def attend(q, k, v, scale):
    B, N = q.shape[:2]
    nb = N // Q_BLOCK
    qb = jnp.moveaxis(q.reshape(B, nb, Q_BLOCK, *q.shape[2:]), 1, 0)

    def one_block(qblk):
        s = jnp.einsum('bqkgd,bmkd->bkgqm', qblk, k, preferred_element_type=jnp.float32) * scale
        p = jax.nn.softmax(s, axis=-1).astype(v.dtype)
        return jnp.einsum('bkgqm,bmke->bqkge', p, v)

    o = lax.map(one_block, qb)
    o = jnp.moveaxis(o, 0, 1)
    return o.reshape(B, N, -1)


def gqa_queries(pq, g_q, rope):
    B, N, _ = pq.shape
    q = rms_norm(pq.reshape(B, N, GQA_HEADS, GQA_HEAD_DIM), g_q)
    if rope is not None:
        q = apply_rope(q, *rope)
    return q.reshape(B, N, GQA_KV_HEADS, GQA_GROUP, GQA_HEAD_DIM)


def gqa_keys_values(pk, pv, g_k, rope):
    B, N, _ = pk.shape
    k = rms_norm(pk.reshape(B, N, GQA_KV_HEADS, GQA_HEAD_DIM), g_k)
    if rope is not None:
        k = apply_rope(k, *rope)
    v = pv.reshape(B, N, GQA_KV_HEADS, GQA_HEAD_DIM)
    return k, v


def mla_queries(pcq, g_cq, w_uq, g_qn, g_qr, rope):
    B, N, _ = pcq.shape
    q = (rms_norm(pcq, g_cq) @ w_uq).reshape(B, N, MLA_HEADS, MLA_NOPE_DIM + MLA_ROPE_DIM)
    qn = rms_norm(q[..., :MLA_NOPE_DIM], g_qn)
    qr = rms_norm(q[..., MLA_NOPE_DIM:], g_qr)
    if rope is not None:
        qr = apply_rope(qr, *rope)
    return jnp.concatenate([qn, qr], axis=-1)[:, :, :, None, :]


def mla_keys_values(pckv, pkr, g_ckv, w_ukv, g_kn, g_kr, rope):
    B, N, _ = pckv.shape
    kv = (rms_norm(pckv, g_ckv) @ w_ukv).reshape(B, N, MLA_HEADS, MLA_NOPE_DIM + MLA_V_DIM)
    kn = rms_norm(kv[..., :MLA_NOPE_DIM], g_kn)
    v = kv[..., MLA_NOPE_DIM:]
    kr = rms_norm(pkr, g_kr)[:, :, None, :]
    if rope is not None:
        kr = apply_rope(kr, *rope)
    k = jnp.concatenate([kn, jnp.broadcast_to(kr, (B, N, MLA_HEADS, MLA_ROPE_DIM))], axis=-1)
    return k, v


def fourier_mix(pf):
    B, N, _ = pf.shape
    f = pf.astype(jnp.float32).reshape(B, N, FOURIER_GROUPS, FOURIER_GROUP_DIM)
    f = jnp.fft.fft2(f, axes=(1, 3), norm="ortho").real
    return f.reshape(B, N, FOURIER_WIDTH).astype(pf.dtype)


def merge_branches(ya, yb, yc, pg, b_gate, w_br_a, w_br_b, w_br_c, w_out):
    B, N, _ = pg.shape
    g = jax.nn.sigmoid((pg + b_gate).astype(jnp.float32)).astype(ya.dtype)
    g = g.reshape(B, N, N_BRANCH, D_MODEL)
    m = g[:, :, 0] * (ya @ w_br_a) + g[:, :, 1] * (yb @ w_br_b) + g[:, :, 2] * (yc @ w_br_c)
    return m @ w_out


def swiglu(h, w_in, w_out):
    gate, up = jnp.split(h @ w_in, 2, axis=-1)
    return (jax.nn.silu(gate) * up) @ w_out


def setup_inputs(seed: int = 0) -> dict:
    key = jax.random.key(seed)
    ks = jax.random.split(key, 32)
    L, D = DEPTH, D_MODEL
    f32 = jnp.float32

    def w(k, shape, fan_in, gain=1.0):
        return jax.random.normal(k, shape, f32) * (gain * fan_in ** -0.5)

    def gain(k, shape):
        return 1.0 + 0.1 * jax.random.normal(k, shape, f32)

    def bias(k, shape):
        return 0.01 * jax.random.normal(k, shape, f32)

    return {
        "x": jax.random.normal(ks[0], (BATCH, SEQ, D), f32),
        "c": jax.random.normal(ks[1], (BATCH, D), f32),
        "ctx": jax.random.normal(ks[2], (BATCH, CTX_LEN, D), f32),
        "c_ctx": jax.random.normal(ks[3], (D,), f32),
        "w_mod": w(ks[4], (L, D, 6 * D), D, 0.5),
        "b_mod": bias(ks[5], (L, 6 * D)),
        "g_norm1": gain(ks[6], (L, D)),
        "g_norm2": gain(ks[7], (L, D)),
        "w_in": w(ks[8], (L, D, IN_WIDTH), D),
        "g_q_gqa": gain(ks[9], (L, GQA_HEAD_DIM)),
        "g_k_gqa": gain(ks[10], (L, GQA_HEAD_DIM)),
        "g_cq": gain(ks[11], (L, MLA_Q_RANK)),
        "g_ckv": gain(ks[12], (L, MLA_KV_RANK)),
        "w_uq": w(ks[13], (L, MLA_Q_RANK, MLA_UQ_WIDTH), MLA_Q_RANK),
        "w_ukv": w(ks[14], (L, MLA_KV_RANK, MLA_UKV_WIDTH), MLA_KV_RANK),
        "g_q_nope": gain(ks[15], (L, MLA_NOPE_DIM)),
        "g_k_nope": gain(ks[16], (L, MLA_NOPE_DIM)),
        "g_q_rope": gain(ks[17], (L, MLA_ROPE_DIM)),
        "g_k_rope": gain(ks[18], (L, MLA_ROPE_DIM)),
        "b_gate": bias(ks[19], (L, N_BRANCH * D)),
        "w_br_a": w(ks[20], (L, GQA_HEADS * GQA_HEAD_DIM, D), GQA_HEADS * GQA_HEAD_DIM),
        "w_br_b": w(ks[21], (L, MLA_HEADS * MLA_V_DIM, D), MLA_HEADS * MLA_V_DIM),
        "w_br_c": w(ks[22], (L, FOURIER_WIDTH, D), FOURIER_WIDTH),
        "w_out": w(ks[23], (L, D, D), D),
        "w_ffn_in": w(ks[24], (L, D, 2 * FFN_HIDDEN), D),
        "w_ffn_out": w(ks[25], (L, FFN_HIDDEN, D), FFN_HIDDEN),
    }


def reference(x, c, ctx, c_ctx, w_mod, b_mod, g_norm1, g_norm2, w_in, g_q_gqa, g_k_gqa,
              g_cq, g_ckv, w_uq, w_ukv, g_q_nope, g_k_nope, g_q_rope, g_k_rope, b_gate,
              w_br_a, w_br_b, w_br_c, w_out, w_ffn_in, w_ffn_out):
    B, N, D = x.shape
    ROWS = N // GRID_W
    rope_a = axial_rope_tables(ROWS, GQA_HEAD_DIM)
    rope_b = axial_rope_tables(ROWS, MLA_ROPE_DIM)
    silu_c = jax.nn.silu(c)
    silu_cc = jax.nn.silu(c_ctx)
    xc = ctx

    for l in range(DEPTH):
        last = l == DEPTH - 1
        mod = (silu_c @ w_mod[l] + b_mod[l])[:, None, :]
        mod_c = (silu_cc @ w_mod[l] + b_mod[l])[None, None, :]
        sh1, sc1, gt1, sh2, sc2, gt2 = jnp.split(mod, 6, axis=-1)
        csh1, csc1, cgt1, csh2, csc2, cgt2 = jnp.split(mod_c, 6, axis=-1)

        h = modulate(x, g_norm1[l], sh1, sc1)
        hc = modulate(xc, g_norm1[l], csh1, csc1)
        p_q, p_k, p_v, p_cq, p_ckv, p_kr, p_f, p_g = split_in(h @ w_in[l])
        c_q, c_k, c_v, c_cq, c_ckv, c_kr, c_f, c_g = split_in(hc @ w_in[l])

        kc_a, vc_a = gqa_keys_values(c_k, c_v, g_k_gqa[l], None)
        kc_b, vc_b = mla_keys_values(c_ckv, c_kr, g_ckv[l], w_ukv[l], g_k_nope[l], g_k_rope[l], None)

        q_a = gqa_queries(p_q, g_q_gqa[l], rope_a)
        k_a, v_a = gqa_keys_values(p_k, p_v, g_k_gqa[l], rope_a)
        ya = attend(q_a, jnp.concatenate([kc_a, k_a], axis=1),
                    jnp.concatenate([vc_a, v_a], axis=1), GQA_SCALE)
        q_b = mla_queries(p_cq, g_cq[l], w_uq[l], g_q_nope[l], g_q_rope[l], rope_b)
        k_b, v_b = mla_keys_values(p_ckv, p_kr, g_ckv[l], w_ukv[l], g_k_nope[l], g_k_rope[l], rope_b)
        yb = attend(q_b, jnp.concatenate([kc_b, k_b], axis=1),
                    jnp.concatenate([vc_b, v_b], axis=1), MLA_SCALE)
        yc = fourier_mix(p_f)

        x_new = x + gt1 * merge_branches(ya, yb, yc, p_g, b_gate[l], w_br_a[l], w_br_b[l],
                                         w_br_c[l], w_out[l])
        x_new = x_new + gt2 * swiglu(modulate(x_new, g_norm2[l], sh2, sc2), w_ffn_in[l], w_ffn_out[l])

        if not last:
            qc_a = gqa_queries(c_q, g_q_gqa[l], None)
            yca = attend(qc_a, kc_a, vc_a, GQA_SCALE)
            qc_b = mla_queries(c_cq, g_cq[l], w_uq[l], g_q_nope[l], g_q_rope[l], None)
            ycb = attend(qc_b, kc_b, vc_b, MLA_SCALE)
            ycc = fourier_mix(c_f)
            xc = xc + cgt1 * merge_branches(yca, ycb, ycc, c_g, b_gate[l], w_br_a[l], w_br_b[l],
                                            w_br_c[l], w_out[l])
            xc = xc + cgt2 * swiglu(modulate(xc, g_norm2[l], csh2, csc2), w_ffn_in[l], w_ffn_out[l])

        x = x_new

    return x
```

```cpp
#include <hip/hip_runtime.h>
#include <hip/hip_cooperative_groups.h>
#include <cstdint>
#include <cstdio>
namespace cg = cooperative_groups;

#ifndef MK_MULTI
#define MK_MULTI 0
#endif

#define LAS __attribute__((address_space(3)))
typedef unsigned short bf16;
typedef short bf16x8 __attribute__((ext_vector_type(8)));
typedef short s16x4 __attribute__((ext_vector_type(4)));
typedef float f32x2 __attribute__((ext_vector_type(2)));
typedef float f32x4 __attribute__((ext_vector_type(4)));
typedef float f32x16 __attribute__((ext_vector_type(16)));
typedef unsigned u32x2 __attribute__((ext_vector_type(2)));
typedef unsigned u32x4 __attribute__((ext_vector_type(4)));
typedef __bf16 bf16x2_t __attribute__((ext_vector_type(2)));

constexpr int DM = 1024, NB = 8, SEQ = 2048, CTX = 256, NKEY = CTX + SEQ;
constexpr int ML = NB * SEQ, MC = NB * CTX, MT = ML + MC;
constexpr int INW = 5024, NINP = 5120;
constexpr int FFH = 2816;
constexpr float EPS = 1e-6f;
constexpr float LOG2E = 1.4426950408889634f;
constexpr float C2A = 0.125f * LOG2E;
constexpr float C2B = 0.10206207261596577f * LOG2E;
constexpr int NWAVES = 8, NTHR = 512;

constexpr size_t MiB = 1u << 20, KiB = 1024;
constexpr size_t O_CTL = 0;
constexpr size_t O_MOD = 256 * KiB;
constexpr size_t O_ROPEA = 704 * KiB;
constexpr size_t O_ROPEB = 712 * KiB;
constexpr size_t O_STATCQ = 1 * MiB;
constexpr size_t O_STATCKV = O_STATCQ + (size_t)MT * 8 * 4;
constexpr size_t O_DN = 2 * MiB;
constexpr size_t O_DN256 = O_DN + 16 * MiB;
constexpr size_t O_DFTC = O_DN256 + 256 * KiB;
constexpr size_t O_W = O_DN + 16 * MiB + 512 * KiB;
constexpr size_t O_WIN = O_W;
constexpr size_t O_WUQ = O_WIN + (size_t)NINP * 1024 * 2;
constexpr size_t O_WUKV = O_WUQ + 768 * 384 * 2;
constexpr size_t O_WBR = O_WUKV + 1024 * 256 * 2;
constexpr size_t O_WOUT = O_WBR + 1024 * 1536 * 2;
constexpr size_t O_XC = O_W + 16 * MiB + 256 * KiB;
constexpr size_t O_HB = O_XC + 8 * MiB;
constexpr size_t O_PF = O_HB + 36 * MiB;
constexpr size_t O_QA = O_PF + 18 * MiB;
constexpr size_t O_QBN = O_QA + 18 * MiB;
constexpr size_t O_QBR = O_QBN + 18 * MiB;
constexpr size_t O_WFI = O_QA;
constexpr size_t O_WFO = O_WFI + (size_t)5632 * 1024 * 2;
constexpr size_t O_G = O_QBR + 9 * MiB;
constexpr size_t O_CQ = O_G;
constexpr size_t O_CKV = O_CQ + (size_t)MT * 384 * 2;
constexpr size_t O_KA = O_CKV + (size_t)MT * 256 * 2;
constexpr size_t O_VA = O_KA + (size_t)NB * NKEY * 128 * 2;
constexpr size_t O_KB = O_VA + (size_t)NB * NKEY * 128 * 2;
constexpr size_t O_VB = O_KB + (size_t)NB * NKEY * 768 * 2;
constexpr size_t O_ZT1 = O_VB + (size_t)NB * NKEY * 512 * 2;
constexpr size_t O_END = O_ZT1 + 32 * MiB;
static_assert(O_END <= 256 * MiB, "d_ws map exceeds 256 MiB");
static_assert(O_WOUT + 2 * MiB <= O_XC, "W region");
static_assert(O_WFO + (size_t)1024 * 2816 * 2 <= O_G, "ffn weights overlay");
static_assert(O_G + (size_t)MT * 3072 * 2 <= O_END, "gates overlay");
static_assert(O_DFTC + 64 * KiB <= O_W, "dft region");
static_assert(O_STATCKV + (size_t)MT * 4 * 4 <= O_DN, "stats region");

__device__ __forceinline__ unsigned cvtpk(float lo, float hi) { f32x2 v = {lo, hi}; bf16x2_t b = __builtin_convertvector(v, bf16x2_t); return __builtin_bit_cast(unsigned, b); }
__device__ __forceinline__ u32x2 pk4(f32x4 v) { u32x2 r; r.x = cvtpk(v[0], v[1]); r.y = cvtpk(v[2], v[3]); return r; }
__device__ __forceinline__ float bf2f(unsigned short h) { return __uint_as_float((unsigned)h << 16); }
__device__ __forceinline__ f32x4 unpk4(u32x2 w) { f32x4 r; r[0] = __uint_as_float(w.x << 16); r[1] = __uint_as_float(w.x & 0xffff0000u); r[2] = __uint_as_float(w.y << 16); r[3] = __uint_as_float(w.y & 0xffff0000u); return r; }
__device__ __forceinline__ float wave_sum(float v) {
#pragma unroll
    for (int o = 1; o < 64; o <<= 1) v += __shfl_xor(v, o);
    return v;
}
__device__ __forceinline__ float fq_sum(float v) { v += __shfl_xor(v, 16); v += __shfl_xor(v, 32); return v; }
__device__ __forceinline__ float sigmoidf_(float x) { return __builtin_amdgcn_rcpf(1.0f + __expf(-x)); }

namespace pg8 {
constexpr int BM = 256, BK = 64, HALF = 128, HTB = HALF * BK * 2, STAGE_BYTES = 8 * HTB, NXCD = 8, WGM = 8;
__host__ __device__ __forceinline__ int lds_byte(int r, int c) { const int st = (r >> 4) * 2 + (c >> 5), rr = r & 15, cc = c & 31, ob = rr * 64 + cc * 2; return st * 1024 + (ob ^ (((ob >> 9) & 1) << 5)); }
__host__ __device__ __forceinline__ void stage_rc(int b, int& R, int& C) { const int st = b / 1024, sb = b % 1024, swz = sb ^ (((sb >> 9) & 1) << 5); R = (st >> 1) * 16 + swz / 64; C = (st & 1) * 32 + (swz % 64) / 2; }

struct Unit { int pm, pn, kb; const char* A; const char* B; };
struct Gemm { int lda, ldb, K; };

__device__ __forceinline__ void tile_order(int L, int nM, int nN, int& pm, int& pn) {
    const int nwg = nM * nN; int wgid = L;
    { const int q = nwg / NXCD, r = nwg % NXCD, xcd = wgid % NXCD, off = wgid / NXCD; wgid = (xcd < r ? xcd * (q + 1) : r * (q + 1) + (xcd - r) * q) + off; }
    const int nig = WGM * nN, gid = wgid / nig, fm = gid * WGM, gsz = (nM - fm) < WGM ? (nM - fm) : WGM;
    pm = fm + ((wgid % nig) % gsz); pn = (wgid % nig) / gsz;
}

template <class Epi, class Sched>
__device__ __forceinline__ void gemm_phase(LAS unsigned char* lds, const Gemm g, const Sched& S, const Epi& E) {
    int tid = threadIdx.x; asm volatile("" : "+v"(tid));
    const int wid = __builtin_amdgcn_readfirstlane(tid >> 6), lane = tid & 63, wr = wid >> 2, wc = wid & 3, fr = lane & 15, fq = lane >> 4;
    int nt = g.K / BK; asm volatile("" : "+s"(nt));
    unsigned voffA, voffB;
    { int R, C; stage_rc(tid * 16, R, C); voffA = (unsigned)(R * g.lda + C) * 2u; voffB = (unsigned)(R * g.ldb + C) * 2u; }
    const size_t pieceA = (size_t)64 * g.lda * 2, pieceB = (size_t)64 * g.ldb * 2;
    const size_t kstep = (size_t)(BK * 2);
    const size_t hstepA = (size_t)HALF * g.lda * 2, hstepB = (size_t)HALF * g.ldb * 2;
    const unsigned ldsw = (unsigned)wid * 1024u;
    const int aoff = lds_byte(wr * 64 + fr, fq * 8), boff = lds_byte(wc * 32 + fr, fq * 8);
#define PG8_SA(b, h) (((b) * 2 + (h)) * HTB)
#define PG8_SB(b, h) ((4 + (b) * 2 + (h)) * HTB)
#define PG8_STAGE_A(bufoff, gbase) do { _Pragma("unroll") for (int _i = 0; _i < 2; ++_i) \
        __builtin_amdgcn_global_load_lds((const unsigned*)((const char*)(gbase) + _i * pieceA + voffA), (LAS unsigned*)(lds + (bufoff) + ldsw + _i * 8192), 16, 0, 0); } while (0)
#define PG8_STAGE_B(bufoff, gbase) do { _Pragma("unroll") for (int _i = 0; _i < 2; ++_i) \
        __builtin_amdgcn_global_load_lds((const unsigned*)((const char*)(gbase) + _i * pieceB + voffB), (LAS unsigned*)(lds + (bufoff) + ldsw + _i * 8192), 16, 0, 0); } while (0)
#define PG8_LDA(dst, b, h) do { _Pragma("unroll") for (int m = 0; m < 4; ++m) _Pragma("unroll") for (int k = 0; k < 2; ++k) dst[m][k] = *(const LAS bf16x8*)(lds + PG8_SA(b, h) + aoff + m * 2048 + k * 1024); } while (0)
#define PG8_LDB(dst, b, h) do { _Pragma("unroll") for (int n = 0; n < 2; ++n) _Pragma("unroll") for (int k = 0; k < 2; ++k) dst[n][k] = *(const LAS bf16x8*)(lds + PG8_SB(b, h) + boff + n * 2048 + k * 1024); } while (0)
#define PG8_MMA(ai, bj, At, Bt) do { __builtin_amdgcn_s_setprio(1); _Pragma("unroll") for (int m = 0; m < 4; ++m) _Pragma("unroll") for (int n = 0; n < 2; ++n) _Pragma("unroll") for (int k = 0; k < 2; ++k) \
        acc[ai][bj][m][n] = __builtin_amdgcn_mfma_f32_16x16x32_bf16(Bt[n][k], At[m][k], acc[ai][bj][m][n], 0, 0, 0); __builtin_amdgcn_s_setprio(0); } while (0)
#define PG8_WAIT_V(n) asm volatile("s_waitcnt vmcnt(" #n ")" ::: "memory")
#define PG8_WAIT_L(n) asm volatile("s_waitcnt lgkmcnt(" #n ")" ::: "memory")
#define PG8_BAR __builtin_amdgcn_s_barrier()
#define PG8_SCHED __builtin_amdgcn_sched_barrier(0)
    Unit cur, nxt; int ui = 0;
    if (!S.next(0, cur)) return;
    f32x4 acc[2][2][4][2];
#pragma unroll
    for (int a = 0; a < 2; ++a)
#pragma unroll
        for (int b = 0; b < 2; ++b)
#pragma unroll
            for (int m = 0; m < 4; ++m)
#pragma unroll
                for (int n = 0; n < 2; ++n) acc[a][b][m][n] = (f32x4){0.f, 0.f, 0.f, 0.f};
    bf16x8 At[4][2], B0[2][2], B1[2][2];
    const char* cA = cur.A; const char* cB = cur.B;
    PG8_STAGE_B(PG8_SB(0, 0), cB); PG8_STAGE_B(PG8_SB(0, 1), cB + hstepB); PG8_STAGE_A(PG8_SA(0, 0), cA); PG8_STAGE_A(PG8_SA(0, 1), cA + hstepA);
    if (wr == 1) PG8_BAR;
    PG8_WAIT_V(2); PG8_BAR;
    PG8_STAGE_B(PG8_SB(1, 0), cB + kstep); PG8_STAGE_A(PG8_SA(1, 0), cA + kstep); PG8_STAGE_B(PG8_SB(1, 1), cB + hstepB + kstep);
    PG8_WAIT_V(6); PG8_BAR;
    for (;;) {
        const bool has_next = S.next(ui + 1, nxt);
        const char* nA = has_next ? nxt.A : cA; const char* nB = has_next ? nxt.B : cB;
        for (int t = 0; t < nt; t += 2) {
            const bool last = (t == nt - 2);
            const char* a1 = cA + (size_t)(t + 1) * kstep;
            const char* a2 = last ? nA : cA + (size_t)(t + 2) * kstep; const char* b2 = last ? nB : cB + (size_t)(t + 2) * kstep;
            const char* a3 = a2 + kstep; const char* b3 = b2 + kstep;
            PG8_LDB(B0, 0, 0); PG8_LDB(B1, 0, 1); PG8_SCHED; PG8_LDA(At, 0, 0); PG8_STAGE_A(PG8_SA(1, 1), a1 + hstepA);
            PG8_WAIT_V(8); PG8_WAIT_L(0); PG8_BAR; PG8_MMA(0, 0, At, B0); PG8_MMA(0, 1, At, B1); PG8_BAR; PG8_SCHED;
            PG8_LDA(At, 0, 1); PG8_STAGE_B(PG8_SB(0, 0), b2); PG8_STAGE_B(PG8_SB(0, 1), b2 + hstepB); PG8_STAGE_A(PG8_SA(0, 0), a2);
            PG8_WAIT_V(8); PG8_WAIT_L(0); PG8_BAR; PG8_MMA(1, 0, At, B0); PG8_MMA(1, 1, At, B1); PG8_BAR; PG8_SCHED;
            PG8_LDB(B0, 1, 0); PG8_LDB(B1, 1, 1); PG8_SCHED; PG8_LDA(At, 1, 0); PG8_STAGE_A(PG8_SA(0, 1), a2 + hstepA);
            PG8_WAIT_V(8); PG8_WAIT_L(0); PG8_BAR; PG8_MMA(0, 0, At, B0); PG8_MMA(0, 1, At, B1); PG8_BAR; PG8_SCHED;
            PG8_LDA(At, 1, 1); PG8_STAGE_B(PG8_SB(1, 0), b3); PG8_STAGE_B(PG8_SB(1, 1), b3 + hstepB); PG8_STAGE_A(PG8_SA(1, 0), a3);
            PG8_WAIT_V(8); PG8_WAIT_L(0); PG8_BAR; PG8_MMA(1, 0, At, B0); PG8_MMA(1, 1, At, B1); PG8_BAR; PG8_SCHED;
        }
        if (wr == 0) PG8_BAR;
        const bool carry = E(acc, cur, wr, wc, fr, fq);
        if (!has_next) break;
        if (!carry) {
#pragma unroll
            for (int a = 0; a < 2; ++a)
#pragma unroll
                for (int b = 0; b < 2; ++b)
#pragma unroll
                    for (int m = 0; m < 4; ++m)
#pragma unroll
                        for (int n = 0; n < 2; ++n) acc[a][b][m][n] = (f32x4){0.f, 0.f, 0.f, 0.f};
        }
        cur = nxt; cA = nA; cB = nB; ++ui;
        if (wr == 1) PG8_BAR;
    }
    PG8_WAIT_V(0);
    PG8_BAR;
#undef PG8_SA
#undef PG8_SB
#undef PG8_STAGE_A
#undef PG8_STAGE_B
#undef PG8_LDA
#undef PG8_LDB
#undef PG8_MMA
#undef PG8_WAIT_V
#undef PG8_WAIT_L
#undef PG8_BAR
#undef PG8_SCHED
}
}
using pg8::Unit; using pg8::Gemm;

typedef f32x4 Acc[2][2][4][2];

struct RectSched {
    int nM, nN, pm0, G, c, nkb; unsigned long long pnmap;
    const char* A0; size_t dA1, dA2; const char* B; size_t strideAm, strideBn, strideBk;
    __device__ __forceinline__ bool next(int i, Unit& u) const {
        const int ti = i / nkb, kb = i - ti * nkb; const long L = (long)ti * G + c; if (L >= (long)nM * nN) return false;
        int pm, pn; pg8::tile_order((int)L, nM, nN, pm, pn);
        if (pnmap != ~0ull) pn = (int)((pnmap >> (4 * pn)) & 15ull);
        u.pm = pm + pm0; u.pn = pn; u.kb = kb;
        u.A = A0 + (size_t)(kb == 1) * dA1 + (size_t)(kb == 2) * dA2 + (size_t)u.pm * strideAm; u.B = B + (size_t)pn * strideBn + (size_t)kb * strideBk; return true;
    }
};

struct RowInfo { bool ctx; int b; int tok0; };
__device__ __forceinline__ RowInfo row_info(int pm) { RowInfo r; r.ctx = pm >= 64; r.b = r.ctx ? pm - 64 : pm >> 3; r.tok0 = r.ctx ? 0 : (pm & 7) * 256; return r; }

template <bool NORM>
__device__ __forceinline__ void head64(const f32x4 (&a)[2][2], const f32x4 (&g)[2][2], float scale, bool rope, int row_id, int col_id, const float* ropeA, int fq, f32x4 (&o)[2][2]) {
    f32x4 v[2][2];
    if (NORM) {
        float ss = 0.f;
#pragma unroll
        for (int bj = 0; bj < 2; ++bj)
#pragma unroll
            for (int n = 0; n < 2; ++n) { const f32x4 x = a[bj][n]; ss += (x[0] * x[0] + x[1] * x[1]) + (x[2] * x[2] + x[3] * x[3]); }
        ss = fq_sum(ss);
        const float rstd = rsqrtf(ss * (1.0f / 64.0f) + EPS);
#pragma unroll
        for (int bj = 0; bj < 2; ++bj)
#pragma unroll
            for (int n = 0; n < 2; ++n) v[bj][n] = a[bj][n] * rstd * g[bj][n];
    } else {
#pragma unroll
        for (int bj = 0; bj < 2; ++bj)
#pragma unroll
            for (int n = 0; n < 2; ++n) v[bj][n] = a[bj][n];
    }
    if (rope) {
#pragma unroll
        for (int bj = 0; bj < 2; ++bj) {
            const int pos = bj ? col_id : row_id;
            const f32x4 cs = *(const f32x4*)(ropeA + pos * 16 + 4 * fq), sn = *(const f32x4*)(ropeA + 1024 + pos * 16 + 4 * fq);
            o[bj][0] = (v[bj][0] * cs - v[bj][1] * sn) * scale; o[bj][1] = (v[bj][1] * cs + v[bj][0] * sn) * scale;
        }
    } else {
#pragma unroll
        for (int bj = 0; bj < 2; ++bj)
#pragma unroll
            for (int n = 0; n < 2; ++n) o[bj][n] = v[bj][n] * scale;
    }
}
__device__ __forceinline__ void rope32(const f32x4 (&a)[2], const float* g, float scale, bool rope, int row_id, int col_id, const float* ropeB, int fq, f32x4 (&o)[2]) {
    float ss = 0.f;
#pragma unroll
    for (int n = 0; n < 2; ++n) { const f32x4 x = a[n]; ss += (x[0] * x[0] + x[1] * x[1]) + (x[2] * x[2] + x[3] * x[3]); }
    ss = fq_sum(ss);
    const float rstd = rsqrtf(ss * (1.0f / 32.0f) + EPS);
    const int d0 = 16 * (fq >> 1) + 4 * (fq & 1);
    f32x4 v[2];
#pragma unroll
    for (int n = 0; n < 2; ++n) v[n] = a[n] * rstd * *(const f32x4*)(g + d0 + 8 * n);
    if (rope) {
        const int pos = (fq >> 1) ? col_id : row_id;
        const f32x4 cs = *(const f32x4*)(ropeB + pos * 8 + 4 * (fq & 1)), sn = *(const f32x4*)(ropeB + 512 + pos * 8 + 4 * (fq & 1));
        o[0] = (v[0] * cs - v[1] * sn) * scale; o[1] = (v[1] * cs + v[0] * sn) * scale;
    } else { o[0] = v[0] * scale; o[1] = v[1] * scale; }
}

struct EpiIn {
    bf16 *QA, *KA, *VA, *CQ, *CKV, *KB, *PF, *G; float *stat_cq, *stat_ckv;
    const float *gq, *gk, *gkr, *bgate, *ropeA, *ropeB;
    __device__ __forceinline__ bool operator()(Acc& acc, const Unit& u, int wr, int wc, int fr_, int fq_) const {
        int fr = fr_, fq = fq_; asm volatile("" : "+v"(fr), "+v"(fq));
        const RowInfo ri = row_info(u.pm); const bool rope = !ri.ctx;
        const int pn = u.pn;
        if (pn <= 2) {
            const bool isv = (pn == 2 && wc >= 2), isk = (pn == 2 && wc < 2);
            const float* gsrc = (pn < 2) ? gq : gk;
            f32x4 g[2][2];
#pragma unroll
            for (int bj = 0; bj < 2; ++bj)
#pragma unroll
                for (int n = 0; n < 2; ++n) g[bj][n] = *(const f32x4*)(gsrc + 32 * bj + 16 * n + 4 * fq);
#pragma unroll
            for (int ai = 0; ai < 2; ++ai)
#pragma unroll
                for (int m = 0; m < 4; ++m) {
                    const int rt = 128 * ai + 64 * wr + 16 * m + fr;
                    const int row_id = (ri.tok0 + 128 * ai + 64 * wr) >> 6, col_id = 16 * m + fr;
                    f32x4 a[2][2], o[2][2];
#pragma unroll
                    for (int bj = 0; bj < 2; ++bj)
#pragma unroll
                        for (int n = 0; n < 2; ++n) a[bj][n] = acc[ai][bj][m][n];
                    bf16* dst;
                    if (pn < 2) { head64<true>(a, g, C2A, rope, row_id, col_id, ropeA, fq, o); dst = QA + (size_t)(u.pm * 256 + rt) * 512 + (4 * pn + wc) * 64; }
                    else {
                        const size_t key = (size_t)ri.b * NKEY + (ri.ctx ? rt : 256 + ri.tok0 + rt);
                        if (isk) { head64<true>(a, g, 1.0f, rope, row_id, col_id, ropeA, fq, o); dst = KA + key * 128 + wc * 64; }
                        else { head64<false>(a, g, 1.0f, false, 0, 0, ropeA, fq, o); dst = VA + key * 128 + (wc - 2) * 64; }
                    }
#pragma unroll
                    for (int bj = 0; bj < 2; ++bj)
#pragma unroll
                        for (int n = 0; n < 2; ++n) *(u32x2*)(dst + 32 * bj + 16 * n + 4 * fq) = pk4(o[bj][n]);
                }
            (void)isv;
        } else if (pn == 3 || pn == 5) {
            bf16* dstb = (pn == 3) ? CQ : CKV; const int ld = (pn == 3) ? 384 : 256;
            float* st = (pn == 3) ? stat_cq : stat_ckv; const int sld = (pn == 3) ? 8 : 4;
#pragma unroll
            for (int ai = 0; ai < 2; ++ai)
#pragma unroll
                for (int m = 0; m < 4; ++m) {
                    const size_t row = (size_t)u.pm * 256 + 128 * ai + 64 * wr + 16 * m + fr; float ss = 0.f;
#pragma unroll
                    for (int bj = 0; bj < 2; ++bj)
#pragma unroll
                        for (int n = 0; n < 2; ++n) { const f32x4 x = acc[ai][bj][m][n]; ss += (x[0] * x[0] + x[1] * x[1]) + (x[2] * x[2] + x[3] * x[3]);
                            *(u32x2*)(dstb + row * ld + 128 * bj + 32 * wc + 16 * n + 4 * fq) = pk4(x); }
                    ss = fq_sum(ss);
                    if (fq == 0) st[row * sld + wc] = ss;
                }
        } else if (pn == 4) {
            f32x4 gk0[2]; (void)gk0;
#pragma unroll
            for (int ai = 0; ai < 2; ++ai)
#pragma unroll
                for (int m = 0; m < 4; ++m) {
                    const int rt = 128 * ai + 64 * wr + 16 * m + fr; const size_t row = (size_t)u.pm * 256 + rt; float ss = 0.f;
#pragma unroll
                    for (int n = 0; n < 2; ++n) { const f32x4 x = acc[ai][0][m][n]; ss += (x[0] * x[0] + x[1] * x[1]) + (x[2] * x[2] + x[3] * x[3]);
                        *(u32x2*)(CQ + row * 384 + 256 + 32 * wc + 16 * n + 4 * fq) = pk4(x); }
                    ss = fq_sum(ss);
                    if (fq == 0) stat_cq[row * 8 + 4 + wc] = ss;
                    if (wc == 0) {
                        const int row_id = (ri.tok0 + 128 * ai + 64 * wr) >> 6, col_id = 16 * m + fr;
                        f32x4 a[2], o[2]; a[0] = acc[ai][1][m][0]; a[1] = acc[ai][1][m][1];
                        rope32(a, gkr, 1.0f, rope, row_id, col_id, ropeB, fq, o);
                        const size_t key = (size_t)ri.b * NKEY + (ri.ctx ? rt : 256 + ri.tok0 + rt);
                        bf16* dst = KB + key * 768 + 64 + 16 * (fq >> 1) + 4 * (fq & 1);
                        const u32x2 w0 = pk4(o[0]), w1 = pk4(o[1]);
#pragma unroll
                        for (int h = 0; h < 8; ++h) { *(u32x2*)(dst + h * 96) = w0; *(u32x2*)(dst + h * 96 + 8) = w1; }
                    }
                }
        } else if (pn < 8) {
#pragma unroll
            for (int ai = 0; ai < 2; ++ai)
#pragma unroll
                for (int m = 0; m < 4; ++m) {
                    const size_t row = (size_t)u.pm * 256 + 128 * ai + 64 * wr + 16 * m + fr;
#pragma unroll
                    for (int bj = 0; bj < 2; ++bj)
#pragma unroll
                        for (int n = 0; n < 2; ++n) *(u32x2*)(PF + row * 512 + (pn - 6) * 256 + 128 * bj + 32 * wc + 16 * n + 4 * fq) = pk4(acc[ai][bj][m][n]);
                }
        } else {
            const int c0 = (pn - 8) * 256 + 32 * wc + 4 * fq;
            f32x4 bv[2][2];
#pragma unroll
            for (int bj = 0; bj < 2; ++bj)
#pragma unroll
                for (int n = 0; n < 2; ++n) bv[bj][n] = *(const f32x4*)(bgate + c0 + 128 * bj + 16 * n);
#pragma unroll
            for (int ai = 0; ai < 2; ++ai)
#pragma unroll
                for (int m = 0; m < 4; ++m) {
                    const size_t row = (size_t)u.pm * 256 + 128 * ai + 64 * wr + 16 * m + fr;
#pragma unroll
                    for (int bj = 0; bj < 2; ++bj)
#pragma unroll
                        for (int n = 0; n < 2; ++n) { f32x4 x = acc[ai][bj][m][n] + bv[bj][n];
                            x[0] = sigmoidf_(x[0]); x[1] = sigmoidf_(x[1]); x[2] = sigmoidf_(x[2]); x[3] = sigmoidf_(x[3]);
                            *(u32x2*)(G + row * 3072 + c0 + 128 * bj + 16 * n) = pk4(x); }
                }
        }
        return false;
    }
};

struct EpiUq {
    bf16 *QBN, *QBR; const float *stat_cq, *gqn, *gqr, *ropeB;
    __device__ __forceinline__ bool operator()(Acc& acc, const Unit& u, int wr, int wc, int fr_, int fq_) const {
        int fr = fr_, fq = fq_; asm volatile("" : "+v"(fr), "+v"(fq));
        const RowInfo ri = row_info(u.pm); const bool rope = !ri.ctx;
        f32x4 g[2][2];
#pragma unroll
        for (int bj = 0; bj < 2; ++bj)
#pragma unroll
            for (int n = 0; n < 2; ++n) g[bj][n] = *(const f32x4*)(gqn + 32 * bj + 16 * n + 4 * fq);
#pragma unroll
        for (int ai = 0; ai < 2; ++ai)
#pragma unroll
            for (int m = 0; m < 4; ++m) {
                const int rt = 128 * ai + 64 * wr + 16 * m + fr; const size_t row = (size_t)u.pm * 256 + rt;
                const f32x4 s0 = *(const f32x4*)(stat_cq + row * 8), s1 = *(const f32x4*)(stat_cq + row * 8 + 4);
                const float rs = rsqrtf(((s0[0] + s0[1]) + (s0[2] + s0[3]) + (s1[0] + s1[1]) + (s1[2] + s1[3])) * (1.0f / 384.0f) + EPS);
                if (u.pn < 2) {
                    f32x4 a[2][2], o[2][2];
#pragma unroll
                    for (int bj = 0; bj < 2; ++bj)
#pragma unroll
                        for (int n = 0; n < 2; ++n) a[bj][n] = acc[ai][bj][m][n] * rs;
                    head64<true>(a, g, C2B, false, 0, 0, ropeB, fq, o);
                    bf16* dst = QBN + row * 512 + (4 * u.pn + wc) * 64;
#pragma unroll
                    for (int bj = 0; bj < 2; ++bj)
#pragma unroll
                        for (int n = 0; n < 2; ++n) *(u32x2*)(dst + 32 * bj + 16 * n + 4 * fq) = pk4(o[bj][n]);
                } else {
                    const int row_id = (ri.tok0 + 128 * ai + 64 * wr) >> 6, col_id = 16 * m + fr;
#pragma unroll
                    for (int bj = 0; bj < 2; ++bj) {
                        f32x4 a[2], o[2]; a[0] = acc[ai][bj][m][0] * rs; a[1] = acc[ai][bj][m][1] * rs;
                        rope32(a, gqr, C2B, rope, row_id, col_id, ropeB, fq, o);
                        bf16* dst = QBR + row * 256 + (4 * bj + wc) * 32 + 16 * (fq >> 1) + 4 * (fq & 1);
                        *(u32x2*)(dst) = pk4(o[0]); *(u32x2*)(dst + 8) = pk4(o[1]);
                    }
                }
            }
        return false;
    }
};

struct EpiUkv {
    bf16 *KB, *VB; const float *stat_ckv, *gkn;
    __device__ __forceinline__ bool operator()(Acc& acc, const Unit& u, int wr, int wc, int fr_, int fq_) const {
        int fr = fr_, fq = fq_; asm volatile("" : "+v"(fr), "+v"(fq));
        const RowInfo ri = row_info(u.pm);
        f32x4 g[2][2];
#pragma unroll
        for (int bj = 0; bj < 2; ++bj)
#pragma unroll
            for (int n = 0; n < 2; ++n) g[bj][n] = *(const f32x4*)(gkn + 32 * bj + 16 * n + 4 * fq);
#pragma unroll
        for (int ai = 0; ai < 2; ++ai)
#pragma unroll
            for (int m = 0; m < 4; ++m) {
                const int rt = 128 * ai + 64 * wr + 16 * m + fr; const size_t row = (size_t)u.pm * 256 + rt;
                const f32x4 s0 = *(const f32x4*)(stat_ckv + row * 4);
                const float rs = rsqrtf(((s0[0] + s0[1]) + (s0[2] + s0[3])) * (1.0f / 256.0f) + EPS);
                const size_t key = (size_t)ri.b * NKEY + (ri.ctx ? rt : 256 + ri.tok0 + rt);
                f32x4 a[2][2], o[2][2];
#pragma unroll
                for (int bj = 0; bj < 2; ++bj)
#pragma unroll
                    for (int n = 0; n < 2; ++n) a[bj][n] = acc[ai][bj][m][n] * rs;
                bf16* dst;
                if (u.pn < 2) { head64<true>(a, g, 1.0f, false, 0, 0, gkn, fq, o); dst = KB + key * 768 + (4 * u.pn + wc) * 96; }
                else { head64<false>(a, g, 1.0f, false, 0, 0, gkn, fq, o); dst = VB + key * 512 + (4 * (u.pn - 2) + wc) * 64; }
#pragma unroll
                for (int bj = 0; bj < 2; ++bj)
#pragma unroll
                    for (int n = 0; n < 2; ++n) *(u32x2*)(dst + 32 * bj + 16 * n + 4 * fq) = pk4(o[bj][n]);
            }
        return false;
    }
};

struct EpiStore {
    bf16* O; int ld;
    __device__ __forceinline__ bool operator()(Acc& acc, const Unit& u, int wr, int wc, int fr_, int fq_) const {
        int fr = fr_, fq = fq_; asm volatile("" : "+v"(fr), "+v"(fq));
#pragma unroll
        for (int ai = 0; ai < 2; ++ai)
#pragma unroll
            for (int m = 0; m < 4; ++m) {
                const size_t row = (size_t)u.pm * 256 + 128 * ai + 64 * wr + 16 * m + fr;
#pragma unroll
                for (int bj = 0; bj < 2; ++bj)
#pragma unroll
                    for (int n = 0; n < 2; ++n) *(u32x2*)(O + row * ld + u.pn * 256 + 128 * bj + 32 * wc + 16 * n + 4 * fq) = pk4(acc[ai][bj][m][n]);
            }
        return false;
    }
};

struct EpiF1 {
    bf16* ZT; int NP;
    __device__ __forceinline__ bool operator()(Acc& acc, const Unit& u, int wr, int wc, int fr_, int fq_) const {
        int fr = fr_, fq = fq_; asm volatile("" : "+v"(fr), "+v"(fq));
        const int b = u.pm >> 2, gch = u.pm & 3;
#pragma unroll
        for (int ai = 0; ai < 2; ++ai)
#pragma unroll
            for (int m = 0; m < 4; ++m) {
                const int ch = gch * 128 + 64 * wr + 16 * m + fr;
                bf16* dst = ZT + ((size_t)b * 512 + ch) * (2 * NP) + ai * NP + u.pn * 256;
#pragma unroll
                for (int bj = 0; bj < 2; ++bj)
#pragma unroll
                    for (int n = 0; n < 2; ++n) *(u32x2*)(dst + 128 * bj + 32 * wc + 16 * n + 4 * fq) = pk4(acc[ai][bj][m][n]);
            }
        return false;
    }
};

struct EpiMerge {
    const bf16* G; bf16* MB;
    __device__ __forceinline__ bool operator()(Acc& acc, const Unit& u, int wr, int wc, int fr_, int fq_) const {
        int fr = fr_, fq = fq_; asm volatile("" : "+v"(fr), "+v"(fq));
        const int kb = u.kb; const int c0 = u.pn * 256 + 32 * wc + 4 * fq;
#pragma unroll
        for (int ai = 0; ai < 2; ++ai)
#pragma unroll
            for (int m = 0; m < 4; ++m) {
                const size_t row = (size_t)u.pm * 256 + 128 * ai + 64 * wr + 16 * m + fr;
                const bf16* gp = G + row * 3072 + c0;
#pragma unroll
                for (int bj = 0; bj < 2; ++bj)
#pragma unroll
                    for (int n = 0; n < 2; ++n) {
                        const int co = 128 * bj + 16 * n;
                        if (kb < 2) { const f32x4 ga = unpk4(*(const u32x2*)(gp + kb * 1024 + co)), gb = unpk4(*(const u32x2*)(gp + (kb + 1) * 1024 + co));
                            f32x4 r; r[0] = ga[0] / gb[0]; r[1] = ga[1] / gb[1]; r[2] = ga[2] / gb[2]; r[3] = ga[3] / gb[3]; acc[ai][bj][m][n] *= r; }
                        else { const f32x4 gc = unpk4(*(const u32x2*)(gp + 2048 + co)); *(u32x2*)(MB + row * 1024 + c0 + co) = pk4(acc[ai][bj][m][n] * gc); }
                    }
            }
        return kb < 2;
    }
};

struct EpiRes {
    const float *xin_lat, *xin_ctx; float *xout_lat, *xout_ctx; const float* gate;
    __device__ __forceinline__ bool operator()(Acc& acc, const Unit& u, int wr, int wc, int fr_, int fq_) const {
        int fr = fr_, fq = fq_; asm volatile("" : "+v"(fr), "+v"(fq));
        const RowInfo ri = row_info(u.pm); const int s = ri.ctx ? 8 : ri.b;
        const int c0 = u.pn * 256 + 32 * wc + 4 * fq;
        const float* xin = ri.ctx ? xin_ctx + (size_t)(u.pm - 64) * 256 * 1024 : xin_lat + (size_t)u.pm * 256 * 1024;
        float* xout = ri.ctx ? xout_ctx + (size_t)(u.pm - 64) * 256 * 1024 : xout_lat + (size_t)u.pm * 256 * 1024;
        f32x4 gv[2][2];
#pragma unroll
        for (int bj = 0; bj < 2; ++bj)
#pragma unroll
            for (int n = 0; n < 2; ++n) gv[bj][n] = *(const f32x4*)(gate + s * 6144 + c0 + 128 * bj + 16 * n);
#pragma unroll
        for (int ai = 0; ai < 2; ++ai)
#pragma unroll
            for (int m = 0; m < 4; ++m) {
                const size_t off = (size_t)(128 * ai + 64 * wr + 16 * m + fr) * 1024 + c0;
#pragma unroll
                for (int bj = 0; bj < 2; ++bj)
#pragma unroll
                    for (int n = 0; n < 2; ++n) { const f32x4 xi = *(const f32x4*)(xin + off + 128 * bj + 16 * n); *(f32x4*)(xout + off + 128 * bj + 16 * n) = xi + gv[bj][n] * acc[ai][bj][m][n]; }
                asm volatile("" ::: "memory");
            }
        return false;
    }
};

struct EpiSwiglu {
    bf16* ACT;
    __device__ __forceinline__ bool operator()(Acc& acc, const Unit& u, int wr, int wc, int fr_, int fq_) const {
        int fr = fr_, fq = fq_; asm volatile("" : "+v"(fr), "+v"(fq));
#pragma unroll
        for (int ai = 0; ai < 2; ++ai)
#pragma unroll
            for (int m = 0; m < 4; ++m) {
                const size_t row = (size_t)u.pm * 256 + 128 * ai + 64 * wr + 16 * m + fr;
#pragma unroll
                for (int n = 0; n < 2; ++n) { const f32x4 gt = acc[ai][0][m][n], up = acc[ai][1][m][n]; f32x4 o;
                    o[0] = gt[0] * sigmoidf_(gt[0]) * up[0]; o[1] = gt[1] * sigmoidf_(gt[1]) * up[1]; o[2] = gt[2] * sigmoidf_(gt[2]) * up[2]; o[3] = gt[3] * sigmoidf_(gt[3]) * up[3];
                    *(u32x2*)(ACT + row * FFH + u.pn * 128 + 32 * wc + 16 * n + 4 * fq) = pk4(o); }
            }
        return false;
    }
};

namespace att {
constexpr int KSLOT = 12288, VSLOT = 8192;
constexpr int L_K = 0, L_V = 2 * KSLOT, L_WS = L_V + 2 * VSLOT, L_OST = L_WS + NWAVES * 64 * 4, L_BYTES = L_OST + NWAVES * 4096;
__device__ __forceinline__ int crow(int r, int hi) { return (r & 3) + 8 * (r >> 2) + 4 * hi; }
__device__ __forceinline__ float max3f(float a, float b, float c) { return __builtin_fmaxf(__builtin_fmaxf(a, b), c); }
__device__ __forceinline__ float rowmax(const f32x16& p0, const f32x16& p1) {
    float a = max3f(p0[0], p0[1], p1[0]), b = max3f(p0[2], p0[3], p1[1]); a = max3f(a, p1[2], p1[3]);
#pragma unroll
    for (int r = 4; r < 16; r += 4) { a = max3f(a, p0[r], p0[r + 1]); b = max3f(b, p0[r + 2], p0[r + 3]); a = max3f(a, p1[r], p1[r + 1]); b = max3f(b, p1[r + 2], p1[r + 3]); }
    const float m = __builtin_fmaxf(a, b);
    auto rr = __builtin_amdgcn_permlane32_swap(__float_as_uint(m), __float_as_uint(m), false, false);
    return __builtin_fmaxf(__uint_as_float(rr[0]), __uint_as_float(rr[1]));
}
__device__ __forceinline__ void pv(f32x16* o, int vb, bf16x8 pa0, bf16x8 pa1, bf16x8 pa2, bf16x8 pa3) {
#pragma unroll
    for (int d0 = 0; d0 < 2; ++d0) { s16x4 lo[4], hi[4];
#pragma unroll
        for (int ks = 0; ks < 4; ++ks) {
            asm volatile("ds_read_b64_tr_b16 %0,%1 offset:%c2" : "=&v"(lo[ks]) : "v"(vb), "i"(d0 * 4096 + ks * 1024) : "memory");
            asm volatile("ds_read_b64_tr_b16 %0,%1 offset:%c2" : "=&v"(hi[ks]) : "v"(vb), "i"(d0 * 4096 + ks * 1024 + 512) : "memory"); }
        asm volatile("s_waitcnt lgkmcnt(0)" ::: "memory"); __builtin_amdgcn_sched_barrier(0);
#define PK(k) (bf16x8){lo[k][0], lo[k][1], lo[k][2], lo[k][3], hi[k][0], hi[k][1], hi[k][2], hi[k][3]}
        o[d0] = __builtin_amdgcn_mfma_f32_32x32x16_bf16(pa0, PK(0), o[d0], 0, 0, 0);
        o[d0] = __builtin_amdgcn_mfma_f32_32x32x16_bf16(pa1, PK(1), o[d0], 0, 0, 0);
        o[d0] = __builtin_amdgcn_mfma_f32_32x32x16_bf16(pa2, PK(2), o[d0], 0, 0, 0);
        o[d0] = __builtin_amdgcn_mfma_f32_32x32x16_bf16(pa3, PK(3), o[d0], 0, 0, 0);
#undef PK
    }
}
template <int DQK>
__device__ __forceinline__ void attn_unit(const bf16* Qn, int pqn, const bf16* Qr, int pqr, const bf16* Kh, int pk, const bf16* Vh, int pv_, bf16* O, int po, int NT, LAS unsigned char* shm) {
    constexpr int ND = DQK / 16, NCH = DQK / 8;
    int tid = threadIdx.x; asm volatile("" : "+v"(tid));
    const int lane = tid & 63, r32 = lane & 31, hi = lane >> 5; const int wid = __builtin_amdgcn_readfirstlane(tid >> 6);
    LAS float* wsf = (LAS float*)(shm + L_WS) + wid * 64;
    const bf16* ksrc = Kh + (size_t)lane * pk + wid * 8;
    const bf16* vsrc = Vh + (size_t)(16 * (wid & 3) + (lane >> 2)) * pv_ + (wid >> 2) * 32 + (lane & 3) * 8;
    const int vb0 = (int)(unsigned)(uintptr_t)(shm + L_V) + ((lane >> 4) & 1) * 32 + (lane & 3) * 8 + (4 * hi + ((lane & 15) >> 2)) * 64;
    const LAS unsigned char* kp0 = shm + L_K + hi * 1024 + r32 * 16;
#define DMA_TILE(t, buf) do { \
        __builtin_amdgcn_global_load_lds((const unsigned*)(ksrc + (size_t)(t) * 64 * pk), (LAS unsigned*)(shm + L_K + (buf) * KSLOT + wid * 1024), 16, 0, 0); \
        if (NCH > 8 && wid < NCH - 8) __builtin_amdgcn_global_load_lds((const unsigned*)(ksrc + (size_t)(t) * 64 * pk + 64), (LAS unsigned*)(shm + L_K + (buf) * KSLOT + (wid + 8) * 1024), 16, 0, 0); \
        __builtin_amdgcn_global_load_lds((const unsigned*)(vsrc + (size_t)(t) * 64 * pv_), (LAS unsigned*)(shm + L_V + (buf) * VSLOT + wid * 1024), 16, 0, 0); } while (0)
    DMA_TILE(0, 0);
    bf16x8 qr[ND];
#pragma unroll
    for (int d0 = 0; d0 < 4; ++d0) qr[d0] = *(const bf16x8*)(Qn + (size_t)(wid * 32 + r32) * pqn + d0 * 16 + hi * 8);
    if (ND > 4) {
#pragma unroll
        for (int d0 = 4; d0 < ND; ++d0) qr[d0] = *(const bf16x8*)(Qr + (size_t)(wid * 32 + r32) * pqr + (d0 - 4) * 16 + hi * 8);
    }
    float mrun = -1e30f, l_reg = 0.f; f32x16 o[2]; o[0] = f32x16{}; o[1] = f32x16{};
    for (int t = 0; t < NT; ++t) {
        const int buf = t & 1;
        asm volatile("s_waitcnt vmcnt(0)" ::: "memory");
        __syncthreads();
        if (t + 1 < NT) DMA_TILE(t + 1, buf ^ 1);
        f32x16 p0 = f32x16{}, p1 = f32x16{};
        const LAS unsigned char* kp = kp0 + buf * KSLOT;
#pragma unroll
        for (int d0 = 0; d0 < ND; ++d0) {
            const bf16x8 b0 = *(const LAS bf16x8*)(kp + d0 * 2048), b1 = *(const LAS bf16x8*)(kp + d0 * 2048 + 512);
            p0 = __builtin_amdgcn_mfma_f32_32x32x16_bf16(b0, qr[d0], p0, 0, 0, 0); p1 = __builtin_amdgcn_mfma_f32_32x32x16_bf16(b1, qr[d0], p1, 0, 0, 0);
        }
        const float rm = rowmax(p0, p1);
        if (__any(rm > mrun)) {
            const float mn = __builtin_fmaxf(mrun, rm), al = __builtin_amdgcn_exp2f(mrun - mn); mrun = mn; l_reg *= al;
            if (hi == 0) wsf[r32] = al;
            asm volatile("s_waitcnt lgkmcnt(0)" ::: "memory");
#pragma unroll
            for (int r = 0; r < 16; ++r) { const float f = wsf[crow(r, hi)]; o[0][r] *= f; o[1][r] *= f; }
        }
        float sacc = 0.f;
#pragma unroll
        for (int r = 0; r < 16; ++r) { p0[r] = __builtin_amdgcn_exp2f(p0[r] - mrun); p1[r] = __builtin_amdgcn_exp2f(p1[r] - mrun); sacc += p0[r] + p1[r]; }
        l_reg += sacc;
        u32x4 w0, w1, w2, w3;
        w0 = (u32x4){cvtpk(p0[0], p0[1]), cvtpk(p0[2], p0[3]), cvtpk(p0[4], p0[5]), cvtpk(p0[6], p0[7])};
        w1 = (u32x4){cvtpk(p0[8], p0[9]), cvtpk(p0[10], p0[11]), cvtpk(p0[12], p0[13]), cvtpk(p0[14], p0[15])};
        w2 = (u32x4){cvtpk(p1[0], p1[1]), cvtpk(p1[2], p1[3]), cvtpk(p1[4], p1[5]), cvtpk(p1[6], p1[7])};
        w3 = (u32x4){cvtpk(p1[8], p1[9]), cvtpk(p1[10], p1[11]), cvtpk(p1[12], p1[13]), cvtpk(p1[14], p1[15])};
        pv(o, vb0 + buf * VSLOT, __builtin_bit_cast(bf16x8, w0), __builtin_bit_cast(bf16x8, w1), __builtin_bit_cast(bf16x8, w2), __builtin_bit_cast(bf16x8, w3));
    }
#undef DMA_TILE
    { auto rr = __builtin_amdgcn_permlane32_swap(__float_as_uint(l_reg), __float_as_uint(l_reg), false, false); l_reg = __uint_as_float(rr[0]) + __uint_as_float(rr[1]); }
    if (hi == 0) wsf[32 + r32] = l_reg;
    asm volatile("s_waitcnt lgkmcnt(0)" ::: "memory");
    float rli[16];
#pragma unroll
    for (int r = 0; r < 16; ++r) rli[r] = __builtin_amdgcn_rcpf(wsf[32 + crow(r, hi)]);
    LAS bf16* stg = (LAS bf16*)(shm + L_OST) + wid * 2048;
#pragma unroll
    for (int r = 0; r < 16; ++r) { const int orow = crow(r, hi);
#pragma unroll
        for (int d0 = 0; d0 < 2; ++d0) stg[orow * 64 + d0 * 32 + r32] = (bf16)(cvtpk(o[d0][r] * rli[r], 0.f) & 0xffffu); }
    asm volatile("s_waitcnt lgkmcnt(0)" ::: "memory");
    bf16* Ow = O + (size_t)(wid * 32) * po;
#pragma unroll
    for (int i = 0; i < 4; ++i) { const int row = i * 8 + (lane >> 3), ch = lane & 7; const u32x4 v = *(const LAS u32x4*)(stg + row * 64 + ch * 8); *(u32x4*)(Ow + (size_t)row * po + ch * 8) = v; }
    asm volatile("s_waitcnt lgkmcnt(0)" ::: "memory");
    __syncthreads();
}
}

struct Args { const float* in[26]; float* out; unsigned char* ws; int ph_lo, ph_hi; };
constexpr int LDS_BYTES = 147456;
constexpr int NPHASE = 21;

typedef const __attribute__((address_space(4))) unsigned char* KP;
__device__ __forceinline__ const float* kin(KP kp, int k) { return *(const float* const __attribute__((address_space(4)))*)(kp + 8 * k); }
__device__ __forceinline__ float* kout(KP kp) { return *(float* const __attribute__((address_space(4)))*)(kp + 208); }
__device__ __forceinline__ unsigned char* kws(KP kp) { return *(unsigned char* const __attribute__((address_space(4)))*)(kp + 216); }
static_assert(sizeof(Args) == 232, "Args layout");
struct Ctx {
    LAS unsigned char* lds; int tid, lane, wave, vcu, G; unsigned char* ws;
};

enum MatId { M_WIN = 0, M_WUQ, M_WUKV, M_NAT, M_FFI };
__device__ __forceinline__ int rope_perm(int p) { const int n = p >> 4, fq = (p >> 2) & 3, j = p & 3; return 16 * (fq >> 1) + 8 * n + 4 * (fq & 1) + j; }
__device__ __forceinline__ int head_perm(int pc, int& wc) { wc = (pc >> 5) & 3; return 32 * (pc >> 7) + (pc & 31); }
__device__ __forceinline__ int src_col(int mat, int n) {
    const int t = n >> 8, pc = n & 255; int wc;
    switch (mat) {
    case M_WIN:
        if (t < 2) { const int d = head_perm(pc, wc); return (4 * t + wc) * 64 + d; }
        if (t == 2) { const int d = head_perm(pc, wc); return wc < 2 ? 512 + wc * 64 + d : 640 + (wc - 2) * 64 + d; }
        if (t == 3) return 768 + pc;
        if (t == 4) { if (pc < 128) return 768 + 256 + pc; if (pc < 160) return 1408 + rope_perm(pc - 128); return -1; }
        if (t == 5) return 1152 + pc;
        if (t < 8) return 1440 + (t - 6) * 256 + pc;
        return 1952 + (t - 8) * 256 + pc;
    case M_WUQ:
        if (t < 2) { const int d = head_perm(pc, wc); return (4 * t + wc) * 96 + d; }
        { const int bj = pc >> 7, w2 = (pc >> 5) & 3; return (4 * bj + w2) * 96 + 64 + rope_perm(pc & 31); }
    case M_WUKV:
        { const int d = head_perm(pc, wc); return t < 2 ? (4 * t + wc) * 128 + d : (4 * (t - 2) + wc) * 128 + 64 + d; }
    case M_FFI:
        return pc < 128 ? t * 128 + pc : FFH + t * 128 + (pc - 128);
    default: return n;
    }
}
__device__ __forceinline__ void xpose_item(const float* W, int ldw, const float* kscale, bf16* WT, int ldo, int kcol0, int mat, int nblk, int item, LAS float* scr, int lane) {
    const int kb = item / nblk, nb = item % nblk, k0 = 64 * kb, n0 = 32 * nb;
    const int sc = src_col(mat, n0 + (lane & 31));
#pragma unroll 8
    for (int i = 0; i < 32; ++i) { const int kk = 2 * i + (lane >> 5); float v = 0.f; if (sc >= 0) { v = W[(size_t)(k0 + kk) * ldw + sc]; if (kscale) v *= kscale[k0 + kk]; } scr[kk * 33 + (lane & 31)] = v; }
    asm volatile("s_waitcnt lgkmcnt(0)" ::: "memory");
    const int c = lane & 7;
#pragma unroll
    for (int j = 0; j < 4; ++j) { const int n = (lane >> 3) + 8 * j; const LAS float* s = scr + (8 * c) * 33 + n;
        u32x4 o; o.x = cvtpk(s[0 * 33], s[1 * 33]); o.y = cvtpk(s[2 * 33], s[3 * 33]); o.z = cvtpk(s[4 * 33], s[5 * 33]); o.w = cvtpk(s[6 * 33], s[7 * 33]);
        *(u32x4*)(WT + (size_t)(n0 + n) * ldo + kcol0 + k0 + 8 * c) = o; }
    asm volatile("s_waitcnt lgkmcnt(0)" ::: "memory");
}
__device__ __forceinline__ void run_xjob(const Ctx& F, int& base, const float* W, int ldw, const float* kscale, bf16* WT, int ldo, int kcol0, int mat, int K, int N) {
    LAS float* scr = (LAS float*)(F.lds + F.wave * 16384);
    const int gw = F.vcu * NWAVES + F.wave, NGW = F.G * NWAVES;
    const int nblk = N / 32, nit = (K / 64) * nblk;
    int first = gw - (base % NGW); if (first < 0) first += NGW;
    for (int it = first; it < nit; it += NGW) xpose_item(W, ldw, kscale, WT, ldo, kcol0, mat, nblk, it, scr, F.lane);
    base += nit;
}

__device__ __forceinline__ void norm_pass(const Ctx& F, const float* x_lat, const float* x_ctx, bf16* HB, const float* gnorm, const float* mod_l, int shift_off, int nrows) {
    const int gw = F.vcu * NWAVES + F.wave, NGW = F.G * NWAVES;
    const int per = (nrows + NGW - 1) / NGW; const int r0 = gw * per, r1 = min(nrows, r0 + per);
    int cur_s = -1; f32x4 ca[4], cb[4];
    for (int r = r0; r < r1; ++r) {
        const bool ctx = r >= ML; const int s = ctx ? 8 : r >> 11;
        if (s != cur_s) { cur_s = s; const float* sh = mod_l + s * 6144 + shift_off; const float* scl = sh + 1024;
#pragma unroll
            for (int j = 0; j < 4; ++j) { const f32x4 g = *(const f32x4*)(gnorm + 256 * j + 4 * F.lane); const f32x4 sc1 = *(const f32x4*)(scl + 256 * j + 4 * F.lane); ca[j] = g * (sc1 + 1.0f); cb[j] = *(const f32x4*)(sh + 256 * j + 4 * F.lane); } }
        const float* xr = ctx ? x_ctx + (size_t)(r - ML) * 1024 : x_lat + (size_t)r * 1024;
        f32x4 v[4]; float ss = 0.f;
#pragma unroll
        for (int j = 0; j < 4; ++j) { v[j] = *(const f32x4*)(xr + 256 * j + 4 * F.lane); ss += (v[j][0] * v[j][0] + v[j][1] * v[j][1]) + (v[j][2] * v[j][2] + v[j][3] * v[j][3]); }
        const float rstd = rsqrtf(wave_sum(ss) * (1.0f / 1024.0f) + EPS);
#pragma unroll
        for (int j = 0; j < 4; ++j) *(u32x2*)(HB + (size_t)r * 1024 + 256 * j + 4 * F.lane) = pk4(v[j] * rstd * ca[j] + cb[j]);
    }
}

__device__ __forceinline__ void mod_items(const Ctx& F, KP kp) {
    const float* c = kin(kp, 1); const float* cc = kin(kp, 3); const float* wmod = kin(kp, 4); const float* bmod = kin(kp, 5);
    float* mod = (float*)(F.ws + O_MOD);
    LAS float* sl = (LAS float*)F.lds;
    LAS float* red = sl + 9 * 1024;
    for (int it = F.vcu; it < 192; it += F.G) {
        const int l = it / 96, n0 = (it % 96) * 64;
        __syncthreads();
        for (int i = F.tid; i < 9 * 1024; i += NTHR) { const float v = (i < 8192) ? c[i] : cc[i - 8192]; sl[i] = v * sigmoidf_(v); }
        __syncthreads();
        float acc[9];
#pragma unroll
        for (int s = 0; s < 9; ++s) acc[s] = 0.f;
        const float* wp = wmod + (size_t)l * 1024 * 6144 + n0 + F.lane;
        for (int k = F.wave * 128; k < F.wave * 128 + 128; ++k) { const float w = wp[(size_t)k * 6144];
#pragma unroll
            for (int s = 0; s < 9; ++s) acc[s] += sl[s * 1024 + k] * w; }
#pragma unroll
        for (int s = 0; s < 9; ++s) red[(F.wave * 9 + s) * 64 + F.lane] = acc[s];
        __syncthreads();
        for (int i = F.tid; i < 9 * 64; i += NTHR) { float t = 0.f;
#pragma unroll
            for (int w = 0; w < 8; ++w) t += red[w * 576 + i];
            const int s = i / 64, n = n0 + (i & 63); mod[(l * 9 + s) * 6144 + n] = t + bmod[l * 6144 + n]; }
    }
    __syncthreads();
}
__device__ __forceinline__ void table_items(const Ctx& F) {
    const int gt = (F.vcu * NTHR) + F.tid, NT_ = F.G * NTHR;
    float* ra = (float*)(F.ws + O_ROPEA); float* rb = (float*)(F.ws + O_ROPEB);
    for (int i = gt; i < 1024; i += NT_) { const int pos = i >> 4, f = i & 15; const float fr = powf(10000.0f, -(float)(2 * f) / 32.0f); const float ang = (float)pos * fr; ra[i] = cosf(ang); ra[1024 + i] = sinf(ang); }
    for (int i = gt; i < 512; i += NT_) { const int pos = i >> 3, f = i & 7; const float fr = powf(10000.0f, -(float)(2 * f) / 16.0f); const float ang = (float)pos * fr; rb[i] = cosf(ang); rb[512 + i] = sinf(ang); }
    bf16* DN = (bf16*)(F.ws + O_DN); bf16* DN2 = (bf16*)(F.ws + O_DN256); bf16* DC = (bf16*)(F.ws + O_DFTC);
    { const float sc = 0.022097086912079608f;
      for (int i = gt; i < 2048 * 2048 / 2; i += NT_) { const int n = i >> 10, k = (i & 1023) * 2; float s0, c0, s1, c1;
          sincospif((float)((n * k) & 2047) * (1.0f / 1024.0f), &s0, &c0); sincospif((float)((n * (k + 1)) & 2047) * (1.0f / 1024.0f), &s1, &c1);
          *(unsigned*)(DN + (size_t)n * 4096 + k) = cvtpk(c0 * sc, c1 * sc); *(unsigned*)(DN + (size_t)n * 4096 + 2048 + k) = cvtpk(-s0 * sc, -s1 * sc); } }
    { const float sc = 0.0625f;
      for (int i = gt; i < 256 * 256; i += NT_) { const int n = i >> 8, k = i & 255; float s0, c0; sincospif((float)((n * k) & 255) * (1.0f / 128.0f), &s0, &c0);
          DN2[n * 512 + k] = (bf16)(cvtpk(c0 * sc, 0.f) & 0xffff); DN2[n * 512 + 256 + k] = (bf16)(cvtpk(-s0 * sc, 0.f) & 0xffff); } }
    { const float sc = 0.08838834764831845f;
      for (int i = gt; i < 256 * 128; i += NT_) { const int r = i >> 7, k = i & 127; float s0, c0; sincospif((float)(((r & 127) * k) & 127) * (1.0f / 64.0f), &s0, &c0);
          DC[i] = (bf16)(cvtpk((r < 128 ? c0 : s0) * sc, 0.f) & 0xffff); } }
}
__device__ __forceinline__ void convert_weights_main(const Ctx& F, KP kp, int l) {
    int base = 0;
    run_xjob(F, base, kin(kp, 8) + (size_t)l * 1024 * INW, INW, nullptr, (bf16*)(F.ws + O_WIN), 1024, 0, M_WIN, 1024, NINP);
    run_xjob(F, base, kin(kp, 13) + (size_t)l * 384 * 768, 768, kin(kp, 11) + l * 384, (bf16*)(F.ws + O_WUQ), 384, 0, M_WUQ, 384, 768);
    run_xjob(F, base, kin(kp, 14) + (size_t)l * 256 * 1024, 1024, kin(kp, 12) + l * 256, (bf16*)(F.ws + O_WUKV), 256, 0, M_WUKV, 256, 1024);
    run_xjob(F, base, kin(kp, 20) + (size_t)l * 512 * 1024, 1024, nullptr, (bf16*)(F.ws + O_WBR), 1536, 0, M_NAT, 512, 1024);
    run_xjob(F, base, kin(kp, 21) + (size_t)l * 512 * 1024, 1024, nullptr, (bf16*)(F.ws + O_WBR), 1536, 512, M_NAT, 512, 1024);
    run_xjob(F, base, kin(kp, 22) + (size_t)l * 512 * 1024, 1024, nullptr, (bf16*)(F.ws + O_WBR), 1536, 1024, M_NAT, 512, 1024);
    run_xjob(F, base, kin(kp, 23) + (size_t)l * 1024 * 1024, 1024, nullptr, (bf16*)(F.ws + O_WOUT), 1024, 0, M_NAT, 1024, 1024);
}
__device__ __forceinline__ void convert_weights_ffn(const Ctx& F, KP kp, int l) {
    int base = 0;
    run_xjob(F, base, kin(kp, 24) + (size_t)l * 1024 * 2 * FFH, 2 * FFH, nullptr, (bf16*)(F.ws + O_WFI), 1024, 0, M_FFI, 1024, 2 * FFH);
    run_xjob(F, base, kin(kp, 25) + (size_t)l * FFH * 1024, 1024, nullptr, (bf16*)(F.ws + O_WFO), FFH, 0, M_NAT, FFH, 1024);
}

struct F1Sched {
    int nb_tok, G, c, row0, rows_per_b, nunits; const char* A; const char* PF;
    __device__ __forceinline__ bool next(int i, Unit& u) const {
        const long L = (long)i * G + c; if (L >= nunits) return false;
        const int j = (int)L % nb_tok, bg = (int)L / nb_tok, gch = bg & 3, b = bg >> 2;
        u.pm = b * 4 + gch; u.pn = j; u.kb = 0; u.A = A; u.B = PF + ((size_t)(row0 + b * rows_per_b + j * 256) * 512 + gch * 128) * 2; return true;
    }
};
struct F2Sched {
    int nM, G, c, row0, rows_per_b, nunits; const char* DN; const char* ZT; size_t K2;
    __device__ __forceinline__ bool next(int i, Unit& u) const {
        const long L = (long)i * G + c; if (L >= nunits) return false;
        const int pn = (int)L & 1, r = (int)L >> 1, pm = r % nM, b = r / nM;
        u.pm = (row0 + b * rows_per_b) / 256 + pm; u.pn = pn; u.kb = 0;
        u.A = DN + (size_t)pm * 256 * K2 * 2; u.B = ZT + ((size_t)b * 512 + pn * 256) * K2 * 2; return true;
    }
};

#ifndef DIAG_SUB
#define DIAG_SUB -1
#endif
#define SUB_ON(k) (DIAG_SUB < 0 || DIAG_SUB == (k))
#ifndef DIAG_PART
#define DIAG_PART 0xffff
#endif
#define PART_ON(b) ((DIAG_PART & (b)) != 0)
__global__ void __launch_bounds__(NTHR, 2) fwd_kernel(Args args) {
    extern __shared__ __attribute__((aligned(16))) unsigned char lds_raw[];
    const int c = (int)blockIdx.x, G = (int)gridDim.x;
#if !MK_MULTI
    cg::grid_group grid = cg::this_grid();
#define GRID_SYNC() grid.sync()
#else
#define GRID_SYNC() do {} while (0)
#endif
    for (int ph = args.ph_lo; ph < args.ph_hi; ++ph) {
        KP kp = (KP)__builtin_amdgcn_kernarg_segment_ptr(); asm volatile("" : "+s"(kp));
        int tid_ = threadIdx.x; asm volatile("" : "+v"(tid_));
        Ctx F; F.lds = (LAS unsigned char*)lds_raw; F.tid = tid_; F.lane = tid_ & 63; F.wave = __builtin_amdgcn_readfirstlane(tid_ >> 6);
        F.G = G; F.vcu = (G % 8 == 0) ? (c % 8) * (G / 8) + c / 8 : c;
        unsigned char* ws = kws(kp); F.ws = ws; float* const outp = kout(kp);
        const float* mod = (const float*)(ws + O_MOD);
        const float* ropeA = (const float*)(ws + O_ROPEA); const float* ropeB = (const float*)(ws + O_ROPEB);
        float* stat_cq = (float*)(ws + O_STATCQ); float* stat_ckv = (float*)(ws + O_STATCKV);
        bf16* HB = (bf16*)(ws + O_HB); bf16* PF = (bf16*)(ws + O_PF); bf16* QA = (bf16*)(ws + O_QA); bf16* QBN = (bf16*)(ws + O_QBN); bf16* QBR = (bf16*)(ws + O_QBR);
        bf16* CQ = (bf16*)(ws + O_CQ); bf16* CKV = (bf16*)(ws + O_CKV); bf16* KA = (bf16*)(ws + O_KA); bf16* VA = (bf16*)(ws + O_VA); bf16* KB = (bf16*)(ws + O_KB); bf16* VB = (bf16*)(ws + O_VB);
        bf16* GT = (bf16*)(ws + O_G); bf16* ACT = (bf16*)(ws + O_G); bf16* MB = HB; bf16* YC = PF;
        float* XC = (float*)(ws + O_XC);
        if (ph == 0) { if (SUB_ON(10))
            { mod_items(F, kp); table_items(F); convert_weights_main(F, kp, 0); }
        } else {
            const int l = (ph - 1) / 10, sub = (ph - 1) % 10;
            const bool L1 = (l == 1);
            const int nMt = L1 ? 64 : 72;
            const float* xin_lat = L1 ? outp : kin(kp, 0); const float* xin_ctx = L1 ? XC : kin(kp, 2);
            const float* mod_l = mod + (size_t)l * 9 * 6144;
            bf16* ZT = L1 ? (bf16*)(ws + O_ZT1) : (bf16*)outp; bf16* ZTC = (bf16*)outp + (size_t)8 * 512 * 4096;
            switch (sub) {
            case 0: if (SUB_ON(0)) {
                if (L1) convert_weights_main(F, kp, 1);
                norm_pass(F, xin_lat, xin_ctx, HB, kin(kp, 6) + l * 1024, mod_l, 0, MT);
            } break;
            case 1: if (SUB_ON(1)) {
                EpiIn E{QA, KA, VA, CQ, CKV, KB, PF, GT, stat_cq, stat_ckv, kin(kp, 9) + l * 64, kin(kp, 10) + l * 64, kin(kp, 18) + l * 32, kin(kp, 19) + l * 3072, ropeA, ropeB};
                const Gemm g{1024, 1024, 1024};
                RectSched S{L1 ? 64 : 72, 8, 0, G, c, 1, ~0ull, (const char*)HB, 0, 0, (const char*)(ws + O_WIN), (size_t)256 * 1024 * 2, (size_t)256 * 1024 * 2, 0};
                pg8::gemm_phase(F.lds, g, S, E);
                if (L1) { RectSched S2{8, 3, 64, G, c, 1, 0x542ull, (const char*)HB, 0, 0, (const char*)(ws + O_WIN), (size_t)256 * 1024 * 2, (size_t)256 * 1024 * 2, 0};
                    pg8::gemm_phase(F.lds, g, S2, E); }
            } break;
            case 2: if (SUB_ON(2)) {
                if (PART_ON(1)) { EpiUq E{QBN, QBR, stat_cq, kin(kp, 15) + l * 64, kin(kp, 17) + l * 32, ropeB}; const Gemm g{384, 384, 384};
                  RectSched S{L1 ? 64 : 72, 3, 0, G, c, 1, ~0ull, (const char*)CQ, 0, 0, (const char*)(ws + O_WUQ), (size_t)256 * 384 * 2, (size_t)256 * 384 * 2, 0};
                  pg8::gemm_phase(F.lds, g, S, E); }
                if (PART_ON(2)) { EpiUkv E{KB, VB, stat_ckv, kin(kp, 16) + l * 64}; const Gemm g{256, 256, 256};
                  RectSched S{72, 4, 0, G, c, 1, ~0ull, (const char*)CKV, 0, 0, (const char*)(ws + O_WUKV), (size_t)256 * 256 * 2, (size_t)256 * 256 * 2, 0};
                  pg8::gemm_phase(F.lds, g, S, E); }
                if (PART_ON(4)) { EpiF1 E{ZT, 2048}; const Gemm g{128, 512, 128};
                  F1Sched S{8, G, c, 0, 2048, 256, (const char*)(ws + O_DFTC), (const char*)PF};
                  pg8::gemm_phase(F.lds, g, S, E); }
                if (PART_ON(8) && !L1) { EpiF1 E{ZTC, 256}; const Gemm g{128, 512, 128};
                  F1Sched S{1, G, c, ML, 256, 32, (const char*)(ws + O_DFTC), (const char*)PF};
                  pg8::gemm_phase(F.lds, g, S, E); }
            } break;
            case 3: if (SUB_ON(3)) {
                LAS unsigned char* shm = F.lds;
                for (int i = 0;; ++i) {
                    const int L = i * G + c; if (L >= 512) break; const int qb = L & 7, h = (L >> 3) & 7, b = L >> 6;
                    const size_t row0 = (size_t)b * SEQ + qb * 256; const size_t key0 = (size_t)b * NKEY;
                    att::attn_unit<64>(QA + row0 * 512 + h * 64, 512, nullptr, 0, KA + key0 * 128 + (h >> 2) * 64, 128, VA + key0 * 128 + (h >> 2) * 64, 128, QA + row0 * 512 + h * 64, 512, NKEY / 64, shm);
                }
                for (int i = 0;; ++i) {
                    const int L = i * G + c; if (L >= 512) break; const int qb = L & 7, h = (L >> 3) & 7, b = L >> 6;
                    const size_t row0 = (size_t)b * SEQ + qb * 256; const size_t key0 = (size_t)b * NKEY;
                    att::attn_unit<96>(QBN + row0 * 512 + h * 64, 512, QBR + row0 * 256 + h * 32, 256, KB + key0 * 768 + h * 96, 768, VB + key0 * 512 + h * 64, 512, QBN + row0 * 512 + h * 64, 512, NKEY / 64, shm);
                }
                if (!L1) {
                    for (int i = 0;; ++i) {
                        const int L = i * G + c; if (L >= 128) break; const int h = L & 7, b = (L >> 3) & 7; const bool mla = L >= 64;
                        const size_t row0 = (size_t)ML + b * CTX; const size_t key0 = (size_t)b * NKEY;
                        if (!mla) att::attn_unit<64>(QA + row0 * 512 + h * 64, 512, nullptr, 0, KA + key0 * 128 + (h >> 2) * 64, 128, VA + key0 * 128 + (h >> 2) * 64, 128, QA + row0 * 512 + h * 64, 512, CTX / 64, shm);
                        else att::attn_unit<96>(QBN + row0 * 512 + h * 64, 512, QBR + row0 * 256 + h * 32, 256, KB + key0 * 768 + h * 96, 768, VB + key0 * 512 + h * 64, 512, QBN + row0 * 512 + h * 64, 512, CTX / 64, shm);
                    }
                }
                { EpiStore E{YC, 512}; const Gemm g{4096, 4096, 4096};
                  F2Sched S{8, G, (c + 128) % G, 0, 2048, 128, (const char*)(ws + O_DN), (const char*)ZT, 4096};
                  pg8::gemm_phase(F.lds, g, S, E); }
                if (!L1) { EpiStore E{YC, 512}; const Gemm g{512, 512, 512};
                  F2Sched S{1, G, c, ML, 256, 16, (const char*)(ws + O_DN256), (const char*)ZTC, 512};
                  pg8::gemm_phase(F.lds, g, S, E); }
            } break;
            case 4: if (SUB_ON(4)) {
                EpiIn E{QA, KA, VA, CQ, CKV, KB, PF, GT, stat_cq, stat_ckv, kin(kp, 9) + l * 64, kin(kp, 10) + l * 64, kin(kp, 18) + l * 32, kin(kp, 19) + l * 3072, ropeA, ropeB};
                const Gemm g{1024, 1024, 1024};
                RectSched S{nMt, 12, 0, G, c, 1, ~0ull, (const char*)HB, 0, 0, (const char*)(ws + O_WIN) + (size_t)8 * 256 * 1024 * 2, (size_t)256 * 1024 * 2, (size_t)256 * 1024 * 2, 0};
                struct PnShift { RectSched s; __device__ __forceinline__ bool next(int i, Unit& u) const { if (!s.next(i, u)) return false; u.pn += 8; return true; } } S8{S};
                pg8::gemm_phase(F.lds, g, S8, E);
            } break;
            case 5: if (SUB_ON(5)) {
                EpiMerge E{GT, MB}; const Gemm g{512, 1536, 512};
                RectSched S{nMt, 4, 0, G, c, 3, ~0ull, (const char*)QA, (size_t)((const char*)QBN - (const char*)QA), (size_t)((const char*)YC - (const char*)QA), (const char*)(ws + O_WBR), (size_t)256 * 512 * 2, (size_t)256 * 1536 * 2, (size_t)512 * 2};
                pg8::gemm_phase(F.lds, g, S, E);
            } break;
            case 6: if (SUB_ON(6)) {
                EpiRes E{xin_lat, xin_ctx, outp, XC, mod_l + 2048}; const Gemm g{1024, 1024, 1024};
                RectSched S{nMt, 4, 0, G, c, 1, ~0ull, (const char*)MB, 0, 0, (const char*)(ws + O_WOUT), (size_t)256 * 1024 * 2, (size_t)256 * 1024 * 2, 0};
                pg8::gemm_phase(F.lds, g, S, E);
            } break;
            case 7: if (SUB_ON(7)) {
                convert_weights_ffn(F, kp, l);
                norm_pass(F, outp, XC, HB, kin(kp, 7) + l * 1024, mod_l, 3072, L1 ? ML : MT);
            } break;
            case 8: if (SUB_ON(8)) {
                EpiSwiglu E{ACT}; const Gemm g{1024, 1024, 1024};
                RectSched S{nMt, 22, 0, G, c, 1, ~0ull, (const char*)HB, 0, 0, (const char*)(ws + O_WFI), (size_t)256 * 1024 * 2, (size_t)256 * 1024 * 2, 0};
                pg8::gemm_phase(F.lds, g, S, E);
            } break;
            case 9: if (SUB_ON(9)) {
                EpiRes E{outp, XC, outp, XC, mod_l + 5120}; const Gemm g{FFH, FFH, FFH};
                RectSched S{nMt, 4, 0, G, c, 1, ~0ull, (const char*)ACT, 0, 0, (const char*)(ws + O_WFO), (size_t)256 * FFH * 2, (size_t)256 * FFH * 2, 0};
                pg8::gemm_phase(F.lds, g, S, E);
            } break;
            }
        }
        if (ph + 1 < args.ph_hi) { GRID_SYNC(); }
    }
}

extern "C" void kernel_launch(void* const* d_in, const int* in_sizes, int n_in, void* d_out, int out_size, void* d_ws, size_t ws_size, hipStream_t stream) {
    static int grid = 0;
    if (grid == 0) {
        if (n_in != 26 || out_size != ML * DM || ws_size < O_END) { fprintf(stderr, "kernel_launch: unexpected shapes (n_in %d out %d ws %zu)\n", n_in, out_size, ws_size); grid = -1; return; }
        int dev = 0, cus = 0, per_cu = 0;
        hipGetDevice(&dev); hipDeviceGetAttribute(&cus, hipDeviceAttributeMultiprocessorCount, dev);
        if (hipFuncSetAttribute((const void*)fwd_kernel, hipFuncAttributeMaxDynamicSharedMemorySize, LDS_BYTES) != hipSuccess) { fprintf(stderr, "kernel_launch: hipFuncSetAttribute failed\n"); grid = -1; return; }
        hipOccupancyMaxActiveBlocksPerMultiprocessor(&per_cu, (const void*)fwd_kernel, NTHR, LDS_BYTES);
        if (per_cu < 1) { fprintf(stderr, "kernel_launch: occupancy query says %d blocks/CU\n", per_cu); per_cu = 1; }
        (void)hipGetLastError();
        grid = cus;
        if (grid > 256) grid = 256;
    }
    if (grid < 0) return;
    Args a{};
    for (int i = 0; i < 26; ++i) a.in[i] = (const float*)d_in[i];
    a.out = (float*)d_out; a.ws = (unsigned char*)d_ws;
#if MK_MULTI
    for (int ph = 0; ph < NPHASE; ++ph) { a.ph_lo = ph; a.ph_hi = ph + 1; hipLaunchKernelGGL(fwd_kernel, dim3(grid), dim3(NTHR), LDS_BYTES, stream, a); }
#else
    a.ph_lo = 0; a.ph_hi = NPHASE;
    void* kargs[] = {&a};
    hipError_t e = hipLaunchCooperativeKernel((const void*)fwd_kernel, dim3(grid), dim3(NTHR), kargs, LDS_BYTES, stream);
    if (e != hipSuccess) fprintf(stderr, "cooperative launch failed: %s (grid %d)\n", hipGetErrorString(e), grid);
#endif
}
```

```cpp
#include <hip/hip_runtime.h>
#include <hip/hip_cooperative_groups.h>
#include <cstdint>
#include <cstdio>
namespace cg = cooperative_groups;

#ifndef MK_MULTI
#define MK_MULTI 0
#endif

#define LAS __attribute__((address_space(3)))
typedef unsigned short bf16;
typedef short bf16x8 __attribute__((ext_vector_type(8)));
typedef short s16x4 __attribute__((ext_vector_type(4)));
typedef float f32x2 __attribute__((ext_vector_type(2)));
typedef float f32x4 __attribute__((ext_vector_type(4)));
typedef float f32x16 __attribute__((ext_vector_type(16)));
typedef unsigned u32x2 __attribute__((ext_vector_type(2)));
typedef unsigned u32x4 __attribute__((ext_vector_type(4)));
typedef __bf16 bf16x2_t __attribute__((ext_vector_type(2)));

constexpr int DM = 1024, NB = 8, SEQ = 2048, CTX = 256, NKEY = CTX + SEQ;
constexpr int ML = NB * SEQ, MC = NB * CTX, MT = ML + MC;
constexpr int INW = 5024, NINP = 5120;
constexpr int FFH = 2816;
constexpr float EPS = 1e-6f;
constexpr float LOG2E = 1.4426950408889634f;
constexpr float C2A = 0.125f * LOG2E;
constexpr float C2B = 0.10206207261596577f * LOG2E;
constexpr int NWAVES = 8, NTHR = 512;

constexpr size_t MiB = 1u << 20, KiB = 1024;
constexpr size_t O_CTL = 0;
constexpr size_t O_MOD = 256 * KiB;
constexpr size_t O_ROPEA = 704 * KiB;
constexpr size_t O_ROPEB = 712 * KiB;
constexpr size_t O_STATCQ = 1 * MiB;
constexpr size_t O_STATCKV = O_STATCQ + (size_t)MT * 8 * 4;
constexpr size_t O_DN = 2 * MiB;
constexpr size_t O_DN256 = O_DN + 16 * MiB;
constexpr size_t O_DFTC = O_DN256 + 256 * KiB;
constexpr size_t O_W = O_DN + 16 * MiB + 512 * KiB;
constexpr size_t O_WIN = O_W;
constexpr size_t O_WUQ = O_WIN + (size_t)NINP * 1024 * 2;
constexpr size_t O_WUKV = O_WUQ + 768 * 384 * 2;
constexpr size_t O_WBR = O_WUKV + 1024 * 256 * 2;
constexpr size_t O_WOUT = O_WBR + 1024 * 1536 * 2;
constexpr size_t O_XC = O_W + 16 * MiB + 256 * KiB;
constexpr size_t O_HB = O_XC + 8 * MiB;
constexpr size_t O_PF = O_HB + 36 * MiB;
constexpr size_t O_QA = O_PF + 18 * MiB;
constexpr size_t O_QBN = O_QA + 18 * MiB;
constexpr size_t O_QBR = O_QBN + 18 * MiB;
constexpr size_t O_WFI = O_QA;
constexpr size_t O_WFO = O_WFI + (size_t)5632 * 1024 * 2;
constexpr size_t O_G = O_QBR + 9 * MiB;
constexpr size_t O_CQ = O_G;
constexpr size_t O_CKV = O_CQ + (size_t)MT * 384 * 2;
constexpr size_t O_KA = O_CKV + (size_t)MT * 256 * 2;
constexpr size_t O_VA = O_KA + (size_t)NB * NKEY * 128 * 2;
constexpr size_t O_KB = O_VA + (size_t)NB * NKEY * 128 * 2;
constexpr size_t O_VB = O_KB + (size_t)NB * NKEY * 768 * 2;
constexpr size_t O_ZT1 = O_VB + (size_t)NB * NKEY * 512 * 2;
constexpr size_t O_END = O_ZT1 + 32 * MiB;
static_assert(O_END <= 256 * MiB, "d_ws map exceeds 256 MiB");
static_assert(O_WOUT + 2 * MiB <= O_XC, "W region");
static_assert(O_WFO + (size_t)1024 * 2816 * 2 <= O_G, "ffn weights overlay");
static_assert(O_G + (size_t)MT * 3072 * 2 <= O_END, "gates overlay");
static_assert(O_DFTC + 64 * KiB <= O_W, "dft region");
static_assert(O_STATCKV + (size_t)MT * 4 * 4 <= O_DN, "stats region");

__device__ __forceinline__ unsigned cvtpk(float lo, float hi) { f32x2 v = {lo, hi}; bf16x2_t b = __builtin_convertvector(v, bf16x2_t); return __builtin_bit_cast(unsigned, b); }
__device__ __forceinline__ u32x2 pk4(f32x4 v) { u32x2 r; r.x = cvtpk(v[0], v[1]); r.y = cvtpk(v[2], v[3]); return r; }
__device__ __forceinline__ float bf2f(unsigned short h) { return __uint_as_float((unsigned)h << 16); }
__device__ __forceinline__ f32x4 unpk4(u32x2 w) { f32x4 r; r[0] = __uint_as_float(w.x << 16); r[1] = __uint_as_float(w.x & 0xffff0000u); r[2] = __uint_as_float(w.y << 16); r[3] = __uint_as_float(w.y & 0xffff0000u); return r; }
__device__ __forceinline__ float wave_sum(float v) {
#pragma unroll
    for (int o = 1; o < 64; o <<= 1) v += __shfl_xor(v, o);
    return v;
}
__device__ __forceinline__ float fq_sum(float v) { v += __shfl_xor(v, 16); v += __shfl_xor(v, 32); return v; }
__device__ __forceinline__ float sigmoidf_(float x) { return __builtin_amdgcn_rcpf(1.0f + __expf(-x)); }

namespace pg8 {
constexpr int BM = 256, BK = 64, HALF = 128, HTB = HALF * BK * 2, STAGE_BYTES = 8 * HTB, NXCD = 8, WGM = 8;
__host__ __device__ __forceinline__ int lds_byte(int r, int c) { const int st = (r >> 4) * 2 + (c >> 5), rr = r & 15, cc = c & 31, ob = rr * 64 + cc * 2; return st * 1024 + (ob ^ (((ob >> 9) & 1) << 5)); }
__host__ __device__ __forceinline__ void stage_rc(int b, int& R, int& C) { const int st = b / 1024, sb = b % 1024, swz = sb ^ (((sb >> 9) & 1) << 5); R = (st >> 1) * 16 + swz / 64; C = (st & 1) * 32 + (swz % 64) / 2; }

struct Unit { int pm, pn, kb; const char* A; const char* B; };
struct Gemm { int lda, ldb, K; };

__device__ __forceinline__ void tile_order(int L, int nM, int nN, int& pm, int& pn) {
    const int nwg = nM * nN; int wgid = L;
    { const int q = nwg / NXCD, r = nwg % NXCD, xcd = wgid % NXCD, off = wgid / NXCD; wgid = (xcd < r ? xcd * (q + 1) : r * (q + 1) + (xcd - r) * q) + off; }
    const int nig = WGM * nN, gid = wgid / nig, fm = gid * WGM, gsz = (nM - fm) < WGM ? (nM - fm) : WGM;
    pm = fm + ((wgid % nig) % gsz); pn = (wgid % nig) / gsz;
}

template <class Epi, class Sched>
__device__ __forceinline__ void gemm_phase(LAS unsigned char* lds, const Gemm g, const Sched& S, const Epi& E) {
    int tid = threadIdx.x; asm volatile("" : "+v"(tid));
    const int wid = __builtin_amdgcn_readfirstlane(tid >> 6), lane = tid & 63, wr = wid >> 2, wc = wid & 3, fr = lane & 15, fq = lane >> 4;
    int nt = g.K / BK; asm volatile("" : "+s"(nt));
    unsigned voffA, voffB;
    { int R, C; stage_rc(tid * 16, R, C); voffA = (unsigned)(R * g.lda + C) * 2u; voffB = (unsigned)(R * g.ldb + C) * 2u; }
    const size_t pieceA = (size_t)64 * g.lda * 2, pieceB = (size_t)64 * g.ldb * 2;
    const size_t kstep = (size_t)(BK * 2);
    const size_t hstepA = (size_t)HALF * g.lda * 2, hstepB = (size_t)HALF * g.ldb * 2;
    const unsigned ldsw = (unsigned)wid * 1024u;
    const int aoff = lds_byte(wr * 64 + fr, fq * 8), boff = lds_byte(wc * 32 + fr, fq * 8);
#define PG8_SA(b, h) (((b) * 2 + (h)) * HTB)
#define PG8_SB(b, h) ((4 + (b) * 2 + (h)) * HTB)
#define PG8_STAGE_A(bufoff, gbase) do { _Pragma("unroll") for (int _i = 0; _i < 2; ++_i) \
        __builtin_amdgcn_global_load_lds((const unsigned*)((const char*)(gbase) + _i * pieceA + voffA), (LAS unsigned*)(lds + (bufoff) + ldsw + _i * 8192), 16, 0, 0); } while (0)
#define PG8_STAGE_B(bufoff, gbase) do { _Pragma("unroll") for (int _i = 0; _i < 2; ++_i) \
        __builtin_amdgcn_global_load_lds((const unsigned*)((const char*)(gbase) + _i * pieceB + voffB), (LAS unsigned*)(lds + (bufoff) + ldsw + _i * 8192), 16, 0, 0); } while (0)
#define PG8_LDA(dst, b, h) do { _Pragma("unroll") for (int m = 0; m < 4; ++m) _Pragma("unroll") for (int k = 0; k < 2; ++k) dst[m][k] = *(const LAS bf16x8*)(lds + PG8_SA(b, h) + aoff + m * 2048 + k * 1024); } while (0)
#define PG8_LDB(dst, b, h) do { _Pragma("unroll") for (int n = 0; n < 2; ++n) _Pragma("unroll") for (int k = 0; k < 2; ++k) dst[n][k] = *(const LAS bf16x8*)(lds + PG8_SB(b, h) + boff + n * 2048 + k * 1024); } while (0)
#define PG8_MMA(ai, bj, At, Bt) do { __builtin_amdgcn_s_setprio(1); _Pragma("unroll") for (int m = 0; m < 4; ++m) _Pragma("unroll") for (int n = 0; n < 2; ++n) _Pragma("unroll") for (int k = 0; k < 2; ++k) \
        acc[ai][bj][m][n] = __builtin_amdgcn_mfma_f32_16x16x32_bf16(Bt[n][k], At[m][k], acc[ai][bj][m][n], 0, 0, 0); __builtin_amdgcn_s_setprio(0); } while (0)
#define PG8_WAIT_V(n) asm volatile("s_waitcnt vmcnt(" #n ")" ::: "memory")
#define PG8_WAIT_L(n) asm volatile("s_waitcnt lgkmcnt(" #n ")" ::: "memory")
#define PG8_BAR __builtin_amdgcn_s_barrier()
#define PG8_SCHED __builtin_amdgcn_sched_barrier(0)
    Unit cur, nxt; int ui = 0;
    if (!S.next(0, cur)) return;
    f32x4 acc[2][2][4][2];
#pragma unroll
    for (int a = 0; a < 2; ++a)
#pragma unroll
        for (int b = 0; b < 2; ++b)
#pragma unroll
            for (int m = 0; m < 4; ++m)
#pragma unroll
                for (int n = 0; n < 2; ++n) acc[a][b][m][n] = (f32x4){0.f, 0.f, 0.f, 0.f};
    bf16x8 At[4][2], B0[2][2], B1[2][2];
    const char* cA = cur.A; const char* cB = cur.B;
    PG8_STAGE_B(PG8_SB(0, 0), cB); PG8_STAGE_B(PG8_SB(0, 1), cB + hstepB); PG8_STAGE_A(PG8_SA(0, 0), cA); PG8_STAGE_A(PG8_SA(0, 1), cA + hstepA);
    if (wr == 1) PG8_BAR;
    PG8_WAIT_V(2); PG8_BAR;
    PG8_STAGE_B(PG8_SB(1, 0), cB + kstep); PG8_STAGE_A(PG8_SA(1, 0), cA + kstep); PG8_STAGE_B(PG8_SB(1, 1), cB + hstepB + kstep);
    PG8_WAIT_V(6); PG8_BAR;
    for (;;) {
        const bool has_next = S.next(ui + 1, nxt);
        const char* nA = has_next ? nxt.A : cA; const char* nB = has_next ? nxt.B : cB;
        for (int t = 0; t < nt; t += 2) {
            const bool last = (t == nt - 2);
            const char* a1 = cA + (size_t)(t + 1) * kstep;
            const char* a2 = last ? nA : cA + (size_t)(t + 2) * kstep; const char* b2 = last ? nB : cB + (size_t)(t + 2) * kstep;
            const char* a3 = a2 + kstep; const char* b3 = b2 + kstep;
            PG8_LDB(B0, 0, 0); PG8_LDB(B1, 0, 1); PG8_SCHED; PG8_LDA(At, 0, 0); PG8_STAGE_A(PG8_SA(1, 1), a1 + hstepA);
            PG8_WAIT_V(8); PG8_WAIT_L(0); PG8_BAR; PG8_MMA(0, 0, At, B0); PG8_MMA(0, 1, At, B1); PG8_BAR; PG8_SCHED;
            PG8_LDA(At, 0, 1); PG8_STAGE_B(PG8_SB(0, 0), b2); PG8_STAGE_B(PG8_SB(0, 1), b2 + hstepB); PG8_STAGE_A(PG8_SA(0, 0), a2);
            PG8_WAIT_V(8); PG8_WAIT_L(0); PG8_BAR; PG8_MMA(1, 0, At, B0); PG8_MMA(1, 1, At, B1); PG8_BAR; PG8_SCHED;
            PG8_LDB(B0, 1, 0); PG8_LDB(B1, 1, 1); PG8_SCHED; PG8_LDA(At, 1, 0); PG8_STAGE_A(PG8_SA(0, 1), a2 + hstepA);
            PG8_WAIT_V(8); PG8_WAIT_L(0); PG8_BAR; PG8_MMA(0, 0, At, B0); PG8_MMA(0, 1, At, B1); PG8_BAR; PG8_SCHED;
            PG8_LDA(At, 1, 1); PG8_STAGE_B(PG8_SB(1, 0), b3); PG8_STAGE_B(PG8_SB(1, 1), b3 + hstepB); PG8_STAGE_A(PG8_SA(1, 0), a3);
            PG8_WAIT_V(8); PG8_WAIT_L(0); PG8_BAR; PG8_MMA(1, 0, At, B0); PG8_MMA(1, 1, At, B1); PG8_BAR; PG8_SCHED;
        }
        if (wr == 0) PG8_BAR;
        const bool carry = E(acc, cur, wr, wc, fr, fq);
        if (!has_next) break;
        if (!carry) {
#pragma unroll
            for (int a = 0; a < 2; ++a)
#pragma unroll
                for (int b = 0; b < 2; ++b)
#pragma unroll
                    for (int m = 0; m < 4; ++m)
#pragma unroll
                        for (int n = 0; n < 2; ++n) acc[a][b][m][n] = (f32x4){0.f, 0.f, 0.f, 0.f};
        }
        cur = nxt; cA = nA; cB = nB; ++ui;
        if (wr == 1) PG8_BAR;
    }
    PG8_WAIT_V(0);
    PG8_BAR;
#undef PG8_SA
#undef PG8_SB
#undef PG8_STAGE_A
#undef PG8_STAGE_B
#undef PG8_LDA
#undef PG8_LDB
#undef PG8_MMA
#undef PG8_WAIT_V
#undef PG8_WAIT_L
#undef PG8_BAR
#undef PG8_SCHED
}
}
using pg8::Unit; using pg8::Gemm;

typedef f32x4 Acc[2][2][4][2];

struct RectSched {
    int nM, nN, pm0, G, c, nkb; unsigned long long pnmap;
    const char* A0; size_t dA1, dA2; const char* B; size_t strideAm, strideBn, strideBk;
    __device__ __forceinline__ bool next(int i, Unit& u) const {
        const int ti = i / nkb, kb = i - ti * nkb; const long L = (long)ti * G + c; if (L >= (long)nM * nN) return false;
        int pm, pn; pg8::tile_order((int)L, nM, nN, pm, pn);
        if (pnmap != ~0ull) pn = (int)((pnmap >> (4 * pn)) & 15ull);
        u.pm = pm + pm0; u.pn = pn; u.kb = kb;
        u.A = A0 + (size_t)(kb == 1) * dA1 + (size_t)(kb == 2) * dA2 + (size_t)u.pm * strideAm; u.B = B + (size_t)pn * strideBn + (size_t)kb * strideBk; return true;
    }
};

struct RowInfo { bool ctx; int b; int tok0; };
__device__ __forceinline__ RowInfo row_info(int pm) { RowInfo r; r.ctx = pm >= 64; r.b = r.ctx ? pm - 64 : pm >> 3; r.tok0 = r.ctx ? 0 : (pm & 7) * 256; return r; }

template <bool NORM>
__device__ __forceinline__ void head64(const f32x4 (&a)[2][2], const f32x4 (&g)[2][2], float scale, bool rope, int row_id, int col_id, const float* ropeA, int fq, f32x4 (&o)[2][2]) {
    f32x4 v[2][2];
    if (NORM) {
        float ss = 0.f;
#pragma unroll
        for (int bj = 0; bj < 2; ++bj)
#pragma unroll
            for (int n = 0; n < 2; ++n) { const f32x4 x = a[bj][n]; ss += (x[0] * x[0] + x[1] * x[1]) + (x[2] * x[2] + x[3] * x[3]); }
        ss = fq_sum(ss);
        const float rstd = rsqrtf(ss * (1.0f / 64.0f) + EPS);
#pragma unroll
        for (int bj = 0; bj < 2; ++bj)
#pragma unroll
            for (int n = 0; n < 2; ++n) v[bj][n] = a[bj][n] * rstd * g[bj][n];
    } else {
#pragma unroll
        for (int bj = 0; bj < 2; ++bj)
#pragma unroll
            for (int n = 0; n < 2; ++n) v[bj][n] = a[bj][n];
    }
    if (rope) {
#pragma unroll
        for (int bj = 0; bj < 2; ++bj) {
            const int pos = bj ? col_id : row_id;
            const f32x4 cs = *(const f32x4*)(ropeA + pos * 16 + 4 * fq), sn = *(const f32x4*)(ropeA + 1024 + pos * 16 + 4 * fq);
            o[bj][0] = (v[bj][0] * cs - v[bj][1] * sn) * scale; o[bj][1] = (v[bj][1] * cs + v[bj][0] * sn) * scale;
        }
    } else {
#pragma unroll
        for (int bj = 0; bj < 2; ++bj)
#pragma unroll
            for (int n = 0; n < 2; ++n) o[bj][n] = v[bj][n] * scale;
    }
}
__device__ __forceinline__ void rope32(const f32x4 (&a)[2], const float* g, float scale, bool rope, int row_id, int col_id, const float* ropeB, int fq, f32x4 (&o)[2]) {
    float ss = 0.f;
#pragma unroll
    for (int n = 0; n < 2; ++n) { const f32x4 x = a[n]; ss += (x[0] * x[0] + x[1] * x[1]) + (x[2] * x[2] + x[3] * x[3]); }
    ss = fq_sum(ss);
    const float rstd = rsqrtf(ss * (1.0f / 32.0f) + EPS);
    const int d0 = 16 * (fq >> 1) + 4 * (fq & 1);
    f32x4 v[2];
#pragma unroll
    for (int n = 0; n < 2; ++n) v[n] = a[n] * rstd * *(const f32x4*)(g + d0 + 8 * n);
    if (rope) {
        const int pos = (fq >> 1) ? col_id : row_id;
        const f32x4 cs = *(const f32x4*)(ropeB + pos * 8 + 4 * (fq & 1)), sn = *(const f32x4*)(ropeB + 512 + pos * 8 + 4 * (fq & 1));
        o[0] = (v[0] * cs - v[1] * sn) * scale; o[1] = (v[1] * cs + v[0] * sn) * scale;
    } else { o[0] = v[0] * scale; o[1] = v[1] * scale; }
}

struct EpiIn {
    bf16 *QA, *KA, *VA, *CQ, *CKV, *KB, *PF, *G; float *stat_cq, *stat_ckv;
    const float *gq, *gk, *gkr, *bgate, *ropeA, *ropeB;
    __device__ __forceinline__ bool operator()(Acc& acc, const Unit& u, int wr, int wc, int fr_, int fq_) const {
        int fr = fr_, fq = fq_; asm volatile("" : "+v"(fr), "+v"(fq));
        const RowInfo ri = row_info(u.pm); const bool rope = !ri.ctx;
        const int pn = u.pn;
        if (pn <= 2) {
            const bool isv = (pn == 2 && wc >= 2), isk = (pn == 2 && wc < 2);
            const float* gsrc = (pn < 2) ? gq : gk;
            f32x4 g[2][2];
#pragma unroll
            for (int bj = 0; bj < 2; ++bj)
#pragma unroll
                for (int n = 0; n < 2; ++n) g[bj][n] = *(const f32x4*)(gsrc + 32 * bj + 16 * n + 4 * fq);
#pragma unroll
            for (int ai = 0; ai < 2; ++ai)
#pragma unroll
                for (int m = 0; m < 4; ++m) {
                    const int rt = 128 * ai + 64 * wr + 16 * m + fr;
                    const int row_id = (ri.tok0 + 128 * ai + 64 * wr) >> 6, col_id = 16 * m + fr;
                    f32x4 a[2][2], o[2][2];
#pragma unroll
                    for (int bj = 0; bj < 2; ++bj)
#pragma unroll
                        for (int n = 0; n < 2; ++n) a[bj][n] = acc[ai][bj][m][n];
                    bf16* dst;
                    if (pn < 2) { head64<true>(a, g, C2A, rope, row_id, col_id, ropeA, fq, o); dst = QA + (size_t)(u.pm * 256 + rt) * 512 + (4 * pn + wc) * 64; }
                    else {
                        const size_t key = (size_t)ri.b * NKEY + (ri.ctx ? rt : 256 + ri.tok0 + rt);
                        if (isk) { head64<true>(a, g, 1.0f, rope, row_id, col_id, ropeA, fq, o); dst = KA + key * 128 + wc * 64; }
                        else { head64<false>(a, g, 1.0f, false, 0, 0, ropeA, fq, o); dst = VA + key * 128 + (wc - 2) * 64; }
                    }
#pragma unroll
                    for (int bj = 0; bj < 2; ++bj)
#pragma unroll
                        for (int n = 0; n < 2; ++n) *(u32x2*)(dst + 32 * bj + 16 * n + 4 * fq) = pk4(o[bj][n]);
                }
            (void)isv;
        } else if (pn == 3 || pn == 5) {
            bf16* dstb = (pn == 3) ? CQ : CKV; const int ld = (pn == 3) ? 384 : 256;
            float* st = (pn == 3) ? stat_cq : stat_ckv; const int sld = (pn == 3) ? 8 : 4;
#pragma unroll
            for (int ai = 0; ai < 2; ++ai)
#pragma unroll
                for (int m = 0; m < 4; ++m) {
                    const size_t row = (size_t)u.pm * 256 + 128 * ai + 64 * wr + 16 * m + fr; float ss = 0.f;
#pragma unroll
                    for (int bj = 0; bj < 2; ++bj)
#pragma unroll
                        for (int n = 0; n < 2; ++n) { const f32x4 x = acc[ai][bj][m][n]; ss += (x[0] * x[0] + x[1] * x[1]) + (x[2] * x[2] + x[3] * x[3]);
                            *(u32x2*)(dstb + row * ld + 128 * bj + 32 * wc + 16 * n + 4 * fq) = pk4(x); }
                    ss = fq_sum(ss);
                    if (fq == 0) st[row * sld + wc] = ss;
                }
        } else if (pn == 4) {
            f32x4 gk0[2]; (void)gk0;
#pragma unroll
            for (int ai = 0; ai < 2; ++ai)
#pragma unroll
                for (int m = 0; m < 4; ++m) {
                    const int rt = 128 * ai + 64 * wr + 16 * m + fr; const size_t row = (size_t)u.pm * 256 + rt; float ss = 0.f;
#pragma unroll
                    for (int n = 0; n < 2; ++n) { const f32x4 x = acc[ai][0][m][n]; ss += (x[0] * x[0] + x[1] * x[1]) + (x[2] * x[2] + x[3] * x[3]);
                        *(u32x2*)(CQ + row * 384 + 256 + 32 * wc + 16 * n + 4 * fq) = pk4(x); }
                    ss = fq_sum(ss);
                    if (fq == 0) stat_cq[row * 8 + 4 + wc] = ss;
                    if (wc == 0) {
                        const int row_id = (ri.tok0 + 128 * ai + 64 * wr) >> 6, col_id = 16 * m + fr;
                        f32x4 a[2], o[2]; a[0] = acc[ai][1][m][0]; a[1] = acc[ai][1][m][1];
                        rope32(a, gkr, 1.0f, rope, row_id, col_id, ropeB, fq, o);
                        const size_t key = (size_t)ri.b * NKEY + (ri.ctx ? rt : 256 + ri.tok0 + rt);
                        bf16* dst = KB + key * 768 + 64 + 16 * (fq >> 1) + 4 * (fq & 1);
                        const u32x2 w0 = pk4(o[0]), w1 = pk4(o[1]);
#pragma unroll
                        for (int h = 0; h < 8; ++h) { *(u32x2*)(dst + h * 96) = w0; *(u32x2*)(dst + h * 96 + 8) = w1; }
                    }
                }
        } else if (pn < 8) {
#pragma unroll
            for (int ai = 0; ai < 2; ++ai)
#pragma unroll
                for (int m = 0; m < 4; ++m) {
                    const size_t row = (size_t)u.pm * 256 + 128 * ai + 64 * wr + 16 * m + fr;
#pragma unroll
                    for (int bj = 0; bj < 2; ++bj)
#pragma unroll
                        for (int n = 0; n < 2; ++n) *(u32x2*)(PF + row * 512 + (pn - 6) * 256 + 128 * bj + 32 * wc + 16 * n + 4 * fq) = pk4(acc[ai][bj][m][n]);
                }
        } else {
            const int c0 = (pn - 8) * 256 + 32 * wc + 4 * fq;
            f32x4 bv[2][2];
#pragma unroll
            for (int bj = 0; bj < 2; ++bj)
#pragma unroll
                for (int n = 0; n < 2; ++n) bv[bj][n] = *(const f32x4*)(bgate + c0 + 128 * bj + 16 * n);
#pragma unroll
            for (int ai = 0; ai < 2; ++ai)
#pragma unroll
                for (int m = 0; m < 4; ++m) {
                    const size_t row = (size_t)u.pm * 256 + 128 * ai + 64 * wr + 16 * m + fr;
#pragma unroll
                    for (int bj = 0; bj < 2; ++bj)
#pragma unroll
                        for (int n = 0; n < 2; ++n) { f32x4 x = acc[ai][bj][m][n] + bv[bj][n];
                            x[0] = sigmoidf_(x[0]); x[1] = sigmoidf_(x[1]); x[2] = sigmoidf_(x[2]); x[3] = sigmoidf_(x[3]);
                            *(u32x2*)(G + row * 3072 + c0 + 128 * bj + 16 * n) = pk4(x); }
                }
        }
        return false;
    }
};

struct EpiUq {
    bf16 *QBN, *QBR; const float *stat_cq, *gqn, *gqr, *ropeB;
    __device__ __forceinline__ bool operator()(Acc& acc, const Unit& u, int wr, int wc, int fr_, int fq_) const {
        int fr = fr_, fq = fq_; asm volatile("" : "+v"(fr), "+v"(fq));
        const RowInfo ri = row_info(u.pm); const bool rope = !ri.ctx;
        f32x4 g[2][2];
#pragma unroll
        for (int bj = 0; bj < 2; ++bj)
#pragma unroll
            for (int n = 0; n < 2; ++n) g[bj][n] = *(const f32x4*)(gqn + 32 * bj + 16 * n + 4 * fq);
#pragma unroll
        for (int ai = 0; ai < 2; ++ai)
#pragma unroll
            for (int m = 0; m < 4; ++m) {
                const int rt = 128 * ai + 64 * wr + 16 * m + fr; const size_t row = (size_t)u.pm * 256 + rt;
                const f32x4 s0 = *(const f32x4*)(stat_cq + row * 8), s1 = *(const f32x4*)(stat_cq + row * 8 + 4);
                const float rs = rsqrtf(((s0[0] + s0[1]) + (s0[2] + s0[3]) + (s1[0] + s1[1]) + (s1[2] + s1[3])) * (1.0f / 384.0f) + EPS);
                if (u.pn < 2) {
                    f32x4 a[2][2], o[2][2];
#pragma unroll
                    for (int bj = 0; bj < 2; ++bj)
#pragma unroll
                        for (int n = 0; n < 2; ++n) a[bj][n] = acc[ai][bj][m][n] * rs;
                    head64<true>(a, g, C2B, false, 0, 0, ropeB, fq, o);
                    bf16* dst = QBN + row * 512 + (4 * u.pn + wc) * 64;
#pragma unroll
                    for (int bj = 0; bj < 2; ++bj)
#pragma unroll
                        for (int n = 0; n < 2; ++n) *(u32x2*)(dst + 32 * bj + 16 * n + 4 * fq) = pk4(o[bj][n]);
                } else {
                    const int row_id = (ri.tok0 + 128 * ai + 64 * wr) >> 6, col_id = 16 * m + fr;
#pragma unroll
                    for (int bj = 0; bj < 2; ++bj) {
                        f32x4 a[2], o[2]; a[0] = acc[ai][bj][m][0] * rs; a[1] = acc[ai][bj][m][1] * rs;
                        rope32(a, gqr, C2B, rope, row_id, col_id, ropeB, fq, o);
                        bf16* dst = QBR + row * 256 + (4 * bj + wc) * 32 + 16 * (fq >> 1) + 4 * (fq & 1);
                        *(u32x2*)(dst) = pk4(o[0]); *(u32x2*)(dst + 8) = pk4(o[1]);
                    }
                }
            }
        return false;
    }
};

struct EpiUkv {
    bf16 *KB, *VB; const float *stat_ckv, *gkn;
    __device__ __forceinline__ bool operator()(Acc& acc, const Unit& u, int wr, int wc, int fr_, int fq_) const {
        int fr = fr_, fq = fq_; asm volatile("" : "+v"(fr), "+v"(fq));
        const RowInfo ri = row_info(u.pm);
        f32x4 g[2][2];
#pragma unroll
        for (int bj = 0; bj < 2; ++bj)
#pragma unroll
            for (int n = 0; n < 2; ++n) g[bj][n] = *(const f32x4*)(gkn + 32 * bj + 16 * n + 4 * fq);
#pragma unroll
        for (int ai = 0; ai < 2; ++ai)
#pragma unroll
            for (int m = 0; m < 4; ++m) {
                const int rt = 128 * ai + 64 * wr + 16 * m + fr; const size_t row = (size_t)u.pm * 256 + rt;
                const f32x4 s0 = *(const f32x4*)(stat_ckv + row * 4);
                const float rs = rsqrtf(((s0[0] + s0[1]) + (s0[2] + s0[3])) * (1.0f / 256.0f) + EPS);
                const size_t key = (size_t)ri.b * NKEY + (ri.ctx ? rt : 256 + ri.tok0 + rt);
                f32x4 a[2][2], o[2][2];
#pragma unroll
                for (int bj = 0; bj < 2; ++bj)
#pragma unroll
                    for (int n = 0; n < 2; ++n) a[bj][n] = acc[ai][bj][m][n] * rs;
                bf16* dst;
                if (u.pn < 2) { head64<true>(a, g, 1.0f, false, 0, 0, gkn, fq, o); dst = KB + key * 768 + (4 * u.pn + wc) * 96; }
                else { head64<false>(a, g, 1.0f, false, 0, 0, gkn, fq, o); dst = VB + key * 512 + (4 * (u.pn - 2) + wc) * 64; }
#pragma unroll
                for (int bj = 0; bj < 2; ++bj)
#pragma unroll
                    for (int n = 0; n < 2; ++n) *(u32x2*)(dst + 32 * bj + 16 * n + 4 * fq) = pk4(o[bj][n]);
            }
        return false;
    }
};

struct EpiStore {
    bf16* O; int ld;
    __device__ __forceinline__ bool operator()(Acc& acc, const Unit& u, int wr, int wc, int fr_, int fq_) const {
        int fr = fr_, fq = fq_; asm volatile("" : "+v"(fr), "+v"(fq));
#pragma unroll
        for (int ai = 0; ai < 2; ++ai)
#pragma unroll
            for (int m = 0; m < 4; ++m) {
                const size_t row = (size_t)u.pm * 256 + 128 * ai + 64 * wr + 16 * m + fr;
#pragma unroll
                for (int bj = 0; bj < 2; ++bj)
#pragma unroll
                    for (int n = 0; n < 2; ++n) *(u32x2*)(O + row * ld + u.pn * 256 + 128 * bj + 32 * wc + 16 * n + 4 * fq) = pk4(acc[ai][bj][m][n]);
            }
        return false;
    }
};

struct EpiF1 {
    bf16* ZT; int NP;
    __device__ __forceinline__ bool operator()(Acc& acc, const Unit& u, int wr, int wc, int fr_, int fq_) const {
        int fr = fr_, fq = fq_; asm volatile("" : "+v"(fr), "+v"(fq));
        const int b = u.pm >> 2, gch = u.pm & 3;
#pragma unroll
        for (int ai = 0; ai < 2; ++ai)
#pragma unroll
            for (int m = 0; m < 4; ++m) {
                const int ch = gch * 128 + 64 * wr + 16 * m + fr;
                bf16* dst = ZT + ((size_t)b * 512 + ch) * (2 * NP) + ai * NP + u.pn * 256;
#pragma unroll
                for (int bj = 0; bj < 2; ++bj)
#pragma unroll
                    for (int n = 0; n < 2; ++n) *(u32x2*)(dst + 128 * bj + 32 * wc + 16 * n + 4 * fq) = pk4(acc[ai][bj][m][n]);
            }
        return false;
    }
};

struct EpiMerge {
    const bf16* G; bf16* MB;
    __device__ __forceinline__ bool operator()(Acc& acc, const Unit& u, int wr, int wc, int fr_, int fq_) const {
        int fr = fr_, fq = fq_; asm volatile("" : "+v"(fr), "+v"(fq));
        const int kb = u.kb; const int c0 = u.pn * 256 + 32 * wc + 4 * fq;
#pragma unroll
        for (int ai = 0; ai < 2; ++ai)
#pragma unroll
            for (int m = 0; m < 4; ++m) {
                const size_t row = (size_t)u.pm * 256 + 128 * ai + 64 * wr + 16 * m + fr;
                const bf16* gp = G + row * 3072 + c0;
#pragma unroll
                for (int bj = 0; bj < 2; ++bj)
#pragma unroll
                    for (int n = 0; n < 2; ++n) {
                        const int co = 128 * bj + 16 * n;
                        if (kb < 2) { const f32x4 ga = unpk4(*(const u32x2*)(gp + kb * 1024 + co)), gb = unpk4(*(const u32x2*)(gp + (kb + 1) * 1024 + co));
                            f32x4 r; r[0] = ga[0] / gb[0]; r[1] = ga[1] / gb[1]; r[2] = ga[2] / gb[2]; r[3] = ga[3] / gb[3]; acc[ai][bj][m][n] *= r; }
                        else { const f32x4 gc = unpk4(*(const u32x2*)(gp + 2048 + co)); *(u32x2*)(MB + row * 1024 + c0 + co) = pk4(acc[ai][bj][m][n] * gc); }
                    }
            }
        return kb < 2;
    }
};

struct EpiRes {
    const float *xin_lat, *xin_ctx; float *xout_lat, *xout_ctx; const float* gate;
    __device__ __forceinline__ bool operator()(Acc& acc, const Unit& u, int wr, int wc, int fr_, int fq_) const {
        int fr = fr_, fq = fq_; asm volatile("" : "+v"(fr), "+v"(fq));
        const RowInfo ri = row_info(u.pm); const int s = ri.ctx ? 8 : ri.b;
        const int c0 = u.pn * 256 + 32 * wc + 4 * fq;
        const float* xin = ri.ctx ? xin_ctx + (size_t)(u.pm - 64) * 256 * 1024 : xin_lat + (size_t)u.pm * 256 * 1024;
        float* xout = ri.ctx ? xout_ctx + (size_t)(u.pm - 64) * 256 * 1024 : xout_lat + (size_t)u.pm * 256 * 1024;
        f32x4 gv[2][2];
#pragma unroll
        for (int bj = 0; bj < 2; ++bj)
#pragma unroll
            for (int n = 0; n < 2; ++n) gv[bj][n] = *(const f32x4*)(gate + s * 6144 + c0 + 128 * bj + 16 * n);
#pragma unroll
        for (int ai = 0; ai < 2; ++ai)
#pragma unroll
            for (int m = 0; m < 4; ++m) {
                const size_t off = (size_t)(128 * ai + 64 * wr + 16 * m + fr) * 1024 + c0;
#pragma unroll
                for (int bj = 0; bj < 2; ++bj)
#pragma unroll
                    for (int n = 0; n < 2; ++n) { const f32x4 xi = *(const f32x4*)(xin + off + 128 * bj + 16 * n); *(f32x4*)(xout + off + 128 * bj + 16 * n) = xi + gv[bj][n] * acc[ai][bj][m][n]; }
                asm volatile("" ::: "memory");
            }
        return false;
    }
};

struct EpiSwiglu {
    bf16* ACT;
    __device__ __forceinline__ bool operator()(Acc& acc, const Unit& u, int wr, int wc, int fr_, int fq_) const {
        int fr = fr_, fq = fq_; asm volatile("" : "+v"(fr), "+v"(fq));
#pragma unroll
        for (int ai = 0; ai < 2; ++ai)
#pragma unroll
            for (int m = 0; m < 4; ++m) {
                const size_t row = (size_t)u.pm * 256 + 128 * ai + 64 * wr + 16 * m + fr;
#pragma unroll
                for (int n = 0; n < 2; ++n) { const f32x4 gt = acc[ai][0][m][n], up = acc[ai][1][m][n]; f32x4 o;
                    o[0] = gt[0] * sigmoidf_(gt[0]) * up[0]; o[1] = gt[1] * sigmoidf_(gt[1]) * up[1]; o[2] = gt[2] * sigmoidf_(gt[2]) * up[2]; o[3] = gt[3] * sigmoidf_(gt[3]) * up[3];
                    *(u32x2*)(ACT + row * FFH + u.pn * 128 + 32 * wc + 16 * n + 4 * fq) = pk4(o); }
            }
        return false;
    }
};

namespace att {
constexpr int KSLOT = 12288, VSLOT = 8192;
constexpr int L_K = 0, L_V = 2 * KSLOT, L_WS = L_V + 2 * VSLOT, L_OST = L_WS + NWAVES * 64 * 4, L_BYTES = L_OST + NWAVES * 4096;
__device__ __forceinline__ int crow(int r, int hi) { return (r & 3) + 8 * (r >> 2) + 4 * hi; }
__device__ __forceinline__ float max3f(float a, float b, float c) { return __builtin_fmaxf(__builtin_fmaxf(a, b), c); }
__device__ __forceinline__ float rowmax(const f32x16& p0, const f32x16& p1) {
    float a = max3f(p0[0], p0[1], p1[0]), b = max3f(p0[2], p0[3], p1[1]); a = max3f(a, p1[2], p1[3]);
#pragma unroll
    for (int r = 4; r < 16; r += 4) { a = max3f(a, p0[r], p0[r + 1]); b = max3f(b, p0[r + 2], p0[r + 3]); a = max3f(a, p1[r], p1[r + 1]); b = max3f(b, p1[r + 2], p1[r + 3]); }
    const float m = __builtin_fmaxf(a, b);
    auto rr = __builtin_amdgcn_permlane32_swap(__float_as_uint(m), __float_as_uint(m), false, false);
    return __builtin_fmaxf(__uint_as_float(rr[0]), __uint_as_float(rr[1]));
}
__device__ __forceinline__ void pv(f32x16* o, int vb, bf16x8 pa0, bf16x8 pa1, bf16x8 pa2, bf16x8 pa3) {
#pragma unroll
    for (int d0 = 0; d0 < 2; ++d0) { s16x4 lo[4], hi[4];
#pragma unroll
        for (int ks = 0; ks < 4; ++ks) {
            asm volatile("ds_read_b64_tr_b16 %0,%1 offset:%c2" : "=&v"(lo[ks]) : "v"(vb), "i"(d0 * 4096 + ks * 1024) : "memory");
            asm volatile("ds_read_b64_tr_b16 %0,%1 offset:%c2" : "=&v"(hi[ks]) : "v"(vb), "i"(d0 * 4096 + ks * 1024 + 512) : "memory"); }
        asm volatile("s_waitcnt lgkmcnt(0)" ::: "memory"); __builtin_amdgcn_sched_barrier(0);
#define PK(k) (bf16x8){lo[k][0], lo[k][1], lo[k][2], lo[k][3], hi[k][0], hi[k][1], hi[k][2], hi[k][3]}
        o[d0] = __builtin_amdgcn_mfma_f32_32x32x16_bf16(pa0, PK(0), o[d0], 0, 0, 0);
        o[d0] = __builtin_amdgcn_mfma_f32_32x32x16_bf16(pa1, PK(1), o[d0], 0, 0, 0);
        o[d0] = __builtin_amdgcn_mfma_f32_32x32x16_bf16(pa2, PK(2), o[d0], 0, 0, 0);
        o[d0] = __builtin_amdgcn_mfma_f32_32x32x16_bf16(pa3, PK(3), o[d0], 0, 0, 0);
#undef PK
    }
}
template <int DQK>
__device__ __forceinline__ void attn_unit(const bf16* Qn, int pqn, const bf16* Qr, int pqr, const bf16* Kh, int pk, const bf16* Vh, int pv_, bf16* O, int po, int NT, LAS unsigned char* shm) {
    constexpr int ND = DQK / 16, NCH = DQK / 8;
    int tid = threadIdx.x; asm volatile("" : "+v"(tid));
    const int lane = tid & 63, r32 = lane & 31, hi = lane >> 5; const int wid = __builtin_amdgcn_readfirstlane(tid >> 6);
    LAS float* wsf = (LAS float*)(shm + L_WS) + wid * 64;
    const bf16* ksrc = Kh + (size_t)lane * pk + wid * 8;
    const bf16* vsrc = Vh + (size_t)(16 * (wid & 3) + (lane >> 2)) * pv_ + (wid >> 2) * 32 + (lane & 3) * 8;
    const int vb0 = (int)(unsigned)(uintptr_t)(shm + L_V) + ((lane >> 4) & 1) * 32 + (lane & 3) * 8 + (4 * hi + ((lane & 15) >> 2)) * 64;
    const LAS unsigned char* kp0 = shm + L_K + hi * 1024 + r32 * 16;
#define DMA_TILE(t, buf) do { \
        __builtin_amdgcn_global_load_lds((const unsigned*)(ksrc + (size_t)(t) * 64 * pk), (LAS unsigned*)(shm + L_K + (buf) * KSLOT + wid * 1024), 16, 0, 0); \
        if (NCH > 8 && wid < NCH - 8) __builtin_amdgcn_global_load_lds((const unsigned*)(ksrc + (size_t)(t) * 64 * pk + 64), (LAS unsigned*)(shm + L_K + (buf) * KSLOT + (wid + 8) * 1024), 16, 0, 0); \
        __builtin_amdgcn_global_load_lds((const unsigned*)(vsrc + (size_t)(t) * 64 * pv_), (LAS unsigned*)(shm + L_V + (buf) * VSLOT + wid * 1024), 16, 0, 0); } while (0)
    DMA_TILE(0, 0);
    bf16x8 qr[ND];
#pragma unroll
    for (int d0 = 0; d0 < 4; ++d0) qr[d0] = *(const bf16x8*)(Qn + (size_t)(wid * 32 + r32) * pqn + d0 * 16 + hi * 8);
    if (ND > 4) {
#pragma unroll
        for (int d0 = 4; d0 < ND; ++d0) qr[d0] = *(const bf16x8*)(Qr + (size_t)(wid * 32 + r32) * pqr + (d0 - 4) * 16 + hi * 8);
    }
    float mrun = -1e30f, l_reg = 0.f; f32x16 o[2]; o[0] = f32x16{}; o[1] = f32x16{};
    for (int t = 0; t < NT; ++t) {
        const int buf = t & 1;
        asm volatile("s_waitcnt vmcnt(0)" ::: "memory");
        __syncthreads();
        if (t + 1 < NT) DMA_TILE(t + 1, buf ^ 1);
        f32x16 p0 = f32x16{}, p1 = f32x16{};
        const LAS unsigned char* kp = kp0 + buf * KSLOT;
#pragma unroll
        for (int d0 = 0; d0 < ND; ++d0) {
            const bf16x8 b0 = *(const LAS bf16x8*)(kp + d0 * 2048), b1 = *(const LAS bf16x8*)(kp + d0 * 2048 + 512);
            p0 = __builtin_amdgcn_mfma_f32_32x32x16_bf16(b0, qr[d0], p0, 0, 0, 0); p1 = __builtin_amdgcn_mfma_f32_32x32x16_bf16(b1, qr[d0], p1, 0, 0, 0);
        }
        const float rm = rowmax(p0, p1);
        if (__any(rm > mrun)) {
            const float mn = __builtin_fmaxf(mrun, rm), al = __builtin_amdgcn_exp2f(mrun - mn); mrun = mn; l_reg *= al;
            if (hi == 0) wsf[r32] = al;
            asm volatile("s_waitcnt lgkmcnt(0)" ::: "memory");
#pragma unroll
            for (int r = 0; r < 16; ++r) { const float f = wsf[crow(r, hi)]; o[0][r] *= f; o[1][r] *= f; }
        }
        float sacc = 0.f;
#pragma unroll
        for (int r = 0; r < 16; ++r) { p0[r] = __builtin_amdgcn_exp2f(p0[r] - mrun); p1[r] = __builtin_amdgcn_exp2f(p1[r] - mrun); sacc += p0[r] + p1[r]; }
        l_reg += sacc;
        u32x4 w0, w1, w2, w3;
        w0 = (u32x4){cvtpk(p0[0], p0[1]), cvtpk(p0[2], p0[3]), cvtpk(p0[4], p0[5]), cvtpk(p0[6], p0[7])};
        w1 = (u32x4){cvtpk(p0[8], p0[9]), cvtpk(p0[10], p0[11]), cvtpk(p0[12], p0[13]), cvtpk(p0[14], p0[15])};
        w2 = (u32x4){cvtpk(p1[0], p1[1]), cvtpk(p1[2], p1[3]), cvtpk(p1[4], p1[5]), cvtpk(p1[6], p1[7])};
        w3 = (u32x4){cvtpk(p1[8], p1[9]), cvtpk(p1[10], p1[11]), cvtpk(p1[12], p1[13]), cvtpk(p1[14], p1[15])};
        pv(o, vb0 + buf * VSLOT, __builtin_bit_cast(bf16x8, w0), __builtin_bit_cast(bf16x8, w1), __builtin_bit_cast(bf16x8, w2), __builtin_bit_cast(bf16x8, w3));
    }
#undef DMA_TILE
    { auto rr = __builtin_amdgcn_permlane32_swap(__float_as_uint(l_reg), __float_as_uint(l_reg), false, false); l_reg = __uint_as_float(rr[0]) + __uint_as_float(rr[1]); }
    if (hi == 0) wsf[32 + r32] = l_reg;
    asm volatile("s_waitcnt lgkmcnt(0)" ::: "memory");
    float rli[16];
#pragma unroll
    for (int r = 0; r < 16; ++r) rli[r] = __builtin_amdgcn_rcpf(wsf[32 + crow(r, hi)]);
    LAS bf16* stg = (LAS bf16*)(shm + L_OST) + wid * 2048;
#pragma unroll
    for (int r = 0; r < 16; ++r) { const int orow = crow(r, hi);
#pragma unroll
        for (int d0 = 0; d0 < 2; ++d0) stg[orow * 64 + d0 * 32 + r32] = (bf16)(cvtpk(o[d0][r] * rli[r], 0.f) & 0xffffu); }
    asm volatile("s_waitcnt lgkmcnt(0)" ::: "memory");
    bf16* Ow = O + (size_t)(wid * 32) * po;
#pragma unroll
    for (int i = 0; i < 4; ++i) { const int row = i * 8 + (lane >> 3), ch = lane & 7; const u32x4 v = *(const LAS u32x4*)(stg + row * 64 + ch * 8); *(u32x4*)(Ow + (size_t)row * po + ch * 8) = v; }
    asm volatile("s_waitcnt lgkmcnt(0)" ::: "memory");
    __syncthreads();
}
}


#define RLX_AGENT __ATOMIC_RELAXED, __HIP_MEMORY_SCOPE_AGENT
#define XB_TMO      128
#define XB_XCNT(j)  (256  + 64 * (j))
#define XB_XSUB(j)  (1280 + 64 * (j))
#define XB_XGEN(j)  (2304 + 64 * (j))
#define XB_TOP      3328
#define XB_TOPGEN   3392
#define XCD_BAR_WORDS 3456
#define XB_SPIN_CAP (1u << 18)
__device__ __forceinline__ unsigned xb_ld(unsigned* p)              { return __hip_atomic_load(p, __ATOMIC_RELAXED, __HIP_MEMORY_SCOPE_AGENT); }
__device__ __forceinline__ unsigned xb_add(unsigned* p, unsigned v) { return __hip_atomic_fetch_add(p, v, __ATOMIC_RELAXED, __HIP_MEMORY_SCOPE_AGENT); }
__device__ __forceinline__ unsigned xb_xcc_id() { return (unsigned)__builtin_amdgcn_s_getreg((3 << 11) | 20) & 0xFu; }
#define XB_SPIN(cond, bar) do { unsigned _sp = 0; while (cond) { __builtin_amdgcn_s_sleep(1); \
    if ((++_sp & 255u) == 0u) { if (xb_ld(&(bar)[XB_TMO])) break; if (_sp > XB_SPIN_CAP) { atomicAdd(&(bar)[XB_TMO], 1u); break; } } } } while (0)
struct XcdBarrier { unsigned* bar; unsigned x; volatile LAS unsigned* st; };
__device__ __forceinline__ XcdBarrier xcd_barrier_post(unsigned* bar, volatile LAS unsigned* st) {
    XcdBarrier b; b.bar = bar; b.x = xb_xcc_id(); b.st = st;
    if (threadIdx.x == 0) (void)xb_add(&bar[XB_XCNT(b.x)], 1u);
    return b;
}
__device__ __forceinline__ void xcd_barrier_complete(unsigned* bar, unsigned x, unsigned& nloc, unsigned& nx) {
    const unsigned G = gridDim.x * gridDim.y * gridDim.z;
    unsigned sum, cnt, mine, sp = 0u;
    for (;;) {
        sum = 0u; cnt = 0u; mine = 0u;
#pragma unroll
        for (unsigned j = 0; j < 16; ++j) { const unsigned c = xb_ld(&bar[XB_XCNT(j)]); sum += c; cnt += (c > 0u) ? 1u : 0u; mine = (j == x) ? c : mine; }
        if (sum == G) break;
        __builtin_amdgcn_s_sleep(1);
        if ((++sp & 255u) == 0u) { if (xb_ld(&bar[XB_TMO])) break; if (sp > XB_SPIN_CAP) { atomicAdd(&bar[XB_TMO], 1u); break; } }
    }
    nloc = mine > 0u ? mine : 1u; nx = cnt > 0u ? cnt : 1u;
}
__device__ __forceinline__ void xcd_barrier(const XcdBarrier& b) {
    asm volatile("s_waitcnt vmcnt(0)" ::: "memory");
    __syncthreads();
    if (threadIdx.x == 0) {
        unsigned* bar = b.bar;
        __builtin_amdgcn_s_waitcnt(0);
        unsigned nloc = b.st[0], nx = b.st[1];
        if (nloc == 0u) { xcd_barrier_complete(bar, b.x, nloc, nx); b.st[0] = nloc; b.st[1] = nx; }
        const unsigned old = xb_add(&bar[XB_XSUB(b.x)], 1u);
        const unsigned gen = old / nloc;
        if (old + 1u == (gen + 1u) * nloc) {
            __builtin_amdgcn_fence(__ATOMIC_RELEASE, "agent");
            asm volatile("s_waitcnt vmcnt(0)" ::: "memory");
            const unsigned og = xb_add(&bar[XB_TOP], 1u);
            const unsigned tg = og / nx;
            if (og + 1u == (tg + 1u) * nx) xb_add(&bar[XB_TOPGEN], 1u);
            else XB_SPIN(xb_ld(&bar[XB_TOPGEN]) == tg, bar);
            __builtin_amdgcn_fence(__ATOMIC_ACQUIRE, "agent");
            xb_add(&bar[XB_XGEN(b.x)], 1u);
            asm volatile("s_waitcnt vmcnt(0)" ::: "memory");
        } else {
            XB_SPIN(xb_ld(&bar[XB_XGEN(b.x)]) == gen, bar);
            __builtin_amdgcn_fence(__ATOMIC_ACQUIRE, "agent");
            asm volatile("s_waitcnt vmcnt(0)" ::: "memory");
        }
    }
    __syncthreads();
}
constexpr int LDS_MISC = 131072 + 1024;
constexpr size_t CTL_ZERO_BYTES = 64 * KiB;

struct Args { const float* in[26]; float* out; unsigned char* ws; int ph_lo, ph_hi; };
constexpr int LDS_BYTES = 147456;
constexpr int NPHASE = 21;

typedef const __attribute__((address_space(4))) unsigned char* KP;
__device__ __forceinline__ const float* kin(KP kp, int k) { return *(const float* const __attribute__((address_space(4)))*)(kp + 8 * k); }
__device__ __forceinline__ float* kout(KP kp) { return *(float* const __attribute__((address_space(4)))*)(kp + 208); }
__device__ __forceinline__ unsigned char* kws(KP kp) { return *(unsigned char* const __attribute__((address_space(4)))*)(kp + 216); }
static_assert(sizeof(Args) == 232, "Args layout");
struct Ctx {
    LAS unsigned char* lds; int tid, lane, wave, vcu, G; unsigned char* ws;
};

enum MatId { M_WIN = 0, M_WUQ, M_WUKV, M_NAT, M_FFI };
__device__ __forceinline__ int rope_perm(int p) { const int n = p >> 4, fq = (p >> 2) & 3, j = p & 3; return 16 * (fq >> 1) + 8 * n + 4 * (fq & 1) + j; }
__device__ __forceinline__ int head_perm(int pc, int& wc) { wc = (pc >> 5) & 3; return 32 * (pc >> 7) + (pc & 31); }
__device__ __forceinline__ int src_col(int mat, int n) {
    const int t = n >> 8, pc = n & 255; int wc;
    switch (mat) {
    case M_WIN:
        if (t < 2) { const int d = head_perm(pc, wc); return (4 * t + wc) * 64 + d; }
        if (t == 2) { const int d = head_perm(pc, wc); return wc < 2 ? 512 + wc * 64 + d : 640 + (wc - 2) * 64 + d; }
        if (t == 3) return 768 + pc;
        if (t == 4) { if (pc < 128) return 768 + 256 + pc; if (pc < 160) return 1408 + rope_perm(pc - 128); return -1; }
        if (t == 5) return 1152 + pc;
        if (t < 8) return 1440 + (t - 6) * 256 + pc;
        return 1952 + (t - 8) * 256 + pc;
    case M_WUQ:
        if (t < 2) { const int d = head_perm(pc, wc); return (4 * t + wc) * 96 + d; }
        { const int bj = pc >> 7, w2 = (pc >> 5) & 3; return (4 * bj + w2) * 96 + 64 + rope_perm(pc & 31); }
    case M_WUKV:
        { const int d = head_perm(pc, wc); return t < 2 ? (4 * t + wc) * 128 + d : (4 * (t - 2) + wc) * 128 + 64 + d; }
    case M_FFI:
        return pc < 128 ? t * 128 + pc : FFH + t * 128 + (pc - 128);
    default: return n;
    }
}
__device__ __forceinline__ void xpose_item(const float* W, int ldw, const float* kscale, bf16* WT, int ldo, int kcol0, int mat, int nblk, int item, LAS float* scr, int lane) {
    const int kb = item / nblk, nb = item % nblk, k0 = 64 * kb, n0 = 32 * nb;
    const int sc = src_col(mat, n0 + (lane & 31));
#pragma unroll 8
    for (int i = 0; i < 32; ++i) { const int kk = 2 * i + (lane >> 5); float v = 0.f; if (sc >= 0) { v = W[(size_t)(k0 + kk) * ldw + sc]; if (kscale) v *= kscale[k0 + kk]; } scr[kk * 33 + (lane & 31)] = v; }
    asm volatile("s_waitcnt lgkmcnt(0)" ::: "memory");
    const int c = lane & 7;
#pragma unroll
    for (int j = 0; j < 4; ++j) { const int n = (lane >> 3) + 8 * j; const LAS float* s = scr + (8 * c) * 33 + n;
        u32x4 o; o.x = cvtpk(s[0 * 33], s[1 * 33]); o.y = cvtpk(s[2 * 33], s[3 * 33]); o.z = cvtpk(s[4 * 33], s[5 * 33]); o.w = cvtpk(s[6 * 33], s[7 * 33]);
        *(u32x4*)(WT + (size_t)(n0 + n) * ldo + kcol0 + k0 + 8 * c) = o; }
    asm volatile("s_waitcnt lgkmcnt(0)" ::: "memory");
}
__device__ __forceinline__ void run_xjob(const Ctx& F, int& base, const float* W, int ldw, const float* kscale, bf16* WT, int ldo, int kcol0, int mat, int K, int N) {
    LAS float* scr = (LAS float*)(F.lds + F.wave * 16384);
    const int gw = F.vcu * NWAVES + F.wave, NGW = F.G * NWAVES;
    const int nblk = N / 32, nit = (K / 64) * nblk;
    int first = gw - (base % NGW); if (first < 0) first += NGW;
    for (int it = first; it < nit; it += NGW) xpose_item(W, ldw, kscale, WT, ldo, kcol0, mat, nblk, it, scr, F.lane);
    base += nit;
}

__device__ __forceinline__ void norm_pass(const Ctx& F, const float* x_lat, const float* x_ctx, bf16* HB, const float* gnorm, const float* mod_l, int shift_off, int nrows) {
    const int gw = F.vcu * NWAVES + F.wave, NGW = F.G * NWAVES;
    const int per = (nrows + NGW - 1) / NGW; const int r0 = gw * per, r1 = min(nrows, r0 + per);
    int cur_s = -1; f32x4 ca[4], cb[4];
    for (int r = r0; r < r1; ++r) {
        const bool ctx = r >= ML; const int s = ctx ? 8 : r >> 11;
        if (s != cur_s) { cur_s = s; const float* sh = mod_l + s * 6144 + shift_off; const float* scl = sh + 1024;
#pragma unroll
            for (int j = 0; j < 4; ++j) { const f32x4 g = *(const f32x4*)(gnorm + 256 * j + 4 * F.lane); const f32x4 sc1 = *(const f32x4*)(scl + 256 * j + 4 * F.lane); ca[j] = g * (sc1 + 1.0f); cb[j] = *(const f32x4*)(sh + 256 * j + 4 * F.lane); } }
        const float* xr = ctx ? x_ctx + (size_t)(r - ML) * 1024 : x_lat + (size_t)r * 1024;
        f32x4 v[4]; float ss = 0.f;
#pragma unroll
        for (int j = 0; j < 4; ++j) { v[j] = *(const f32x4*)(xr + 256 * j + 4 * F.lane); ss += (v[j][0] * v[j][0] + v[j][1] * v[j][1]) + (v[j][2] * v[j][2] + v[j][3] * v[j][3]); }
        const float rstd = rsqrtf(wave_sum(ss) * (1.0f / 1024.0f) + EPS);
#pragma unroll
        for (int j = 0; j < 4; ++j) *(u32x2*)(HB + (size_t)r * 1024 + 256 * j + 4 * F.lane) = pk4(v[j] * rstd * ca[j] + cb[j]);
    }
}

__device__ __forceinline__ void mod_items(const Ctx& F, KP kp) {
    const float* c = kin(kp, 1); const float* cc = kin(kp, 3); const float* wmod = kin(kp, 4); const float* bmod = kin(kp, 5);
    float* mod = (float*)(F.ws + O_MOD);
    LAS float* sl = (LAS float*)F.lds;
    LAS float* red = sl + 9 * 1024;
    for (int it = F.vcu; it < 192; it += F.G) {
        const int l = it / 96, n0 = (it % 96) * 64;
        __syncthreads();
        for (int i = F.tid; i < 9 * 1024; i += NTHR) { const float v = (i < 8192) ? c[i] : cc[i - 8192]; sl[i] = v * sigmoidf_(v); }
        __syncthreads();
        float acc[9];
#pragma unroll
        for (int s = 0; s < 9; ++s) acc[s] = 0.f;
        const float* wp = wmod + (size_t)l * 1024 * 6144 + n0 + F.lane;
        for (int k = F.wave * 128; k < F.wave * 128 + 128; ++k) { const float w = wp[(size_t)k * 6144];
#pragma unroll
            for (int s = 0; s < 9; ++s) acc[s] += sl[s * 1024 + k] * w; }
#pragma unroll
        for (int s = 0; s < 9; ++s) red[(F.wave * 9 + s) * 64 + F.lane] = acc[s];
        __syncthreads();
        for (int i = F.tid; i < 9 * 64; i += NTHR) { float t = 0.f;
#pragma unroll
            for (int w = 0; w < 8; ++w) t += red[w * 576 + i];
            const int s = i / 64, n = n0 + (i & 63); mod[(l * 9 + s) * 6144 + n] = t + bmod[l * 6144 + n]; }
    }
    __syncthreads();
}
__device__ __forceinline__ void table_items(const Ctx& F) {
    const int gt = (F.vcu * NTHR) + F.tid, NT_ = F.G * NTHR;
    float* ra = (float*)(F.ws + O_ROPEA); float* rb = (float*)(F.ws + O_ROPEB);
    for (int i = gt; i < 1024; i += NT_) { const int pos = i >> 4, f = i & 15; const float fr = powf(10000.0f, -(float)(2 * f) / 32.0f); const float ang = (float)pos * fr; ra[i] = cosf(ang); ra[1024 + i] = sinf(ang); }
    for (int i = gt; i < 512; i += NT_) { const int pos = i >> 3, f = i & 7; const float fr = powf(10000.0f, -(float)(2 * f) / 16.0f); const float ang = (float)pos * fr; rb[i] = cosf(ang); rb[512 + i] = sinf(ang); }
    bf16* DN = (bf16*)(F.ws + O_DN); bf16* DN2 = (bf16*)(F.ws + O_DN256); bf16* DC = (bf16*)(F.ws + O_DFTC);
    { const float sc = 0.022097086912079608f;
      for (int i = gt; i < 2048 * 2048 / 2; i += NT_) { const int n = i >> 10, k = (i & 1023) * 2; float s0, c0, s1, c1;
          sincospif((float)((n * k) & 2047) * (1.0f / 1024.0f), &s0, &c0); sincospif((float)((n * (k + 1)) & 2047) * (1.0f / 1024.0f), &s1, &c1);
          *(unsigned*)(DN + (size_t)n * 4096 + k) = cvtpk(c0 * sc, c1 * sc); *(unsigned*)(DN + (size_t)n * 4096 + 2048 + k) = cvtpk(-s0 * sc, -s1 * sc); } }
    { const float sc = 0.0625f;
      for (int i = gt; i < 256 * 256; i += NT_) { const int n = i >> 8, k = i & 255; float s0, c0; sincospif((float)((n * k) & 255) * (1.0f / 128.0f), &s0, &c0);
          DN2[n * 512 + k] = (bf16)(cvtpk(c0 * sc, 0.f) & 0xffff); DN2[n * 512 + 256 + k] = (bf16)(cvtpk(-s0 * sc, 0.f) & 0xffff); } }
    { const float sc = 0.08838834764831845f;
      for (int i = gt; i < 256 * 128; i += NT_) { const int r = i >> 7, k = i & 127; float s0, c0; sincospif((float)(((r & 127) * k) & 127) * (1.0f / 64.0f), &s0, &c0);
          DC[i] = (bf16)(cvtpk((r < 128 ? c0 : s0) * sc, 0.f) & 0xffff); } }
}
__device__ __forceinline__ void convert_weights_main(const Ctx& F, KP kp, int l) {
    int base = 0;
    run_xjob(F, base, kin(kp, 8) + (size_t)l * 1024 * INW, INW, nullptr, (bf16*)(F.ws + O_WIN), 1024, 0, M_WIN, 1024, NINP);
    run_xjob(F, base, kin(kp, 13) + (size_t)l * 384 * 768, 768, kin(kp, 11) + l * 384, (bf16*)(F.ws + O_WUQ), 384, 0, M_WUQ, 384, 768);
    run_xjob(F, base, kin(kp, 14) + (size_t)l * 256 * 1024, 1024, kin(kp, 12) + l * 256, (bf16*)(F.ws + O_WUKV), 256, 0, M_WUKV, 256, 1024);
    run_xjob(F, base, kin(kp, 20) + (size_t)l * 512 * 1024, 1024, nullptr, (bf16*)(F.ws + O_WBR), 1536, 0, M_NAT, 512, 1024);
    run_xjob(F, base, kin(kp, 21) + (size_t)l * 512 * 1024, 1024, nullptr, (bf16*)(F.ws + O_WBR), 1536, 512, M_NAT, 512, 1024);
    run_xjob(F, base, kin(kp, 22) + (size_t)l * 512 * 1024, 1024, nullptr, (bf16*)(F.ws + O_WBR), 1536, 1024, M_NAT, 512, 1024);
    run_xjob(F, base, kin(kp, 23) + (size_t)l * 1024 * 1024, 1024, nullptr, (bf16*)(F.ws + O_WOUT), 1024, 0, M_NAT, 1024, 1024);
}
__device__ __forceinline__ void convert_weights_ffn(const Ctx& F, KP kp, int l) {
    int base = 0;
    run_xjob(F, base, kin(kp, 24) + (size_t)l * 1024 * 2 * FFH, 2 * FFH, nullptr, (bf16*)(F.ws + O_WFI), 1024, 0, M_FFI, 1024, 2 * FFH);
    run_xjob(F, base, kin(kp, 25) + (size_t)l * FFH * 1024, 1024, nullptr, (bf16*)(F.ws + O_WFO), FFH, 0, M_NAT, FFH, 1024);
}

struct F1Sched {
    int nb_tok, G, c, row0, rows_per_b, nunits; const char* A; const char* PF;
    __device__ __forceinline__ bool next(int i, Unit& u) const {
        const long L = (long)i * G + c; if (L >= nunits) return false;
        const int j = (int)L % nb_tok, bg = (int)L / nb_tok, gch = bg & 3, b = bg >> 2;
        u.pm = b * 4 + gch; u.pn = j; u.kb = 0; u.A = A; u.B = PF + ((size_t)(row0 + b * rows_per_b + j * 256) * 512 + gch * 128) * 2; return true;
    }
};
struct F2Sched {
    int nM, G, c, row0, rows_per_b, nunits; const char* DN; const char* ZT; size_t K2;
    __device__ __forceinline__ bool next(int i, Unit& u) const {
        const long L = (long)i * G + c; if (L >= nunits) return false;
        const int pn = (int)L & 1, r = (int)L >> 1, pm = r % nM, b = r / nM;
        u.pm = (row0 + b * rows_per_b) / 256 + pm; u.pn = pn; u.kb = 0;
        u.A = DN + (size_t)pm * 256 * K2 * 2; u.B = ZT + ((size_t)b * 512 + pn * 256) * K2 * 2; return true;
    }
};

#ifndef DIAG_SUB
#define DIAG_SUB -1
#endif
#define SUB_ON(k) (DIAG_SUB < 0 || DIAG_SUB == (k))
#ifndef DIAG_PART
#define DIAG_PART 0xffff
#endif
#define PART_ON(b) ((DIAG_PART & (b)) != 0)
__global__ void __launch_bounds__(NTHR, 2) fwd_kernel(Args args) {
    extern __shared__ __attribute__((aligned(16))) unsigned char lds_raw[];
    const int c = (int)blockIdx.x, G = (int)gridDim.x;
#if !MK_MULTI
    cg::grid_group grid = cg::this_grid();
    if (threadIdx.x < 2) ((volatile LAS unsigned*)((LAS unsigned char*)lds_raw + LDS_MISC))[threadIdx.x] = 0u;
    __syncthreads();
    const XcdBarrier xbar = xcd_barrier_post((unsigned*)(*(unsigned char* const __attribute__((address_space(4)))*)((KP)__builtin_amdgcn_kernarg_segment_ptr() + 216) + O_CTL) + 1024, (volatile LAS unsigned*)((LAS unsigned char*)lds_raw + LDS_MISC));
#define GRID_SYNC(first) do { if (first) grid.sync(); else xcd_barrier(xbar); } while (0)
#else
#define GRID_SYNC(first) do {} while (0)
#endif
    for (int ph = args.ph_lo; ph < args.ph_hi; ++ph) {
        KP kp = (KP)__builtin_amdgcn_kernarg_segment_ptr(); asm volatile("" : "+s"(kp));
        int tid_ = threadIdx.x; asm volatile("" : "+v"(tid_));
        Ctx F; F.lds = (LAS unsigned char*)lds_raw; F.tid = tid_; F.lane = tid_ & 63; F.wave = __builtin_amdgcn_readfirstlane(tid_ >> 6);
        F.G = G; F.vcu = (G % 8 == 0) ? (c % 8) * (G / 8) + c / 8 : c;
        unsigned char* ws = kws(kp); F.ws = ws; float* const outp = kout(kp);
        const float* mod = (const float*)(ws + O_MOD);
        const float* ropeA = (const float*)(ws + O_ROPEA); const float* ropeB = (const float*)(ws + O_ROPEB);
        float* stat_cq = (float*)(ws + O_STATCQ); float* stat_ckv = (float*)(ws + O_STATCKV);
        bf16* HB = (bf16*)(ws + O_HB); bf16* PF = (bf16*)(ws + O_PF); bf16* QA = (bf16*)(ws + O_QA); bf16* QBN = (bf16*)(ws + O_QBN); bf16* QBR = (bf16*)(ws + O_QBR);
        bf16* CQ = (bf16*)(ws + O_CQ); bf16* CKV = (bf16*)(ws + O_CKV); bf16* KA = (bf16*)(ws + O_KA); bf16* VA = (bf16*)(ws + O_VA); bf16* KB = (bf16*)(ws + O_KB); bf16* VB = (bf16*)(ws + O_VB);
        bf16* GT = (bf16*)(ws + O_G); bf16* ACT = (bf16*)(ws + O_G); bf16* MB = HB; bf16* YC = PF;
        float* XC = (float*)(ws + O_XC);
        if (ph == 0) { if (SUB_ON(10))
            { mod_items(F, kp); table_items(F); convert_weights_main(F, kp, 0); }
        } else {
            const int l = (ph - 1) / 10, sub = (ph - 1) % 10;
            const bool L1 = (l == 1);
            const int nMt = L1 ? 64 : 72;
            const float* xin_lat = L1 ? outp : kin(kp, 0); const float* xin_ctx = L1 ? XC : kin(kp, 2);
            const float* mod_l = mod + (size_t)l * 9 * 6144;
            bf16* ZT = L1 ? (bf16*)(ws + O_ZT1) : (bf16*)outp; bf16* ZTC = (bf16*)outp + (size_t)8 * 512 * 4096;
            switch (sub) {
            case 0: if (SUB_ON(0)) {
                if (L1) convert_weights_main(F, kp, 1);
                norm_pass(F, xin_lat, xin_ctx, HB, kin(kp, 6) + l * 1024, mod_l, 0, MT);
            } break;
            case 1: if (SUB_ON(1)) {
                EpiIn E{QA, KA, VA, CQ, CKV, KB, PF, GT, stat_cq, stat_ckv, kin(kp, 9) + l * 64, kin(kp, 10) + l * 64, kin(kp, 18) + l * 32, kin(kp, 19) + l * 3072, ropeA, ropeB};
                const Gemm g{1024, 1024, 1024};
                RectSched S{L1 ? 64 : 72, 8, 0, G, c, 1, ~0ull, (const char*)HB, 0, 0, (const char*)(ws + O_WIN), (size_t)256 * 1024 * 2, (size_t)256 * 1024 * 2, 0};
                pg8::gemm_phase(F.lds, g, S, E);
                if (L1) { RectSched S2{8, 3, 64, G, c, 1, 0x542ull, (const char*)HB, 0, 0, (const char*)(ws + O_WIN), (size_t)256 * 1024 * 2, (size_t)256 * 1024 * 2, 0};
                    pg8::gemm_phase(F.lds, g, S2, E); }
            } break;
            case 2: if (SUB_ON(2)) {
                if (PART_ON(1)) { EpiUq E{QBN, QBR, stat_cq, kin(kp, 15) + l * 64, kin(kp, 17) + l * 32, ropeB}; const Gemm g{384, 384, 384};
                  RectSched S{L1 ? 64 : 72, 3, 0, G, c, 1, ~0ull, (const char*)CQ, 0, 0, (const char*)(ws + O_WUQ), (size_t)256 * 384 * 2, (size_t)256 * 384 * 2, 0};
                  pg8::gemm_phase(F.lds, g, S, E); }
                if (PART_ON(2)) { EpiUkv E{KB, VB, stat_ckv, kin(kp, 16) + l * 64}; const Gemm g{256, 256, 256};
                  RectSched S{72, 4, 0, G, c, 1, ~0ull, (const char*)CKV, 0, 0, (const char*)(ws + O_WUKV), (size_t)256 * 256 * 2, (size_t)256 * 256 * 2, 0};
                  pg8::gemm_phase(F.lds, g, S, E); }
                if (PART_ON(4)) { EpiF1 E{ZT, 2048}; const Gemm g{128, 512, 128};
                  F1Sched S{8, G, c, 0, 2048, 256, (const char*)(ws + O_DFTC), (const char*)PF};
                  pg8::gemm_phase(F.lds, g, S, E); }
                if (PART_ON(8) && !L1) { EpiF1 E{ZTC, 256}; const Gemm g{128, 512, 128};
                  F1Sched S{1, G, c, ML, 256, 32, (const char*)(ws + O_DFTC), (const char*)PF};
                  pg8::gemm_phase(F.lds, g, S, E); }
            } break;
            case 3: if (SUB_ON(3)) {
                LAS unsigned char* shm = F.lds;
                for (int i = 0;; ++i) {
                    const int L = i * G + c; if (L >= 512) break; const int qb = L & 7, h = (L >> 3) & 7, b = L >> 6;
                    const size_t row0 = (size_t)b * SEQ + qb * 256; const size_t key0 = (size_t)b * NKEY;
                    att::attn_unit<64>(QA + row0 * 512 + h * 64, 512, nullptr, 0, KA + key0 * 128 + (h >> 2) * 64, 128, VA + key0 * 128 + (h >> 2) * 64, 128, QA + row0 * 512 + h * 64, 512, NKEY / 64, shm);
                }
                for (int i = 0;; ++i) {
                    const int L = i * G + c; if (L >= 512) break; const int qb = L & 7, h = (L >> 3) & 7, b = L >> 6;
                    const size_t row0 = (size_t)b * SEQ + qb * 256; const size_t key0 = (size_t)b * NKEY;
                    att::attn_unit<96>(QBN + row0 * 512 + h * 64, 512, QBR + row0 * 256 + h * 32, 256, KB + key0 * 768 + h * 96, 768, VB + key0 * 512 + h * 64, 512, QBN + row0 * 512 + h * 64, 512, NKEY / 64, shm);
                }
                if (!L1) {
                    for (int i = 0;; ++i) {
                        const int L = i * G + c; if (L >= 128) break; const int h = L & 7, b = (L >> 3) & 7; const bool mla = L >= 64;
                        const size_t row0 = (size_t)ML + b * CTX; const size_t key0 = (size_t)b * NKEY;
                        if (!mla) att::attn_unit<64>(QA + row0 * 512 + h * 64, 512, nullptr, 0, KA + key0 * 128 + (h >> 2) * 64, 128, VA + key0 * 128 + (h >> 2) * 64, 128, QA + row0 * 512 + h * 64, 512, CTX / 64, shm);
                        else att::attn_unit<96>(QBN + row0 * 512 + h * 64, 512, QBR + row0 * 256 + h * 32, 256, KB + key0 * 768 + h * 96, 768, VB + key0 * 512 + h * 64, 512, QBN + row0 * 512 + h * 64, 512, CTX / 64, shm);
                    }
                }
                { EpiStore E{YC, 512}; const Gemm g{4096, 4096, 4096};
                  F2Sched S{8, G, (c + 128) % G, 0, 2048, 128, (const char*)(ws + O_DN), (const char*)ZT, 4096};
                  pg8::gemm_phase(F.lds, g, S, E); }
                if (!L1) { EpiStore E{YC, 512}; const Gemm g{512, 512, 512};
                  F2Sched S{1, G, c, ML, 256, 16, (const char*)(ws + O_DN256), (const char*)ZTC, 512};
                  pg8::gemm_phase(F.lds, g, S, E); }
            } break;
            case 4: if (SUB_ON(4)) {
                EpiIn E{QA, KA, VA, CQ, CKV, KB, PF, GT, stat_cq, stat_ckv, kin(kp, 9) + l * 64, kin(kp, 10) + l * 64, kin(kp, 18) + l * 32, kin(kp, 19) + l * 3072, ropeA, ropeB};
                const Gemm g{1024, 1024, 1024};
                RectSched S{nMt, 12, 0, G, c, 1, ~0ull, (const char*)HB, 0, 0, (const char*)(ws + O_WIN) + (size_t)8 * 256 * 1024 * 2, (size_t)256 * 1024 * 2, (size_t)256 * 1024 * 2, 0};
                struct PnShift { RectSched s; __device__ __forceinline__ bool next(int i, Unit& u) const { if (!s.next(i, u)) return false; u.pn += 8; return true; } } S8{S};
                pg8::gemm_phase(F.lds, g, S8, E);
            } break;
            case 5: if (SUB_ON(5)) {
                EpiMerge E{GT, MB}; const Gemm g{512, 1536, 512};
                RectSched S{nMt, 4, 0, G, c, 3, ~0ull, (const char*)QA, (size_t)((const char*)QBN - (const char*)QA), (size_t)((const char*)YC - (const char*)QA), (const char*)(ws + O_WBR), (size_t)256 * 512 * 2, (size_t)256 * 1536 * 2, (size_t)512 * 2};
                pg8::gemm_phase(F.lds, g, S, E);
            } break;
            case 6: if (SUB_ON(6)) {
                EpiRes E{xin_lat, xin_ctx, outp, XC, mod_l + 2048}; const Gemm g{1024, 1024, 1024};
                RectSched S{nMt, 4, 0, G, c, 1, ~0ull, (const char*)MB, 0, 0, (const char*)(ws + O_WOUT), (size_t)256 * 1024 * 2, (size_t)256 * 1024 * 2, 0};
                pg8::gemm_phase(F.lds, g, S, E);
            } break;
            case 7: if (SUB_ON(7)) {
                convert_weights_ffn(F, kp, l);
                norm_pass(F, outp, XC, HB, kin(kp, 7) + l * 1024, mod_l, 3072, L1 ? ML : MT);
            } break;
            case 8: if (SUB_ON(8)) {
                EpiSwiglu E{ACT}; const Gemm g{1024, 1024, 1024};
                RectSched S{nMt, 22, 0, G, c, 1, ~0ull, (const char*)HB, 0, 0, (const char*)(ws + O_WFI), (size_t)256 * 1024 * 2, (size_t)256 * 1024 * 2, 0};
                pg8::gemm_phase(F.lds, g, S, E);
            } break;
            case 9: if (SUB_ON(9)) {
                EpiRes E{outp, XC, outp, XC, mod_l + 5120}; const Gemm g{FFH, FFH, FFH};
                RectSched S{nMt, 4, 0, G, c, 1, ~0ull, (const char*)ACT, 0, 0, (const char*)(ws + O_WFO), (size_t)256 * FFH * 2, (size_t)256 * FFH * 2, 0};
                pg8::gemm_phase(F.lds, g, S, E);
            } break;
            }
        }
        if (ph + 1 < args.ph_hi) { GRID_SYNC(ph == 0); }
    }
}

extern "C" void kernel_launch(void* const* d_in, const int* in_sizes, int n_in, void* d_out, int out_size, void* d_ws, size_t ws_size, hipStream_t stream) {
    static int grid = 0;
    if (grid == 0) {
        if (n_in != 26 || out_size != ML * DM || ws_size < O_END) { fprintf(stderr, "kernel_launch: unexpected shapes (n_in %d out %d ws %zu)\n", n_in, out_size, ws_size); grid = -1; return; }
        int dev = 0, cus = 0, per_cu = 0;
        hipGetDevice(&dev); hipDeviceGetAttribute(&cus, hipDeviceAttributeMultiprocessorCount, dev);
        if (hipFuncSetAttribute((const void*)fwd_kernel, hipFuncAttributeMaxDynamicSharedMemorySize, LDS_BYTES) != hipSuccess) { fprintf(stderr, "kernel_launch: hipFuncSetAttribute failed\n"); grid = -1; return; }
        hipOccupancyMaxActiveBlocksPerMultiprocessor(&per_cu, (const void*)fwd_kernel, NTHR, LDS_BYTES);
        if (per_cu < 1) { fprintf(stderr, "kernel_launch: occupancy query says %d blocks/CU\n", per_cu); per_cu = 1; }
        (void)hipGetLastError();
        grid = cus;
        if (grid > 256) grid = 256;
    }
    if (grid < 0) return;
    (void)hipMemsetAsync((char*)d_ws + O_CTL, 0, CTL_ZERO_BYTES, stream);
    Args a{};
    for (int i = 0; i < 26; ++i) a.in[i] = (const float*)d_in[i];
    a.out = (float*)d_out; a.ws = (unsigned char*)d_ws;
#if MK_MULTI
    for (int ph = 0; ph < NPHASE; ++ph) { a.ph_lo = ph; a.ph_hi = ph + 1; hipLaunchKernelGGL(fwd_kernel, dim3(grid), dim3(NTHR), LDS_BYTES, stream, a); }
#else
    a.ph_lo = 0; a.ph_hi = NPHASE;
    void* kargs[] = {&a};
    hipError_t e = hipLaunchCooperativeKernel((const void*)fwd_kernel, dim3(grid), dim3(NTHR), kargs, LDS_BYTES, stream);
    if (e != hipSuccess) fprintf(stderr, "cooperative launch failed: %s (grid %d)\n", hipGetErrorString(e), grid);
#endif
}
```

```cpp
#include <hip/hip_runtime.h>
#include <hip/hip_cooperative_groups.h>
#include <cstdint>
#include <cstdio>
namespace cg = cooperative_groups;

#ifndef MK_MULTI
#define MK_MULTI 0
#endif

#define LAS __attribute__((address_space(3)))
typedef unsigned short bf16;
typedef short bf16x8 __attribute__((ext_vector_type(8)));
typedef short s16x4 __attribute__((ext_vector_type(4)));
typedef float f32x2 __attribute__((ext_vector_type(2)));
typedef float f32x4 __attribute__((ext_vector_type(4)));
typedef float f32x16 __attribute__((ext_vector_type(16)));
typedef unsigned u32x2 __attribute__((ext_vector_type(2)));
typedef unsigned u32x4 __attribute__((ext_vector_type(4)));
typedef __bf16 bf16x2_t __attribute__((ext_vector_type(2)));

constexpr int DM = 1024, NB = 8, SEQ = 2048, CTX = 256, NKEY = CTX + SEQ;
constexpr int ML = NB * SEQ, MC = NB * CTX, MT = ML + MC;
constexpr int INW = 5024, NINP = 5120;
constexpr int FFH = 2816;
constexpr float EPS = 1e-6f;
constexpr float LOG2E = 1.4426950408889634f;
constexpr float C2A = 0.125f * LOG2E;
constexpr float C2B = 0.10206207261596577f * LOG2E;
constexpr int NWAVES = 8, NTHR = 512;

constexpr size_t MiB = 1u << 20, KiB = 1024;
constexpr size_t O_CTL = 0;
constexpr size_t O_MOD = 256 * KiB;
constexpr size_t O_ROPEA = 704 * KiB;
constexpr size_t O_ROPEB = 712 * KiB;
constexpr size_t O_STATCQ = 1 * MiB;
constexpr size_t O_STATCKV = O_STATCQ + (size_t)MT * 8 * 4;
constexpr size_t O_DN = 2 * MiB;
constexpr size_t O_DN256 = O_DN + 16 * MiB;
constexpr size_t O_DFTC = O_DN256 + 256 * KiB;
constexpr size_t O_W = O_DN + 16 * MiB + 512 * KiB;
constexpr size_t O_WIN = O_W;
constexpr size_t O_WUQ = O_WIN + (size_t)NINP * 1024 * 2;
constexpr size_t O_WUKV = O_WUQ + 768 * 384 * 2;
constexpr size_t O_WBR = O_WUKV + 1024 * 256 * 2;
constexpr size_t O_WOUT = O_WBR + 1024 * 1536 * 2;
constexpr size_t O_XC = O_W + 16 * MiB + 256 * KiB;
constexpr size_t O_HB = O_XC + 8 * MiB;
constexpr size_t O_PF = O_HB + 36 * MiB;
constexpr size_t O_QA = O_PF + 18 * MiB;
constexpr size_t O_QBN = O_QA + 18 * MiB;
constexpr size_t O_QBR = O_QBN + 18 * MiB;
constexpr size_t O_WFI = O_QA;
constexpr size_t O_WFO = O_WFI + (size_t)5632 * 1024 * 2;
constexpr size_t O_G = O_QBR + 9 * MiB;
constexpr size_t O_CQ = O_G;
constexpr size_t O_CKV = O_CQ + (size_t)MT * 384 * 2;
constexpr size_t O_KA = O_CKV + (size_t)MT * 256 * 2;
constexpr size_t O_VA = O_KA + (size_t)NB * NKEY * 128 * 2;
constexpr size_t O_KB = O_VA + (size_t)NB * NKEY * 128 * 2;
constexpr size_t O_VB = O_KB + (size_t)NB * NKEY * 768 * 2;
constexpr size_t O_ZT1 = O_VB + (size_t)NB * NKEY * 512 * 2;
constexpr size_t O_END = O_ZT1 + 32 * MiB;
static_assert(O_END <= 256 * MiB, "d_ws map exceeds 256 MiB");
static_assert(O_WOUT + 2 * MiB <= O_XC, "W region");
static_assert(O_WFO + (size_t)1024 * 2816 * 2 <= O_G, "ffn weights overlay");
static_assert(O_G + (size_t)MT * 3072 * 2 <= O_END, "gates overlay");
static_assert(O_DFTC + 64 * KiB <= O_W, "dft region");
static_assert(O_STATCKV + (size_t)MT * 4 * 4 <= O_DN, "stats region");

__device__ __forceinline__ unsigned cvtpk(float lo, float hi) { f32x2 v = {lo, hi}; bf16x2_t b = __builtin_convertvector(v, bf16x2_t); return __builtin_bit_cast(unsigned, b); }
__device__ __forceinline__ u32x2 pk4(f32x4 v) { u32x2 r; r.x = cvtpk(v[0], v[1]); r.y = cvtpk(v[2], v[3]); return r; }
__device__ __forceinline__ float bf2f(unsigned short h) { return __uint_as_float((unsigned)h << 16); }
__device__ __forceinline__ f32x4 unpk4(u32x2 w) { f32x4 r; r[0] = __uint_as_float(w.x << 16); r[1] = __uint_as_float(w.x & 0xffff0000u); r[2] = __uint_as_float(w.y << 16); r[3] = __uint_as_float(w.y & 0xffff0000u); return r; }
__device__ __forceinline__ float wave_sum(float v) {
#pragma unroll
    for (int o = 1; o < 64; o <<= 1) v += __shfl_xor(v, o);
    return v;
}
__device__ __forceinline__ float fq_sum(float v) { v += __shfl_xor(v, 16); v += __shfl_xor(v, 32); return v; }
__device__ __forceinline__ float sigmoidf_(float x) { return __builtin_amdgcn_rcpf(1.0f + __expf(-x)); }

namespace pg8 {
constexpr int BM = 256, BK = 64, HALF = 128, HTB = HALF * BK * 2, STAGE_BYTES = 8 * HTB, NXCD = 8, WGM = 8;
__host__ __device__ __forceinline__ int lds_byte(int r, int c) { const int st = (r >> 4) * 2 + (c >> 5), rr = r & 15, cc = c & 31, ob = rr * 64 + cc * 2; return st * 1024 + (ob ^ (((ob >> 9) & 1) << 5)); }
__host__ __device__ __forceinline__ void stage_rc(int b, int& R, int& C) { const int st = b / 1024, sb = b % 1024, swz = sb ^ (((sb >> 9) & 1) << 5); R = (st >> 1) * 16 + swz / 64; C = (st & 1) * 32 + (swz % 64) / 2; }

struct Unit { int pm, pn, kb; const char* A; const char* B; };
struct Gemm { int lda, ldb, K; };

__device__ __forceinline__ void tile_order(int L, int nM, int nN, int& pm, int& pn) {
    const int nwg = nM * nN; int wgid = L;
    { const int q = nwg / NXCD, r = nwg % NXCD, xcd = wgid % NXCD, off = wgid / NXCD; wgid = (xcd < r ? xcd * (q + 1) : r * (q + 1) + (xcd - r) * q) + off; }
    const int nig = WGM * nN, gid = wgid / nig, fm = gid * WGM, gsz = (nM - fm) < WGM ? (nM - fm) : WGM;
    pm = fm + ((wgid % nig) % gsz); pn = (wgid % nig) / gsz;
}

template <class Epi, class Sched>
__device__ __forceinline__ void gemm_phase(LAS unsigned char* lds, const Gemm g, const Sched& S, const Epi& E) {
    int tid = threadIdx.x; asm volatile("" : "+v"(tid));
    const int wid = __builtin_amdgcn_readfirstlane(tid >> 6), lane = tid & 63, wr = wid >> 2, wc = wid & 3, fr = lane & 15, fq = lane >> 4;
    int nt = g.K / BK; asm volatile("" : "+s"(nt));
    unsigned voffA, voffB;
    { int R, C; stage_rc(tid * 16, R, C); voffA = (unsigned)(R * g.lda + C) * 2u; voffB = (unsigned)(R * g.ldb + C) * 2u; }
    const size_t pieceA = (size_t)64 * g.lda * 2, pieceB = (size_t)64 * g.ldb * 2;
    const size_t kstep = (size_t)(BK * 2);
    const size_t hstepA = (size_t)HALF * g.lda * 2, hstepB = (size_t)HALF * g.ldb * 2;
    const unsigned ldsw = (unsigned)wid * 1024u;
    const int aoff = lds_byte(wr * 64 + fr, fq * 8), boff = lds_byte(wc * 32 + fr, fq * 8);
#define PG8_SA(b, h) (((b) * 2 + (h)) * HTB)
#define PG8_SB(b, h) ((4 + (b) * 2 + (h)) * HTB)
#define PG8_STAGE_A(bufoff, gbase) do { _Pragma("unroll") for (int _i = 0; _i < 2; ++_i) \
        __builtin_amdgcn_global_load_lds((const unsigned*)((const char*)(gbase) + _i * pieceA + voffA), (LAS unsigned*)(lds + (bufoff) + ldsw + _i * 8192), 16, 0, 0); } while (0)
#define PG8_STAGE_B(bufoff, gbase) do { _Pragma("unroll") for (int _i = 0; _i < 2; ++_i) \
        __builtin_amdgcn_global_load_lds((const unsigned*)((const char*)(gbase) + _i * pieceB + voffB), (LAS unsigned*)(lds + (bufoff) + ldsw + _i * 8192), 16, 0, 0); } while (0)
#define PG8_LDA(dst, b, h) do { _Pragma("unroll") for (int m = 0; m < 4; ++m) _Pragma("unroll") for (int k = 0; k < 2; ++k) dst[m][k] = *(const LAS bf16x8*)(lds + PG8_SA(b, h) + aoff + m * 2048 + k * 1024); } while (0)
#define PG8_LDB(dst, b, h) do { _Pragma("unroll") for (int n = 0; n < 2; ++n) _Pragma("unroll") for (int k = 0; k < 2; ++k) dst[n][k] = *(const LAS bf16x8*)(lds + PG8_SB(b, h) + boff + n * 2048 + k * 1024); } while (0)
#define PG8_MMA(ai, bj, At, Bt) do { __builtin_amdgcn_s_setprio(1); _Pragma("unroll") for (int m = 0; m < 4; ++m) _Pragma("unroll") for (int n = 0; n < 2; ++n) _Pragma("unroll") for (int k = 0; k < 2; ++k) \
        acc[ai][bj][m][n] = __builtin_amdgcn_mfma_f32_16x16x32_bf16(Bt[n][k], At[m][k], acc[ai][bj][m][n], 0, 0, 0); __builtin_amdgcn_s_setprio(0); } while (0)
#define PG8_WAIT_V(n) asm volatile("s_waitcnt vmcnt(" #n ")" ::: "memory")
#define PG8_WAIT_L(n) asm volatile("s_waitcnt lgkmcnt(" #n ")" ::: "memory")
#define PG8_BAR __builtin_amdgcn_s_barrier()
#define PG8_SCHED __builtin_amdgcn_sched_barrier(0)
    Unit cur, nxt; int ui = 0;
    if (!S.next(0, cur)) return;
    f32x4 acc[2][2][4][2];
#pragma unroll
    for (int a = 0; a < 2; ++a)
#pragma unroll
        for (int b = 0; b < 2; ++b)
#pragma unroll
            for (int m = 0; m < 4; ++m)
#pragma unroll
                for (int n = 0; n < 2; ++n) acc[a][b][m][n] = (f32x4){0.f, 0.f, 0.f, 0.f};
    bf16x8 At[4][2], B0[2][2], B1[2][2];
    const char* cA = cur.A; const char* cB = cur.B;
    PG8_STAGE_B(PG8_SB(0, 0), cB); PG8_STAGE_B(PG8_SB(0, 1), cB + hstepB); PG8_STAGE_A(PG8_SA(0, 0), cA); PG8_STAGE_A(PG8_SA(0, 1), cA + hstepA);
    if (wr == 1) PG8_BAR;
    PG8_WAIT_V(2); PG8_BAR;
    PG8_STAGE_B(PG8_SB(1, 0), cB + kstep); PG8_STAGE_A(PG8_SA(1, 0), cA + kstep); PG8_STAGE_B(PG8_SB(1, 1), cB + hstepB + kstep);
    PG8_WAIT_V(6); PG8_BAR;
    for (;;) {
        const bool has_next = S.next(ui + 1, nxt);
        const char* nA = has_next ? nxt.A : cA; const char* nB = has_next ? nxt.B : cB;
        for (int t = 0; t < nt; t += 2) {
            const bool last = (t == nt - 2);
            const char* a1 = cA + (size_t)(t + 1) * kstep;
            const char* a2 = last ? nA : cA + (size_t)(t + 2) * kstep; const char* b2 = last ? nB : cB + (size_t)(t + 2) * kstep;
            const char* a3 = a2 + kstep; const char* b3 = b2 + kstep;
            PG8_LDB(B0, 0, 0); PG8_LDB(B1, 0, 1); PG8_SCHED; PG8_LDA(At, 0, 0); PG8_STAGE_A(PG8_SA(1, 1), a1 + hstepA);
            PG8_WAIT_V(8); PG8_WAIT_L(0); PG8_BAR; PG8_MMA(0, 0, At, B0); PG8_MMA(0, 1, At, B1); PG8_BAR; PG8_SCHED;
            PG8_LDA(At, 0, 1); PG8_STAGE_B(PG8_SB(0, 0), b2); PG8_STAGE_B(PG8_SB(0, 1), b2 + hstepB); PG8_STAGE_A(PG8_SA(0, 0), a2);
            PG8_WAIT_V(8); PG8_WAIT_L(0); PG8_BAR; PG8_MMA(1, 0, At, B0); PG8_MMA(1, 1, At, B1); PG8_BAR; PG8_SCHED;
            PG8_LDB(B0, 1, 0); PG8_LDB(B1, 1, 1); PG8_SCHED; PG8_LDA(At, 1, 0); PG8_STAGE_A(PG8_SA(0, 1), a2 + hstepA);
            PG8_WAIT_V(8); PG8_WAIT_L(0); PG8_BAR; PG8_MMA(0, 0, At, B0); PG8_MMA(0, 1, At, B1); PG8_BAR; PG8_SCHED;
            PG8_LDA(At, 1, 1); PG8_STAGE_B(PG8_SB(1, 0), b3); PG8_STAGE_B(PG8_SB(1, 1), b3 + hstepB); PG8_STAGE_A(PG8_SA(1, 0), a3);
            PG8_WAIT_V(8); PG8_WAIT_L(0); PG8_BAR; PG8_MMA(1, 0, At, B0); PG8_MMA(1, 1, At, B1); PG8_BAR; PG8_SCHED;
        }
        if (wr == 0) PG8_BAR;
        const bool carry = E(acc, cur, wr, wc, fr, fq);
        if (!has_next) break;
        if (!carry) {
#pragma unroll
            for (int a = 0; a < 2; ++a)
#pragma unroll
                for (int b = 0; b < 2; ++b)
#pragma unroll
                    for (int m = 0; m < 4; ++m)
#pragma unroll
                        for (int n = 0; n < 2; ++n) acc[a][b][m][n] = (f32x4){0.f, 0.f, 0.f, 0.f};
        }
        cur = nxt; cA = nA; cB = nB; ++ui;
        if (wr == 1) PG8_BAR;
    }
    PG8_WAIT_V(0);
    PG8_BAR;
#undef PG8_SA
#undef PG8_SB
#undef PG8_STAGE_A
#undef PG8_STAGE_B
#undef PG8_LDA
#undef PG8_LDB
#undef PG8_MMA
#undef PG8_WAIT_V
#undef PG8_WAIT_L
#undef PG8_BAR
#undef PG8_SCHED
}
}
using pg8::Unit; using pg8::Gemm;

typedef f32x4 Acc[2][2][4][2];

struct RectSched {
    int nM, nN, pm0, G, c, nkb; unsigned long long pnmap;
    const char* A0; size_t dA1, dA2; const char* B; size_t strideAm, strideBn, strideBk;
    __device__ __forceinline__ bool next(int i, Unit& u) const {
        const int ti = i / nkb, kb = i - ti * nkb; const long L = (long)ti * G + c; if (L >= (long)nM * nN) return false;
        int pm, pn; pg8::tile_order((int)L, nM, nN, pm, pn);
        if (pnmap != ~0ull) pn = (int)((pnmap >> (4 * pn)) & 15ull);
        u.pm = pm + pm0; u.pn = pn; u.kb = kb;
        u.A = A0 + (size_t)(kb == 1) * dA1 + (size_t)(kb == 2) * dA2 + (size_t)u.pm * strideAm; u.B = B + (size_t)pn * strideBn + (size_t)kb * strideBk; return true;
    }
};

struct RowInfo { bool ctx; int b; int tok0; };
__device__ __forceinline__ RowInfo row_info(int pm) { RowInfo r; r.ctx = pm >= 64; r.b = r.ctx ? pm - 64 : pm >> 3; r.tok0 = r.ctx ? 0 : (pm & 7) * 256; return r; }

template <bool NORM>
__device__ __forceinline__ void head64(const f32x4 (&a)[2][2], const f32x4 (&g)[2][2], float scale, bool rope, int row_id, int col_id, const float* ropeA, int fq, f32x4 (&o)[2][2]) {
    f32x4 v[2][2];
    if (NORM) {
        float ss = 0.f;
#pragma unroll
        for (int bj = 0; bj < 2; ++bj)
#pragma unroll
            for (int n = 0; n < 2; ++n) { const f32x4 x = a[bj][n]; ss += (x[0] * x[0] + x[1] * x[1]) + (x[2] * x[2] + x[3] * x[3]); }
        ss = fq_sum(ss);
        const float rstd = rsqrtf(ss * (1.0f / 64.0f) + EPS);
#pragma unroll
        for (int bj = 0; bj < 2; ++bj)
#pragma unroll
            for (int n = 0; n < 2; ++n) v[bj][n] = a[bj][n] * rstd * g[bj][n];
    } else {
#pragma unroll
        for (int bj = 0; bj < 2; ++bj)
#pragma unroll
            for (int n = 0; n < 2; ++n) v[bj][n] = a[bj][n];
    }
    if (rope) {
#pragma unroll
        for (int bj = 0; bj < 2; ++bj) {
            const int pos = bj ? col_id : row_id;
            const f32x4 cs = *(const f32x4*)(ropeA + pos * 16 + 4 * fq), sn = *(const f32x4*)(ropeA + 1024 + pos * 16 + 4 * fq);
            o[bj][0] = (v[bj][0] * cs - v[bj][1] * sn) * scale; o[bj][1] = (v[bj][1] * cs + v[bj][0] * sn) * scale;
        }
    } else {
#pragma unroll
        for (int bj = 0; bj < 2; ++bj)
#pragma unroll
            for (int n = 0; n < 2; ++n) o[bj][n] = v[bj][n] * scale;
    }
}
__device__ __forceinline__ void rope32(const f32x4 (&a)[2], const float* g, float scale, bool rope, int row_id, int col_id, const float* ropeB, int fq, f32x4 (&o)[2]) {
    float ss = 0.f;
#pragma unroll
    for (int n = 0; n < 2; ++n) { const f32x4 x = a[n]; ss += (x[0] * x[0] + x[1] * x[1]) + (x[2] * x[2] + x[3] * x[3]); }
    ss = fq_sum(ss);
    const float rstd = rsqrtf(ss * (1.0f / 32.0f) + EPS);
    const int d0 = 16 * (fq >> 1) + 4 * (fq & 1);
    f32x4 v[2];
#pragma unroll
    for (int n = 0; n < 2; ++n) v[n] = a[n] * rstd * *(const f32x4*)(g + d0 + 8 * n);
    if (rope) {
        const int pos = (fq >> 1) ? col_id : row_id;
        const f32x4 cs = *(const f32x4*)(ropeB + pos * 8 + 4 * (fq & 1)), sn = *(const f32x4*)(ropeB + 512 + pos * 8 + 4 * (fq & 1));
        o[0] = (v[0] * cs - v[1] * sn) * scale; o[1] = (v[1] * cs + v[0] * sn) * scale;
    } else { o[0] = v[0] * scale; o[1] = v[1] * scale; }
}

struct EpiIn {
    bf16 *QA, *KA, *VA, *CQ, *CKV, *KB, *PF, *G; float *stat_cq, *stat_ckv;
    const float *gq, *gk, *gkr, *bgate, *ropeA, *ropeB;
    __device__ __forceinline__ bool operator()(Acc& acc, const Unit& u, int wr, int wc, int fr_, int fq_) const {
        int fr = fr_, fq = fq_; asm volatile("" : "+v"(fr), "+v"(fq));
        const RowInfo ri = row_info(u.pm); const bool rope = !ri.ctx;
        const int pn = u.pn;
        if (pn <= 2) {
            const bool isv = (pn == 2 && wc >= 2), isk = (pn == 2 && wc < 2);
            const float* gsrc = (pn < 2) ? gq : gk;
            f32x4 g[2][2];
#pragma unroll
            for (int bj = 0; bj < 2; ++bj)
#pragma unroll
                for (int n = 0; n < 2; ++n) g[bj][n] = *(const f32x4*)(gsrc + 32 * bj + 16 * n + 4 * fq);
#pragma unroll
            for (int ai = 0; ai < 2; ++ai)
#pragma unroll
                for (int m = 0; m < 4; ++m) {
                    const int rt = 128 * ai + 64 * wr + 16 * m + fr;
                    const int row_id = (ri.tok0 + 128 * ai + 64 * wr) >> 6, col_id = 16 * m + fr;
                    f32x4 a[2][2], o[2][2];
#pragma unroll
                    for (int bj = 0; bj < 2; ++bj)
#pragma unroll
                        for (int n = 0; n < 2; ++n) a[bj][n] = acc[ai][bj][m][n];
                    bf16* dst;
                    if (pn < 2) { head64<true>(a, g, C2A, rope, row_id, col_id, ropeA, fq, o); dst = QA + (size_t)(u.pm * 256 + rt) * 512 + (4 * pn + wc) * 64; }
                    else {
                        const size_t key = (size_t)ri.b * NKEY + (ri.ctx ? rt : 256 + ri.tok0 + rt);
                        if (isk) { head64<true>(a, g, 1.0f, rope, row_id, col_id, ropeA, fq, o); dst = KA + key * 128 + wc * 64; }
                        else { head64<false>(a, g, 1.0f, false, 0, 0, ropeA, fq, o); dst = VA + key * 128 + (wc - 2) * 64; }
                    }
#pragma unroll
                    for (int bj = 0; bj < 2; ++bj)
#pragma unroll
                        for (int n = 0; n < 2; ++n) *(u32x2*)(dst + 32 * bj + 16 * n + 4 * fq) = pk4(o[bj][n]);
                }
            (void)isv;
        } else if (pn == 3 || pn == 5) {
            bf16* dstb = (pn == 3) ? CQ : CKV; const int ld = (pn == 3) ? 384 : 256;
            float* st = (pn == 3) ? stat_cq : stat_ckv; const int sld = (pn == 3) ? 8 : 4;
#pragma unroll
            for (int ai = 0; ai < 2; ++ai)
#pragma unroll
                for (int m = 0; m < 4; ++m) {
                    const size_t row = (size_t)u.pm * 256 + 128 * ai + 64 * wr + 16 * m + fr; float ss = 0.f;
#pragma unroll
                    for (int bj = 0; bj < 2; ++bj)
#pragma unroll
                        for (int n = 0; n < 2; ++n) { const f32x4 x = acc[ai][bj][m][n]; ss += (x[0] * x[0] + x[1] * x[1]) + (x[2] * x[2] + x[3] * x[3]);
                            *(u32x2*)(dstb + row * ld + 128 * bj + 32 * wc + 16 * n + 4 * fq) = pk4(x); }
                    ss = fq_sum(ss);
                    if (fq == 0) st[row * sld + wc] = ss;
                }
        } else if (pn == 4) {
            f32x4 gk0[2]; (void)gk0;
#pragma unroll
            for (int ai = 0; ai < 2; ++ai)
#pragma unroll
                for (int m = 0; m < 4; ++m) {
                    const int rt = 128 * ai + 64 * wr + 16 * m + fr; const size_t row = (size_t)u.pm * 256 + rt; float ss = 0.f;
#pragma unroll
                    for (int n = 0; n < 2; ++n) { const f32x4 x = acc[ai][0][m][n]; ss += (x[0] * x[0] + x[1] * x[1]) + (x[2] * x[2] + x[3] * x[3]);
                        *(u32x2*)(CQ + row * 384 + 256 + 32 * wc + 16 * n + 4 * fq) = pk4(x); }
                    ss = fq_sum(ss);
                    if (fq == 0) stat_cq[row * 8 + 4 + wc] = ss;
                    if (wc == 0) {
                        const int row_id = (ri.tok0 + 128 * ai + 64 * wr) >> 6, col_id = 16 * m + fr;
                        f32x4 a[2], o[2]; a[0] = acc[ai][1][m][0]; a[1] = acc[ai][1][m][1];
                        rope32(a, gkr, 1.0f, rope, row_id, col_id, ropeB, fq, o);
                        const size_t key = (size_t)ri.b * NKEY + (ri.ctx ? rt : 256 + ri.tok0 + rt);
                        bf16* dst = KB + key * 768 + 64 + 16 * (fq >> 1) + 4 * (fq & 1);
                        const u32x2 w0 = pk4(o[0]), w1 = pk4(o[1]);
#pragma unroll
                        for (int h = 0; h < 8; ++h) { *(u32x2*)(dst + h * 96) = w0; *(u32x2*)(dst + h * 96 + 8) = w1; }
                    }
                }
        } else if (pn < 8) {
#pragma unroll
            for (int ai = 0; ai < 2; ++ai)
#pragma unroll
                for (int m = 0; m < 4; ++m) {
                    const size_t row = (size_t)u.pm * 256 + 128 * ai + 64 * wr + 16 * m + fr;
#pragma unroll
                    for (int bj = 0; bj < 2; ++bj)
#pragma unroll
                        for (int n = 0; n < 2; ++n) *(u32x2*)(PF + row * 512 + (pn - 6) * 256 + 128 * bj + 32 * wc + 16 * n + 4 * fq) = pk4(acc[ai][bj][m][n]);
                }
        } else {
            const int c0 = (pn - 8) * 256 + 32 * wc + 4 * fq;
            f32x4 bv[2][2];
#pragma unroll
            for (int bj = 0; bj < 2; ++bj)
#pragma unroll
                for (int n = 0; n < 2; ++n) bv[bj][n] = *(const f32x4*)(bgate + c0 + 128 * bj + 16 * n);
#pragma unroll
            for (int ai = 0; ai < 2; ++ai)
#pragma unroll
                for (int m = 0; m < 4; ++m) {
                    const size_t row = (size_t)u.pm * 256 + 128 * ai + 64 * wr + 16 * m + fr;
#pragma unroll
                    for (int bj = 0; bj < 2; ++bj)
#pragma unroll
                        for (int n = 0; n < 2; ++n) { f32x4 x = acc[ai][bj][m][n] + bv[bj][n];
                            x[0] = sigmoidf_(x[0]); x[1] = sigmoidf_(x[1]); x[2] = sigmoidf_(x[2]); x[3] = sigmoidf_(x[3]);
                            *(u32x2*)(G + row * 3072 + c0 + 128 * bj + 16 * n) = pk4(x); }
                }
        }
        return false;
    }
};

struct EpiUq {
    bf16 *QBN, *QBR; const float *stat_cq, *gqn, *gqr, *ropeB;
    __device__ __forceinline__ bool operator()(Acc& acc, const Unit& u, int wr, int wc, int fr_, int fq_) const {
        int fr = fr_, fq = fq_; asm volatile("" : "+v"(fr), "+v"(fq));
        const RowInfo ri = row_info(u.pm); const bool rope = !ri.ctx;
        f32x4 g[2][2];
#pragma unroll
        for (int bj = 0; bj < 2; ++bj)
#pragma unroll
            for (int n = 0; n < 2; ++n) g[bj][n] = *(const f32x4*)(gqn + 32 * bj + 16 * n + 4 * fq);
#pragma unroll
        for (int ai = 0; ai < 2; ++ai)
#pragma unroll
            for (int m = 0; m < 4; ++m) {
                const int rt = 128 * ai + 64 * wr + 16 * m + fr; const size_t row = (size_t)u.pm * 256 + rt;
                const f32x4 s0 = *(const f32x4*)(stat_cq + row * 8), s1 = *(const f32x4*)(stat_cq + row * 8 + 4);
                const float rs = rsqrtf(((s0[0] + s0[1]) + (s0[2] + s0[3]) + (s1[0] + s1[1]) + (s1[2] + s1[3])) * (1.0f / 384.0f) + EPS);
                if (u.pn < 2) {
                    f32x4 a[2][2], o[2][2];
#pragma unroll
                    for (int bj = 0; bj < 2; ++bj)
#pragma unroll
                        for (int n = 0; n < 2; ++n) a[bj][n] = acc[ai][bj][m][n] * rs;
                    head64<true>(a, g, C2B, false, 0, 0, ropeB, fq, o);
                    bf16* dst = QBN + row * 512 + (4 * u.pn + wc) * 64;
#pragma unroll
                    for (int bj = 0; bj < 2; ++bj)
#pragma unroll
                        for (int n = 0; n < 2; ++n) *(u32x2*)(dst + 32 * bj + 16 * n + 4 * fq) = pk4(o[bj][n]);
                } else {
                    const int row_id = (ri.tok0 + 128 * ai + 64 * wr) >> 6, col_id = 16 * m + fr;
#pragma unroll
                    for (int bj = 0; bj < 2; ++bj) {
                        f32x4 a[2], o[2]; a[0] = acc[ai][bj][m][0] * rs; a[1] = acc[ai][bj][m][1] * rs;
                        rope32(a, gqr, C2B, rope, row_id, col_id, ropeB, fq, o);
                        bf16* dst = QBR + row * 256 + (4 * bj + wc) * 32 + 16 * (fq >> 1) + 4 * (fq & 1);
                        *(u32x2*)(dst) = pk4(o[0]); *(u32x2*)(dst + 8) = pk4(o[1]);
                    }
                }
            }
        return false;
    }
};

struct EpiUkv {
    bf16 *KB, *VB; const float *stat_ckv, *gkn;
    __device__ __forceinline__ bool operator()(Acc& acc, const Unit& u, int wr, int wc, int fr_, int fq_) const {
        int fr = fr_, fq = fq_; asm volatile("" : "+v"(fr), "+v"(fq));
        const RowInfo ri = row_info(u.pm);
        f32x4 g[2][2];
#pragma unroll
        for (int bj = 0; bj < 2; ++bj)
#pragma unroll
            for (int n = 0; n < 2; ++n) g[bj][n] = *(const f32x4*)(gkn + 32 * bj + 16 * n + 4 * fq);
#pragma unroll
        for (int ai = 0; ai < 2; ++ai)
#pragma unroll
            for (int m = 0; m < 4; ++m) {
                const int rt = 128 * ai + 64 * wr + 16 * m + fr; const size_t row = (size_t)u.pm * 256 + rt;
                const f32x4 s0 = *(const f32x4*)(stat_ckv + row * 4);
                const float rs = rsqrtf(((s0[0] + s0[1]) + (s0[2] + s0[3])) * (1.0f / 256.0f) + EPS);
                const size_t key = (size_t)ri.b * NKEY + (ri.ctx ? rt : 256 + ri.tok0 + rt);
                f32x4 a[2][2], o[2][2];
#pragma unroll
                for (int bj = 0; bj < 2; ++bj)
#pragma unroll
                    for (int n = 0; n < 2; ++n) a[bj][n] = acc[ai][bj][m][n] * rs;
                bf16* dst;
                if (u.pn < 2) { head64<true>(a, g, 1.0f, false, 0, 0, gkn, fq, o); dst = KB + key * 768 + (4 * u.pn + wc) * 96; }
                else { head64<false>(a, g, 1.0f, false, 0, 0, gkn, fq, o); dst = VB + key * 512 + (4 * (u.pn - 2) + wc) * 64; }
#pragma unroll
                for (int bj = 0; bj < 2; ++bj)
#pragma unroll
                    for (int n = 0; n < 2; ++n) *(u32x2*)(dst + 32 * bj + 16 * n + 4 * fq) = pk4(o[bj][n]);
            }
        return false;
    }
};

struct EpiStore {
    bf16* O; int ld;
    __device__ __forceinline__ bool operator()(Acc& acc, const Unit& u, int wr, int wc, int fr_, int fq_) const {
        int fr = fr_, fq = fq_; asm volatile("" : "+v"(fr), "+v"(fq));
#pragma unroll
        for (int ai = 0; ai < 2; ++ai)
#pragma unroll
            for (int m = 0; m < 4; ++m) {
                const size_t row = (size_t)u.pm * 256 + 128 * ai + 64 * wr + 16 * m + fr;
#pragma unroll
                for (int bj = 0; bj < 2; ++bj)
#pragma unroll
                    for (int n = 0; n < 2; ++n) *(u32x2*)(O + row * ld + u.pn * 256 + 128 * bj + 32 * wc + 16 * n + 4 * fq) = pk4(acc[ai][bj][m][n]);
            }
        return false;
    }
};

struct EpiF1 {
    bf16* ZT; int NP;
    __device__ __forceinline__ bool operator()(Acc& acc, const Unit& u, int wr, int wc, int fr_, int fq_) const {
        int fr = fr_, fq = fq_; asm volatile("" : "+v"(fr), "+v"(fq));
        const int b = u.pm >> 2, gch = u.pm & 3;
#pragma unroll
        for (int ai = 0; ai < 2; ++ai)
#pragma unroll
            for (int m = 0; m < 4; ++m) {
                const int ch = gch * 128 + 64 * wr + 16 * m + fr;
                bf16* dst = ZT + ((size_t)b * 512 + ch) * (2 * NP) + ai * NP + u.pn * 256;
#pragma unroll
                for (int bj = 0; bj < 2; ++bj)
#pragma unroll
                    for (int n = 0; n < 2; ++n) *(u32x2*)(dst + 128 * bj + 32 * wc + 16 * n + 4 * fq) = pk4(acc[ai][bj][m][n]);
            }
        return false;
    }
};

struct EpiMerge {
    const bf16* G; bf16* MB;
    __device__ __forceinline__ bool operator()(Acc& acc, const Unit& u, int wr, int wc, int fr_, int fq_) const {
        int fr = fr_, fq = fq_; asm volatile("" : "+v"(fr), "+v"(fq));
        const int kb = u.kb; const int c0 = u.pn * 256 + 32 * wc + 4 * fq;
#pragma unroll
        for (int ai = 0; ai < 2; ++ai)
#pragma unroll
            for (int m = 0; m < 4; ++m) {
                const size_t row = (size_t)u.pm * 256 + 128 * ai + 64 * wr + 16 * m + fr;
                const bf16* gp = G + row * 3072 + c0;
#pragma unroll
                for (int bj = 0; bj < 2; ++bj)
#pragma unroll
                    for (int n = 0; n < 2; ++n) {
                        const int co = 128 * bj + 16 * n;
                        if (kb < 2) { const f32x4 ga = unpk4(*(const u32x2*)(gp + kb * 1024 + co)), gb = unpk4(*(const u32x2*)(gp + (kb + 1) * 1024 + co));
                            f32x4 r; r[0] = ga[0] / gb[0]; r[1] = ga[1] / gb[1]; r[2] = ga[2] / gb[2]; r[3] = ga[3] / gb[3]; acc[ai][bj][m][n] *= r; }
                        else { const f32x4 gc = unpk4(*(const u32x2*)(gp + 2048 + co)); *(u32x2*)(MB + row * 1024 + c0 + co) = pk4(acc[ai][bj][m][n] * gc); }
                    }
            }
        return kb < 2;
    }
};

struct EpiRes {
    const float *xin_lat, *xin_ctx; float *xout_lat, *xout_ctx; const float* gate;
    __device__ __forceinline__ bool operator()(Acc& acc, const Unit& u, int wr, int wc, int fr_, int fq_) const {
        int fr = fr_, fq = fq_; asm volatile("" : "+v"(fr), "+v"(fq));
        const RowInfo ri = row_info(u.pm); const int s = ri.ctx ? 8 : ri.b;
        const int c0 = u.pn * 256 + 32 * wc + 4 * fq;
        const float* xin = ri.ctx ? xin_ctx + (size_t)(u.pm - 64) * 256 * 1024 : xin_lat + (size_t)u.pm * 256 * 1024;
        float* xout = ri.ctx ? xout_ctx + (size_t)(u.pm - 64) * 256 * 1024 : xout_lat + (size_t)u.pm * 256 * 1024;
        f32x4 gv[2][2];
#pragma unroll
        for (int bj = 0; bj < 2; ++bj)
#pragma unroll
            for (int n = 0; n < 2; ++n) gv[bj][n] = *(const f32x4*)(gate + s * 6144 + c0 + 128 * bj + 16 * n);
#pragma unroll
        for (int ai = 0; ai < 2; ++ai)
#pragma unroll
            for (int m = 0; m < 4; ++m) {
                const size_t off = (size_t)(128 * ai + 64 * wr + 16 * m + fr) * 1024 + c0;
#pragma unroll
                for (int bj = 0; bj < 2; ++bj)
#pragma unroll
                    for (int n = 0; n < 2; ++n) { const f32x4 xi = *(const f32x4*)(xin + off + 128 * bj + 16 * n); *(f32x4*)(xout + off + 128 * bj + 16 * n) = xi + gv[bj][n] * acc[ai][bj][m][n]; }
                asm volatile("" ::: "memory");
            }
        return false;
    }
};

struct EpiSwiglu {
    bf16* ACT;
    __device__ __forceinline__ bool operator()(Acc& acc, const Unit& u, int wr, int wc, int fr_, int fq_) const {
        int fr = fr_, fq = fq_; asm volatile("" : "+v"(fr), "+v"(fq));
#pragma unroll
        for (int ai = 0; ai < 2; ++ai)
#pragma unroll
            for (int m = 0; m < 4; ++m) {
                const size_t row = (size_t)u.pm * 256 + 128 * ai + 64 * wr + 16 * m + fr;
#pragma unroll
                for (int n = 0; n < 2; ++n) { const f32x4 gt = acc[ai][0][m][n], up = acc[ai][1][m][n]; f32x4 o;
                    o[0] = gt[0] * sigmoidf_(gt[0]) * up[0]; o[1] = gt[1] * sigmoidf_(gt[1]) * up[1]; o[2] = gt[2] * sigmoidf_(gt[2]) * up[2]; o[3] = gt[3] * sigmoidf_(gt[3]) * up[3];
                    *(u32x2*)(ACT + row * FFH + u.pn * 128 + 32 * wc + 16 * n + 4 * fq) = pk4(o); }
            }
        return false;
    }
};

namespace att {
constexpr int KSLOT = 12288, VSLOT = 8192;
constexpr int L_K = 0, L_V = 2 * KSLOT, L_WS = L_V + 2 * VSLOT, L_OST = L_WS + NWAVES * 64 * 4, L_BYTES = L_OST + NWAVES * 4096;
__device__ __forceinline__ int crow(int r, int hi) { return (r & 3) + 8 * (r >> 2) + 4 * hi; }
__device__ __forceinline__ float max3f(float a, float b, float c) { return __builtin_fmaxf(__builtin_fmaxf(a, b), c); }
__device__ __forceinline__ float rowmax(const f32x16& p0, const f32x16& p1) {
    float a = max3f(p0[0], p0[1], p1[0]), b = max3f(p0[2], p0[3], p1[1]); a = max3f(a, p1[2], p1[3]);
#pragma unroll
    for (int r = 4; r < 16; r += 4) { a = max3f(a, p0[r], p0[r + 1]); b = max3f(b, p0[r + 2], p0[r + 3]); a = max3f(a, p1[r], p1[r + 1]); b = max3f(b, p1[r + 2], p1[r + 3]); }
    const float m = __builtin_fmaxf(a, b);
    auto rr = __builtin_amdgcn_permlane32_swap(__float_as_uint(m), __float_as_uint(m), false, false);
    return __builtin_fmaxf(__uint_as_float(rr[0]), __uint_as_float(rr[1]));
}
__device__ __forceinline__ void pv(f32x16* o, int vb, bf16x8 pa0, bf16x8 pa1, bf16x8 pa2, bf16x8 pa3) {
#pragma unroll
    for (int d0 = 0; d0 < 2; ++d0) { s16x4 lo[4], hi[4];
#pragma unroll
        for (int ks = 0; ks < 4; ++ks) {
            asm volatile("ds_read_b64_tr_b16 %0,%1 offset:%c2" : "=&v"(lo[ks]) : "v"(vb), "i"(d0 * 4096 + ks * 1024) : "memory");
            asm volatile("ds_read_b64_tr_b16 %0,%1 offset:%c2" : "=&v"(hi[ks]) : "v"(vb), "i"(d0 * 4096 + ks * 1024 + 512) : "memory"); }
        asm volatile("s_waitcnt lgkmcnt(0)" ::: "memory"); __builtin_amdgcn_sched_barrier(0);
#define PK(k) (bf16x8){lo[k][0], lo[k][1], lo[k][2], lo[k][3], hi[k][0], hi[k][1], hi[k][2], hi[k][3]}
        o[d0] = __builtin_amdgcn_mfma_f32_32x32x16_bf16(pa0, PK(0), o[d0], 0, 0, 0);
        o[d0] = __builtin_amdgcn_mfma_f32_32x32x16_bf16(pa1, PK(1), o[d0], 0, 0, 0);
        o[d0] = __builtin_amdgcn_mfma_f32_32x32x16_bf16(pa2, PK(2), o[d0], 0, 0, 0);
        o[d0] = __builtin_amdgcn_mfma_f32_32x32x16_bf16(pa3, PK(3), o[d0], 0, 0, 0);
#undef PK
    }
}
template <int DQK>
__device__ __forceinline__ void attn_unit(const bf16* Qn, int pqn, const bf16* Qr, int pqr, const bf16* Kh, int pk, const bf16* Vh, int pv_, bf16* O, int po, int NT, LAS unsigned char* shm) {
    constexpr int ND = DQK / 16, NCH = DQK / 8;
    int tid = threadIdx.x; asm volatile("" : "+v"(tid));
    const int lane = tid & 63, r32 = lane & 31, hi = lane >> 5; const int wid = __builtin_amdgcn_readfirstlane(tid >> 6);
    LAS float* wsf = (LAS float*)(shm + L_WS) + wid * 64;
    const bf16* ksrc = Kh + (size_t)lane * pk + wid * 8;
    const bf16* vsrc = Vh + (size_t)(16 * (wid & 3) + (lane >> 2)) * pv_ + (wid >> 2) * 32 + (lane & 3) * 8;
    const int vb0 = (int)(unsigned)(uintptr_t)(shm + L_V) + ((lane >> 4) & 1) * 32 + (lane & 3) * 8 + (4 * hi + ((lane & 15) >> 2)) * 64;
    const LAS unsigned char* kp0 = shm + L_K + hi * 1024 + r32 * 16;
#define DMA_TILE(t, buf) do { \
        __builtin_amdgcn_global_load_lds((const unsigned*)(ksrc + (size_t)(t) * 64 * pk), (LAS unsigned*)(shm + L_K + (buf) * KSLOT + wid * 1024), 16, 0, 0); \
        if (NCH > 8 && wid < NCH - 8) __builtin_amdgcn_global_load_lds((const unsigned*)(ksrc + (size_t)(t) * 64 * pk + 64), (LAS unsigned*)(shm + L_K + (buf) * KSLOT + (wid + 8) * 1024), 16, 0, 0); \
        __builtin_amdgcn_global_load_lds((const unsigned*)(vsrc + (size_t)(t) * 64 * pv_), (LAS unsigned*)(shm + L_V + (buf) * VSLOT + wid * 1024), 16, 0, 0); } while (0)
    DMA_TILE(0, 0);
    bf16x8 qr[ND];
#pragma unroll
    for (int d0 = 0; d0 < 4; ++d0) qr[d0] = *(const bf16x8*)(Qn + (size_t)(wid * 32 + r32) * pqn + d0 * 16 + hi * 8);
    if (ND > 4) {
#pragma unroll
        for (int d0 = 4; d0 < ND; ++d0) qr[d0] = *(const bf16x8*)(Qr + (size_t)(wid * 32 + r32) * pqr + (d0 - 4) * 16 + hi * 8);
    }
    float mrun = -1e30f, l_reg = 0.f; f32x16 o[2]; o[0] = f32x16{}; o[1] = f32x16{};
    for (int t = 0; t < NT; ++t) {
        const int buf = t & 1;
        asm volatile("s_waitcnt vmcnt(0)" ::: "memory");
        __syncthreads();
        if (t + 1 < NT) DMA_TILE(t + 1, buf ^ 1);
        f32x16 p0 = f32x16{}, p1 = f32x16{};
        const LAS unsigned char* kp = kp0 + buf * KSLOT;
#pragma unroll
        for (int d0 = 0; d0 < ND; ++d0) {
            const bf16x8 b0 = *(const LAS bf16x8*)(kp + d0 * 2048), b1 = *(const LAS bf16x8*)(kp + d0 * 2048 + 512);
            p0 = __builtin_amdgcn_mfma_f32_32x32x16_bf16(b0, qr[d0], p0, 0, 0, 0); p1 = __builtin_amdgcn_mfma_f32_32x32x16_bf16(b1, qr[d0], p1, 0, 0, 0);
        }
        const float rm = rowmax(p0, p1);
        if (__any(rm > mrun)) {
            const float mn = __builtin_fmaxf(mrun, rm), al = __builtin_amdgcn_exp2f(mrun - mn); mrun = mn; l_reg *= al;
            if (hi == 0) wsf[r32] = al;
            asm volatile("s_waitcnt lgkmcnt(0)" ::: "memory");
#pragma unroll
            for (int r = 0; r < 16; ++r) { const float f = wsf[crow(r, hi)]; o[0][r] *= f; o[1][r] *= f; }
        }
        float sacc = 0.f;
#pragma unroll
        for (int r = 0; r < 16; ++r) { p0[r] = __builtin_amdgcn_exp2f(p0[r] - mrun); p1[r] = __builtin_amdgcn_exp2f(p1[r] - mrun); sacc += p0[r] + p1[r]; }
        l_reg += sacc;
        u32x4 w0, w1, w2, w3;
        w0 = (u32x4){cvtpk(p0[0], p0[1]), cvtpk(p0[2], p0[3]), cvtpk(p0[4], p0[5]), cvtpk(p0[6], p0[7])};
        w1 = (u32x4){cvtpk(p0[8], p0[9]), cvtpk(p0[10], p0[11]), cvtpk(p0[12], p0[13]), cvtpk(p0[14], p0[15])};
        w2 = (u32x4){cvtpk(p1[0], p1[1]), cvtpk(p1[2], p1[3]), cvtpk(p1[4], p1[5]), cvtpk(p1[6], p1[7])};
        w3 = (u32x4){cvtpk(p1[8], p1[9]), cvtpk(p1[10], p1[11]), cvtpk(p1[12], p1[13]), cvtpk(p1[14], p1[15])};
        pv(o, vb0 + buf * VSLOT, __builtin_bit_cast(bf16x8, w0), __builtin_bit_cast(bf16x8, w1), __builtin_bit_cast(bf16x8, w2), __builtin_bit_cast(bf16x8, w3));
    }
#undef DMA_TILE
    { auto rr = __builtin_amdgcn_permlane32_swap(__float_as_uint(l_reg), __float_as_uint(l_reg), false, false); l_reg = __uint_as_float(rr[0]) + __uint_as_float(rr[1]); }
    if (hi == 0) wsf[32 + r32] = l_reg;
    asm volatile("s_waitcnt lgkmcnt(0)" ::: "memory");
    float rli[16];
#pragma unroll
    for (int r = 0; r < 16; ++r) rli[r] = __builtin_amdgcn_rcpf(wsf[32 + crow(r, hi)]);
    LAS bf16* stg = (LAS bf16*)(shm + L_OST) + wid * 2048;
#pragma unroll
    for (int r = 0; r < 16; ++r) { const int orow = crow(r, hi);
#pragma unroll
        for (int d0 = 0; d0 < 2; ++d0) stg[orow * 64 + d0 * 32 + r32] = (bf16)(cvtpk(o[d0][r] * rli[r], 0.f) & 0xffffu); }
    asm volatile("s_waitcnt lgkmcnt(0)" ::: "memory");
    bf16* Ow = O + (size_t)(wid * 32) * po;
#pragma unroll
    for (int i = 0; i < 4; ++i) { const int row = i * 8 + (lane >> 3), ch = lane & 7; const u32x4 v = *(const LAS u32x4*)(stg + row * 64 + ch * 8); *(u32x4*)(Ow + (size_t)row * po + ch * 8) = v; }
    asm volatile("s_waitcnt lgkmcnt(0)" ::: "memory");
    __syncthreads();
}
}


namespace att64 {
using att::crow;
constexpr int NSLOT = 3, SLOTB = 8192;
constexpr int LDS_K = 0, LDS_V = NSLOT * SLOTB, LDS_WS = 2 * NSLOT * SLOTB, LDS_OST = LDS_WS + NWAVES * 64 * 4, LDS_BYTES_ = LDS_OST + NWAVES * 4096;
#define SBAR() __builtin_amdgcn_sched_barrier(0)
__device__ __forceinline__ void glds16(const void* gsrc, unsigned lds_dst) { unsigned keep;
    asm volatile("s_mov_b32 %0, m0\n\ts_mov_b32 m0, %2\n\ts_nop 0\n\tglobal_load_lds_dwordx4 %1, off\n\ts_mov_b32 m0, %0" : "=&s"(keep) : "v"(gsrc), "s"(lds_dst) : "memory"); }
__device__ __forceinline__ float max3f(float a, float b, float c) { float r; asm("v_max3_f32 %0, %1, %2, %3" : "=v"(r) : "v"(a), "v"(b), "v"(c)); return r; }
__device__ __forceinline__ float max2f(float a, float b) { float r; asm("v_max_f32_e32 %0, %1, %2" : "=v"(r) : "v"(a), "v"(b)); return r; }
__device__ __forceinline__ float fadd_s(float a, float b) { float r; asm("v_add_f32_e32 %0, %1, %2" : "=v"(r) : "v"(a), "v"(b)); return r; }
__device__ __forceinline__ float fsub_s(float a, float b) { float r; asm("v_sub_f32_e32 %0, %1, %2" : "=v"(r) : "v"(a), "v"(b)); return r; }
#define WAIT_BAR(N) asm volatile("s_waitcnt vmcnt(" #N ") lgkmcnt(0)\n\ts_barrier" ::: "memory")
__device__ __forceinline__ void qkt(f32x16& p0, f32x16& p1, const char* Kslot, const bf16x8* qr, const f32x16& negm, int r32, int hi) {
    const char* kb = Kslot + hi * 1024 + r32 * 16;
#pragma unroll
    for (int d0 = 0; d0 < 4; ++d0) {
        const bf16x8 b0 = *reinterpret_cast<const bf16x8*>(kb + d0 * 2048);
        const bf16x8 b1 = *reinterpret_cast<const bf16x8*>(kb + d0 * 2048 + 512);
        if (d0 == 0) { p0 = __builtin_amdgcn_mfma_f32_32x32x16_bf16(b0, qr[0], negm, 0, 0, 0); p1 = __builtin_amdgcn_mfma_f32_32x32x16_bf16(b1, qr[0], negm, 0, 0, 0); }
        else { p0 = __builtin_amdgcn_mfma_f32_32x32x16_bf16(b0, qr[d0], p0, 0, 0, 0); p1 = __builtin_amdgcn_mfma_f32_32x32x16_bf16(b1, qr[d0], p1, 0, 0, 0); } }
}
typedef __attribute__((address_space(3))) const char* lds_cptr;
typedef short v4i16_t __attribute__((ext_vector_type(4)));
__device__ __forceinline__ void kload8(bf16x8* kf, lds_cptr kp) {
    kf[0] = *(const LAS bf16x8*)(kp);        kf[1] = *(const LAS bf16x8*)(kp + 512);
    kf[2] = *(const LAS bf16x8*)(kp + 2048); kf[3] = *(const LAS bf16x8*)(kp + 2560);
    kf[4] = *(const LAS bf16x8*)(kp + 4096); kf[5] = *(const LAS bf16x8*)(kp + 4608);
    kf[6] = *(const LAS bf16x8*)(kp + 6144); kf[7] = *(const LAS bf16x8*)(kp + 6656);
}
__device__ __forceinline__ void kload2(bf16x8* kf, lds_cptr kp, int j) { kf[2 * j] = *(const LAS bf16x8*)(kp + j * 2048); kf[2 * j + 1] = *(const LAS bf16x8*)(kp + j * 2048 + 512); }
__device__ __forceinline__ s16x4 vtr(lds_cptr p) { return __builtin_bit_cast(s16x4, __builtin_amdgcn_ds_read_tr16_b64_v4i16((LAS v4i16_t*)p)); }
__device__ __forceinline__ float rowmax(const f32x16& p0, const f32x16& p1) {
    float a = max3f(p0[0], p0[1], p1[0]), b = max3f(p0[2], p0[3], p1[1]); a = max3f(a, p1[2], p1[3]);
#pragma unroll
    for (int r = 4; r < 16; r += 4) { a = max3f(a, p0[r], p0[r + 1]); b = max3f(b, p0[r + 2], p0[r + 3]); a = max3f(a, p1[r], p1[r + 1]); b = max3f(b, p1[r + 2], p1[r + 3]); }
    const float m = max2f(a, b);
    auto rr = __builtin_amdgcn_permlane32_swap(__float_as_uint(m), __float_as_uint(m), false, false);
    return max2f(__uint_as_float(rr[0]), __uint_as_float(rr[1]));
}
template <int THRL>
__device__ __forceinline__ void attn_unit(const bf16* Q, int pq, const bf16* __restrict__ Kh, const bf16* __restrict__ Vh, int pkv, bf16* O, int po, int NT, char* shm) {
    int tid = threadIdx.x; asm volatile("" : "+v"(tid));
    const int lane = tid & 63, r32 = lane & 31, hi = lane >> 5; const int wid = __builtin_amdgcn_readfirstlane(tid >> 6);
    const bf16* Qw = Q + (size_t)(wid * 32) * pq;
    const unsigned lds0 = (unsigned)(uintptr_t)shm;
    float* wsf = (float*)(shm + LDS_WS) + wid * 64;
    const bf16* ksrc = Kh + (size_t)lane * pkv + wid * 8;
    const bf16* vsrc = Vh + (size_t)(16 * (wid & 3) + (lane >> 2)) * pkv + (wid >> 2) * 32 + (lane & 3) * 8;
    const unsigned kdst = lds0 + LDS_K + wid * 1024, vdst = lds0 + LDS_V + wid * 1024;
#define DMA_K(t, slot) glds16(ksrc + (size_t)(t) * 64 * pkv, (unsigned)__builtin_amdgcn_readfirstlane(kdst + (slot)))
#define DMA_V(t, slot) glds16(vsrc + (size_t)(t) * 64 * pkv, (unsigned)__builtin_amdgcn_readfirstlane(vdst + (slot)))
    const int vb0 = (int)(lds0 + LDS_V) + ((lane >> 4) & 1) * 32 + (lane & 3) * 8 + (4 * hi + ((lane & 15) >> 2)) * 64;
    const char* Kbase = shm + LDS_K; bf16x8 kf[8];
    const lds_cptr shm3 = (lds_cptr)shm; const lds_cptr kp0 = shm3 + LDS_K + hi * 1024 + r32 * 16; const lds_cptr vp0 = shm3 + LDS_V + ((lane >> 4) & 1) * 32 + (lane & 3) * 8 + (4 * hi + ((lane & 15) >> 2)) * 64;
    DMA_K(0, 0); DMA_V(0, 0); DMA_K(1, SLOTB);
    bf16x8 qr[4];
#pragma unroll
    for (int d0 = 0; d0 < 4; ++d0) qr[d0] = *reinterpret_cast<const bf16x8*>(&Qw[(size_t)r32 * pq + d0 * 16 + hi * 8]);
    float mhat = 0.f, l_reg = 0.f; f32x16 o[2]; o[0] = f32x16{}; o[1] = f32x16{}; f32x16 negm = f32x16{}; asm volatile("" : "+v"(negm));
    bool resc = false;
#define START(P0, P1) do { const float rm = rowmax(P0, P1); resc = false; \
    { const float dl = rm; mhat = fadd_s(mhat, dl); \
      _Pragma("unroll") for (int r = 0; r < 16; ++r) { P0[r] = fsub_s(P0[r], dl); P1[r] = fsub_s(P1[r], dl); } \
      _Pragma("unroll") for (int r = 0; r < 16; ++r) negm[r] = -mhat; asm volatile("" : "+v"(negm)); } \
    _Pragma("unroll") for (int r = 0; r < 16; ++r) P0[r] = __builtin_amdgcn_exp2f(P0[r]); } while (0)
#define RESC() do { if (resc) { asm volatile("s_waitcnt lgkmcnt(0)" ::: "memory"); \
      _Pragma("unroll") for (int d_ = 0; d_ < 2; ++d_) _Pragma("unroll") for (int r = 0; r < 16; ++r) o[d_][r] *= wsf[crow(r, hi)]; } } while (0)
    f32x16 pA0, pA1, pB0, pB1;
    int sl_prev = 0, sl_cur = 0, sl_next = SLOTB;
#define ROT() do { sl_prev = sl_cur; sl_cur = sl_next; sl_next = (sl_next == (NSLOT - 1) * SLOTB) ? 0 : sl_next + SLOTB; } while (0)
    DMA_K(2, 2 * SLOTB);
    WAIT_BAR(3);
    qkt(pA0, pA1, Kbase, qr, negm, r32, hi); asm volatile("s_nop 15\n\ts_nop 7" : "+v"(pA0), "+v"(pA1));
    START(pA0, pA1);
    _Pragma("unroll") for (int r = 0; r < 16; ++r) pA1[r] = __builtin_amdgcn_exp2f(pA1[r]);
    WAIT_BAR(0);
    DMA_K(3, 0); DMA_V(1, SLOTB);
    ROT();
    kload8(kf, kp0 + sl_cur);
    WAIT_BAR(2);
    s16x4 vlo[8], vhi[8]; u32x4 pw0, pw1, pw2, pw3;
#define PKW(P, B) cvtpk(P[B], P[B + 1])
#define PAF(k) __builtin_bit_cast(bf16x8, pw##k)
#define VFR(i) (bf16x8){vlo[i][0], vlo[i][1], vlo[i][2], vlo[i][3], vhi[i][0], vhi[i][1], vhi[i][2], vhi[i][3]}
#define PIN(x) asm volatile("" : "+v"(x))
#define MX3(a, b, c) __builtin_fmaxf(__builtin_fmaxf((a), (b)), (c))
#define GAPA(MF, A0, A1, A2, A3, W0, W1, PW) do { MF; sacc += A0; sacc += A1; sacc += A2; sacc += A3; PIN(sacc); W0; W1; PIN(PW); SBAR(); } while (0)
#define EX(v) __builtin_amdgcn_exp2f(v)
#define GAPB(MF, X, B) do { MF; X[B] = EX(X[B]); X[B + 1] = EX(X[B + 1]); X[B + 2] = EX(X[B + 2]); X[B + 3] = EX(X[B + 3]); PIN(X); SBAR(); } while (0)
#define VRD(i) do { vlo[i] = vtr(vp_ + (((i) >> 2) * 4096 + ((i) & 3) * 1024)); vhi[i] = vtr(vp_ + (((i) >> 2) * 4096 + ((i) & 3) * 1024 + 512)); } while (0)
#define KRD(G, j) do { if (G) { kload2(kf, kp0 + sl_next, j); SBAR(); } } while (0)
#define STEP(C0, C1, P0, P1, t, GK, GV, GL) do { SBAR(); \
    const lds_cptr vp_ = vp0 + sl_prev; \
    VRD(0); SBAR(); float sacc = (P0[0] + P0[1]); \
    GAPA(C0 = __builtin_amdgcn_mfma_f32_32x32x16_bf16(kf[0], qr[0], negm, 0, 0, 0), P0[2], P0[3], P0[4], P0[5],     pw0[0] = PKW(P0, 0), pw0[1] = PKW(P0, 2), pw0); \
    VRD(4); SBAR(); GAPA(C1 = __builtin_amdgcn_mfma_f32_32x32x16_bf16(kf[1], qr[0], negm, 0, 0, 0), P0[6], P0[7], P0[8], P0[9],     pw0[2] = PKW(P0, 4), pw0[3] = PKW(P0, 6), pw0); \
    VRD(1); SBAR(); GAPA(C0 = __builtin_amdgcn_mfma_f32_32x32x16_bf16(kf[2], qr[1], C0, 0, 0, 0),   P0[10], P0[11], P0[12], P0[13], pw1[0] = PKW(P0, 8), pw1[1] = PKW(P0, 10), pw1); \
    VRD(5); SBAR(); GAPA(C1 = __builtin_amdgcn_mfma_f32_32x32x16_bf16(kf[3], qr[1], C1, 0, 0, 0),   P0[14], P0[15], P1[0], P1[1],   pw1[2] = PKW(P0, 12), pw1[3] = PKW(P0, 14), pw1); \
    VRD(2); SBAR(); GAPA(C0 = __builtin_amdgcn_mfma_f32_32x32x16_bf16(kf[4], qr[2], C0, 0, 0, 0),   P1[2], P1[3], P1[4], P1[5],     pw2[0] = PKW(P1, 0), pw2[1] = PKW(P1, 2), pw2); \
    VRD(6); SBAR(); GAPA(C1 = __builtin_amdgcn_mfma_f32_32x32x16_bf16(kf[5], qr[2], C1, 0, 0, 0),   P1[6], P1[7], P1[8], P1[9],     pw2[2] = PKW(P1, 4), pw2[3] = PKW(P1, 6), pw2); \
    VRD(3); SBAR(); GAPA(C0 = __builtin_amdgcn_mfma_f32_32x32x16_bf16(kf[6], qr[3], C0, 0, 0, 0),   P1[10], P1[11], P1[12], P1[13], pw3[0] = PKW(P1, 8), pw3[1] = PKW(P1, 10), pw3); \
    VRD(7); SBAR(); GAPA(C1 = __builtin_amdgcn_mfma_f32_32x32x16_bf16(kf[7], qr[3], C1, 0, 0, 0),   P1[14], P1[15], 0.f, 0.f,       pw3[2] = PKW(P1, 12), pw3[3] = PKW(P1, 14), pw3); \
    l_reg += sacc; \
    if (GK) { DMA_K((t) + 3, sl_cur); } if (GV) { DMA_V((t) + 1, sl_next); } \
    { float a = MX3(C0[0], C0[1], C1[0]), b = MX3(C0[2], C0[3], C1[1]); a = MX3(a, C1[2], C1[3]); \
      _Pragma("unroll") for (int r = 4; r < 16; r += 4) { a = MX3(a, C0[r], C0[r + 1]); b = MX3(b, C0[r + 2], C0[r + 3]); a = MX3(a, C1[r], C1[r + 1]); b = MX3(b, C1[r + 2], C1[r + 3]); } \
      float rm = __builtin_fmaxf(a, b); { auto rr = __builtin_amdgcn_permlane32_swap(__float_as_uint(rm), __float_as_uint(rm), false, false); rm = __builtin_fmaxf(__uint_as_float(rr[0]), __uint_as_float(rr[1])); } \
      resc = false; \
      if (__builtin_expect(__any(rm > (float)THRL), 0)) { const float dl = __builtin_fmaxf(rm, 0.f); mhat += dl; \
        _Pragma("unroll") for (int r = 0; r < 16; ++r) { C0[r] -= dl; C1[r] -= dl; } \
        _Pragma("unroll") for (int r = 0; r < 16; ++r) negm[r] = -mhat; asm volatile("" : "+v"(negm)); \
        const float f = __builtin_amdgcn_exp2f(-dl); l_reg *= f; if (hi == 0) wsf[r32] = f; resc = true; } } \
    SBAR(); \
    GAPB(o[0] = __builtin_amdgcn_mfma_f32_32x32x16_bf16(PAF(0), VFR(0), o[0], 0, 0, 0), C0, 0); \
    GAPB(o[1] = __builtin_amdgcn_mfma_f32_32x32x16_bf16(PAF(0), VFR(4), o[1], 0, 0, 0), C0, 4); \
    KRD(GL, 0); GAPB(o[0] = __builtin_amdgcn_mfma_f32_32x32x16_bf16(PAF(1), VFR(1), o[0], 0, 0, 0), C0, 8); \
    KRD(GL, 1); GAPB(o[1] = __builtin_amdgcn_mfma_f32_32x32x16_bf16(PAF(1), VFR(5), o[1], 0, 0, 0), C0, 12); \
    KRD(GL, 2); GAPB(o[0] = __builtin_amdgcn_mfma_f32_32x32x16_bf16(PAF(2), VFR(2), o[0], 0, 0, 0), C1, 0); \
    KRD(GL, 3); GAPB(o[1] = __builtin_amdgcn_mfma_f32_32x32x16_bf16(PAF(2), VFR(6), o[1], 0, 0, 0), C1, 4); \
    GAPB(o[0] = __builtin_amdgcn_mfma_f32_32x32x16_bf16(PAF(3), VFR(3), o[0], 0, 0, 0), C1, 8); \
    GAPB(o[1] = __builtin_amdgcn_mfma_f32_32x32x16_bf16(PAF(3), VFR(7), o[1], 0, 0, 0), C1, 12); \
    } while (0)
    int t = 1;
    for (; t + 5 < NT; t += 2) {
        STEP(pB0, pB1, pA0, pA1, t, true, true, true);     WAIT_BAR(2); RESC(); ROT();
        STEP(pA0, pA1, pB0, pB1, t + 1, true, true, true); WAIT_BAR(2); RESC(); ROT();
    }
#define ENDW(tt) do { if ((tt) + 3 < NT) { WAIT_BAR(2); } else if ((tt) + 2 < NT) { WAIT_BAR(1); } else { WAIT_BAR(0); } } while (0)
    for (; t + 1 < NT; t += 2) {
        STEP(pB0, pB1, pA0, pA1, t, (t + 3 < NT), (t + 1 < NT), (t + 1 < NT));     ENDW(t);     RESC(); ROT();
        STEP(pA0, pA1, pB0, pB1, t + 1, (t + 4 < NT), (t + 2 < NT), (t + 2 < NT)); ENDW(t + 1); RESC(); ROT();
    }
    STEP(pB0, pB1, pA0, pA1, NT - 1, false, false, false); RESC();
    { float sacc = pB0[0] + pB0[1]; _Pragma("unroll") for (int r = 2; r < 16; ++r) sacc += pB0[r]; _Pragma("unroll") for (int r = 0; r < 16; ++r) sacc += pB1[r]; l_reg += sacc;
      pw0 = (u32x4){PKW(pB0, 0), PKW(pB0, 2), PKW(pB0, 4), PKW(pB0, 6)}; pw1 = (u32x4){PKW(pB0, 8), PKW(pB0, 10), PKW(pB0, 12), PKW(pB0, 14)}; pw2 = (u32x4){PKW(pB1, 0), PKW(pB1, 2), PKW(pB1, 4), PKW(pB1, 6)}; pw3 = (u32x4){PKW(pB1, 8), PKW(pB1, 10), PKW(pB1, 12), PKW(pB1, 14)};
      SBAR(); att::pv(o, vb0 + sl_cur, PAF(0), PAF(1), PAF(2), PAF(3)); }
#undef PKW
#undef PAF
#undef VFR
#undef PIN
#undef MX3
#undef GAPA
#undef GAPB
#undef EX
#undef VRD
#undef KRD
#undef STEP
#undef ENDW
    { auto rr = __builtin_amdgcn_permlane32_swap(__float_as_uint(l_reg), __float_as_uint(l_reg), false, false); l_reg = __uint_as_float(rr[0]) + __uint_as_float(rr[1]); }
    if (hi == 0) wsf[32 + r32] = l_reg; asm volatile("s_waitcnt lgkmcnt(0)" ::: "memory");
    float rli[16];
#pragma unroll
    for (int r = 0; r < 16; ++r) rli[r] = __builtin_amdgcn_rcpf(wsf[32 + crow(r, hi)]);
    bf16* Ow = O + (size_t)(wid * 32) * po;
    { bf16* stg = (bf16*)(shm + LDS_OST) + wid * 2048;
#pragma unroll
      for (int r = 0; r < 16; ++r) { const int orow = crow(r, hi);
#pragma unroll
        for (int d0 = 0; d0 < 2; ++d0) stg[orow * 64 + d0 * 32 + r32] = (bf16)(cvtpk(o[d0][r] * rli[r], 0.f) & 0xffffu); }
      asm volatile("s_waitcnt lgkmcnt(0)" ::: "memory");
#pragma unroll
      for (int i = 0; i < 4; ++i) { const int row = i * 8 + (lane >> 3), ch = lane & 7; const u32x4 v = *(const u32x4*)(stg + row * 64 + ch * 8); *(u32x4*)(Ow + (size_t)row * po + ch * 8) = v; } }
    asm volatile("s_waitcnt lgkmcnt(0)\n\ts_barrier" ::: "memory");
#undef DMA_K
#undef DMA_V
#undef START
#undef RESC
#undef ROT
}
#undef SBAR
#undef WAIT_BAR
}

#define RLX_AGENT __ATOMIC_RELAXED, __HIP_MEMORY_SCOPE_AGENT
#define XB_TMO      128
#define XB_XCNT(j)  (256  + 64 * (j))
#define XB_XSUB(j)  (1280 + 64 * (j))
#define XB_XGEN(j)  (2304 + 64 * (j))
#define XB_TOP      3328
#define XB_TOPGEN   3392
#define XCD_BAR_WORDS 3456
#define XB_SPIN_CAP (1u << 18)
__device__ __forceinline__ unsigned xb_ld(unsigned* p)              { return __hip_atomic_load(p, __ATOMIC_RELAXED, __HIP_MEMORY_SCOPE_AGENT); }
__device__ __forceinline__ unsigned xb_add(unsigned* p, unsigned v) { return __hip_atomic_fetch_add(p, v, __ATOMIC_RELAXED, __HIP_MEMORY_SCOPE_AGENT); }
__device__ __forceinline__ unsigned xb_xcc_id() { return (unsigned)__builtin_amdgcn_s_getreg((3 << 11) | 20) & 0xFu; }
#define XB_SPIN(cond, bar) do { unsigned _sp = 0; while (cond) { __builtin_amdgcn_s_sleep(1); \
    if ((++_sp & 255u) == 0u) { if (xb_ld(&(bar)[XB_TMO])) break; if (_sp > XB_SPIN_CAP) { atomicAdd(&(bar)[XB_TMO], 1u); break; } } } } while (0)
struct XcdBarrier { unsigned* bar; unsigned x; volatile LAS unsigned* st; };
__device__ __forceinline__ XcdBarrier xcd_barrier_post(unsigned* bar, volatile LAS unsigned* st) {
    XcdBarrier b; b.bar = bar; b.x = xb_xcc_id(); b.st = st;
    if (threadIdx.x == 0) (void)xb_add(&bar[XB_XCNT(b.x)], 1u);
    return b;
}
__device__ __forceinline__ void xcd_barrier_complete(unsigned* bar, unsigned x, unsigned& nloc, unsigned& nx) {
    const unsigned G = gridDim.x * gridDim.y * gridDim.z;
    unsigned sum, cnt, mine, sp = 0u;
    for (;;) {
        sum = 0u; cnt = 0u; mine = 0u;
#pragma unroll
        for (unsigned j = 0; j < 16; ++j) { const unsigned c = xb_ld(&bar[XB_XCNT(j)]); sum += c; cnt += (c > 0u) ? 1u : 0u; mine = (j == x) ? c : mine; }
        if (sum == G) break;
        __builtin_amdgcn_s_sleep(1);
        if ((++sp & 255u) == 0u) { if (xb_ld(&bar[XB_TMO])) break; if (sp > XB_SPIN_CAP) { atomicAdd(&bar[XB_TMO], 1u); break; } }
    }
    nloc = mine > 0u ? mine : 1u; nx = cnt > 0u ? cnt : 1u;
}
__device__ __forceinline__ void xcd_barrier(const XcdBarrier& b) {
    asm volatile("s_waitcnt vmcnt(0)" ::: "memory");
    __syncthreads();
    if (threadIdx.x == 0) {
        unsigned* bar = b.bar;
        __builtin_amdgcn_s_waitcnt(0);
        unsigned nloc = b.st[0], nx = b.st[1];
        if (nloc == 0u) { xcd_barrier_complete(bar, b.x, nloc, nx); b.st[0] = nloc; b.st[1] = nx; }
        const unsigned old = xb_add(&bar[XB_XSUB(b.x)], 1u);
        const unsigned gen = old / nloc;
        if (old + 1u == (gen + 1u) * nloc) {
            __builtin_amdgcn_fence(__ATOMIC_RELEASE, "agent");
            asm volatile("s_waitcnt vmcnt(0)" ::: "memory");
            const unsigned og = xb_add(&bar[XB_TOP], 1u);
            const unsigned tg = og / nx;
            if (og + 1u == (tg + 1u) * nx) xb_add(&bar[XB_TOPGEN], 1u);
            else XB_SPIN(xb_ld(&bar[XB_TOPGEN]) == tg, bar);
            __builtin_amdgcn_fence(__ATOMIC_ACQUIRE, "agent");
            xb_add(&bar[XB_XGEN(b.x)], 1u);
            asm volatile("s_waitcnt vmcnt(0)" ::: "memory");
        } else {
            XB_SPIN(xb_ld(&bar[XB_XGEN(b.x)]) == gen, bar);
            __builtin_amdgcn_fence(__ATOMIC_ACQUIRE, "agent");
            asm volatile("s_waitcnt vmcnt(0)" ::: "memory");
        }
    }
    __syncthreads();
}
constexpr int LDS_MISC = 131072 + 1024;
constexpr size_t CTL_ZERO_BYTES = 64 * KiB;

struct Args { const float* in[26]; float* out; unsigned char* ws; int ph_lo, ph_hi; };
constexpr int LDS_BYTES = 147456;
constexpr int NPHASE = 21;

typedef const __attribute__((address_space(4))) unsigned char* KP;
__device__ __forceinline__ const float* kin(KP kp, int k) { return *(const float* const __attribute__((address_space(4)))*)(kp + 8 * k); }
__device__ __forceinline__ float* kout(KP kp) { return *(float* const __attribute__((address_space(4)))*)(kp + 208); }
__device__ __forceinline__ unsigned char* kws(KP kp) { return *(unsigned char* const __attribute__((address_space(4)))*)(kp + 216); }
static_assert(sizeof(Args) == 232, "Args layout");
struct Ctx {
    LAS unsigned char* lds; int tid, lane, wave, vcu, G; unsigned char* ws;
};

enum MatId { M_WIN = 0, M_WUQ, M_WUKV, M_NAT, M_FFI };
__device__ __forceinline__ int rope_perm(int p) { const int n = p >> 4, fq = (p >> 2) & 3, j = p & 3; return 16 * (fq >> 1) + 8 * n + 4 * (fq & 1) + j; }
__device__ __forceinline__ int head_perm(int pc, int& wc) { wc = (pc >> 5) & 3; return 32 * (pc >> 7) + (pc & 31); }
__device__ __forceinline__ int src_col(int mat, int n) {
    const int t = n >> 8, pc = n & 255; int wc;
    switch (mat) {
    case M_WIN:
        if (t < 2) { const int d = head_perm(pc, wc); return (4 * t + wc) * 64 + d; }
        if (t == 2) { const int d = head_perm(pc, wc); return wc < 2 ? 512 + wc * 64 + d : 640 + (wc - 2) * 64 + d; }
        if (t == 3) return 768 + pc;
        if (t == 4) { if (pc < 128) return 768 + 256 + pc; if (pc < 160) return 1408 + rope_perm(pc - 128); return -1; }
        if (t == 5) return 1152 + pc;
        if (t < 8) return 1440 + (t - 6) * 256 + pc;
        return 1952 + (t - 8) * 256 + pc;
    case M_WUQ:
        if (t < 2) { const int d = head_perm(pc, wc); return (4 * t + wc) * 96 + d; }
        { const int bj = pc >> 7, w2 = (pc >> 5) & 3; return (4 * bj + w2) * 96 + 64 + rope_perm(pc & 31); }
    case M_WUKV:
        { const int d = head_perm(pc, wc); return t < 2 ? (4 * t + wc) * 128 + d : (4 * (t - 2) + wc) * 128 + 64 + d; }
    case M_FFI:
        return pc < 128 ? t * 128 + pc : FFH + t * 128 + (pc - 128);
    default: return n;
    }
}
__device__ __forceinline__ void xpose_item(const float* W, int ldw, const float* kscale, bf16* WT, int ldo, int kcol0, int mat, int nblk, int item, LAS float* scr, int lane) {
    const int kb = item / nblk, nb = item % nblk, k0 = 64 * kb, n0 = 32 * nb;
    const int sc = src_col(mat, n0 + (lane & 31));
#pragma unroll 8
    for (int i = 0; i < 32; ++i) { const int kk = 2 * i + (lane >> 5); float v = 0.f; if (sc >= 0) { v = W[(size_t)(k0 + kk) * ldw + sc]; if (kscale) v *= kscale[k0 + kk]; } scr[kk * 33 + (lane & 31)] = v; }
    asm volatile("s_waitcnt lgkmcnt(0)" ::: "memory");
    const int c = lane & 7;
#pragma unroll
    for (int j = 0; j < 4; ++j) { const int n = (lane >> 3) + 8 * j; const LAS float* s = scr + (8 * c) * 33 + n;
        u32x4 o; o.x = cvtpk(s[0 * 33], s[1 * 33]); o.y = cvtpk(s[2 * 33], s[3 * 33]); o.z = cvtpk(s[4 * 33], s[5 * 33]); o.w = cvtpk(s[6 * 33], s[7 * 33]);
        *(u32x4*)(WT + (size_t)(n0 + n) * ldo + kcol0 + k0 + 8 * c) = o; }
    asm volatile("s_waitcnt lgkmcnt(0)" ::: "memory");
}
__device__ __forceinline__ void run_xjob(const Ctx& F, int& base, const float* W, int ldw, const float* kscale, bf16* WT, int ldo, int kcol0, int mat, int K, int N) {
    LAS float* scr = (LAS float*)(F.lds + F.wave * 16384);
    const int gw = F.vcu * NWAVES + F.wave, NGW = F.G * NWAVES;
    const int nblk = N / 32, nit = (K / 64) * nblk;
    int first = gw - (base % NGW); if (first < 0) first += NGW;
    for (int it = first; it < nit; it += NGW) xpose_item(W, ldw, kscale, WT, ldo, kcol0, mat, nblk, it, scr, F.lane);
    base += nit;
}

__device__ __forceinline__ void norm_pass(const Ctx& F, const float* x_lat, const float* x_ctx, bf16* HB, const float* gnorm, const float* mod_l, int shift_off, int nrows) {
    const int gw = F.vcu * NWAVES + F.wave, NGW = F.G * NWAVES;
    const int per = (nrows + NGW - 1) / NGW; const int r0 = gw * per, r1 = min(nrows, r0 + per);
    int cur_s = -1; f32x4 ca[4], cb[4];
    for (int r = r0; r < r1; ++r) {
        const bool ctx = r >= ML; const int s = ctx ? 8 : r >> 11;
        if (s != cur_s) { cur_s = s; const float* sh = mod_l + s * 6144 + shift_off; const float* scl = sh + 1024;
#pragma unroll
            for (int j = 0; j < 4; ++j) { const f32x4 g = *(const f32x4*)(gnorm + 256 * j + 4 * F.lane); const f32x4 sc1 = *(const f32x4*)(scl + 256 * j + 4 * F.lane); ca[j] = g * (sc1 + 1.0f); cb[j] = *(const f32x4*)(sh + 256 * j + 4 * F.lane); } }
        const float* xr = ctx ? x_ctx + (size_t)(r - ML) * 1024 : x_lat + (size_t)r * 1024;
        f32x4 v[4]; float ss = 0.f;
#pragma unroll
        for (int j = 0; j < 4; ++j) { v[j] = *(const f32x4*)(xr + 256 * j + 4 * F.lane); ss += (v[j][0] * v[j][0] + v[j][1] * v[j][1]) + (v[j][2] * v[j][2] + v[j][3] * v[j][3]); }
        const float rstd = rsqrtf(wave_sum(ss) * (1.0f / 1024.0f) + EPS);
#pragma unroll
        for (int j = 0; j < 4; ++j) *(u32x2*)(HB + (size_t)r * 1024 + 256 * j + 4 * F.lane) = pk4(v[j] * rstd * ca[j] + cb[j]);
    }
}

__device__ __forceinline__ void mod_items(const Ctx& F, KP kp) {
    const float* c = kin(kp, 1); const float* cc = kin(kp, 3); const float* wmod = kin(kp, 4); const float* bmod = kin(kp, 5);
    float* mod = (float*)(F.ws + O_MOD);
    LAS float* sl = (LAS float*)F.lds;
    LAS float* red = sl + 9 * 1024;
    for (int it = F.vcu; it < 192; it += F.G) {
        const int l = it / 96, n0 = (it % 96) * 64;
        __syncthreads();
        for (int i = F.tid; i < 9 * 1024; i += NTHR) { const float v = (i < 8192) ? c[i] : cc[i - 8192]; sl[i] = v * sigmoidf_(v); }
        __syncthreads();
        float acc[9];
#pragma unroll
        for (int s = 0; s < 9; ++s) acc[s] = 0.f;
        const float* wp = wmod + (size_t)l * 1024 * 6144 + n0 + F.lane;
        for (int k = F.wave * 128; k < F.wave * 128 + 128; ++k) { const float w = wp[(size_t)k * 6144];
#pragma unroll
            for (int s = 0; s < 9; ++s) acc[s] += sl[s * 1024 + k] * w; }
#pragma unroll
        for (int s = 0; s < 9; ++s) red[(F.wave * 9 + s) * 64 + F.lane] = acc[s];
        __syncthreads();
        for (int i = F.tid; i < 9 * 64; i += NTHR) { float t = 0.f;
#pragma unroll
            for (int w = 0; w < 8; ++w) t += red[w * 576 + i];
            const int s = i / 64, n = n0 + (i & 63); mod[(l * 9 + s) * 6144 + n] = t + bmod[l * 6144 + n]; }
    }
    __syncthreads();
}
__device__ __forceinline__ void table_items(const Ctx& F) {
    const int gt = (F.vcu * NTHR) + F.tid, NT_ = F.G * NTHR;
    float* ra = (float*)(F.ws + O_ROPEA); float* rb = (float*)(F.ws + O_ROPEB);
    for (int i = gt; i < 1024; i += NT_) { const int pos = i >> 4, f = i & 15; const float fr = powf(10000.0f, -(float)(2 * f) / 32.0f); const float ang = (float)pos * fr; ra[i] = cosf(ang); ra[1024 + i] = sinf(ang); }
    for (int i = gt; i < 512; i += NT_) { const int pos = i >> 3, f = i & 7; const float fr = powf(10000.0f, -(float)(2 * f) / 16.0f); const float ang = (float)pos * fr; rb[i] = cosf(ang); rb[512 + i] = sinf(ang); }
    bf16* DN = (bf16*)(F.ws + O_DN); bf16* DN2 = (bf16*)(F.ws + O_DN256); bf16* DC = (bf16*)(F.ws + O_DFTC);
    { const float sc = 0.022097086912079608f;
      for (int i = gt; i < 2048 * 2048 / 2; i += NT_) { const int n = i >> 10, k = (i & 1023) * 2; float s0, c0, s1, c1;
          sincospif((float)((n * k) & 2047) * (1.0f / 1024.0f), &s0, &c0); sincospif((float)((n * (k + 1)) & 2047) * (1.0f / 1024.0f), &s1, &c1);
          *(unsigned*)(DN + (size_t)n * 4096 + k) = cvtpk(c0 * sc, c1 * sc); *(unsigned*)(DN + (size_t)n * 4096 + 2048 + k) = cvtpk(-s0 * sc, -s1 * sc); } }
    { const float sc = 0.0625f;
      for (int i = gt; i < 256 * 256; i += NT_) { const int n = i >> 8, k = i & 255; float s0, c0; sincospif((float)((n * k) & 255) * (1.0f / 128.0f), &s0, &c0);
          DN2[n * 512 + k] = (bf16)(cvtpk(c0 * sc, 0.f) & 0xffff); DN2[n * 512 + 256 + k] = (bf16)(cvtpk(-s0 * sc, 0.f) & 0xffff); } }
    { const float sc = 0.08838834764831845f;
      for (int i = gt; i < 256 * 128; i += NT_) { const int r = i >> 7, k = i & 127; float s0, c0; sincospif((float)(((r & 127) * k) & 127) * (1.0f / 64.0f), &s0, &c0);
          DC[i] = (bf16)(cvtpk((r < 128 ? c0 : s0) * sc, 0.f) & 0xffff); } }
}
__device__ __forceinline__ void convert_weights_main(const Ctx& F, KP kp, int l) {
    int base = 0;
    run_xjob(F, base, kin(kp, 8) + (size_t)l * 1024 * INW, INW, nullptr, (bf16*)(F.ws + O_WIN), 1024, 0, M_WIN, 1024, NINP);
    run_xjob(F, base, kin(kp, 13) + (size_t)l * 384 * 768, 768, kin(kp, 11) + l * 384, (bf16*)(F.ws + O_WUQ), 384, 0, M_WUQ, 384, 768);
    run_xjob(F, base, kin(kp, 14) + (size_t)l * 256 * 1024, 1024, kin(kp, 12) + l * 256, (bf16*)(F.ws + O_WUKV), 256, 0, M_WUKV, 256, 1024);
    run_xjob(F, base, kin(kp, 20) + (size_t)l * 512 * 1024, 1024, nullptr, (bf16*)(F.ws + O_WBR), 1536, 0, M_NAT, 512, 1024);
    run_xjob(F, base, kin(kp, 21) + (size_t)l * 512 * 1024, 1024, nullptr, (bf16*)(F.ws + O_WBR), 1536, 512, M_NAT, 512, 1024);
    run_xjob(F, base, kin(kp, 22) + (size_t)l * 512 * 1024, 1024, nullptr, (bf16*)(F.ws + O_WBR), 1536, 1024, M_NAT, 512, 1024);
    run_xjob(F, base, kin(kp, 23) + (size_t)l * 1024 * 1024, 1024, nullptr, (bf16*)(F.ws + O_WOUT), 1024, 0, M_NAT, 1024, 1024);
}
__device__ __forceinline__ void convert_weights_ffn(const Ctx& F, KP kp, int l) {
    int base = 0;
    run_xjob(F, base, kin(kp, 24) + (size_t)l * 1024 * 2 * FFH, 2 * FFH, nullptr, (bf16*)(F.ws + O_WFI), 1024, 0, M_FFI, 1024, 2 * FFH);
    run_xjob(F, base, kin(kp, 25) + (size_t)l * FFH * 1024, 1024, nullptr, (bf16*)(F.ws + O_WFO), FFH, 0, M_NAT, FFH, 1024);
}

struct F1Sched {
    int nb_tok, G, c, row0, rows_per_b, nunits; const char* A; const char* PF;
    __device__ __forceinline__ bool next(int i, Unit& u) const {
        const long L = (long)i * G + c; if (L >= nunits) return false;
        const int j = (int)L % nb_tok, bg = (int)L / nb_tok, gch = bg & 3, b = bg >> 2;
        u.pm = b * 4 + gch; u.pn = j; u.kb = 0; u.A = A; u.B = PF + ((size_t)(row0 + b * rows_per_b + j * 256) * 512 + gch * 128) * 2; return true;
    }
};
struct F2Sched {
    int nM, G, c, row0, rows_per_b, nunits; const char* DN; const char* ZT; size_t K2;
    __device__ __forceinline__ bool next(int i, Unit& u) const {
        const long L = (long)i * G + c; if (L >= nunits) return false;
        const int pn = (int)L & 1, r = (int)L >> 1, pm = r % nM, b = r / nM;
        u.pm = (row0 + b * rows_per_b) / 256 + pm; u.pn = pn; u.kb = 0;
        u.A = DN + (size_t)pm * 256 * K2 * 2; u.B = ZT + ((size_t)b * 512 + pn * 256) * K2 * 2; return true;
    }
};

#ifndef DIAG_SUB
#define DIAG_SUB -1
#endif
#ifndef TIME_REP
#define TIME_REP 0
#endif
#define REP(b) ((TIME_REP & (b)) ? 2 : 1)
#define SUB_ON(k) (DIAG_SUB < 0 || DIAG_SUB == (k))
#ifndef DIAG_PART
#define DIAG_PART 0xffff
#endif
#define PART_ON(b) ((DIAG_PART & (b)) != 0)
__global__ void __launch_bounds__(NTHR, 2) fwd_kernel(Args args) {
    extern __shared__ __attribute__((aligned(16))) unsigned char lds_raw[];
    const int c = (int)blockIdx.x, G = (int)gridDim.x;
#if !MK_MULTI
    cg::grid_group grid = cg::this_grid();
    if (threadIdx.x < 2) ((volatile LAS unsigned*)((LAS unsigned char*)lds_raw + LDS_MISC))[threadIdx.x] = 0u;
    __syncthreads();
    const XcdBarrier xbar = xcd_barrier_post((unsigned*)(*(unsigned char* const __attribute__((address_space(4)))*)((KP)__builtin_amdgcn_kernarg_segment_ptr() + 216) + O_CTL) + 1024, (volatile LAS unsigned*)((LAS unsigned char*)lds_raw + LDS_MISC));
#define GRID_SYNC(first) do { if (first) grid.sync(); else xcd_barrier(xbar); } while (0)
#else
#define GRID_SYNC(first) do {} while (0)
#endif
    for (int ph = args.ph_lo; ph < args.ph_hi; ++ph) {
        KP kp = (KP)__builtin_amdgcn_kernarg_segment_ptr(); asm volatile("" : "+s"(kp));
        int tid_ = threadIdx.x; asm volatile("" : "+v"(tid_));
        Ctx F; F.lds = (LAS unsigned char*)lds_raw; F.tid = tid_; F.lane = tid_ & 63; F.wave = __builtin_amdgcn_readfirstlane(tid_ >> 6);
        F.G = G; F.vcu = (G % 8 == 0) ? (c % 8) * (G / 8) + c / 8 : c;
        unsigned char* ws = kws(kp); F.ws = ws; float* const outp = kout(kp);
        const float* mod = (const float*)(ws + O_MOD);
        const float* ropeA = (const float*)(ws + O_ROPEA); const float* ropeB = (const float*)(ws + O_ROPEB);
        float* stat_cq = (float*)(ws + O_STATCQ); float* stat_ckv = (float*)(ws + O_STATCKV);
        bf16* HB = (bf16*)(ws + O_HB); bf16* PF = (bf16*)(ws + O_PF); bf16* QA = (bf16*)(ws + O_QA); bf16* QBN = (bf16*)(ws + O_QBN); bf16* QBR = (bf16*)(ws + O_QBR);
        bf16* CQ = (bf16*)(ws + O_CQ); bf16* CKV = (bf16*)(ws + O_CKV); bf16* KA = (bf16*)(ws + O_KA); bf16* VA = (bf16*)(ws + O_VA); bf16* KB = (bf16*)(ws + O_KB); bf16* VB = (bf16*)(ws + O_VB);
        bf16* GT = (bf16*)(ws + O_G); bf16* ACT = (bf16*)(ws + O_G); bf16* MB = HB; bf16* YC = PF;
        float* XC = (float*)(ws + O_XC);
        if (ph == 0) { if (SUB_ON(10))
            for (int rep_ = 0; rep_ < REP(1); ++rep_) { mod_items(F, kp); table_items(F); convert_weights_main(F, kp, 0); }
        } else {
            const int l = (ph - 1) / 10, sub = (ph - 1) % 10;
            const bool L1 = (l == 1);
            const int nMt = L1 ? 64 : 72;
            const float* xin_lat = L1 ? outp : kin(kp, 0); const float* xin_ctx = L1 ? XC : kin(kp, 2);
            const float* mod_l = mod + (size_t)l * 9 * 6144;
            bf16* ZT = L1 ? (bf16*)(ws + O_ZT1) : (bf16*)outp; bf16* ZTC = (bf16*)outp + (size_t)8 * 512 * 4096;
            switch (sub) {
            case 0: if (SUB_ON(0)) {
                if (L1) convert_weights_main(F, kp, 1);
                for (int rep_ = 0; rep_ < REP(2); ++rep_) norm_pass(F, xin_lat, xin_ctx, HB, kin(kp, 6) + l * 1024, mod_l, 0, MT);
            } break;
            case 1: if (SUB_ON(1)) {
                EpiIn E{QA, KA, VA, CQ, CKV, KB, PF, GT, stat_cq, stat_ckv, kin(kp, 9) + l * 64, kin(kp, 10) + l * 64, kin(kp, 18) + l * 32, kin(kp, 19) + l * 3072, ropeA, ropeB};
                const Gemm g{1024, 1024, 1024};
                RectSched S{L1 ? 64 : 72, 8, 0, G, c, 1, ~0ull, (const char*)HB, 0, 0, (const char*)(ws + O_WIN), (size_t)256 * 1024 * 2, (size_t)256 * 1024 * 2, 0};
                pg8::gemm_phase(F.lds, g, S, E);
                if (L1) { RectSched S2{8, 3, 64, G, c, 1, 0x542ull, (const char*)HB, 0, 0, (const char*)(ws + O_WIN), (size_t)256 * 1024 * 2, (size_t)256 * 1024 * 2, 0};
                    pg8::gemm_phase(F.lds, g, S2, E); }
            } break;
            case 2: if (SUB_ON(2)) {
                for (int rep_ = 0; rep_ < REP(4); ++rep_) { EpiUq E{QBN, QBR, stat_cq, kin(kp, 15) + l * 64, kin(kp, 17) + l * 32, ropeB}; const Gemm g{384, 384, 384};
                  RectSched S{L1 ? 64 : 72, 3, 0, G, c, 1, ~0ull, (const char*)CQ, 0, 0, (const char*)(ws + O_WUQ), (size_t)256 * 384 * 2, (size_t)256 * 384 * 2, 0};
                  pg8::gemm_phase(F.lds, g, S, E); }
                for (int rep_ = 0; rep_ < REP(8); ++rep_) { EpiUkv E{KB, VB, stat_ckv, kin(kp, 16) + l * 64}; const Gemm g{256, 256, 256};
                  RectSched S{72, 4, 0, G, c, 1, ~0ull, (const char*)CKV, 0, 0, (const char*)(ws + O_WUKV), (size_t)256 * 256 * 2, (size_t)256 * 256 * 2, 0};
                  pg8::gemm_phase(F.lds, g, S, E); }
                for (int rep_ = 0; rep_ < REP(16); ++rep_) { EpiF1 E{ZT, 2048}; const Gemm g{128, 512, 128};
                  F1Sched S{8, G, c, 0, 2048, 256, (const char*)(ws + O_DFTC), (const char*)PF};
                  pg8::gemm_phase(F.lds, g, S, E); }
                if (!L1) { EpiF1 E{ZTC, 256}; const Gemm g{128, 512, 128};
                  F1Sched S{1, G, c, ML, 256, 32, (const char*)(ws + O_DFTC), (const char*)PF};
                  pg8::gemm_phase(F.lds, g, S, E); }
            } break;
            case 3: if (SUB_ON(3)) {
                LAS unsigned char* shm = F.lds;
                if (TIME_REP & 32) for (int i = 0;; ++i) {
                    const int L = i * G + c; if (L >= 512) break; const int qb = L & 7, h = (L >> 3) & 7, b = L >> 6;
                    const size_t row0 = (size_t)b * SEQ + qb * 256; const size_t key0 = (size_t)b * NKEY;
                    att64::attn_unit<8>(QA + row0 * 512 + h * 64, 512, KA + key0 * 128 + (h >> 2) * 64, VA + key0 * 128 + (h >> 2) * 64, 128, CQ + row0 * 512 + h * 64, 512, NKEY / 64, (char*)lds_raw);
                }
                if (TIME_REP & 64) for (int i = 0;; ++i) {
                    const int L = i * G + c; if (L >= 512) break; const int qb = L & 7, h = (L >> 3) & 7, b = L >> 6;
                    const size_t row0 = (size_t)b * SEQ + qb * 256; const size_t key0 = (size_t)b * NKEY;
                    att::attn_unit<96>(QBN + row0 * 512 + h * 64, 512, QBR + row0 * 256 + h * 32, 256, KB + key0 * 768 + h * 96, 768, VB + key0 * 512 + h * 64, 512, CQ + row0 * 512 + h * 64, 512, NKEY / 64, shm);
                }
                for (int i = 0;; ++i) {
                    const int L = i * G + c; if (L >= 512) break; const int qb = L & 7, h = (L >> 3) & 7, b = L >> 6;
                    const size_t row0 = (size_t)b * SEQ + qb * 256; const size_t key0 = (size_t)b * NKEY;
                    att64::attn_unit<8>(QA + row0 * 512 + h * 64, 512, KA + key0 * 128 + (h >> 2) * 64, VA + key0 * 128 + (h >> 2) * 64, 128, QA + row0 * 512 + h * 64, 512, NKEY / 64, (char*)lds_raw);
                }
                for (int i = 0;; ++i) {
                    const int L = i * G + c; if (L >= 512) break; const int qb = L & 7, h = (L >> 3) & 7, b = L >> 6;
                    const size_t row0 = (size_t)b * SEQ + qb * 256; const size_t key0 = (size_t)b * NKEY;
                    att::attn_unit<96>(QBN + row0 * 512 + h * 64, 512, QBR + row0 * 256 + h * 32, 256, KB + key0 * 768 + h * 96, 768, VB + key0 * 512 + h * 64, 512, QBN + row0 * 512 + h * 64, 512, NKEY / 64, shm);
                }
                if (!L1) {
                    for (int i = 0;; ++i) {
                        const int L = i * G + c; if (L >= 128) break; const int h = L & 7, b = (L >> 3) & 7; const bool mla = L >= 64;
                        const size_t row0 = (size_t)ML + b * CTX; const size_t key0 = (size_t)b * NKEY;
                        if (!mla) att64::attn_unit<8>(QA + row0 * 512 + h * 64, 512, KA + key0 * 128 + (h >> 2) * 64, VA + key0 * 128 + (h >> 2) * 64, 128, QA + row0 * 512 + h * 64, 512, CTX / 64, (char*)lds_raw);
                        else att::attn_unit<96>(QBN + row0 * 512 + h * 64, 512, QBR + row0 * 256 + h * 32, 256, KB + key0 * 768 + h * 96, 768, VB + key0 * 512 + h * 64, 512, QBN + row0 * 512 + h * 64, 512, CTX / 64, shm);
                    }
                }
                for (int rep_ = 0; rep_ < REP(128); ++rep_) { EpiStore E{YC, 512}; const Gemm g{4096, 4096, 4096};
                  F2Sched S{8, G, (c + 128) % G, 0, 2048, 128, (const char*)(ws + O_DN), (const char*)ZT, 4096};
                  pg8::gemm_phase(F.lds, g, S, E); }
                if (!L1) { EpiStore E{YC, 512}; const Gemm g{512, 512, 512};
                  F2Sched S{1, G, c, ML, 256, 16, (const char*)(ws + O_DN256), (const char*)ZTC, 512};
                  pg8::gemm_phase(F.lds, g, S, E); }
            } break;
            case 4: if (SUB_ON(4)) {
                EpiIn E{QA, KA, VA, CQ, CKV, KB, PF, GT, stat_cq, stat_ckv, kin(kp, 9) + l * 64, kin(kp, 10) + l * 64, kin(kp, 18) + l * 32, kin(kp, 19) + l * 3072, ropeA, ropeB};
                const Gemm g{1024, 1024, 1024};
                RectSched S{nMt, 12, 0, G, c, 1, ~0ull, (const char*)HB, 0, 0, (const char*)(ws + O_WIN) + (size_t)8 * 256 * 1024 * 2, (size_t)256 * 1024 * 2, (size_t)256 * 1024 * 2, 0};
                struct PnShift { RectSched s; __device__ __forceinline__ bool next(int i, Unit& u) const { if (!s.next(i, u)) return false; u.pn += 8; return true; } } S8{S};
                for (int rep_ = 0; rep_ < REP(256); ++rep_) pg8::gemm_phase(F.lds, g, S8, E);
            } break;
            case 5: if (SUB_ON(5)) {
                for (int rep_ = 0; rep_ < REP(512); ++rep_) { EpiMerge E{GT, MB}; const Gemm g{512, 1536, 512};
                RectSched S{nMt, 4, 0, G, c, 3, ~0ull, (const char*)QA, (size_t)((const char*)QBN - (const char*)QA), (size_t)((const char*)YC - (const char*)QA), (const char*)(ws + O_WBR), (size_t)256 * 512 * 2, (size_t)256 * 1536 * 2, (size_t)512 * 2};
                pg8::gemm_phase(F.lds, g, S, E); }
            } break;
            case 6: if (SUB_ON(6)) {
                EpiRes E{xin_lat, xin_ctx, outp, XC, mod_l + 2048}; const Gemm g{1024, 1024, 1024};
                RectSched S{nMt, 4, 0, G, c, 1, ~0ull, (const char*)MB, 0, 0, (const char*)(ws + O_WOUT), (size_t)256 * 1024 * 2, (size_t)256 * 1024 * 2, 0};
                pg8::gemm_phase(F.lds, g, S, E);
            } break;
            case 7: if (SUB_ON(7)) {
                for (int rep_ = 0; rep_ < REP(1024); ++rep_) convert_weights_ffn(F, kp, l);
                for (int rep_ = 0; rep_ < REP(2048); ++rep_) norm_pass(F, outp, XC, HB, kin(kp, 7) + l * 1024, mod_l, 3072, L1 ? ML : MT);
            } break;
            case 8: if (SUB_ON(8)) {
                for (int rep_ = 0; rep_ < REP(4096); ++rep_) { EpiSwiglu E{ACT}; const Gemm g{1024, 1024, 1024};
                RectSched S{nMt, 22, 0, G, c, 1, ~0ull, (const char*)HB, 0, 0, (const char*)(ws + O_WFI), (size_t)256 * 1024 * 2, (size_t)256 * 1024 * 2, 0};
                pg8::gemm_phase(F.lds, g, S, E); }
            } break;
            case 9: if (SUB_ON(9)) {
                EpiRes E{outp, XC, outp, XC, mod_l + 5120}; const Gemm g{FFH, FFH, FFH};
                RectSched S{nMt, 4, 0, G, c, 1, ~0ull, (const char*)ACT, 0, 0, (const char*)(ws + O_WFO), (size_t)256 * FFH * 2, (size_t)256 * FFH * 2, 0};
                pg8::gemm_phase(F.lds, g, S, E);
            } break;
            }
        }
        if (ph + 1 < args.ph_hi) { GRID_SYNC(ph == 0); }
    }
}

extern "C" void kernel_launch(void* const* d_in, const int* in_sizes, int n_in, void* d_out, int out_size, void* d_ws, size_t ws_size, hipStream_t stream) {
    static int grid = 0;
    if (grid == 0) {
        if (n_in != 26 || out_size != ML * DM || ws_size < O_END) { fprintf(stderr, "kernel_launch: unexpected shapes (n_in %d out %d ws %zu)\n", n_in, out_size, ws_size); grid = -1; return; }
        int dev = 0, cus = 0, per_cu = 0;
        hipGetDevice(&dev); hipDeviceGetAttribute(&cus, hipDeviceAttributeMultiprocessorCount, dev);
        if (hipFuncSetAttribute((const void*)fwd_kernel, hipFuncAttributeMaxDynamicSharedMemorySize, LDS_BYTES) != hipSuccess) { fprintf(stderr, "kernel_launch: hipFuncSetAttribute failed\n"); grid = -1; return; }
        hipOccupancyMaxActiveBlocksPerMultiprocessor(&per_cu, (const void*)fwd_kernel, NTHR, LDS_BYTES);
        if (per_cu < 1) { fprintf(stderr, "kernel_launch: occupancy query says %d blocks/CU\n", per_cu); per_cu = 1; }
        (void)hipGetLastError();
        grid = cus;
        if (grid > 256) grid = 256;
    }
    if (grid < 0) return;
    (void)hipMemsetAsync((char*)d_ws + O_CTL, 0, CTL_ZERO_BYTES, stream);
    Args a{};
    for (int i = 0; i < 26; ++i) a.in[i] = (const float*)d_in[i];
    a.out = (float*)d_out; a.ws = (unsigned char*)d_ws;
#if MK_MULTI
    for (int ph = 0; ph < NPHASE; ++ph) { a.ph_lo = ph; a.ph_hi = ph + 1; hipLaunchKernelGGL(fwd_kernel, dim3(grid), dim3(NTHR), LDS_BYTES, stream, a); }
#else
    a.ph_lo = 0; a.ph_hi = NPHASE;
    void* kargs[] = {&a};
    hipError_t e = hipLaunchCooperativeKernel((const void*)fwd_kernel, dim3(grid), dim3(NTHR), kargs, LDS_BYTES, stream);
    if (e != hipSuccess) fprintf(stderr, "cooperative launch failed: %s (grid %d)\n", hipGetErrorString(e), grid);
#endif
}
```

```cpp
#include <hip/hip_runtime.h>
#include <hip/hip_cooperative_groups.h>
#include <cstdint>
#include <cstdio>
namespace cg = cooperative_groups;

#ifndef MK_MULTI
#define MK_MULTI 0
#endif

#define LAS __attribute__((address_space(3)))
typedef unsigned short bf16;
typedef short bf16x8 __attribute__((ext_vector_type(8)));
typedef short s16x4 __attribute__((ext_vector_type(4)));
typedef float f32x2 __attribute__((ext_vector_type(2)));
typedef float f32x4 __attribute__((ext_vector_type(4)));
typedef float f32x16 __attribute__((ext_vector_type(16)));
typedef unsigned u32x2 __attribute__((ext_vector_type(2)));
typedef unsigned u32x4 __attribute__((ext_vector_type(4)));
typedef __bf16 bf16x2_t __attribute__((ext_vector_type(2)));

constexpr int DM = 1024, NB = 8, SEQ = 2048, CTX = 256, NKEY = CTX + SEQ;
constexpr int ML = NB * SEQ, MC = NB * CTX, MT = ML + MC;
constexpr int INW = 5024, NINP = 5120;
constexpr int FFH = 2816;
constexpr float EPS = 1e-6f;
constexpr float LOG2E = 1.4426950408889634f;
constexpr float C2A = 0.125f * LOG2E;
constexpr float C2B = 0.10206207261596577f * LOG2E;
constexpr int NWAVES = 8, NTHR = 512;

constexpr size_t MiB = 1u << 20, KiB = 1024;
constexpr size_t O_CTL = 0;
constexpr size_t O_MOD = 256 * KiB;
constexpr size_t O_ROPEA = 704 * KiB;
constexpr size_t O_ROPEB = 712 * KiB;
constexpr size_t O_STATCQ = 1 * MiB;
constexpr size_t O_STATCKV = O_STATCQ + (size_t)MT * 8 * 4;
constexpr size_t O_DN = 2 * MiB;
constexpr size_t O_DN256 = O_DN + 16 * MiB;
constexpr size_t O_DFTC = O_DN256 + 256 * KiB;
constexpr size_t O_W = O_DN + 16 * MiB + 512 * KiB;
constexpr size_t O_WIN = O_W;
constexpr size_t O_WUQ = O_WIN + (size_t)NINP * 1024 * 2;
constexpr size_t O_WUKV = O_WUQ + 768 * 384 * 2;
constexpr size_t O_WBR = O_WUKV + 1024 * 256 * 2;
constexpr size_t O_WOUT = O_WBR + 1024 * 1536 * 2;
constexpr size_t O_XC = O_W + 16 * MiB + 256 * KiB;
constexpr size_t O_HB = O_XC + 8 * MiB;
constexpr size_t O_PF = O_HB + 36 * MiB;
constexpr size_t O_QA = O_PF + 18 * MiB;
constexpr size_t O_QBN = O_QA + 18 * MiB;
constexpr size_t O_QBR = O_QBN + 18 * MiB;
constexpr size_t O_WFI = O_QA;
constexpr size_t O_WFO = O_WFI + (size_t)5632 * 1024 * 2;
constexpr size_t O_G = O_QBR + 9 * MiB;
constexpr size_t O_CQ = O_G;
constexpr size_t O_CKV = O_CQ + (size_t)MT * 384 * 2;
constexpr size_t O_KA = O_CKV + (size_t)MT * 256 * 2;
constexpr size_t O_VA = O_KA + (size_t)NB * NKEY * 128 * 2;
constexpr size_t O_KB = O_VA + (size_t)NB * NKEY * 128 * 2;
constexpr size_t O_VB = O_KB + (size_t)NB * NKEY * 768 * 2;
constexpr size_t O_ZT1 = O_VB + (size_t)NB * NKEY * 512 * 2;
constexpr size_t O_END = O_ZT1 + 32 * MiB;
static_assert(O_END <= 256 * MiB, "d_ws map exceeds 256 MiB");
static_assert(O_WOUT + 2 * MiB <= O_XC, "W region");
static_assert(O_WFO + (size_t)1024 * 2816 * 2 <= O_G, "ffn weights overlay");
static_assert(O_G + (size_t)MT * 3072 * 2 <= O_END, "gates overlay");
static_assert(O_DFTC + 64 * KiB <= O_W, "dft region");
static_assert(O_STATCKV + (size_t)MT * 4 * 4 <= O_DN, "stats region");

__device__ __forceinline__ unsigned cvtpk(float lo, float hi) { f32x2 v = {lo, hi}; bf16x2_t b = __builtin_convertvector(v, bf16x2_t); return __builtin_bit_cast(unsigned, b); }
__device__ __forceinline__ u32x2 pk4(f32x4 v) { u32x2 r; r.x = cvtpk(v[0], v[1]); r.y = cvtpk(v[2], v[3]); return r; }
__device__ __forceinline__ float bf2f(unsigned short h) { return __uint_as_float((unsigned)h << 16); }
__device__ __forceinline__ f32x4 unpk4(u32x2 w) { f32x4 r; r[0] = __uint_as_float(w.x << 16); r[1] = __uint_as_float(w.x & 0xffff0000u); r[2] = __uint_as_float(w.y << 16); r[3] = __uint_as_float(w.y & 0xffff0000u); return r; }
__device__ __forceinline__ float wave_sum(float v) {
#pragma unroll
    for (int o = 1; o < 64; o <<= 1) v += __shfl_xor(v, o);
    return v;
}
__device__ __forceinline__ float fq_sum(float v) { v += __shfl_xor(v, 16); v += __shfl_xor(v, 32); return v; }
__device__ __forceinline__ float sigmoidf_(float x) { return __builtin_amdgcn_rcpf(1.0f + __expf(-x)); }

namespace pg8 {
constexpr int BM = 256, BK = 64, HALF = 128, HTB = HALF * BK * 2, STAGE_BYTES = 8 * HTB, NXCD = 8, WGM = 8;
__host__ __device__ __forceinline__ int lds_byte(int r, int c) { const int st = (r >> 4) * 2 + (c >> 5), rr = r & 15, cc = c & 31, ob = rr * 64 + cc * 2; return st * 1024 + (ob ^ (((ob >> 9) & 1) << 5)); }
__host__ __device__ __forceinline__ void stage_rc(int b, int& R, int& C) { const int st = b / 1024, sb = b % 1024, swz = sb ^ (((sb >> 9) & 1) << 5); R = (st >> 1) * 16 + swz / 64; C = (st & 1) * 32 + (swz % 64) / 2; }

struct Unit { int pm, pn, kb; const char* A; const char* B; };
struct Gemm { int lda, ldb, K; };

__device__ __forceinline__ void tile_order(int L, int nM, int nN, int& pm, int& pn) {
    const int nwg = nM * nN; int wgid = L;
    { const int q = nwg / NXCD, r = nwg % NXCD, xcd = wgid % NXCD, off = wgid / NXCD; wgid = (xcd < r ? xcd * (q + 1) : r * (q + 1) + (xcd - r) * q) + off; }
    const int nig = WGM * nN, gid = wgid / nig, fm = gid * WGM, gsz = (nM - fm) < WGM ? (nM - fm) : WGM;
    pm = fm + ((wgid % nig) % gsz); pn = (wgid % nig) / gsz;
}

template <class Epi, class Sched>
__device__ __forceinline__ void gemm_phase(LAS unsigned char* lds, const Gemm g, const Sched& S, const Epi& E) {
    int tid = threadIdx.x; asm volatile("" : "+v"(tid));
    const int wid = __builtin_amdgcn_readfirstlane(tid >> 6), lane = tid & 63, wr = wid >> 2, wc = wid & 3, fr = lane & 15, fq = lane >> 4;
    int nt = g.K / BK; asm volatile("" : "+s"(nt));
    unsigned voffA, voffB;
    { int R, C; stage_rc(tid * 16, R, C); voffA = (unsigned)(R * g.lda + C) * 2u; voffB = (unsigned)(R * g.ldb + C) * 2u; }
    const size_t pieceA = (size_t)64 * g.lda * 2, pieceB = (size_t)64 * g.ldb * 2;
    const size_t kstep = (size_t)(BK * 2);
    const size_t hstepA = (size_t)HALF * g.lda * 2, hstepB = (size_t)HALF * g.ldb * 2;
    const unsigned ldsw = (unsigned)wid * 1024u;
    const int aoff = lds_byte(wr * 64 + fr, fq * 8), boff = lds_byte(wc * 32 + fr, fq * 8);
#define PG8_SA(b, h) (((b) * 2 + (h)) * HTB)
#define PG8_SB(b, h) ((4 + (b) * 2 + (h)) * HTB)
#define PG8_STAGE_A(bufoff, gbase) do { _Pragma("unroll") for (int _i = 0; _i < 2; ++_i) \
        __builtin_amdgcn_global_load_lds((const unsigned*)((const char*)(gbase) + _i * pieceA + voffA), (LAS unsigned*)(lds + (bufoff) + ldsw + _i * 8192), 16, 0, 0); } while (0)
#define PG8_STAGE_B(bufoff, gbase) do { _Pragma("unroll") for (int _i = 0; _i < 2; ++_i) \
        __builtin_amdgcn_global_load_lds((const unsigned*)((const char*)(gbase) + _i * pieceB + voffB), (LAS unsigned*)(lds + (bufoff) + ldsw + _i * 8192), 16, 0, 0); } while (0)
#define PG8_LDA(dst, b, h) do { _Pragma("unroll") for (int m = 0; m < 4; ++m) _Pragma("unroll") for (int k = 0; k < 2; ++k) dst[m][k] = *(const LAS bf16x8*)(lds + PG8_SA(b, h) + aoff + m * 2048 + k * 1024); } while (0)
#define PG8_LDB(dst, b, h) do { _Pragma("unroll") for (int n = 0; n < 2; ++n) _Pragma("unroll") for (int k = 0; k < 2; ++k) dst[n][k] = *(const LAS bf16x8*)(lds + PG8_SB(b, h) + boff + n * 2048 + k * 1024); } while (0)
#define PG8_MMA(ai, bj, At, Bt) do { __builtin_amdgcn_s_setprio(1); _Pragma("unroll") for (int m = 0; m < 4; ++m) _Pragma("unroll") for (int n = 0; n < 2; ++n) _Pragma("unroll") for (int k = 0; k < 2; ++k) \
        acc[ai][bj][m][n] = __builtin_amdgcn_mfma_f32_16x16x32_bf16(Bt[n][k], At[m][k], acc[ai][bj][m][n], 0, 0, 0); __builtin_amdgcn_s_setprio(0); } while (0)
#define PG8_WAIT_V(n) asm volatile("s_waitcnt vmcnt(" #n ")" ::: "memory")
#define PG8_WAIT_L(n) asm volatile("s_waitcnt lgkmcnt(" #n ")" ::: "memory")
#define PG8_BAR __builtin_amdgcn_s_barrier()
#define PG8_SCHED __builtin_amdgcn_sched_barrier(0)
    Unit cur, nxt; int ui = 0;
    if (!S.next(0, cur)) return;
    f32x4 acc[2][2][4][2];
#pragma unroll
    for (int a = 0; a < 2; ++a)
#pragma unroll
        for (int b = 0; b < 2; ++b)
#pragma unroll
            for (int m = 0; m < 4; ++m)
#pragma unroll
                for (int n = 0; n < 2; ++n) acc[a][b][m][n] = (f32x4){0.f, 0.f, 0.f, 0.f};
    bf16x8 At[4][2], B0[2][2], B1[2][2];
    const char* cA = cur.A; const char* cB = cur.B;
    PG8_STAGE_B(PG8_SB(0, 0), cB); PG8_STAGE_B(PG8_SB(0, 1), cB + hstepB); PG8_STAGE_A(PG8_SA(0, 0), cA); PG8_STAGE_A(PG8_SA(0, 1), cA + hstepA);
    if (wr == 1) PG8_BAR;
    PG8_WAIT_V(2); PG8_BAR;
    PG8_STAGE_B(PG8_SB(1, 0), cB + kstep); PG8_STAGE_A(PG8_SA(1, 0), cA + kstep); PG8_STAGE_B(PG8_SB(1, 1), cB + hstepB + kstep);
    PG8_WAIT_V(6); PG8_BAR;
    for (;;) {
        const bool has_next = S.next(ui + 1, nxt);
        const char* nA = has_next ? nxt.A : cA; const char* nB = has_next ? nxt.B : cB;
        for (int t = 0; t < nt; t += 2) {
            const bool last = (t == nt - 2);
            const char* a1 = cA + (size_t)(t + 1) * kstep;
            const char* a2 = last ? nA : cA + (size_t)(t + 2) * kstep; const char* b2 = last ? nB : cB + (size_t)(t + 2) * kstep;
            const char* a3 = a2 + kstep; const char* b3 = b2 + kstep;
            PG8_LDB(B0, 0, 0); PG8_LDB(B1, 0, 1); PG8_SCHED; PG8_LDA(At, 0, 0); PG8_STAGE_A(PG8_SA(1, 1), a1 + hstepA);
            PG8_WAIT_V(8); PG8_WAIT_L(0); PG8_BAR; PG8_MMA(0, 0, At, B0); PG8_MMA(0, 1, At, B1); PG8_BAR; PG8_SCHED;
            PG8_LDA(At, 0, 1); PG8_STAGE_B(PG8_SB(0, 0), b2); PG8_STAGE_B(PG8_SB(0, 1), b2 + hstepB); PG8_STAGE_A(PG8_SA(0, 0), a2);
            PG8_WAIT_V(8); PG8_WAIT_L(0); PG8_BAR; PG8_MMA(1, 0, At, B0); PG8_MMA(1, 1, At, B1); PG8_BAR; PG8_SCHED;
            PG8_LDB(B0, 1, 0); PG8_LDB(B1, 1, 1); PG8_SCHED; PG8_LDA(At, 1, 0); PG8_STAGE_A(PG8_SA(0, 1), a2 + hstepA);
            PG8_WAIT_V(8); PG8_WAIT_L(0); PG8_BAR; PG8_MMA(0, 0, At, B0); PG8_MMA(0, 1, At, B1); PG8_BAR; PG8_SCHED;
            PG8_LDA(At, 1, 1); PG8_STAGE_B(PG8_SB(1, 0), b3); PG8_STAGE_B(PG8_SB(1, 1), b3 + hstepB); PG8_STAGE_A(PG8_SA(1, 0), a3);
            PG8_WAIT_V(8); PG8_WAIT_L(0); PG8_BAR; PG8_MMA(1, 0, At, B0); PG8_MMA(1, 1, At, B1); PG8_BAR; PG8_SCHED;
        }
        if (wr == 0) PG8_BAR;
        const bool carry = E(acc, cur, wr, wc, fr, fq);
        if (!has_next) break;
        if (!carry) {
#pragma unroll
            for (int a = 0; a < 2; ++a)
#pragma unroll
                for (int b = 0; b < 2; ++b)
#pragma unroll
                    for (int m = 0; m < 4; ++m)
#pragma unroll
                        for (int n = 0; n < 2; ++n) acc[a][b][m][n] = (f32x4){0.f, 0.f, 0.f, 0.f};
        }
        cur = nxt; cA = nA; cB = nB; ++ui;
        if (wr == 1) PG8_BAR;
    }
    PG8_WAIT_V(0);
    PG8_BAR;
#undef PG8_SA
#undef PG8_SB
#undef PG8_STAGE_A
#undef PG8_STAGE_B
#undef PG8_LDA
#undef PG8_LDB
#undef PG8_MMA
#undef PG8_WAIT_V
#undef PG8_WAIT_L
#undef PG8_BAR
#undef PG8_SCHED
}
}
using pg8::Unit; using pg8::Gemm;

typedef f32x4 Acc[2][2][4][2];

struct RectSched {
    int nM, nN, pm0, G, c, nkb; unsigned long long pnmap;
    const char* A0; size_t dA1, dA2; const char* B; size_t strideAm, strideBn, strideBk;
    __device__ __forceinline__ bool next(int i, Unit& u) const {
        const int ti = i / nkb, kb = i - ti * nkb; const long L = (long)ti * G + c; if (L >= (long)nM * nN) return false;
        int pm, pn; pg8::tile_order((int)L, nM, nN, pm, pn);
        if (pnmap != ~0ull) pn = (int)((pnmap >> (4 * pn)) & 15ull);
        u.pm = pm + pm0; u.pn = pn; u.kb = kb;
        u.A = A0 + (size_t)(kb == 1) * dA1 + (size_t)(kb == 2) * dA2 + (size_t)u.pm * strideAm; u.B = B + (size_t)pn * strideBn + (size_t)kb * strideBk; return true;
    }
};

struct RowInfo { bool ctx; int b; int tok0; };
__device__ __forceinline__ RowInfo row_info(int pm) { RowInfo r; r.ctx = pm >= 64; r.b = r.ctx ? pm - 64 : pm >> 3; r.tok0 = r.ctx ? 0 : (pm & 7) * 256; return r; }

template <bool NORM>
__device__ __forceinline__ void head64(const f32x4 (&a)[2][2], const f32x4 (&g)[2][2], float scale, bool rope, int row_id, int col_id, const float* ropeA, int fq, f32x4 (&o)[2][2]) {
    f32x4 v[2][2];
    if (NORM) {
        float ss = 0.f;
#pragma unroll
        for (int bj = 0; bj < 2; ++bj)
#pragma unroll
            for (int n = 0; n < 2; ++n) { const f32x4 x = a[bj][n]; ss += (x[0] * x[0] + x[1] * x[1]) + (x[2] * x[2] + x[3] * x[3]); }
        ss = fq_sum(ss);
        const float rstd = rsqrtf(ss * (1.0f / 64.0f) + EPS);
#pragma unroll
        for (int bj = 0; bj < 2; ++bj)
#pragma unroll
            for (int n = 0; n < 2; ++n) v[bj][n] = a[bj][n] * rstd * g[bj][n];
    } else {
#pragma unroll
        for (int bj = 0; bj < 2; ++bj)
#pragma unroll
            for (int n = 0; n < 2; ++n) v[bj][n] = a[bj][n];
    }
    if (rope) {
#pragma unroll
        for (int bj = 0; bj < 2; ++bj) {
            const int pos = bj ? col_id : row_id;
            const f32x4 cs = *(const f32x4*)(ropeA + pos * 16 + 4 * fq), sn = *(const f32x4*)(ropeA + 1024 + pos * 16 + 4 * fq);
            o[bj][0] = (v[bj][0] * cs - v[bj][1] * sn) * scale; o[bj][1] = (v[bj][1] * cs + v[bj][0] * sn) * scale;
        }
    } else {
#pragma unroll
        for (int bj = 0; bj < 2; ++bj)
#pragma unroll
            for (int n = 0; n < 2; ++n) o[bj][n] = v[bj][n] * scale;
    }
}
__device__ __forceinline__ void rope32(const f32x4 (&a)[2], const float* g, float scale, bool rope, int row_id, int col_id, const float* ropeB, int fq, f32x4 (&o)[2]) {
    float ss = 0.f;
#pragma unroll
    for (int n = 0; n < 2; ++n) { const f32x4 x = a[n]; ss += (x[0] * x[0] + x[1] * x[1]) + (x[2] * x[2] + x[3] * x[3]); }
    ss = fq_sum(ss);
    const float rstd = rsqrtf(ss * (1.0f / 32.0f) + EPS);
    const int d0 = 16 * (fq >> 1) + 4 * (fq & 1);
    f32x4 v[2];
#pragma unroll
    for (int n = 0; n < 2; ++n) v[n] = a[n] * rstd * *(const f32x4*)(g + d0 + 8 * n);
    if (rope) {
        const int pos = (fq >> 1) ? col_id : row_id;
        const f32x4 cs = *(const f32x4*)(ropeB + pos * 8 + 4 * (fq & 1)), sn = *(const f32x4*)(ropeB + 512 + pos * 8 + 4 * (fq & 1));
        o[0] = (v[0] * cs - v[1] * sn) * scale; o[1] = (v[1] * cs + v[0] * sn) * scale;
    } else { o[0] = v[0] * scale; o[1] = v[1] * scale; }
}

struct EpiIn {
    bf16 *QA, *KA, *VA, *CQ, *CKV, *KB, *PF, *G; float *stat_cq, *stat_ckv;
    const float *gq, *gk, *gkr, *bgate, *ropeA, *ropeB;
    __device__ __forceinline__ bool operator()(Acc& acc, const Unit& u, int wr, int wc, int fr_, int fq_) const {
        int fr = fr_, fq = fq_; asm volatile("" : "+v"(fr), "+v"(fq));
        const RowInfo ri = row_info(u.pm); const bool rope = !ri.ctx;
        const int pn = u.pn;
        if (pn <= 2) {
            const bool isv = (pn == 2 && wc >= 2), isk = (pn == 2 && wc < 2);
            const float* gsrc = (pn < 2) ? gq : gk;
            f32x4 g[2][2];
#pragma unroll
            for (int bj = 0; bj < 2; ++bj)
#pragma unroll
                for (int n = 0; n < 2; ++n) g[bj][n] = *(const f32x4*)(gsrc + 32 * bj + 16 * n + 4 * fq);
#pragma unroll
            for (int ai = 0; ai < 2; ++ai)
#pragma unroll
                for (int m = 0; m < 4; ++m) {
                    const int rt = 128 * ai + 64 * wr + 16 * m + fr;
                    const int row_id = (ri.tok0 + 128 * ai + 64 * wr) >> 6, col_id = 16 * m + fr;
                    f32x4 a[2][2], o[2][2];
#pragma unroll
                    for (int bj = 0; bj < 2; ++bj)
#pragma unroll
                        for (int n = 0; n < 2; ++n) a[bj][n] = acc[ai][bj][m][n];
                    bf16* dst;
                    if (pn < 2) { head64<true>(a, g, C2A, rope, row_id, col_id, ropeA, fq, o); dst = QA + (size_t)(u.pm * 256 + rt) * 512 + (4 * pn + wc) * 64; }
                    else {
                        const size_t key = (size_t)ri.b * NKEY + (ri.ctx ? rt : 256 + ri.tok0 + rt);
                        if (isk) { head64<true>(a, g, 1.0f, rope, row_id, col_id, ropeA, fq, o); dst = KA + key * 128 + wc * 64; }
                        else { head64<false>(a, g, 1.0f, false, 0, 0, ropeA, fq, o); dst = VA + key * 128 + (wc - 2) * 64; }
                    }
#pragma unroll
                    for (int bj = 0; bj < 2; ++bj)
#pragma unroll
                        for (int n = 0; n < 2; ++n) *(u32x2*)(dst + 32 * bj + 16 * n + 4 * fq) = pk4(o[bj][n]);
                }
            (void)isv;
        } else if (pn == 3 || pn == 5) {
            bf16* dstb = (pn == 3) ? CQ : CKV; const int ld = (pn == 3) ? 384 : 256;
            float* st = (pn == 3) ? stat_cq : stat_ckv; const int sld = (pn == 3) ? 8 : 4;
#pragma unroll
            for (int ai = 0; ai < 2; ++ai)
#pragma unroll
                for (int m = 0; m < 4; ++m) {
                    const size_t row = (size_t)u.pm * 256 + 128 * ai + 64 * wr + 16 * m + fr; float ss = 0.f;
#pragma unroll
                    for (int bj = 0; bj < 2; ++bj)
#pragma unroll
                        for (int n = 0; n < 2; ++n) { const f32x4 x = acc[ai][bj][m][n]; ss += (x[0] * x[0] + x[1] * x[1]) + (x[2] * x[2] + x[3] * x[3]);
                            *(u32x2*)(dstb + row * ld + 128 * bj + 32 * wc + 16 * n + 4 * fq) = pk4(x); }
                    ss = fq_sum(ss);
                    if (fq == 0) st[row * sld + wc] = ss;
                }
        } else if (pn == 4) {
            f32x4 gk0[2]; (void)gk0;
#pragma unroll
            for (int ai = 0; ai < 2; ++ai)
#pragma unroll
                for (int m = 0; m < 4; ++m) {
                    const int rt = 128 * ai + 64 * wr + 16 * m + fr; const size_t row = (size_t)u.pm * 256 + rt; float ss = 0.f;
#pragma unroll
                    for (int n = 0; n < 2; ++n) { const f32x4 x = acc[ai][0][m][n]; ss += (x[0] * x[0] + x[1] * x[1]) + (x[2] * x[2] + x[3] * x[3]);
                        *(u32x2*)(CQ + row * 384 + 256 + 32 * wc + 16 * n + 4 * fq) = pk4(x); }
                    ss = fq_sum(ss);
                    if (fq == 0) stat_cq[row * 8 + 4 + wc] = ss;
                    if (wc == 0) {
                        const int row_id = (ri.tok0 + 128 * ai + 64 * wr) >> 6, col_id = 16 * m + fr;
                        f32x4 a[2], o[2]; a[0] = acc[ai][1][m][0]; a[1] = acc[ai][1][m][1];
                        rope32(a, gkr, 1.0f, rope, row_id, col_id, ropeB, fq, o);
                        const size_t key = (size_t)ri.b * NKEY + (ri.ctx ? rt : 256 + ri.tok0 + rt);
                        bf16* dst = KB + key * 768 + 64 + 16 * (fq >> 1) + 4 * (fq & 1);
                        const u32x2 w0 = pk4(o[0]), w1 = pk4(o[1]);
#pragma unroll
                        for (int h = 0; h < 8; ++h) { *(u32x2*)(dst + h * 96) = w0; *(u32x2*)(dst + h * 96 + 8) = w1; }
                    }
                }
        } else if (pn < 8) {
#pragma unroll
            for (int ai = 0; ai < 2; ++ai)
#pragma unroll
                for (int m = 0; m < 4; ++m) {
                    const size_t row = (size_t)u.pm * 256 + 128 * ai + 64 * wr + 16 * m + fr;
#pragma unroll
                    for (int bj = 0; bj < 2; ++bj)
#pragma unroll
                        for (int n = 0; n < 2; ++n) *(u32x2*)(PF + row * 512 + (pn - 6) * 256 + 128 * bj + 32 * wc + 16 * n + 4 * fq) = pk4(acc[ai][bj][m][n]);
                }
        } else {
            const int c0 = (pn - 8) * 256 + 32 * wc + 4 * fq;
            f32x4 bv[2][2];
#pragma unroll
            for (int bj = 0; bj < 2; ++bj)
#pragma unroll
                for (int n = 0; n < 2; ++n) bv[bj][n] = *(const f32x4*)(bgate + c0 + 128 * bj + 16 * n);
#pragma unroll
            for (int ai = 0; ai < 2; ++ai)
#pragma unroll
                for (int m = 0; m < 4; ++m) {
                    const size_t row = (size_t)u.pm * 256 + 128 * ai + 64 * wr + 16 * m + fr;
#pragma unroll
                    for (int bj = 0; bj < 2; ++bj)
#pragma unroll
                        for (int n = 0; n < 2; ++n) { f32x4 x = acc[ai][bj][m][n] + bv[bj][n];
                            x[0] = sigmoidf_(x[0]); x[1] = sigmoidf_(x[1]); x[2] = sigmoidf_(x[2]); x[3] = sigmoidf_(x[3]);
                            *(u32x2*)(G + row * 3072 + c0 + 128 * bj + 16 * n) = pk4(x); }
                }
        }
        return false;
    }
};

struct EpiUq {
    bf16 *QBN, *QBR; const float *stat_cq, *gqn, *gqr, *ropeB;
    __device__ __forceinline__ bool operator()(Acc& acc, const Unit& u, int wr, int wc, int fr_, int fq_) const {
        int fr = fr_, fq = fq_; asm volatile("" : "+v"(fr), "+v"(fq));
        const RowInfo ri = row_info(u.pm); const bool rope = !ri.ctx;
        f32x4 g[2][2];
#pragma unroll
        for (int bj = 0; bj < 2; ++bj)
#pragma unroll
            for (int n = 0; n < 2; ++n) g[bj][n] = *(const f32x4*)(gqn + 32 * bj + 16 * n + 4 * fq);
#pragma unroll
        for (int ai = 0; ai < 2; ++ai)
#pragma unroll
            for (int m = 0; m < 4; ++m) {
                const int rt = 128 * ai + 64 * wr + 16 * m + fr; const size_t row = (size_t)u.pm * 256 + rt;
                const f32x4 s0 = *(const f32x4*)(stat_cq + row * 8), s1 = *(const f32x4*)(stat_cq + row * 8 + 4);
                const float rs = rsqrtf(((s0[0] + s0[1]) + (s0[2] + s0[3]) + (s1[0] + s1[1]) + (s1[2] + s1[3])) * (1.0f / 384.0f) + EPS);
                if (u.pn < 2) {
                    f32x4 a[2][2], o[2][2];
#pragma unroll
                    for (int bj = 0; bj < 2; ++bj)
#pragma unroll
                        for (int n = 0; n < 2; ++n) a[bj][n] = acc[ai][bj][m][n] * rs;
                    head64<true>(a, g, C2B, false, 0, 0, ropeB, fq, o);
                    bf16* dst = QBN + row * 512 + (4 * u.pn + wc) * 64;
#pragma unroll
                    for (int bj = 0; bj < 2; ++bj)
#pragma unroll
                        for (int n = 0; n < 2; ++n) *(u32x2*)(dst + 32 * bj + 16 * n + 4 * fq) = pk4(o[bj][n]);
                } else {
                    const int row_id = (ri.tok0 + 128 * ai + 64 * wr) >> 6, col_id = 16 * m + fr;
#pragma unroll
                    for (int bj = 0; bj < 2; ++bj) {
                        f32x4 a[2], o[2]; a[0] = acc[ai][bj][m][0] * rs; a[1] = acc[ai][bj][m][1] * rs;
                        rope32(a, gqr, C2B, rope, row_id, col_id, ropeB, fq, o);
                        bf16* dst = QBR + row * 256 + (4 * bj + wc) * 32 + 16 * (fq >> 1) + 4 * (fq & 1);
                        *(u32x2*)(dst) = pk4(o[0]); *(u32x2*)(dst + 8) = pk4(o[1]);
                    }
                }
            }
        return false;
    }
};

struct EpiUkv {
    bf16 *KB, *VB; const float *stat_ckv, *gkn;
    __device__ __forceinline__ bool operator()(Acc& acc, const Unit& u, int wr, int wc, int fr_, int fq_) const {
        int fr = fr_, fq = fq_; asm volatile("" : "+v"(fr), "+v"(fq));
        const RowInfo ri = row_info(u.pm);
        f32x4 g[2][2];
#pragma unroll
        for (int bj = 0; bj < 2; ++bj)
#pragma unroll
            for (int n = 0; n < 2; ++n) g[bj][n] = *(const f32x4*)(gkn + 32 * bj + 16 * n + 4 * fq);
#pragma unroll
        for (int ai = 0; ai < 2; ++ai)
#pragma unroll
            for (int m = 0; m < 4; ++m) {
                const int rt = 128 * ai + 64 * wr + 16 * m + fr; const size_t row = (size_t)u.pm * 256 + rt;
                const f32x4 s0 = *(const f32x4*)(stat_ckv + row * 4);
                const float rs = rsqrtf(((s0[0] + s0[1]) + (s0[2] + s0[3])) * (1.0f / 256.0f) + EPS);
                const size_t key = (size_t)ri.b * NKEY + (ri.ctx ? rt : 256 + ri.tok0 + rt);
                f32x4 a[2][2], o[2][2];
#pragma unroll
                for (int bj = 0; bj < 2; ++bj)
#pragma unroll
                    for (int n = 0; n < 2; ++n) a[bj][n] = acc[ai][bj][m][n] * rs;
                bf16* dst;
                if (u.pn < 2) { head64<true>(a, g, 1.0f, false, 0, 0, gkn, fq, o); dst = KB + key * 768 + (4 * u.pn + wc) * 96; }
                else { head64<false>(a, g, 1.0f, false, 0, 0, gkn, fq, o); dst = VB + key * 512 + (4 * (u.pn - 2) + wc) * 64; }
#pragma unroll
                for (int bj = 0; bj < 2; ++bj)
#pragma unroll
                    for (int n = 0; n < 2; ++n) *(u32x2*)(dst + 32 * bj + 16 * n + 4 * fq) = pk4(o[bj][n]);
            }
        return false;
    }
};

struct EpiStore {
    bf16* O; int ld;
    __device__ __forceinline__ bool operator()(Acc& acc, const Unit& u, int wr, int wc, int fr_, int fq_) const {
        int fr = fr_, fq = fq_; asm volatile("" : "+v"(fr), "+v"(fq));
#pragma unroll
        for (int ai = 0; ai < 2; ++ai)
#pragma unroll
            for (int m = 0; m < 4; ++m) {
                const size_t row = (size_t)u.pm * 256 + 128 * ai + 64 * wr + 16 * m + fr;
#pragma unroll
                for (int bj = 0; bj < 2; ++bj)
#pragma unroll
                    for (int n = 0; n < 2; ++n) *(u32x2*)(O + row * ld + u.pn * 256 + 128 * bj + 32 * wc + 16 * n + 4 * fq) = pk4(acc[ai][bj][m][n]);
            }
        return false;
    }
};

struct EpiF1 {
    bf16* ZT; int NP;
    __device__ __forceinline__ bool operator()(Acc& acc, const Unit& u, int wr, int wc, int fr_, int fq_) const {
        int fr = fr_, fq = fq_; asm volatile("" : "+v"(fr), "+v"(fq));
        const int b = u.pm >> 2, gch = u.pm & 3;
#pragma unroll
        for (int ai = 0; ai < 2; ++ai)
#pragma unroll
            for (int m = 0; m < 4; ++m) {
                const int ch = gch * 128 + 64 * wr + 16 * m + fr;
                bf16* dst = ZT + ((size_t)b * 512 + ch) * (2 * NP) + ai * NP + u.pn * 256;
#pragma unroll
                for (int bj = 0; bj < 2; ++bj)
#pragma unroll
                    for (int n = 0; n < 2; ++n) *(u32x2*)(dst + 128 * bj + 32 * wc + 16 * n + 4 * fq) = pk4(acc[ai][bj][m][n]);
            }
        return false;
    }
};

struct EpiMerge {
    const bf16* G; bf16* MB;
    __device__ __forceinline__ bool operator()(Acc& acc, const Unit& u, int wr, int wc, int fr_, int fq_) const {
        int fr = fr_, fq = fq_; asm volatile("" : "+v"(fr), "+v"(fq));
        const int kb = u.kb; const int c0 = u.pn * 256 + 32 * wc + 4 * fq;
#pragma unroll
        for (int ai = 0; ai < 2; ++ai)
#pragma unroll
            for (int m = 0; m < 4; ++m) {
                const size_t row = (size_t)u.pm * 256 + 128 * ai + 64 * wr + 16 * m + fr;
                const bf16* gp = G + row * 3072 + c0;
#pragma unroll
                for (int bj = 0; bj < 2; ++bj)
#pragma unroll
                    for (int n = 0; n < 2; ++n) {
                        const int co = 128 * bj + 16 * n;
                        if (kb < 2) { const f32x4 ga = unpk4(*(const u32x2*)(gp + kb * 1024 + co)), gb = unpk4(*(const u32x2*)(gp + (kb + 1) * 1024 + co));
                            f32x4 r; r[0] = ga[0] / gb[0]; r[1] = ga[1] / gb[1]; r[2] = ga[2] / gb[2]; r[3] = ga[3] / gb[3]; acc[ai][bj][m][n] *= r; }
                        else { const f32x4 gc = unpk4(*(const u32x2*)(gp + 2048 + co)); *(u32x2*)(MB + row * 1024 + c0 + co) = pk4(acc[ai][bj][m][n] * gc); }
                    }
            }
        return kb < 2;
    }
};

struct EpiRes {
    const float *xin_lat, *xin_ctx; float *xout_lat, *xout_ctx; const float* gate;
    __device__ __forceinline__ bool operator()(Acc& acc, const Unit& u, int wr, int wc, int fr_, int fq_) const {
        int fr = fr_, fq = fq_; asm volatile("" : "+v"(fr), "+v"(fq));
        const RowInfo ri = row_info(u.pm); const int s = ri.ctx ? 8 : ri.b;
        const int c0 = u.pn * 256 + 32 * wc + 4 * fq;
        const float* xin = ri.ctx ? xin_ctx + (size_t)(u.pm - 64) * 256 * 1024 : xin_lat + (size_t)u.pm * 256 * 1024;
        float* xout = ri.ctx ? xout_ctx + (size_t)(u.pm - 64) * 256 * 1024 : xout_lat + (size_t)u.pm * 256 * 1024;
        f32x4 gv[2][2];
#pragma unroll
        for (int bj = 0; bj < 2; ++bj)
#pragma unroll
            for (int n = 0; n < 2; ++n) gv[bj][n] = *(const f32x4*)(gate + s * 6144 + c0 + 128 * bj + 16 * n);
#pragma unroll
        for (int ai = 0; ai < 2; ++ai)
#pragma unroll
            for (int m = 0; m < 4; ++m) {
                const size_t off = (size_t)(128 * ai + 64 * wr + 16 * m + fr) * 1024 + c0;
#pragma unroll
                for (int bj = 0; bj < 2; ++bj)
#pragma unroll
                    for (int n = 0; n < 2; ++n) { const f32x4 xi = *(const f32x4*)(xin + off + 128 * bj + 16 * n); *(f32x4*)(xout + off + 128 * bj + 16 * n) = xi + gv[bj][n] * acc[ai][bj][m][n]; }
                asm volatile("" ::: "memory");
            }
        return false;
    }
};

struct EpiSwiglu {
    bf16* ACT;
    __device__ __forceinline__ bool operator()(Acc& acc, const Unit& u, int wr, int wc, int fr_, int fq_) const {
        int fr = fr_, fq = fq_; asm volatile("" : "+v"(fr), "+v"(fq));
#pragma unroll
        for (int ai = 0; ai < 2; ++ai)
#pragma unroll
            for (int m = 0; m < 4; ++m) {
                const size_t row = (size_t)u.pm * 256 + 128 * ai + 64 * wr + 16 * m + fr;
#pragma unroll
                for (int n = 0; n < 2; ++n) { const f32x4 gt = acc[ai][0][m][n], up = acc[ai][1][m][n]; f32x4 o;
                    o[0] = gt[0] * sigmoidf_(gt[0]) * up[0]; o[1] = gt[1] * sigmoidf_(gt[1]) * up[1]; o[2] = gt[2] * sigmoidf_(gt[2]) * up[2]; o[3] = gt[3] * sigmoidf_(gt[3]) * up[3];
                    *(u32x2*)(ACT + row * FFH + u.pn * 128 + 32 * wc + 16 * n + 4 * fq) = pk4(o); }
            }
        return false;
    }
};

namespace att {
constexpr int KSLOT = 12288, VSLOT = 8192;
constexpr int L_K = 0, L_V = 2 * KSLOT, L_WS = L_V + 2 * VSLOT, L_OST = L_WS + NWAVES * 64 * 4, L_BYTES = L_OST + NWAVES * 4096;
__device__ __forceinline__ int crow(int r, int hi) { return (r & 3) + 8 * (r >> 2) + 4 * hi; }
__device__ __forceinline__ float max3f(float a, float b, float c) { return __builtin_fmaxf(__builtin_fmaxf(a, b), c); }
__device__ __forceinline__ float rowmax(const f32x16& p0, const f32x16& p1) {
    float a = max3f(p0[0], p0[1], p1[0]), b = max3f(p0[2], p0[3], p1[1]); a = max3f(a, p1[2], p1[3]);
#pragma unroll
    for (int r = 4; r < 16; r += 4) { a = max3f(a, p0[r], p0[r + 1]); b = max3f(b, p0[r + 2], p0[r + 3]); a = max3f(a, p1[r], p1[r + 1]); b = max3f(b, p1[r + 2], p1[r + 3]); }
    const float m = __builtin_fmaxf(a, b);
    auto rr = __builtin_amdgcn_permlane32_swap(__float_as_uint(m), __float_as_uint(m), false, false);
    return __builtin_fmaxf(__uint_as_float(rr[0]), __uint_as_float(rr[1]));
}
__device__ __forceinline__ void pv(f32x16* o, int vb, bf16x8 pa0, bf16x8 pa1, bf16x8 pa2, bf16x8 pa3) {
#pragma unroll
    for (int d0 = 0; d0 < 2; ++d0) { s16x4 lo[4], hi[4];
#pragma unroll
        for (int ks = 0; ks < 4; ++ks) {
            asm volatile("ds_read_b64_tr_b16 %0,%1 offset:%c2" : "=&v"(lo[ks]) : "v"(vb), "i"(d0 * 4096 + ks * 1024) : "memory");
            asm volatile("ds_read_b64_tr_b16 %0,%1 offset:%c2" : "=&v"(hi[ks]) : "v"(vb), "i"(d0 * 4096 + ks * 1024 + 512) : "memory"); }
        asm volatile("s_waitcnt lgkmcnt(0)" ::: "memory"); __builtin_amdgcn_sched_barrier(0);
#define PK(k) (bf16x8){lo[k][0], lo[k][1], lo[k][2], lo[k][3], hi[k][0], hi[k][1], hi[k][2], hi[k][3]}
        o[d0] = __builtin_amdgcn_mfma_f32_32x32x16_bf16(pa0, PK(0), o[d0], 0, 0, 0);
        o[d0] = __builtin_amdgcn_mfma_f32_32x32x16_bf16(pa1, PK(1), o[d0], 0, 0, 0);
        o[d0] = __builtin_amdgcn_mfma_f32_32x32x16_bf16(pa2, PK(2), o[d0], 0, 0, 0);
        o[d0] = __builtin_amdgcn_mfma_f32_32x32x16_bf16(pa3, PK(3), o[d0], 0, 0, 0);
#undef PK
    }
}
template <int DQK>
__device__ __forceinline__ void attn_unit(const bf16* Qn, int pqn, const bf16* Qr, int pqr, const bf16* Kh, int pk, const bf16* Vh, int pv_, bf16* O, int po, int NT, LAS unsigned char* shm) {
    constexpr int ND = DQK / 16, NCH = DQK / 8;
    int tid = threadIdx.x; asm volatile("" : "+v"(tid));
    const int lane = tid & 63, r32 = lane & 31, hi = lane >> 5; const int wid = __builtin_amdgcn_readfirstlane(tid >> 6);
    LAS float* wsf = (LAS float*)(shm + L_WS) + wid * 64;
    const bf16* ksrc = Kh + (size_t)lane * pk + wid * 8;
    const bf16* vsrc = Vh + (size_t)(16 * (wid & 3) + (lane >> 2)) * pv_ + (wid >> 2) * 32 + (lane & 3) * 8;
    const int vb0 = (int)(unsigned)(uintptr_t)(shm + L_V) + ((lane >> 4) & 1) * 32 + (lane & 3) * 8 + (4 * hi + ((lane & 15) >> 2)) * 64;
    const LAS unsigned char* kp0 = shm + L_K + hi * 1024 + r32 * 16;
#define DMA_TILE(t, buf) do { \
        __builtin_amdgcn_global_load_lds((const unsigned*)(ksrc + (size_t)(t) * 64 * pk), (LAS unsigned*)(shm + L_K + (buf) * KSLOT + wid * 1024), 16, 0, 0); \
        if (NCH > 8 && wid < NCH - 8) __builtin_amdgcn_global_load_lds((const unsigned*)(ksrc + (size_t)(t) * 64 * pk + 64), (LAS unsigned*)(shm + L_K + (buf) * KSLOT + (wid + 8) * 1024), 16, 0, 0); \
        __builtin_amdgcn_global_load_lds((const unsigned*)(vsrc + (size_t)(t) * 64 * pv_), (LAS unsigned*)(shm + L_V + (buf) * VSLOT + wid * 1024), 16, 0, 0); } while (0)
    DMA_TILE(0, 0);
    bf16x8 qr[ND];
#pragma unroll
    for (int d0 = 0; d0 < 4; ++d0) qr[d0] = *(const bf16x8*)(Qn + (size_t)(wid * 32 + r32) * pqn + d0 * 16 + hi * 8);
    if (ND > 4) {
#pragma unroll
        for (int d0 = 4; d0 < ND; ++d0) qr[d0] = *(const bf16x8*)(Qr + (size_t)(wid * 32 + r32) * pqr + (d0 - 4) * 16 + hi * 8);
    }
    float mrun = -1e30f, l_reg = 0.f; f32x16 o[2]; o[0] = f32x16{}; o[1] = f32x16{};
    for (int t = 0; t < NT; ++t) {
        const int buf = t & 1;
        asm volatile("s_waitcnt vmcnt(0)" ::: "memory");
        __syncthreads();
        if (t + 1 < NT) DMA_TILE(t + 1, buf ^ 1);
        f32x16 p0 = f32x16{}, p1 = f32x16{};
        const LAS unsigned char* kp = kp0 + buf * KSLOT;
#pragma unroll
        for (int d0 = 0; d0 < ND; ++d0) {
            const bf16x8 b0 = *(const LAS bf16x8*)(kp + d0 * 2048), b1 = *(const LAS bf16x8*)(kp + d0 * 2048 + 512);
            p0 = __builtin_amdgcn_mfma_f32_32x32x16_bf16(b0, qr[d0], p0, 0, 0, 0); p1 = __builtin_amdgcn_mfma_f32_32x32x16_bf16(b1, qr[d0], p1, 0, 0, 0);
        }
        const float rm = rowmax(p0, p1);
        if (__any(rm > mrun)) {
            const float mn = __builtin_fmaxf(mrun, rm), al = __builtin_amdgcn_exp2f(mrun - mn); mrun = mn; l_reg *= al;
            if (hi == 0) wsf[r32] = al;
            asm volatile("s_waitcnt lgkmcnt(0)" ::: "memory");
#pragma unroll
            for (int r = 0; r < 16; ++r) { const float f = wsf[crow(r, hi)]; o[0][r] *= f; o[1][r] *= f; }
        }
        float sacc = 0.f;
#pragma unroll
        for (int r = 0; r < 16; ++r) { p0[r] = __builtin_amdgcn_exp2f(p0[r] - mrun); p1[r] = __builtin_amdgcn_exp2f(p1[r] - mrun); sacc += p0[r] + p1[r]; }
        l_reg += sacc;
        u32x4 w0, w1, w2, w3;
        w0 = (u32x4){cvtpk(p0[0], p0[1]), cvtpk(p0[2], p0[3]), cvtpk(p0[4], p0[5]), cvtpk(p0[6], p0[7])};
        w1 = (u32x4){cvtpk(p0[8], p0[9]), cvtpk(p0[10], p0[11]), cvtpk(p0[12], p0[13]), cvtpk(p0[14], p0[15])};
        w2 = (u32x4){cvtpk(p1[0], p1[1]), cvtpk(p1[2], p1[3]), cvtpk(p1[4], p1[5]), cvtpk(p1[6], p1[7])};
        w3 = (u32x4){cvtpk(p1[8], p1[9]), cvtpk(p1[10], p1[11]), cvtpk(p1[12], p1[13]), cvtpk(p1[14], p1[15])};
        pv(o, vb0 + buf * VSLOT, __builtin_bit_cast(bf16x8, w0), __builtin_bit_cast(bf16x8, w1), __builtin_bit_cast(bf16x8, w2), __builtin_bit_cast(bf16x8, w3));
    }
#undef DMA_TILE
    { auto rr = __builtin_amdgcn_permlane32_swap(__float_as_uint(l_reg), __float_as_uint(l_reg), false, false); l_reg = __uint_as_float(rr[0]) + __uint_as_float(rr[1]); }
    if (hi == 0) wsf[32 + r32] = l_reg;
    asm volatile("s_waitcnt lgkmcnt(0)" ::: "memory");
    float rli[16];
#pragma unroll
    for (int r = 0; r < 16; ++r) rli[r] = __builtin_amdgcn_rcpf(wsf[32 + crow(r, hi)]);
    LAS bf16* stg = (LAS bf16*)(shm + L_OST) + wid * 2048;
#pragma unroll
    for (int r = 0; r < 16; ++r) { const int orow = crow(r, hi);
#pragma unroll
        for (int d0 = 0; d0 < 2; ++d0) stg[orow * 64 + d0 * 32 + r32] = (bf16)(cvtpk(o[d0][r] * rli[r], 0.f) & 0xffffu); }
    asm volatile("s_waitcnt lgkmcnt(0)" ::: "memory");
    bf16* Ow = O + (size_t)(wid * 32) * po;
#pragma unroll
    for (int i = 0; i < 4; ++i) { const int row = i * 8 + (lane >> 3), ch = lane & 7; const u32x4 v = *(const LAS u32x4*)(stg + row * 64 + ch * 8); *(u32x4*)(Ow + (size_t)row * po + ch * 8) = v; }
    asm volatile("s_waitcnt lgkmcnt(0)" ::: "memory");
    __syncthreads();
}
}


namespace attq {
using att::crow;
constexpr int NSLOT = 3;
#define SBAR() __builtin_amdgcn_sched_barrier(0)
__device__ __forceinline__ void glds16(const void* gsrc, unsigned lds_dst) { unsigned keep;
    asm volatile("s_mov_b32 %0, m0\n\ts_mov_b32 m0, %2\n\ts_nop 0\n\tglobal_load_lds_dwordx4 %1, off\n\ts_mov_b32 m0, %0" : "=&s"(keep) : "v"(gsrc), "s"(lds_dst) : "memory"); }
__device__ __forceinline__ float max3f(float a, float b, float c) { float r; asm("v_max3_f32 %0, %1, %2, %3" : "=v"(r) : "v"(a), "v"(b), "v"(c)); return r; }
__device__ __forceinline__ float max2f(float a, float b) { float r; asm("v_max_f32_e32 %0, %1, %2" : "=v"(r) : "v"(a), "v"(b)); return r; }
__device__ __forceinline__ float fadd_s(float a, float b) { float r; asm("v_add_f32_e32 %0, %1, %2" : "=v"(r) : "v"(a), "v"(b)); return r; }
__device__ __forceinline__ float fsub_s(float a, float b) { float r; asm("v_sub_f32_e32 %0, %1, %2" : "=v"(r) : "v"(a), "v"(b)); return r; }
template <int N> __device__ __forceinline__ void wait_bar() { asm volatile("s_waitcnt vmcnt(%0) lgkmcnt(0)\n\ts_barrier" :: "n"(N) : "memory"); }
#define WAIT_BAR(N) wait_bar<(N)>()
template <int ND> __device__ __forceinline__ void qkt(f32x16& p0, f32x16& p1, const char* Kslot, const bf16x8* qr, const f32x16& negm, int r32, int hi) {
    const char* kb = Kslot + hi * 1024 + r32 * 16;
#pragma unroll
    for (int d0 = 0; d0 < ND; ++d0) {
        const bf16x8 b0 = *reinterpret_cast<const bf16x8*>(kb + d0 * 2048);
        const bf16x8 b1 = *reinterpret_cast<const bf16x8*>(kb + d0 * 2048 + 512);
        if (d0 == 0) { p0 = __builtin_amdgcn_mfma_f32_32x32x16_bf16(b0, qr[0], negm, 0, 0, 0); p1 = __builtin_amdgcn_mfma_f32_32x32x16_bf16(b1, qr[0], negm, 0, 0, 0); }
        else { p0 = __builtin_amdgcn_mfma_f32_32x32x16_bf16(b0, qr[d0], p0, 0, 0, 0); p1 = __builtin_amdgcn_mfma_f32_32x32x16_bf16(b1, qr[d0], p1, 0, 0, 0); } }
}
typedef __attribute__((address_space(3))) const char* lds_cptr;
typedef short v4i16_t __attribute__((ext_vector_type(4)));
template <int ND> __device__ __forceinline__ void kloadall(bf16x8* kf, lds_cptr kp) {
    kf[0] = *(const LAS bf16x8*)(kp);        kf[1] = *(const LAS bf16x8*)(kp + 512);
    kf[2] = *(const LAS bf16x8*)(kp + 2048); kf[3] = *(const LAS bf16x8*)(kp + 2560);
    kf[4] = *(const LAS bf16x8*)(kp + 4096); kf[5] = *(const LAS bf16x8*)(kp + 4608);
    kf[6] = *(const LAS bf16x8*)(kp + 6144); kf[7] = *(const LAS bf16x8*)(kp + 6656);
    if constexpr (ND == 6) { kf[8] = *(const LAS bf16x8*)(kp + 8192); kf[9] = *(const LAS bf16x8*)(kp + 8704); kf[10] = *(const LAS bf16x8*)(kp + 10240); kf[11] = *(const LAS bf16x8*)(kp + 10752); }
}
__device__ __forceinline__ void kload2(bf16x8* kf, lds_cptr kp, int j) { kf[2 * j] = *(const LAS bf16x8*)(kp + j * 2048); kf[2 * j + 1] = *(const LAS bf16x8*)(kp + j * 2048 + 512); }
__device__ __forceinline__ s16x4 vtr(lds_cptr p) { return __builtin_bit_cast(s16x4, __builtin_amdgcn_ds_read_tr16_b64_v4i16((LAS v4i16_t*)p)); }
__device__ __forceinline__ float rowmax(const f32x16& p0, const f32x16& p1) {
    float a = max3f(p0[0], p0[1], p1[0]), b = max3f(p0[2], p0[3], p1[1]); a = max3f(a, p1[2], p1[3]);
#pragma unroll
    for (int r = 4; r < 16; r += 4) { a = max3f(a, p0[r], p0[r + 1]); b = max3f(b, p0[r + 2], p0[r + 3]); a = max3f(a, p1[r], p1[r + 1]); b = max3f(b, p1[r + 2], p1[r + 3]); }
    const float m = max2f(a, b);
    auto rr = __builtin_amdgcn_permlane32_swap(__float_as_uint(m), __float_as_uint(m), false, false);
    return max2f(__uint_as_float(rr[0]), __uint_as_float(rr[1]));
}
template <int ND, int THRL>
__device__ __forceinline__ void attn_unit(const bf16* Q, int pq, const bf16* Qr, int pqr, const bf16* __restrict__ Kh, int pk, const bf16* __restrict__ Vh, int pkv, bf16* O, int po, int NT, char* shm) {
    constexpr int SLOTB = (ND == 6) ? 12288 : 8192, KD = (ND == 6) ? 2 : 1;
    constexpr int LDS_K = 0, LDS_V = NSLOT * SLOTB, LDS_WS = 2 * NSLOT * SLOTB, LDS_OST = LDS_WS + NWAVES * 64 * 4;
    int tid = threadIdx.x; asm volatile("" : "+v"(tid));
    const int lane = tid & 63, r32 = lane & 31, hi = lane >> 5; const int wid = __builtin_amdgcn_readfirstlane(tid >> 6);
    const bf16* Qw = Q + (size_t)(wid * 32) * pq;
    const unsigned lds0 = (unsigned)(uintptr_t)shm;
    float* wsf = (float*)(shm + LDS_WS) + wid * 64;
    const bf16* ksrc = Kh + (size_t)lane * pk + wid * 8;
    const bf16* ksrc2 = Kh + (size_t)lane * pk + (8 + (wid & 3)) * 8;
    const unsigned kdst2 = lds0 + LDS_K + (8 + (wid & 3)) * 1024; (void)ksrc2; (void)kdst2;
    const bf16* vsrc = Vh + (size_t)(16 * (wid & 3) + (lane >> 2)) * pkv + (wid >> 2) * 32 + (lane & 3) * 8;
    const unsigned kdst = lds0 + LDS_K + wid * 1024, vdst = lds0 + LDS_V + wid * 1024;
#define DMA_K(t, slot) do { glds16(ksrc + (size_t)(t) * 64 * pk, (unsigned)__builtin_amdgcn_readfirstlane(kdst + (slot))); if constexpr (ND == 6) glds16(ksrc2 + (size_t)(t) * 64 * pk, (unsigned)__builtin_amdgcn_readfirstlane(kdst2 + (slot))); } while (0)
#define DMA_V(t, slot) glds16(vsrc + (size_t)(t) * 64 * pkv, (unsigned)__builtin_amdgcn_readfirstlane(vdst + (slot)))
    const int vb0 = (int)(lds0 + LDS_V) + ((lane >> 4) & 1) * 32 + (lane & 3) * 8 + (4 * hi + ((lane & 15) >> 2)) * 64;
    const char* Kbase = shm + LDS_K; bf16x8 kf[2 * ND];
    const lds_cptr shm3 = (lds_cptr)shm; const lds_cptr kp0 = shm3 + LDS_K + hi * 1024 + r32 * 16; const lds_cptr vp0 = shm3 + LDS_V + ((lane >> 4) & 1) * 32 + (lane & 3) * 8 + (4 * hi + ((lane & 15) >> 2)) * 64;
    DMA_K(0, 0); DMA_V(0, 0); DMA_K(1, SLOTB);
    bf16x8 qr[ND];
#pragma unroll
    for (int d0 = 0; d0 < 4; ++d0) qr[d0] = *reinterpret_cast<const bf16x8*>(&Qw[(size_t)r32 * pq + d0 * 16 + hi * 8]);
    if constexpr (ND == 6) {
#pragma unroll
        for (int d0 = 4; d0 < 6; ++d0) qr[d0] = *reinterpret_cast<const bf16x8*>(&Qr[(size_t)(wid * 32 + r32) * pqr + (d0 - 4) * 16 + hi * 8]); }
    float mhat = 0.f, l_reg = 0.f; f32x16 o[2]; o[0] = f32x16{}; o[1] = f32x16{}; f32x16 negm = f32x16{}; asm volatile("" : "+v"(negm));
    bool resc = false;
#define START(P0, P1) do { const float rm = rowmax(P0, P1); resc = false; \
    { const float dl = rm; mhat = fadd_s(mhat, dl); \
      _Pragma("unroll") for (int r = 0; r < 16; ++r) { P0[r] = fsub_s(P0[r], dl); P1[r] = fsub_s(P1[r], dl); } \
      _Pragma("unroll") for (int r = 0; r < 16; ++r) negm[r] = -mhat; asm volatile("" : "+v"(negm)); } \
    _Pragma("unroll") for (int r = 0; r < 16; ++r) P0[r] = __builtin_amdgcn_exp2f(P0[r]); } while (0)
#define RESC() do { if (resc) { asm volatile("s_waitcnt lgkmcnt(0)" ::: "memory"); \
      _Pragma("unroll") for (int d_ = 0; d_ < 2; ++d_) _Pragma("unroll") for (int r = 0; r < 16; ++r) o[d_][r] *= wsf[crow(r, hi)]; } } while (0)
    f32x16 pA0, pA1, pB0, pB1;
    int sl_prev = 0, sl_cur = 0, sl_next = SLOTB;
#define ROT() do { sl_prev = sl_cur; sl_cur = sl_next; sl_next = (sl_next == (NSLOT - 1) * SLOTB) ? 0 : sl_next + SLOTB; } while (0)
    DMA_K(2, 2 * SLOTB);
    WAIT_BAR(1 + 2 * KD);
    qkt<ND>(pA0, pA1, Kbase, qr, negm, r32, hi); asm volatile("s_nop 15\n\ts_nop 7" : "+v"(pA0), "+v"(pA1));
    START(pA0, pA1);
    _Pragma("unroll") for (int r = 0; r < 16; ++r) pA1[r] = __builtin_amdgcn_exp2f(pA1[r]);
    WAIT_BAR(0);
    DMA_K(3, 0); DMA_V(1, SLOTB);
    ROT();
    kloadall<ND>(kf, kp0 + sl_cur);
    WAIT_BAR(KD + 1);
    s16x4 vlo[8], vhi[8]; u32x4 pw0, pw1, pw2, pw3;
#define PKW(P, B) cvtpk(P[B], P[B + 1])
#define PAF(k) __builtin_bit_cast(bf16x8, pw##k)
#define VFR(i) (bf16x8){vlo[i][0], vlo[i][1], vlo[i][2], vlo[i][3], vhi[i][0], vhi[i][1], vhi[i][2], vhi[i][3]}
#define PIN(x) asm volatile("" : "+v"(x))
#define MX3(a, b, c) __builtin_fmaxf(__builtin_fmaxf((a), (b)), (c))
#define GAPA(MF, A0, A1, A2, A3, W0, W1, PW) do { MF; sacc += A0; sacc += A1; sacc += A2; sacc += A3; PIN(sacc); W0; W1; PIN(PW); SBAR(); } while (0)
#define EX(v) __builtin_amdgcn_exp2f(v)
#define GAPB(MF, X, B) do { MF; X[B] = EX(X[B]); X[B + 1] = EX(X[B + 1]); X[B + 2] = EX(X[B + 2]); X[B + 3] = EX(X[B + 3]); PIN(X); SBAR(); } while (0)
#define VRD(i) do { vlo[i] = vtr(vp_ + (((i) >> 2) * 4096 + ((i) & 3) * 1024)); vhi[i] = vtr(vp_ + (((i) >> 2) * 4096 + ((i) & 3) * 1024 + 512)); } while (0)
#define KRD(G, j) do { if (G) { kload2(kf, kp0 + sl_next, j); SBAR(); } } while (0)
#define STEP(C0, C1, P0, P1, t, GK, GV, GL) do { SBAR(); \
    const lds_cptr vp_ = vp0 + sl_prev; \
    VRD(0); SBAR(); float sacc = (P0[0] + P0[1]); \
    GAPA(C0 = __builtin_amdgcn_mfma_f32_32x32x16_bf16(kf[0], qr[0], negm, 0, 0, 0), P0[2], P0[3], P0[4], P0[5],     pw0[0] = PKW(P0, 0), pw0[1] = PKW(P0, 2), pw0); \
    VRD(4); SBAR(); GAPA(C1 = __builtin_amdgcn_mfma_f32_32x32x16_bf16(kf[1], qr[0], negm, 0, 0, 0), P0[6], P0[7], P0[8], P0[9],     pw0[2] = PKW(P0, 4), pw0[3] = PKW(P0, 6), pw0); \
    VRD(1); SBAR(); GAPA(C0 = __builtin_amdgcn_mfma_f32_32x32x16_bf16(kf[2], qr[1], C0, 0, 0, 0),   P0[10], P0[11], P0[12], P0[13], pw1[0] = PKW(P0, 8), pw1[1] = PKW(P0, 10), pw1); \
    VRD(5); SBAR(); GAPA(C1 = __builtin_amdgcn_mfma_f32_32x32x16_bf16(kf[3], qr[1], C1, 0, 0, 0),   P0[14], P0[15], P1[0], P1[1],   pw1[2] = PKW(P0, 12), pw1[3] = PKW(P0, 14), pw1); \
    VRD(2); SBAR(); GAPA(C0 = __builtin_amdgcn_mfma_f32_32x32x16_bf16(kf[4], qr[2], C0, 0, 0, 0),   P1[2], P1[3], P1[4], P1[5],     pw2[0] = PKW(P1, 0), pw2[1] = PKW(P1, 2), pw2); \
    VRD(6); SBAR(); GAPA(C1 = __builtin_amdgcn_mfma_f32_32x32x16_bf16(kf[5], qr[2], C1, 0, 0, 0),   P1[6], P1[7], P1[8], P1[9],     pw2[2] = PKW(P1, 4), pw2[3] = PKW(P1, 6), pw2); \
    VRD(3); SBAR(); GAPA(C0 = __builtin_amdgcn_mfma_f32_32x32x16_bf16(kf[6], qr[3], C0, 0, 0, 0),   P1[10], P1[11], P1[12], P1[13], pw3[0] = PKW(P1, 8), pw3[1] = PKW(P1, 10), pw3); \
    VRD(7); SBAR(); GAPA(C1 = __builtin_amdgcn_mfma_f32_32x32x16_bf16(kf[7], qr[3], C1, 0, 0, 0),   P1[14], P1[15], 0.f, 0.f,       pw3[2] = PKW(P1, 12), pw3[3] = PKW(P1, 14), pw3); \
    if constexpr (ND == 6) { C0 = __builtin_amdgcn_mfma_f32_32x32x16_bf16(kf[8], qr[4], C0, 0, 0, 0); SBAR(); C1 = __builtin_amdgcn_mfma_f32_32x32x16_bf16(kf[9], qr[4], C1, 0, 0, 0); SBAR(); \
      C0 = __builtin_amdgcn_mfma_f32_32x32x16_bf16(kf[10], qr[5], C0, 0, 0, 0); SBAR(); C1 = __builtin_amdgcn_mfma_f32_32x32x16_bf16(kf[11], qr[5], C1, 0, 0, 0); SBAR(); } \
    l_reg += sacc; \
    if (GK) { DMA_K((t) + 3, sl_cur); } if (GV) { DMA_V((t) + 1, sl_next); } \
    { float a = MX3(C0[0], C0[1], C1[0]), b = MX3(C0[2], C0[3], C1[1]); a = MX3(a, C1[2], C1[3]); \
      _Pragma("unroll") for (int r = 4; r < 16; r += 4) { a = MX3(a, C0[r], C0[r + 1]); b = MX3(b, C0[r + 2], C0[r + 3]); a = MX3(a, C1[r], C1[r + 1]); b = MX3(b, C1[r + 2], C1[r + 3]); } \
      float rm = __builtin_fmaxf(a, b); { auto rr = __builtin_amdgcn_permlane32_swap(__float_as_uint(rm), __float_as_uint(rm), false, false); rm = __builtin_fmaxf(__uint_as_float(rr[0]), __uint_as_float(rr[1])); } \
      resc = false; \
      if (__builtin_expect(__any(rm > (float)THRL), 0)) { const float dl = __builtin_fmaxf(rm, 0.f); mhat += dl; \
        _Pragma("unroll") for (int r = 0; r < 16; ++r) { C0[r] -= dl; C1[r] -= dl; } \
        _Pragma("unroll") for (int r = 0; r < 16; ++r) negm[r] = -mhat; asm volatile("" : "+v"(negm)); \
        const float f = __builtin_amdgcn_exp2f(-dl); l_reg *= f; if (hi == 0) wsf[r32] = f; resc = true; } } \
    SBAR(); \
    GAPB(o[0] = __builtin_amdgcn_mfma_f32_32x32x16_bf16(PAF(0), VFR(0), o[0], 0, 0, 0), C0, 0); \
    GAPB(o[1] = __builtin_amdgcn_mfma_f32_32x32x16_bf16(PAF(0), VFR(4), o[1], 0, 0, 0), C0, 4); \
    KRD(GL, 0); GAPB(o[0] = __builtin_amdgcn_mfma_f32_32x32x16_bf16(PAF(1), VFR(1), o[0], 0, 0, 0), C0, 8); \
    KRD(GL, 1); GAPB(o[1] = __builtin_amdgcn_mfma_f32_32x32x16_bf16(PAF(1), VFR(5), o[1], 0, 0, 0), C0, 12); \
    KRD(GL, 2); GAPB(o[0] = __builtin_amdgcn_mfma_f32_32x32x16_bf16(PAF(2), VFR(2), o[0], 0, 0, 0), C1, 0); \
    KRD(GL, 3); GAPB(o[1] = __builtin_amdgcn_mfma_f32_32x32x16_bf16(PAF(2), VFR(6), o[1], 0, 0, 0), C1, 4); \
    if constexpr (ND == 6) { KRD(GL, 4); } GAPB(o[0] = __builtin_amdgcn_mfma_f32_32x32x16_bf16(PAF(3), VFR(3), o[0], 0, 0, 0), C1, 8); \
    if constexpr (ND == 6) { KRD(GL, 5); } GAPB(o[1] = __builtin_amdgcn_mfma_f32_32x32x16_bf16(PAF(3), VFR(7), o[1], 0, 0, 0), C1, 12); \
    } while (0)
    int t = 1;
    for (; t + 5 < NT; t += 2) {
        STEP(pB0, pB1, pA0, pA1, t, true, true, true);     WAIT_BAR(KD + 1); RESC(); ROT();
        STEP(pA0, pA1, pB0, pB1, t + 1, true, true, true); WAIT_BAR(KD + 1); RESC(); ROT();
    }
#define ENDW(tt) do { if ((tt) + 3 < NT) { WAIT_BAR(KD + 1); } else if ((tt) + 2 < NT) { WAIT_BAR(1); } else { WAIT_BAR(0); } } while (0)
    for (; t + 1 < NT; t += 2) {
        STEP(pB0, pB1, pA0, pA1, t, (t + 3 < NT), (t + 1 < NT), (t + 1 < NT));     ENDW(t);     RESC(); ROT();
        STEP(pA0, pA1, pB0, pB1, t + 1, (t + 4 < NT), (t + 2 < NT), (t + 2 < NT)); ENDW(t + 1); RESC(); ROT();
    }
    STEP(pB0, pB1, pA0, pA1, NT - 1, false, false, false); RESC();
    { float sacc = pB0[0] + pB0[1]; _Pragma("unroll") for (int r = 2; r < 16; ++r) sacc += pB0[r]; _Pragma("unroll") for (int r = 0; r < 16; ++r) sacc += pB1[r]; l_reg += sacc;
      pw0 = (u32x4){PKW(pB0, 0), PKW(pB0, 2), PKW(pB0, 4), PKW(pB0, 6)}; pw1 = (u32x4){PKW(pB0, 8), PKW(pB0, 10), PKW(pB0, 12), PKW(pB0, 14)}; pw2 = (u32x4){PKW(pB1, 0), PKW(pB1, 2), PKW(pB1, 4), PKW(pB1, 6)}; pw3 = (u32x4){PKW(pB1, 8), PKW(pB1, 10), PKW(pB1, 12), PKW(pB1, 14)};
      SBAR(); att::pv(o, vb0 + sl_cur, PAF(0), PAF(1), PAF(2), PAF(3)); }
#undef PKW
#undef PAF
#undef VFR
#undef PIN
#undef MX3
#undef GAPA
#undef GAPB
#undef EX
#undef VRD
#undef KRD
#undef STEP
#undef ENDW
    { auto rr = __builtin_amdgcn_permlane32_swap(__float_as_uint(l_reg), __float_as_uint(l_reg), false, false); l_reg = __uint_as_float(rr[0]) + __uint_as_float(rr[1]); }
    if (hi == 0) wsf[32 + r32] = l_reg; asm volatile("s_waitcnt lgkmcnt(0)" ::: "memory");
    float rli[16];
#pragma unroll
    for (int r = 0; r < 16; ++r) rli[r] = __builtin_amdgcn_rcpf(wsf[32 + crow(r, hi)]);
    bf16* Ow = O + (size_t)(wid * 32) * po;
    { bf16* stg = (bf16*)(shm + LDS_OST) + wid * 2048;
#pragma unroll
      for (int r = 0; r < 16; ++r) { const int orow = crow(r, hi);
#pragma unroll
        for (int d0 = 0; d0 < 2; ++d0) stg[orow * 64 + d0 * 32 + r32] = (bf16)(cvtpk(o[d0][r] * rli[r], 0.f) & 0xffffu); }
      asm volatile("s_waitcnt lgkmcnt(0)" ::: "memory");
#pragma unroll
      for (int i = 0; i < 4; ++i) { const int row = i * 8 + (lane >> 3), ch = lane & 7; const u32x4 v = *(const u32x4*)(stg + row * 64 + ch * 8); *(u32x4*)(Ow + (size_t)row * po + ch * 8) = v; } }
    asm volatile("s_waitcnt lgkmcnt(0)\n\ts_barrier" ::: "memory");
#undef DMA_K
#undef DMA_V
#undef START
#undef RESC
#undef ROT
}
#undef SBAR
#undef WAIT_BAR
}

#define RLX_AGENT __ATOMIC_RELAXED, __HIP_MEMORY_SCOPE_AGENT
#define XB_TMO      128
#define XB_XCNT(j)  (256  + 64 * (j))
#define XB_XSUB(j)  (1280 + 64 * (j))
#define XB_XGEN(j)  (2304 + 64 * (j))
#define XB_TOP      3328
#define XB_TOPGEN   3392
#define XCD_BAR_WORDS 3456
#define XB_SPIN_CAP (1u << 18)
__device__ __forceinline__ unsigned xb_ld(unsigned* p)              { return __hip_atomic_load(p, __ATOMIC_RELAXED, __HIP_MEMORY_SCOPE_AGENT); }
__device__ __forceinline__ unsigned xb_add(unsigned* p, unsigned v) { return __hip_atomic_fetch_add(p, v, __ATOMIC_RELAXED, __HIP_MEMORY_SCOPE_AGENT); }
__device__ __forceinline__ unsigned xb_xcc_id() { return (unsigned)__builtin_amdgcn_s_getreg((3 << 11) | 20) & 0xFu; }
#define XB_SPIN(cond, bar) do { unsigned _sp = 0; while (cond) { __builtin_amdgcn_s_sleep(1); \
    if ((++_sp & 255u) == 0u) { if (xb_ld(&(bar)[XB_TMO])) break; if (_sp > XB_SPIN_CAP) { atomicAdd(&(bar)[XB_TMO], 1u); break; } } } } while (0)
struct XcdBarrier { unsigned* bar; unsigned x; volatile LAS unsigned* st; };
__device__ __forceinline__ XcdBarrier xcd_barrier_post(unsigned* bar, volatile LAS unsigned* st) {
    XcdBarrier b; b.bar = bar; b.x = xb_xcc_id(); b.st = st;
    if (threadIdx.x == 0) (void)xb_add(&bar[XB_XCNT(b.x)], 1u);
    return b;
}
__device__ __forceinline__ void xcd_barrier_complete(unsigned* bar, unsigned x, unsigned& nloc, unsigned& nx) {
    const unsigned G = gridDim.x * gridDim.y * gridDim.z;
    unsigned sum, cnt, mine, sp = 0u;
    for (;;) {
        sum = 0u; cnt = 0u; mine = 0u;
#pragma unroll
        for (unsigned j = 0; j < 16; ++j) { const unsigned c = xb_ld(&bar[XB_XCNT(j)]); sum += c; cnt += (c > 0u) ? 1u : 0u; mine = (j == x) ? c : mine; }
        if (sum == G) break;
        __builtin_amdgcn_s_sleep(1);
        if ((++sp & 255u) == 0u) { if (xb_ld(&bar[XB_TMO])) break; if (sp > XB_SPIN_CAP) { atomicAdd(&bar[XB_TMO], 1u); break; } }
    }
    nloc = mine > 0u ? mine : 1u; nx = cnt > 0u ? cnt : 1u;
}
__device__ __forceinline__ void xcd_barrier(const XcdBarrier& b) {
    asm volatile("s_waitcnt vmcnt(0)" ::: "memory");
    __syncthreads();
    if (threadIdx.x == 0) {
        unsigned* bar = b.bar;
        __builtin_amdgcn_s_waitcnt(0);
        unsigned nloc = b.st[0], nx = b.st[1];
        if (nloc == 0u) { xcd_barrier_complete(bar, b.x, nloc, nx); b.st[0] = nloc; b.st[1] = nx; }
        const unsigned old = xb_add(&bar[XB_XSUB(b.x)], 1u);
        const unsigned gen = old / nloc;
        if (old + 1u == (gen + 1u) * nloc) {
            __builtin_amdgcn_fence(__ATOMIC_RELEASE, "agent");
            asm volatile("s_waitcnt vmcnt(0)" ::: "memory");
            const unsigned og = xb_add(&bar[XB_TOP], 1u);
            const unsigned tg = og / nx;
            if (og + 1u == (tg + 1u) * nx) xb_add(&bar[XB_TOPGEN], 1u);
            else XB_SPIN(xb_ld(&bar[XB_TOPGEN]) == tg, bar);
            __builtin_amdgcn_fence(__ATOMIC_ACQUIRE, "agent");
            xb_add(&bar[XB_XGEN(b.x)], 1u);
            asm volatile("s_waitcnt vmcnt(0)" ::: "memory");
        } else {
            XB_SPIN(xb_ld(&bar[XB_XGEN(b.x)]) == gen, bar);
            __builtin_amdgcn_fence(__ATOMIC_ACQUIRE, "agent");
            asm volatile("s_waitcnt vmcnt(0)" ::: "memory");
        }
    }
    __syncthreads();
}
constexpr int LDS_MISC = 131072 + 1024;
constexpr size_t CTL_ZERO_BYTES = 64 * KiB;

struct Args { const float* in[26]; float* out; unsigned char* ws; int ph_lo, ph_hi; };
constexpr int LDS_BYTES = 147456;
constexpr int NPHASE = 21;

typedef const __attribute__((address_space(4))) unsigned char* KP;
__device__ __forceinline__ const float* kin(KP kp, int k) { return *(const float* const __attribute__((address_space(4)))*)(kp + 8 * k); }
__device__ __forceinline__ float* kout(KP kp) { return *(float* const __attribute__((address_space(4)))*)(kp + 208); }
__device__ __forceinline__ unsigned char* kws(KP kp) { return *(unsigned char* const __attribute__((address_space(4)))*)(kp + 216); }
static_assert(sizeof(Args) == 232, "Args layout");
struct Ctx {
    LAS unsigned char* lds; int tid, lane, wave, vcu, G; unsigned char* ws;
};

enum MatId { M_WIN = 0, M_WUQ, M_WUKV, M_NAT, M_FFI };
__device__ __forceinline__ int rope_perm(int p) { const int n = p >> 4, fq = (p >> 2) & 3, j = p & 3; return 16 * (fq >> 1) + 8 * n + 4 * (fq & 1) + j; }
__device__ __forceinline__ int head_perm(int pc, int& wc) { wc = (pc >> 5) & 3; return 32 * (pc >> 7) + (pc & 31); }
__device__ __forceinline__ int src_col(int mat, int n) {
    const int t = n >> 8, pc = n & 255; int wc;
    switch (mat) {
    case M_WIN:
        if (t < 2) { const int d = head_perm(pc, wc); return (4 * t + wc) * 64 + d; }
        if (t == 2) { const int d = head_perm(pc, wc); return wc < 2 ? 512 + wc * 64 + d : 640 + (wc - 2) * 64 + d; }
        if (t == 3) return 768 + pc;
        if (t == 4) { if (pc < 128) return 768 + 256 + pc; if (pc < 160) return 1408 + rope_perm(pc - 128); return -1; }
        if (t == 5) return 1152 + pc;
        if (t < 8) return 1440 + (t - 6) * 256 + pc;
        return 1952 + (t - 8) * 256 + pc;
    case M_WUQ:
        if (t < 2) { const int d = head_perm(pc, wc); return (4 * t + wc) * 96 + d; }
        { const int bj = pc >> 7, w2 = (pc >> 5) & 3; return (4 * bj + w2) * 96 + 64 + rope_perm(pc & 31); }
    case M_WUKV:
        { const int d = head_perm(pc, wc); return t < 2 ? (4 * t + wc) * 128 + d : (4 * (t - 2) + wc) * 128 + 64 + d; }
    case M_FFI:
        return pc < 128 ? t * 128 + pc : FFH + t * 128 + (pc - 128);
    default: return n;
    }
}
__device__ __forceinline__ void xpose_item(const float* W, int ldw, const float* kscale, bf16* WT, int ldo, int kcol0, int mat, int nblk, int item, LAS float* scr, int lane) {
    const int kb = item / nblk, nb = item % nblk, k0 = 64 * kb, n0 = 32 * nb;
    const int sc = src_col(mat, n0 + (lane & 31));
#pragma unroll 8
    for (int i = 0; i < 32; ++i) { const int kk = 2 * i + (lane >> 5); float v = 0.f; if (sc >= 0) { v = W[(size_t)(k0 + kk) * ldw + sc]; if (kscale) v *= kscale[k0 + kk]; } scr[kk * 33 + (lane & 31)] = v; }
    asm volatile("s_waitcnt lgkmcnt(0)" ::: "memory");
    const int c = lane & 7;
#pragma unroll
    for (int j = 0; j < 4; ++j) { const int n = (lane >> 3) + 8 * j; const LAS float* s = scr + (8 * c) * 33 + n;
        u32x4 o; o.x = cvtpk(s[0 * 33], s[1 * 33]); o.y = cvtpk(s[2 * 33], s[3 * 33]); o.z = cvtpk(s[4 * 33], s[5 * 33]); o.w = cvtpk(s[6 * 33], s[7 * 33]);
        *(u32x4*)(WT + (size_t)(n0 + n) * ldo + kcol0 + k0 + 8 * c) = o; }
    asm volatile("s_waitcnt lgkmcnt(0)" ::: "memory");
}
__device__ __forceinline__ void run_xjob(const Ctx& F, int& base, const float* W, int ldw, const float* kscale, bf16* WT, int ldo, int kcol0, int mat, int K, int N) {
    LAS float* scr = (LAS float*)(F.lds + F.wave * 16384);
    const int gw = F.vcu * NWAVES + F.wave, NGW = F.G * NWAVES;
    const int nblk = N / 32, nit = (K / 64) * nblk;
    int first = gw - (base % NGW); if (first < 0) first += NGW;
    for (int it = first; it < nit; it += NGW) xpose_item(W, ldw, kscale, WT, ldo, kcol0, mat, nblk, it, scr, F.lane);
    base += nit;
}

__device__ __forceinline__ void norm_pass(const Ctx& F, const float* x_lat, const float* x_ctx, bf16* HB, const float* gnorm, const float* mod_l, int shift_off, int nrows) {
    const int gw = F.vcu * NWAVES + F.wave, NGW = F.G * NWAVES;
    const int per = (nrows + NGW - 1) / NGW; const int r0 = gw * per, r1 = min(nrows, r0 + per);
    int cur_s = -1; f32x4 ca[4], cb[4];
    for (int r = r0; r < r1; ++r) {
        const bool ctx = r >= ML; const int s = ctx ? 8 : r >> 11;
        if (s != cur_s) { cur_s = s; const float* sh = mod_l + s * 6144 + shift_off; const float* scl = sh + 1024;
#pragma unroll
            for (int j = 0; j < 4; ++j) { const f32x4 g = *(const f32x4*)(gnorm + 256 * j + 4 * F.lane); const f32x4 sc1 = *(const f32x4*)(scl + 256 * j + 4 * F.lane); ca[j] = g * (sc1 + 1.0f); cb[j] = *(const f32x4*)(sh + 256 * j + 4 * F.lane); } }
        const float* xr = ctx ? x_ctx + (size_t)(r - ML) * 1024 : x_lat + (size_t)r * 1024;
        f32x4 v[4]; float ss = 0.f;
#pragma unroll
        for (int j = 0; j < 4; ++j) { v[j] = *(const f32x4*)(xr + 256 * j + 4 * F.lane); ss += (v[j][0] * v[j][0] + v[j][1] * v[j][1]) + (v[j][2] * v[j][2] + v[j][3] * v[j][3]); }
        const float rstd = rsqrtf(wave_sum(ss) * (1.0f / 1024.0f) + EPS);
#pragma unroll
        for (int j = 0; j < 4; ++j) *(u32x2*)(HB + (size_t)r * 1024 + 256 * j + 4 * F.lane) = pk4(v[j] * rstd * ca[j] + cb[j]);
    }
}

__device__ __forceinline__ void mod_items(const Ctx& F, KP kp) {
    const float* c = kin(kp, 1); const float* cc = kin(kp, 3); const float* wmod = kin(kp, 4); const float* bmod = kin(kp, 5);
    float* mod = (float*)(F.ws + O_MOD);
    LAS float* sl = (LAS float*)F.lds;
    LAS float* red = sl + 9 * 1024;
    for (int it = F.vcu; it < 192; it += F.G) {
        const int l = it / 96, n0 = (it % 96) * 64;
        __syncthreads();
        for (int i = F.tid; i < 9 * 1024; i += NTHR) { const float v = (i < 8192) ? c[i] : cc[i - 8192]; sl[i] = v * sigmoidf_(v); }
        __syncthreads();
        float acc[9];
#pragma unroll
        for (int s = 0; s < 9; ++s) acc[s] = 0.f;
        const float* wp = wmod + (size_t)l * 1024 * 6144 + n0 + F.lane;
        for (int k = F.wave * 128; k < F.wave * 128 + 128; ++k) { const float w = wp[(size_t)k * 6144];
#pragma unroll
            for (int s = 0; s < 9; ++s) acc[s] += sl[s * 1024 + k] * w; }
#pragma unroll
        for (int s = 0; s < 9; ++s) red[(F.wave * 9 + s) * 64 + F.lane] = acc[s];
        __syncthreads();
        for (int i = F.tid; i < 9 * 64; i += NTHR) { float t = 0.f;
#pragma unroll
            for (int w = 0; w < 8; ++w) t += red[w * 576 + i];
            const int s = i / 64, n = n0 + (i & 63); mod[(l * 9 + s) * 6144 + n] = t + bmod[l * 6144 + n]; }
    }
    __syncthreads();
}
__device__ __forceinline__ void table_items(const Ctx& F) {
    const int gt = (F.vcu * NTHR) + F.tid, NT_ = F.G * NTHR;
    float* ra = (float*)(F.ws + O_ROPEA); float* rb = (float*)(F.ws + O_ROPEB);
    for (int i = gt; i < 1024; i += NT_) { const int pos = i >> 4, f = i & 15; const float fr = powf(10000.0f, -(float)(2 * f) / 32.0f); const float ang = (float)pos * fr; ra[i] = cosf(ang); ra[1024 + i] = sinf(ang); }
    for (int i = gt; i < 512; i += NT_) { const int pos = i >> 3, f = i & 7; const float fr = powf(10000.0f, -(float)(2 * f) / 16.0f); const float ang = (float)pos * fr; rb[i] = cosf(ang); rb[512 + i] = sinf(ang); }
    bf16* DN = (bf16*)(F.ws + O_DN); bf16* DN2 = (bf16*)(F.ws + O_DN256); bf16* DC = (bf16*)(F.ws + O_DFTC);
    { const float sc = 0.022097086912079608f;
      for (int i = gt; i < 2048 * 2048 / 2; i += NT_) { const int n = i >> 10, k = (i & 1023) * 2; float s0, c0, s1, c1;
          sincospif((float)((n * k) & 2047) * (1.0f / 1024.0f), &s0, &c0); sincospif((float)((n * (k + 1)) & 2047) * (1.0f / 1024.0f), &s1, &c1);
          *(unsigned*)(DN + (size_t)n * 4096 + k) = cvtpk(c0 * sc, c1 * sc); *(unsigned*)(DN + (size_t)n * 4096 + 2048 + k) = cvtpk(-s0 * sc, -s1 * sc); } }
    { const float sc = 0.0625f;
      for (int i = gt; i < 256 * 256; i += NT_) { const int n = i >> 8, k = i & 255; float s0, c0; sincospif((float)((n * k) & 255) * (1.0f / 128.0f), &s0, &c0);
          DN2[n * 512 + k] = (bf16)(cvtpk(c0 * sc, 0.f) & 0xffff); DN2[n * 512 + 256 + k] = (bf16)(cvtpk(-s0 * sc, 0.f) & 0xffff); } }
    { const float sc = 0.08838834764831845f;
      for (int i = gt; i < 256 * 128; i += NT_) { const int r = i >> 7, k = i & 127; float s0, c0; sincospif((float)(((r & 127) * k) & 127) * (1.0f / 64.0f), &s0, &c0);
          DC[i] = (bf16)(cvtpk((r < 128 ? c0 : s0) * sc, 0.f) & 0xffff); } }
}
__device__ __forceinline__ void convert_weights_main(const Ctx& F, KP kp, int l) {
    int base = 0;
    run_xjob(F, base, kin(kp, 8) + (size_t)l * 1024 * INW, INW, nullptr, (bf16*)(F.ws + O_WIN), 1024, 0, M_WIN, 1024, NINP);
    run_xjob(F, base, kin(kp, 13) + (size_t)l * 384 * 768, 768, kin(kp, 11) + l * 384, (bf16*)(F.ws + O_WUQ), 384, 0, M_WUQ, 384, 768);
    run_xjob(F, base, kin(kp, 14) + (size_t)l * 256 * 1024, 1024, kin(kp, 12) + l * 256, (bf16*)(F.ws + O_WUKV), 256, 0, M_WUKV, 256, 1024);
    run_xjob(F, base, kin(kp, 20) + (size_t)l * 512 * 1024, 1024, nullptr, (bf16*)(F.ws + O_WBR), 1536, 0, M_NAT, 512, 1024);
    run_xjob(F, base, kin(kp, 21) + (size_t)l * 512 * 1024, 1024, nullptr, (bf16*)(F.ws + O_WBR), 1536, 512, M_NAT, 512, 1024);
    run_xjob(F, base, kin(kp, 22) + (size_t)l * 512 * 1024, 1024, nullptr, (bf16*)(F.ws + O_WBR), 1536, 1024, M_NAT, 512, 1024);
    run_xjob(F, base, kin(kp, 23) + (size_t)l * 1024 * 1024, 1024, nullptr, (bf16*)(F.ws + O_WOUT), 1024, 0, M_NAT, 1024, 1024);
}
__device__ __forceinline__ void convert_weights_ffn(const Ctx& F, KP kp, int l) {
    int base = 0;
    run_xjob(F, base, kin(kp, 24) + (size_t)l * 1024 * 2 * FFH, 2 * FFH, nullptr, (bf16*)(F.ws + O_WFI), 1024, 0, M_FFI, 1024, 2 * FFH);
    run_xjob(F, base, kin(kp, 25) + (size_t)l * FFH * 1024, 1024, nullptr, (bf16*)(F.ws + O_WFO), FFH, 0, M_NAT, FFH, 1024);
}

struct F1Sched {
    int nb_tok, G, c, row0, rows_per_b, nunits; const char* A; const char* PF;
    __device__ __forceinline__ bool next(int i, Unit& u) const {
        const long L = (long)i * G + c; if (L >= nunits) return false;
        const int j = (int)L % nb_tok, bg = (int)L / nb_tok, gch = bg & 3, b = bg >> 2;
        u.pm = b * 4 + gch; u.pn = j; u.kb = 0; u.A = A; u.B = PF + ((size_t)(row0 + b * rows_per_b + j * 256) * 512 + gch * 128) * 2; return true;
    }
};
struct F2Sched {
    int nM, G, c, row0, rows_per_b, nunits; const char* DN; const char* ZT; size_t K2;
    __device__ __forceinline__ bool next(int i, Unit& u) const {
        const long L = (long)i * G + c; if (L >= nunits) return false;
        const int pn = (int)L & 1, r = (int)L >> 1, pm = r % nM, b = r / nM;
        u.pm = (row0 + b * rows_per_b) / 256 + pm; u.pn = pn; u.kb = 0;
        u.A = DN + (size_t)pm * 256 * K2 * 2; u.B = ZT + ((size_t)b * 512 + pn * 256) * K2 * 2; return true;
    }
};

#ifndef DIAG_SUB
#define DIAG_SUB -1
#endif
#ifndef TIME_REP
#define TIME_REP 0
#endif
#define REP(b) ((TIME_REP & (b)) ? 2 : 1)
#define SUB_ON(k) (DIAG_SUB < 0 || DIAG_SUB == (k))
#ifndef DIAG_PART
#define DIAG_PART 0xffff
#endif
#define PART_ON(b) ((DIAG_PART & (b)) != 0)
__global__ void __launch_bounds__(NTHR, 2) fwd_kernel(Args args) {
    extern __shared__ __attribute__((aligned(16))) unsigned char lds_raw[];
    const int c = (int)blockIdx.x, G = (int)gridDim.x;
#if !MK_MULTI
    cg::grid_group grid = cg::this_grid();
    if (threadIdx.x < 2) ((volatile LAS unsigned*)((LAS unsigned char*)lds_raw + LDS_MISC))[threadIdx.x] = 0u;
    __syncthreads();
    const XcdBarrier xbar = xcd_barrier_post((unsigned*)(*(unsigned char* const __attribute__((address_space(4)))*)((KP)__builtin_amdgcn_kernarg_segment_ptr() + 216) + O_CTL) + 1024, (volatile LAS unsigned*)((LAS unsigned char*)lds_raw + LDS_MISC));
#define GRID_SYNC(first) do { if (first) grid.sync(); else xcd_barrier(xbar); } while (0)
#else
#define GRID_SYNC(first) do {} while (0)
#endif
    for (int ph = args.ph_lo; ph < args.ph_hi; ++ph) {
        KP kp = (KP)__builtin_amdgcn_kernarg_segment_ptr(); asm volatile("" : "+s"(kp));
        int tid_ = threadIdx.x; asm volatile("" : "+v"(tid_));
        Ctx F; F.lds = (LAS unsigned char*)lds_raw; F.tid = tid_; F.lane = tid_ & 63; F.wave = __builtin_amdgcn_readfirstlane(tid_ >> 6);
        F.G = G; F.vcu = (G % 8 == 0) ? (c % 8) * (G / 8) + c / 8 : c;
        unsigned char* ws = kws(kp); F.ws = ws; float* const outp = kout(kp);
        const float* mod = (const float*)(ws + O_MOD);
        const float* ropeA = (const float*)(ws + O_ROPEA); const float* ropeB = (const float*)(ws + O_ROPEB);
        float* stat_cq = (float*)(ws + O_STATCQ); float* stat_ckv = (float*)(ws + O_STATCKV);
        bf16* HB = (bf16*)(ws + O_HB); bf16* PF = (bf16*)(ws + O_PF); bf16* QA = (bf16*)(ws + O_QA); bf16* QBN = (bf16*)(ws + O_QBN); bf16* QBR = (bf16*)(ws + O_QBR);
        bf16* CQ = (bf16*)(ws + O_CQ); bf16* CKV = (bf16*)(ws + O_CKV); bf16* KA = (bf16*)(ws + O_KA); bf16* VA = (bf16*)(ws + O_VA); bf16* KB = (bf16*)(ws + O_KB); bf16* VB = (bf16*)(ws + O_VB);
        bf16* GT = (bf16*)(ws + O_G); bf16* ACT = (bf16*)(ws + O_G); bf16* MB = HB; bf16* YC = PF;
        float* XC = (float*)(ws + O_XC);
        if (ph == 0) { if (SUB_ON(10))
            for (int rep_ = 0; rep_ < REP(1); ++rep_) { mod_items(F, kp); table_items(F); convert_weights_main(F, kp, 0); }
        } else {
            const int l = (ph - 1) / 10, sub = (ph - 1) % 10;
            const bool L1 = (l == 1);
            const int nMt = L1 ? 64 : 72;
            const float* xin_lat = L1 ? outp : kin(kp, 0); const float* xin_ctx = L1 ? XC : kin(kp, 2);
            const float* mod_l = mod + (size_t)l * 9 * 6144;
            bf16* ZT = L1 ? (bf16*)(ws + O_ZT1) : (bf16*)outp; bf16* ZTC = (bf16*)outp + (size_t)8 * 512 * 4096;
            switch (sub) {
            case 0: if (SUB_ON(0)) {
                if (L1) convert_weights_main(F, kp, 1);
                for (int rep_ = 0; rep_ < REP(2); ++rep_) norm_pass(F, xin_lat, xin_ctx, HB, kin(kp, 6) + l * 1024, mod_l, 0, MT);
            } break;
            case 1: if (SUB_ON(1)) {
                EpiIn E{QA, KA, VA, CQ, CKV, KB, PF, GT, stat_cq, stat_ckv, kin(kp, 9) + l * 64, kin(kp, 10) + l * 64, kin(kp, 18) + l * 32, kin(kp, 19) + l * 3072, ropeA, ropeB};
                const Gemm g{1024, 1024, 1024};
                RectSched S{L1 ? 64 : 72, 8, 0, G, c, 1, ~0ull, (const char*)HB, 0, 0, (const char*)(ws + O_WIN), (size_t)256 * 1024 * 2, (size_t)256 * 1024 * 2, 0};
                pg8::gemm_phase(F.lds, g, S, E);
                if (L1) { RectSched S2{8, 3, 64, G, c, 1, 0x542ull, (const char*)HB, 0, 0, (const char*)(ws + O_WIN), (size_t)256 * 1024 * 2, (size_t)256 * 1024 * 2, 0};
                    pg8::gemm_phase(F.lds, g, S2, E); }
            } break;
            case 2: if (SUB_ON(2)) {
                for (int rep_ = 0; rep_ < REP(4); ++rep_) { EpiUq E{QBN, QBR, stat_cq, kin(kp, 15) + l * 64, kin(kp, 17) + l * 32, ropeB}; const Gemm g{384, 384, 384};
                  RectSched S{L1 ? 64 : 72, 3, 0, G, c, 1, ~0ull, (const char*)CQ, 0, 0, (const char*)(ws + O_WUQ), (size_t)256 * 384 * 2, (size_t)256 * 384 * 2, 0};
                  pg8::gemm_phase(F.lds, g, S, E); }
                for (int rep_ = 0; rep_ < REP(8); ++rep_) { EpiUkv E{KB, VB, stat_ckv, kin(kp, 16) + l * 64}; const Gemm g{256, 256, 256};
                  RectSched S{72, 4, 0, G, c, 1, ~0ull, (const char*)CKV, 0, 0, (const char*)(ws + O_WUKV), (size_t)256 * 256 * 2, (size_t)256 * 256 * 2, 0};
                  pg8::gemm_phase(F.lds, g, S, E); }
                for (int rep_ = 0; rep_ < REP(16); ++rep_) { EpiF1 E{ZT, 2048}; const Gemm g{128, 512, 128};
                  F1Sched S{8, G, c, 0, 2048, 256, (const char*)(ws + O_DFTC), (const char*)PF};
                  pg8::gemm_phase(F.lds, g, S, E); }
                if (!L1) { EpiF1 E{ZTC, 256}; const Gemm g{128, 512, 128};
                  F1Sched S{1, G, c, ML, 256, 32, (const char*)(ws + O_DFTC), (const char*)PF};
                  pg8::gemm_phase(F.lds, g, S, E); }
            } break;
            case 3: if (SUB_ON(3)) {
                LAS unsigned char* shm = F.lds;
                if (TIME_REP & 32) for (int i = 0;; ++i) {
                    const int L = i * G + c; if (L >= 512) break; const int qb = L & 7, h = (L >> 3) & 7, b = L >> 6;
                    const size_t row0 = (size_t)b * SEQ + qb * 256; const size_t key0 = (size_t)b * NKEY;
                    attq::attn_unit<4, 8>(QA + row0 * 512 + h * 64, 512, nullptr, 0, KA + key0 * 128 + (h >> 2) * 64, 128, VA + key0 * 128 + (h >> 2) * 64, 128, CQ + row0 * 512 + h * 64, 512, NKEY / 64, (char*)lds_raw);
                }
                if (TIME_REP & 64) for (int i = 0;; ++i) {
                    const int L = i * G + c; if (L >= 512) break; const int qb = L & 7, h = (L >> 3) & 7, b = L >> 6;
                    const size_t row0 = (size_t)b * SEQ + qb * 256; const size_t key0 = (size_t)b * NKEY;
                    attq::attn_unit<6, 8>(QBN + row0 * 512 + h * 64, 512, QBR + row0 * 256 + h * 32, 256, KB + key0 * 768 + h * 96, 768, VB + key0 * 512 + h * 64, 512, CQ + row0 * 512 + h * 64, 512, NKEY / 64, (char*)lds_raw);
                }
                for (int i = 0;; ++i) {
                    int L; if (G == 256) { if (c < 128) { if (i >= 3) break; L = c + 128 * i; } else { if (i >= 1) break; L = 384 + (c - 128); } } else { L = i * G + c; if (L >= 512) break; }
                    const int qb = L & 7, h = (L >> 3) & 7, b = L >> 6;
                    const size_t row0 = (size_t)b * SEQ + qb * 256; const size_t key0 = (size_t)b * NKEY;
                    attq::attn_unit<4, 8>(QA + row0 * 512 + h * 64, 512, nullptr, 0, KA + key0 * 128 + (h >> 2) * 64, 128, VA + key0 * 128 + (h >> 2) * 64, 128, QA + row0 * 512 + h * 64, 512, NKEY / 64, (char*)lds_raw);
                }
                for (int i = 0;; ++i) {
                    const int L = i * G + c; if (L >= 512) break; const int qb = L & 7, h = (L >> 3) & 7, b = L >> 6;
                    const size_t row0 = (size_t)b * SEQ + qb * 256; const size_t key0 = (size_t)b * NKEY;
                    attq::attn_unit<6, 8>(QBN + row0 * 512 + h * 64, 512, QBR + row0 * 256 + h * 32, 256, KB + key0 * 768 + h * 96, 768, VB + key0 * 512 + h * 64, 512, QBN + row0 * 512 + h * 64, 512, NKEY / 64, (char*)lds_raw);
                }
                if (!L1) {
                    for (int i = 0;; ++i) {
                        const int L = i * G + ((c + 128) % G); if (L >= 128) break; const int h = L & 7, b = (L >> 3) & 7; const bool mla = L >= 64;
                        const size_t row0 = (size_t)ML + b * CTX; const size_t key0 = (size_t)b * NKEY;
                        if (!mla) attq::attn_unit<4, 8>(QA + row0 * 512 + h * 64, 512, nullptr, 0, KA + key0 * 128 + (h >> 2) * 64, 128, VA + key0 * 128 + (h >> 2) * 64, 128, QA + row0 * 512 + h * 64, 512, CTX / 64, (char*)lds_raw);
                        else attq::attn_unit<6, 8>(QBN + row0 * 512 + h * 64, 512, QBR + row0 * 256 + h * 32, 256, KB + key0 * 768 + h * 96, 768, VB + key0 * 512 + h * 64, 512, QBN + row0 * 512 + h * 64, 512, CTX / 64, (char*)lds_raw);
                    }
                }
                for (int rep_ = 0; rep_ < REP(128); ++rep_) { EpiStore E{YC, 512}; const Gemm g{4096, 4096, 4096};
                  F2Sched S{8, G, (c + 128) % G, 0, 2048, 128, (const char*)(ws + O_DN), (const char*)ZT, 4096};
                  pg8::gemm_phase(F.lds, g, S, E); }
                if (!L1) { EpiStore E{YC, 512}; const Gemm g{512, 512, 512};
                  F2Sched S{1, G, c, ML, 256, 16, (const char*)(ws + O_DN256), (const char*)ZTC, 512};
                  pg8::gemm_phase(F.lds, g, S, E); }
            } break;
            case 4: if (SUB_ON(4)) {
                EpiIn E{QA, KA, VA, CQ, CKV, KB, PF, GT, stat_cq, stat_ckv, kin(kp, 9) + l * 64, kin(kp, 10) + l * 64, kin(kp, 18) + l * 32, kin(kp, 19) + l * 3072, ropeA, ropeB};
                const Gemm g{1024, 1024, 1024};
                RectSched S{nMt, 12, 0, G, c, 1, ~0ull, (const char*)HB, 0, 0, (const char*)(ws + O_WIN) + (size_t)8 * 256 * 1024 * 2, (size_t)256 * 1024 * 2, (size_t)256 * 1024 * 2, 0};
                struct PnShift { RectSched s; __device__ __forceinline__ bool next(int i, Unit& u) const { if (!s.next(i, u)) return false; u.pn += 8; return true; } } S8{S};
                for (int rep_ = 0; rep_ < REP(256); ++rep_) pg8::gemm_phase(F.lds, g, S8, E);
            } break;
            case 5: if (SUB_ON(5)) {
                for (int rep_ = 0; rep_ < REP(512); ++rep_) { EpiMerge E{GT, MB}; const Gemm g{512, 1536, 512};
                RectSched S{nMt, 4, 0, G, c, 3, ~0ull, (const char*)QA, (size_t)((const char*)QBN - (const char*)QA), (size_t)((const char*)YC - (const char*)QA), (const char*)(ws + O_WBR), (size_t)256 * 512 * 2, (size_t)256 * 1536 * 2, (size_t)512 * 2};
                pg8::gemm_phase(F.lds, g, S, E); }
            } break;
            case 6: if (SUB_ON(6)) {
                EpiRes E{xin_lat, xin_ctx, outp, XC, mod_l + 2048}; const Gemm g{1024, 1024, 1024};
                RectSched S{nMt, 4, 0, G, c, 1, ~0ull, (const char*)MB, 0, 0, (const char*)(ws + O_WOUT), (size_t)256 * 1024 * 2, (size_t)256 * 1024 * 2, 0};
                pg8::gemm_phase(F.lds, g, S, E);
            } break;
            case 7: if (SUB_ON(7)) {
                for (int rep_ = 0; rep_ < REP(1024); ++rep_) convert_weights_ffn(F, kp, l);
                for (int rep_ = 0; rep_ < REP(2048); ++rep_) norm_pass(F, outp, XC, HB, kin(kp, 7) + l * 1024, mod_l, 3072, L1 ? ML : MT);
            } break;
            case 8: if (SUB_ON(8)) {
                for (int rep_ = 0; rep_ < REP(4096); ++rep_) { EpiSwiglu E{ACT}; const Gemm g{1024, 1024, 1024};
                RectSched S{nMt, 22, 0, G, c, 1, ~0ull, (const char*)HB, 0, 0, (const char*)(ws + O_WFI), (size_t)256 * 1024 * 2, (size_t)256 * 1024 * 2, 0};
                pg8::gemm_phase(F.lds, g, S, E); }
            } break;
            case 9: if (SUB_ON(9)) {
                EpiRes E{outp, XC, outp, XC, mod_l + 5120}; const Gemm g{FFH, FFH, FFH};
                RectSched S{nMt, 4, 0, G, c, 1, ~0ull, (const char*)ACT, 0, 0, (const char*)(ws + O_WFO), (size_t)256 * FFH * 2, (size_t)256 * FFH * 2, 0};
                pg8::gemm_phase(F.lds, g, S, E);
            } break;
            }
        }
        if (ph + 1 < args.ph_hi) { GRID_SYNC(ph == 0); }
    }
}

extern "C" void kernel_launch(void* const* d_in, const int* in_sizes, int n_in, void* d_out, int out_size, void* d_ws, size_t ws_size, hipStream_t stream) {
    static int grid = 0;
    if (grid == 0) {
        if (n_in != 26 || out_size != ML * DM || ws_size < O_END) { fprintf(stderr, "kernel_launch: unexpected shapes (n_in %d out %d ws %zu)\n", n_in, out_size, ws_size); grid = -1; return; }
        int dev = 0, cus = 0, per_cu = 0;
        hipGetDevice(&dev); hipDeviceGetAttribute(&cus, hipDeviceAttributeMultiprocessorCount, dev);
        if (hipFuncSetAttribute((const void*)fwd_kernel, hipFuncAttributeMaxDynamicSharedMemorySize, LDS_BYTES) != hipSuccess) { fprintf(stderr, "kernel_launch: hipFuncSetAttribute failed\n"); grid = -1; return; }
        hipOccupancyMaxActiveBlocksPerMultiprocessor(&per_cu, (const void*)fwd_kernel, NTHR, LDS_BYTES);
        if (per_cu < 1) { fprintf(stderr, "kernel_launch: occupancy query says %d blocks/CU\n", per_cu); per_cu = 1; }
        (void)hipGetLastError();
        grid = cus;
        if (grid > 256) grid = 256;
    }
    if (grid < 0) return;
    (void)hipMemsetAsync((char*)d_ws + O_CTL, 0, CTL_ZERO_BYTES, stream);
    Args a{};
    for (int i = 0; i < 26; ++i) a.in[i] = (const float*)d_in[i];
    a.out = (float*)d_out; a.ws = (unsigned char*)d_ws;
#if MK_MULTI
    for (int ph = 0; ph < NPHASE; ++ph) { a.ph_lo = ph; a.ph_hi = ph + 1; hipLaunchKernelGGL(fwd_kernel, dim3(grid), dim3(NTHR), LDS_BYTES, stream, a); }
#else
    a.ph_lo = 0; a.ph_hi = NPHASE;
    void* kargs[] = {&a};
    hipError_t e = hipLaunchCooperativeKernel((const void*)fwd_kernel, dim3(grid), dim3(NTHR), kargs, LDS_BYTES, stream);
    if (e != hipSuccess) fprintf(stderr, "cooperative launch failed: %s (grid %d)\n", hipGetErrorString(e), grid);
#endif
}
```

```cpp
#include <hip/hip_runtime.h>
#include <hip/hip_cooperative_groups.h>
#include <cstdint>
#include <cstdio>
namespace cg = cooperative_groups;

#ifndef MK_MULTI
#define MK_MULTI 0
#endif

#define LAS __attribute__((address_space(3)))
typedef unsigned short bf16;
typedef short bf16x8 __attribute__((ext_vector_type(8)));
typedef short s16x4 __attribute__((ext_vector_type(4)));
typedef float f32x2 __attribute__((ext_vector_type(2)));
typedef float f32x4 __attribute__((ext_vector_type(4)));
typedef float f32x16 __attribute__((ext_vector_type(16)));
typedef unsigned u32x2 __attribute__((ext_vector_type(2)));
typedef unsigned u32x4 __attribute__((ext_vector_type(4)));
typedef __bf16 bf16x2_t __attribute__((ext_vector_type(2)));

constexpr int DM = 1024, NB = 8, SEQ = 2048, CTX = 256, NKEY = CTX + SEQ;
constexpr int ML = NB * SEQ, MC = NB * CTX, MT = ML + MC;
constexpr int INW = 5024, NINP = 5120;
constexpr int FFH = 2816;
constexpr float EPS = 1e-6f;
constexpr float LOG2E = 1.4426950408889634f;
constexpr float C2A = 0.125f * LOG2E;
constexpr float C2B = 0.10206207261596577f * LOG2E;
constexpr int NWAVES = 8, NTHR = 512;

constexpr size_t MiB = 1u << 20, KiB = 1024;
constexpr size_t O_CTL = 0;
constexpr size_t O_MOD = 256 * KiB;
constexpr size_t O_ROPEA = 704 * KiB;
constexpr size_t O_ROPEB = 712 * KiB;
constexpr size_t O_STATCQ = 1 * MiB;
constexpr size_t O_STATCKV = O_STATCQ + (size_t)MT * 8 * 4;
constexpr size_t O_DN = 2 * MiB;
constexpr size_t O_DN256 = O_DN + 16 * MiB;
constexpr size_t O_DFTC = O_DN256 + 256 * KiB;
constexpr size_t O_W = O_DN + 16 * MiB + 512 * KiB;
constexpr size_t O_WIN = O_W;
constexpr size_t O_WUQ = O_WIN + (size_t)NINP * 1024 * 2;
constexpr size_t O_WUKV = O_WUQ + 768 * 384 * 2;
constexpr size_t O_WBR = O_WUKV + 1024 * 256 * 2;
constexpr size_t O_WOUT = O_WBR + 1024 * 1536 * 2;
constexpr size_t O_XC = O_W + 16 * MiB + 256 * KiB;
constexpr size_t O_HB = O_XC + 8 * MiB;
constexpr size_t O_PF = O_HB + 36 * MiB;
constexpr size_t O_QA = O_PF + 18 * MiB;
constexpr size_t O_QBN = O_QA + 18 * MiB;
constexpr size_t O_QBR = O_QBN + 18 * MiB;
constexpr size_t O_WFI = O_QA;
constexpr size_t O_WFO = O_WFI + (size_t)5632 * 1024 * 2;
constexpr size_t O_G = O_QBR + 9 * MiB;
constexpr size_t O_CQ = O_G;
constexpr size_t O_CKV = O_CQ + (size_t)MT * 384 * 2;
constexpr size_t O_KA = O_CKV + (size_t)MT * 256 * 2;
constexpr size_t O_VA = O_KA + (size_t)NB * NKEY * 128 * 2;
constexpr size_t O_KB = O_VA + (size_t)NB * NKEY * 128 * 2;
constexpr size_t O_VB = O_KB + (size_t)NB * NKEY * 768 * 2;
constexpr size_t O_ZT1 = O_VB + (size_t)NB * NKEY * 512 * 2;
constexpr size_t O_END = O_ZT1 + 32 * MiB;
static_assert(O_END <= 256 * MiB, "d_ws map exceeds 256 MiB");
static_assert(O_WOUT + 2 * MiB <= O_XC, "W region");
static_assert(O_WFO + (size_t)1024 * 2816 * 2 <= O_G, "ffn weights overlay");
static_assert(O_G + (size_t)MT * 3072 * 2 <= O_END, "gates overlay");
static_assert(O_DFTC + 64 * KiB <= O_W, "dft region");
static_assert(O_STATCKV + (size_t)MT * 4 * 4 <= O_DN, "stats region");

__device__ __forceinline__ unsigned cvtpk(float lo, float hi) { f32x2 v = {lo, hi}; bf16x2_t b = __builtin_convertvector(v, bf16x2_t); return __builtin_bit_cast(unsigned, b); }
__device__ __forceinline__ u32x2 pk4(f32x4 v) { u32x2 r; r.x = cvtpk(v[0], v[1]); r.y = cvtpk(v[2], v[3]); return r; }
__device__ __forceinline__ float bf2f(unsigned short h) { return __uint_as_float((unsigned)h << 16); }
__device__ __forceinline__ f32x4 unpk4(u32x2 w) { f32x4 r; r[0] = __uint_as_float(w.x << 16); r[1] = __uint_as_float(w.x & 0xffff0000u); r[2] = __uint_as_float(w.y << 16); r[3] = __uint_as_float(w.y & 0xffff0000u); return r; }
__device__ __forceinline__ u32x4 pk8(f32x4 a, f32x4 b) { u32x4 r; r.x = cvtpk(a[0], a[1]); r.y = cvtpk(a[2], a[3]); r.z = cvtpk(b[0], b[1]); r.w = cvtpk(b[2], b[3]); return r; }
__device__ __forceinline__ unsigned q8(float g) { return (unsigned)__builtin_rintf(__builtin_fminf(__builtin_fmaxf(g * 255.0f, 1.0f), 255.0f)); }
__device__ __forceinline__ unsigned q8x4(f32x4 g) { return q8(g[0]) | (q8(g[1]) << 8) | (q8(g[2]) << 16) | (q8(g[3]) << 24); }
__device__ __forceinline__ f32x4 uq8x4(unsigned w) { f32x4 r; r[0] = (float)(w & 0xffu); r[1] = (float)((w >> 8) & 0xffu); r[2] = (float)((w >> 16) & 0xffu); r[3] = (float)(w >> 24); return r; }
__device__ __forceinline__ float wave_sum(float v) {
#pragma unroll
    for (int o = 1; o < 64; o <<= 1) v += __shfl_xor(v, o);
    return v;
}
__device__ __forceinline__ float fq_sum(float v) { v += __shfl_xor(v, 16); v += __shfl_xor(v, 32); return v; }
__device__ __forceinline__ float sigmoidf_(float x) { return __builtin_amdgcn_rcpf(1.0f + __expf(-x)); }

namespace pg8 {
constexpr int BM = 256, BK = 64, HALF = 128, HTB = HALF * BK * 2, STAGE_BYTES = 8 * HTB, NXCD = 8, WGM = 8;
__host__ __device__ __forceinline__ int lds_byte(int r, int c) { const int st = (r >> 4) * 2 + (c >> 5), rr = r & 15, cc = c & 31, ob = rr * 64 + cc * 2; return st * 1024 + (ob ^ (((ob >> 9) & 1) << 5)); }
__host__ __device__ __forceinline__ void stage_rc(int b, int& R, int& C) { const int st = b / 1024, sb = b % 1024, swz = sb ^ (((sb >> 9) & 1) << 5); R = (st >> 1) * 16 + swz / 64; C = (st & 1) * 32 + (swz % 64) / 2; }

struct Unit { int pm, pn, kb; const char* A; const char* B; };
struct Gemm { int lda, ldb, K; };

__device__ __forceinline__ void tile_order(int L, int nM, int nN, int& pm, int& pn) {
    const int nwg = nM * nN; int wgid = L;
    { const int q = nwg / NXCD, r = nwg % NXCD, xcd = wgid % NXCD, off = wgid / NXCD; wgid = (xcd < r ? xcd * (q + 1) : r * (q + 1) + (xcd - r) * q) + off; }
    const int nig = WGM * nN, gid = wgid / nig, fm = gid * WGM, gsz = (nM - fm) < WGM ? (nM - fm) : WGM;
    pm = fm + ((wgid % nig) % gsz); pn = (wgid % nig) / gsz;
}

template <class Epi, class Sched>
__device__ __forceinline__ void gemm_phase(LAS unsigned char* lds, const Gemm g, const Sched& S, const Epi& E) {
    int tid = threadIdx.x; asm volatile("" : "+v"(tid));
    const int wid = __builtin_amdgcn_readfirstlane(tid >> 6), lane = tid & 63, wr = wid >> 2, wc = wid & 3, fr = lane & 15, fq = lane >> 4;
    int nt = g.K / BK; asm volatile("" : "+s"(nt));
    unsigned voffA, voffB;
    { int R, C; stage_rc(tid * 16, R, C); voffA = (unsigned)(R * g.lda + C) * 2u; voffB = (unsigned)(R * g.ldb + C) * 2u; }
    const size_t pieceA = (size_t)64 * g.lda * 2, pieceB = (size_t)64 * g.ldb * 2;
    const size_t kstep = (size_t)(BK * 2);
    const size_t hstepA = (size_t)HALF * g.lda * 2, hstepB = (size_t)HALF * g.ldb * 2;
    const unsigned ldsw = (unsigned)wid * 1024u;
    const int aoff = lds_byte(wr * 64 + fr, fq * 8), boff = lds_byte(wc * 32 + fr, fq * 8);
#define PG8_SA(b, h) (((b) * 2 + (h)) * HTB)
#define PG8_SB(b, h) ((4 + (b) * 2 + (h)) * HTB)
#define PG8_STAGE_A(bufoff, gbase) do { _Pragma("unroll") for (int _i = 0; _i < 2; ++_i) \
        __builtin_amdgcn_global_load_lds((const unsigned*)((const char*)(gbase) + _i * pieceA + voffA), (LAS unsigned*)(lds + (bufoff) + ldsw + _i * 8192), 16, 0, 0); } while (0)
#define PG8_STAGE_B(bufoff, gbase) do { _Pragma("unroll") for (int _i = 0; _i < 2; ++_i) \
        __builtin_amdgcn_global_load_lds((const unsigned*)((const char*)(gbase) + _i * pieceB + voffB), (LAS unsigned*)(lds + (bufoff) + ldsw + _i * 8192), 16, 0, 0); } while (0)
#define PG8_LDA(dst, b, h) do { _Pragma("unroll") for (int m = 0; m < 4; ++m) _Pragma("unroll") for (int k = 0; k < 2; ++k) dst[m][k] = *(const LAS bf16x8*)(lds + PG8_SA(b, h) + aoff + m * 2048 + k * 1024); } while (0)
#define PG8_LDB(dst, b, h) do { _Pragma("unroll") for (int n = 0; n < 2; ++n) _Pragma("unroll") for (int k = 0; k < 2; ++k) dst[n][k] = *(const LAS bf16x8*)(lds + PG8_SB(b, h) + boff + n * 2048 + k * 1024); } while (0)
#define PG8_MMA(ai, bj, At, Bt) do { __builtin_amdgcn_s_setprio(1); _Pragma("unroll") for (int m = 0; m < 4; ++m) _Pragma("unroll") for (int n = 0; n < 2; ++n) _Pragma("unroll") for (int k = 0; k < 2; ++k) \
        acc[ai][bj][m][n] = __builtin_amdgcn_mfma_f32_16x16x32_bf16(Bt[n][k], At[m][k], acc[ai][bj][m][n], 0, 0, 0); __builtin_amdgcn_s_setprio(0); } while (0)
#define PG8_WAIT_V(n) asm volatile("s_waitcnt vmcnt(" #n ")" ::: "memory")
#define PG8_WAIT_L(n) asm volatile("s_waitcnt lgkmcnt(" #n ")" ::: "memory")
#define PG8_BAR __builtin_amdgcn_s_barrier()
#define PG8_SCHED __builtin_amdgcn_sched_barrier(0)
    Unit cur, nxt; int ui = 0;
    if (!S.next(0, cur)) return;
    f32x4 acc[2][2][4][2];
#pragma unroll
    for (int a = 0; a < 2; ++a)
#pragma unroll
        for (int b = 0; b < 2; ++b)
#pragma unroll
            for (int m = 0; m < 4; ++m)
#pragma unroll
                for (int n = 0; n < 2; ++n) acc[a][b][m][n] = (f32x4){0.f, 0.f, 0.f, 0.f};
    bf16x8 At[4][2], B0[2][2], B1[2][2];
    const char* cA = cur.A; const char* cB = cur.B;
    PG8_STAGE_B(PG8_SB(0, 0), cB); PG8_STAGE_B(PG8_SB(0, 1), cB + hstepB); PG8_STAGE_A(PG8_SA(0, 0), cA); PG8_STAGE_A(PG8_SA(0, 1), cA + hstepA);
    if (wr == 1) PG8_BAR;
    PG8_WAIT_V(2); PG8_BAR;
    PG8_STAGE_B(PG8_SB(1, 0), cB + kstep); PG8_STAGE_A(PG8_SA(1, 0), cA + kstep); PG8_STAGE_B(PG8_SB(1, 1), cB + hstepB + kstep);
    PG8_WAIT_V(6); PG8_BAR;
    for (;;) {
        const bool has_next = S.next(ui + 1, nxt);
        const char* nA = has_next ? nxt.A : cA; const char* nB = has_next ? nxt.B : cB;
        for (int t = 0; t < nt; t += 2) {
            const bool last = (t == nt - 2);
            const char* a1 = cA + (size_t)(t + 1) * kstep;
            const char* a2 = last ? nA : cA + (size_t)(t + 2) * kstep; const char* b2 = last ? nB : cB + (size_t)(t + 2) * kstep;
            const char* a3 = a2 + kstep; const char* b3 = b2 + kstep;
            PG8_LDB(B0, 0, 0); PG8_LDB(B1, 0, 1); PG8_SCHED; PG8_LDA(At, 0, 0); PG8_STAGE_A(PG8_SA(1, 1), a1 + hstepA);
            PG8_WAIT_V(8); PG8_WAIT_L(0); PG8_BAR; PG8_MMA(0, 0, At, B0); PG8_MMA(0, 1, At, B1); PG8_BAR; PG8_SCHED;
            PG8_LDA(At, 0, 1); PG8_STAGE_B(PG8_SB(0, 0), b2); PG8_STAGE_B(PG8_SB(0, 1), b2 + hstepB); PG8_STAGE_A(PG8_SA(0, 0), a2);
            PG8_WAIT_V(8); PG8_WAIT_L(0); PG8_BAR; PG8_MMA(1, 0, At, B0); PG8_MMA(1, 1, At, B1); PG8_BAR; PG8_SCHED;
            PG8_LDB(B0, 1, 0); PG8_LDB(B1, 1, 1); PG8_SCHED; PG8_LDA(At, 1, 0); PG8_STAGE_A(PG8_SA(0, 1), a2 + hstepA);
            PG8_WAIT_V(8); PG8_WAIT_L(0); PG8_BAR; PG8_MMA(0, 0, At, B0); PG8_MMA(0, 1, At, B1); PG8_BAR; PG8_SCHED;
            PG8_LDA(At, 1, 1); PG8_STAGE_B(PG8_SB(1, 0), b3); PG8_STAGE_B(PG8_SB(1, 1), b3 + hstepB); PG8_STAGE_A(PG8_SA(1, 0), a3);
            PG8_WAIT_V(8); PG8_WAIT_L(0); PG8_BAR; PG8_MMA(1, 0, At, B0); PG8_MMA(1, 1, At, B1); PG8_BAR; PG8_SCHED;
        }
        if (wr == 0) PG8_BAR;
        const bool carry = E(acc, cur, wr, wc, fr, fq);
        if (!has_next) break;
        if (!carry) {
#pragma unroll
            for (int a = 0; a < 2; ++a)
#pragma unroll
                for (int b = 0; b < 2; ++b)
#pragma unroll
                    for (int m = 0; m < 4; ++m)
#pragma unroll
                        for (int n = 0; n < 2; ++n) acc[a][b][m][n] = (f32x4){0.f, 0.f, 0.f, 0.f};
        }
        cur = nxt; cA = nA; cB = nB; ++ui;
        if (wr == 1) PG8_BAR;
    }
    PG8_WAIT_V(0);
    PG8_BAR;
#undef PG8_SA
#undef PG8_SB
#undef PG8_STAGE_A
#undef PG8_STAGE_B
#undef PG8_LDA
#undef PG8_LDB
#undef PG8_MMA
#undef PG8_WAIT_V
#undef PG8_WAIT_L
#undef PG8_BAR
#undef PG8_SCHED
}
}
using pg8::Unit; using pg8::Gemm;

typedef f32x4 Acc[2][2][4][2];

struct RectSched {
    int nM, nN, pm0, G, c, nkb; unsigned long long pnmap;
    const char* A0; size_t dA1, dA2; const char* B; size_t strideAm, strideBn, strideBk;
    __device__ __forceinline__ bool next(int i, Unit& u) const {
        const int ti = i / nkb, kb = i - ti * nkb; const long L = (long)ti * G + c; if (L >= (long)nM * nN) return false;
        int pm, pn; pg8::tile_order((int)L, nM, nN, pm, pn);
        if (pnmap != ~0ull) pn = (int)((pnmap >> (4 * pn)) & 15ull);
        u.pm = pm + pm0; u.pn = pn; u.kb = kb;
        u.A = A0 + (size_t)(kb == 1) * dA1 + (size_t)(kb == 2) * dA2 + (size_t)u.pm * strideAm; u.B = B + (size_t)pn * strideBn + (size_t)kb * strideBk; return true;
    }
};

struct RowInfo { bool ctx; int b; int tok0; };
__device__ __forceinline__ RowInfo row_info(int pm) { RowInfo r; r.ctx = pm >= 64; r.b = r.ctx ? pm - 64 : pm >> 3; r.tok0 = r.ctx ? 0 : (pm & 7) * 256; return r; }

template <bool NORM>
__device__ __forceinline__ void head64(const f32x4 (&a)[2][2], const f32x4 (&g)[2][2], float scale, bool rope, int row_id, int col_id, const float* ropeA, int fq, f32x4 (&o)[2][2]) {
    f32x4 v[2][2];
    if (NORM) {
        float ss = 0.f;
#pragma unroll
        for (int bj = 0; bj < 2; ++bj)
#pragma unroll
            for (int n = 0; n < 2; ++n) { const f32x4 x = a[bj][n]; ss += (x[0] * x[0] + x[1] * x[1]) + (x[2] * x[2] + x[3] * x[3]); }
        ss = fq_sum(ss);
        const float rstd = rsqrtf(ss * (1.0f / 64.0f) + EPS);
#pragma unroll
        for (int bj = 0; bj < 2; ++bj)
#pragma unroll
            for (int n = 0; n < 2; ++n) v[bj][n] = a[bj][n] * rstd * g[bj][n];
    } else {
#pragma unroll
        for (int bj = 0; bj < 2; ++bj)
#pragma unroll
            for (int n = 0; n < 2; ++n) v[bj][n] = a[bj][n];
    }
    if (rope) {
#pragma unroll
        for (int bj = 0; bj < 2; ++bj) {
            const int pos = bj ? col_id : row_id;
            const f32x4 cs = *(const f32x4*)(ropeA + pos * 16 + 4 * fq), sn = *(const f32x4*)(ropeA + 1024 + pos * 16 + 4 * fq);
            o[bj][0] = (v[bj][0] * cs - v[bj][1] * sn) * scale; o[bj][1] = (v[bj][1] * cs + v[bj][0] * sn) * scale;
        }
    } else {
#pragma unroll
        for (int bj = 0; bj < 2; ++bj)
#pragma unroll
            for (int n = 0; n < 2; ++n) o[bj][n] = v[bj][n] * scale;
    }
}
__device__ __forceinline__ void rope32(const f32x4 (&a)[2], const float* g, float scale, bool rope, int row_id, int col_id, const float* ropeB, int fq, f32x4 (&o)[2]) {
    float ss = 0.f;
#pragma unroll
    for (int n = 0; n < 2; ++n) { const f32x4 x = a[n]; ss += (x[0] * x[0] + x[1] * x[1]) + (x[2] * x[2] + x[3] * x[3]); }
    ss = fq_sum(ss);
    const float rstd = rsqrtf(ss * (1.0f / 32.0f) + EPS);
    const int d0 = 16 * (fq >> 1) + 4 * (fq & 1);
    f32x4 v[2];
#pragma unroll
    for (int n = 0; n < 2; ++n) v[n] = a[n] * rstd * *(const f32x4*)(g + d0 + 8 * n);
    if (rope) {
        const int pos = (fq >> 1) ? col_id : row_id;
        const f32x4 cs = *(const f32x4*)(ropeB + pos * 8 + 4 * (fq & 1)), sn = *(const f32x4*)(ropeB + 512 + pos * 8 + 4 * (fq & 1));
        o[0] = (v[0] * cs - v[1] * sn) * scale; o[1] = (v[1] * cs + v[0] * sn) * scale;
    } else { o[0] = v[0] * scale; o[1] = v[1] * scale; }
}

struct EpiIn {
    bf16 *QA, *KA, *VA, *CQ, *CKV, *KB, *PF, *G; float *stat_cq, *stat_ckv;
    const float *gq, *gk, *gkr, *bgate, *ropeA, *ropeB;
    __device__ __forceinline__ bool operator()(Acc& acc, const Unit& u, int wr, int wc, int fr_, int fq_) const {
        int fr = fr_, fq = fq_; asm volatile("" : "+v"(fr), "+v"(fq));
        const RowInfo ri = row_info(u.pm); const bool rope = !ri.ctx;
        const int pn = u.pn;
        if (pn <= 2) {
            const bool isv = (pn == 2 && wc >= 2), isk = (pn == 2 && wc < 2);
            const float* gsrc = (pn < 2) ? gq : gk;
            f32x4 g[2][2];
#pragma unroll
            for (int bj = 0; bj < 2; ++bj)
#pragma unroll
                for (int n = 0; n < 2; ++n) g[bj][n] = *(const f32x4*)(gsrc + 32 * bj + 16 * n + 4 * fq);
#pragma unroll
            for (int ai = 0; ai < 2; ++ai)
#pragma unroll
                for (int m = 0; m < 4; ++m) {
                    const int rt = 128 * ai + 64 * wr + 16 * m + fr;
                    const int row_id = (ri.tok0 + 128 * ai + 64 * wr) >> 6, col_id = 16 * m + fr;
                    f32x4 a[2][2], o[2][2];
#pragma unroll
                    for (int bj = 0; bj < 2; ++bj)
#pragma unroll
                        for (int n = 0; n < 2; ++n) a[bj][n] = acc[ai][bj][m][n];
                    bf16* dst;
                    if (pn < 2) { head64<true>(a, g, C2A, rope, row_id, col_id, ropeA, fq, o); dst = QA + (size_t)(u.pm * 256 + rt) * 512 + (4 * pn + wc) * 64; }
                    else {
                        const size_t key = (size_t)ri.b * NKEY + (ri.ctx ? rt : 256 + ri.tok0 + rt);
                        if (isk) { head64<true>(a, g, 1.0f, rope, row_id, col_id, ropeA, fq, o); dst = KA + key * 128 + wc * 64; }
                        else { head64<false>(a, g, 1.0f, false, 0, 0, ropeA, fq, o); dst = VA + key * 128 + (wc - 2) * 64; }
                    }
#pragma unroll
                    for (int bj = 0; bj < 2; ++bj)
#pragma unroll
                        for (int n = 0; n < 2; ++n) *(u32x2*)(dst + 32 * bj + 16 * n + 4 * fq) = pk4(o[bj][n]);
                }
            (void)isv;
        } else if (pn == 3 || pn == 5) {
            bf16* dstb = (pn == 3) ? CQ : CKV; const int ld = (pn == 3) ? 384 : 256;
            float* st = (pn == 3) ? stat_cq : stat_ckv; const int sld = (pn == 3) ? 8 : 4;
#pragma unroll
            for (int ai = 0; ai < 2; ++ai)
#pragma unroll
                for (int m = 0; m < 4; ++m) {
                    const size_t row = (size_t)u.pm * 256 + 128 * ai + 64 * wr + 16 * m + fr; float ss = 0.f;
#pragma unroll
                    for (int bj = 0; bj < 2; ++bj) { const f32x4 x = acc[ai][bj][m][0], y = acc[ai][bj][m][1];
                        ss += (x[0] * x[0] + x[1] * x[1]) + (x[2] * x[2] + x[3] * x[3]) + (y[0] * y[0] + y[1] * y[1]) + (y[2] * y[2] + y[3] * y[3]);
                        *(u32x4*)(dstb + row * ld + 128 * bj + 32 * wc + 8 * fq) = pk8(x, y); }
                    ss = fq_sum(ss);
                    if (fq == 0) st[row * sld + wc] = ss;
                }
        } else if (pn == 4) {
            f32x4 gk0[2]; (void)gk0;
#pragma unroll
            for (int ai = 0; ai < 2; ++ai)
#pragma unroll
                for (int m = 0; m < 4; ++m) {
                    const int rt = 128 * ai + 64 * wr + 16 * m + fr; const size_t row = (size_t)u.pm * 256 + rt; float ss = 0.f;
                    { const f32x4 x = acc[ai][0][m][0], y = acc[ai][0][m][1];
                      ss += (x[0] * x[0] + x[1] * x[1]) + (x[2] * x[2] + x[3] * x[3]) + (y[0] * y[0] + y[1] * y[1]) + (y[2] * y[2] + y[3] * y[3]);
                      *(u32x4*)(CQ + row * 384 + 256 + 32 * wc + 8 * fq) = pk8(x, y); }
                    ss = fq_sum(ss);
                    if (fq == 0) stat_cq[row * 8 + 4 + wc] = ss;
                    if (wc == 0) {
                        const int row_id = (ri.tok0 + 128 * ai + 64 * wr) >> 6, col_id = 16 * m + fr;
                        f32x4 a[2], o[2]; a[0] = acc[ai][1][m][0]; a[1] = acc[ai][1][m][1];
                        rope32(a, gkr, 1.0f, rope, row_id, col_id, ropeB, fq, o);
                        const size_t key = (size_t)ri.b * NKEY + (ri.ctx ? rt : 256 + ri.tok0 + rt);
                        bf16* dst = KB + key * 768 + 64 + 16 * (fq >> 1) + 4 * (fq & 1);
                        const u32x2 w0 = pk4(o[0]), w1 = pk4(o[1]);
#pragma unroll
                        for (int h = 0; h < 8; ++h) { *(u32x2*)(dst + h * 96) = w0; *(u32x2*)(dst + h * 96 + 8) = w1; }
                    }
                }
        } else if (pn < 8) {
#pragma unroll
            for (int ai = 0; ai < 2; ++ai)
#pragma unroll
                for (int m = 0; m < 4; ++m) {
                    const size_t row = (size_t)u.pm * 256 + 128 * ai + 64 * wr + 16 * m + fr;
#pragma unroll
                    for (int bj = 0; bj < 2; ++bj) *(u32x4*)(PF + row * 512 + (pn - 6) * 256 + 128 * bj + 32 * wc + 8 * fq) = pk8(acc[ai][bj][m][0], acc[ai][bj][m][1]);
                }
        } else {
            const int c0 = (pn - 8) * 256 + 32 * wc + 8 * fq;
            f32x4 bv[2][2];
#pragma unroll
            for (int bj = 0; bj < 2; ++bj)
#pragma unroll
                for (int n = 0; n < 2; ++n) bv[bj][n] = *(const f32x4*)(bgate + c0 + 128 * bj + 4 * n);
            unsigned char* G8 = (unsigned char*)G;
#pragma unroll
            for (int ai = 0; ai < 2; ++ai)
#pragma unroll
                for (int m = 0; m < 4; ++m) {
                    const size_t row = (size_t)u.pm * 256 + 128 * ai + 64 * wr + 16 * m + fr;
#pragma unroll
                    for (int bj = 0; bj < 2; ++bj) { u32x2 w;
#pragma unroll
                        for (int n = 0; n < 2; ++n) { f32x4 x = acc[ai][bj][m][n] + bv[bj][n];
                            x[0] = sigmoidf_(x[0]); x[1] = sigmoidf_(x[1]); x[2] = sigmoidf_(x[2]); x[3] = sigmoidf_(x[3]);
                            if (n == 0) w.x = q8x4(x); else w.y = q8x4(x); }
                        *(u32x2*)(G8 + row * 3072 + c0 + 128 * bj) = w; }
                }
        }
        return false;
    }
};

struct EpiUq {
    bf16 *QBN, *QBR; const float *stat_cq, *gqn, *gqr, *ropeB;
    __device__ __forceinline__ bool operator()(Acc& acc, const Unit& u, int wr, int wc, int fr_, int fq_) const {
        int fr = fr_, fq = fq_; asm volatile("" : "+v"(fr), "+v"(fq));
        const RowInfo ri = row_info(u.pm); const bool rope = !ri.ctx;
        f32x4 g[2][2];
#pragma unroll
        for (int bj = 0; bj < 2; ++bj)
#pragma unroll
            for (int n = 0; n < 2; ++n) g[bj][n] = *(const f32x4*)(gqn + 32 * bj + 16 * n + 4 * fq);
#pragma unroll
        for (int ai = 0; ai < 2; ++ai)
#pragma unroll
            for (int m = 0; m < 4; ++m) {
                const int rt = 128 * ai + 64 * wr + 16 * m + fr; const size_t row = (size_t)u.pm * 256 + rt;
                const f32x4 s0 = *(const f32x4*)(stat_cq + row * 8), s1 = *(const f32x4*)(stat_cq + row * 8 + 4);
                const float rs = rsqrtf(((s0[0] + s0[1]) + (s0[2] + s0[3]) + (s1[0] + s1[1]) + (s1[2] + s1[3])) * (1.0f / 384.0f) + EPS);
                if (u.pn < 2) {
                    f32x4 a[2][2], o[2][2];
#pragma unroll
                    for (int bj = 0; bj < 2; ++bj)
#pragma unroll
                        for (int n = 0; n < 2; ++n) a[bj][n] = acc[ai][bj][m][n] * rs;
                    head64<true>(a, g, C2B, false, 0, 0, ropeB, fq, o);
                    bf16* dst = QBN + row * 512 + (4 * u.pn + wc) * 64;
#pragma unroll
                    for (int bj = 0; bj < 2; ++bj)
#pragma unroll
                        for (int n = 0; n < 2; ++n) *(u32x2*)(dst + 32 * bj + 16 * n + 4 * fq) = pk4(o[bj][n]);
                } else {
                    const int row_id = (ri.tok0 + 128 * ai + 64 * wr) >> 6, col_id = 16 * m + fr;
#pragma unroll
                    for (int bj = 0; bj < 2; ++bj) {
                        f32x4 a[2], o[2]; a[0] = acc[ai][bj][m][0] * rs; a[1] = acc[ai][bj][m][1] * rs;
                        rope32(a, gqr, C2B, rope, row_id, col_id, ropeB, fq, o);
                        bf16* dst = QBR + row * 256 + (4 * bj + wc) * 32 + 16 * (fq >> 1) + 4 * (fq & 1);
                        *(u32x2*)(dst) = pk4(o[0]); *(u32x2*)(dst + 8) = pk4(o[1]);
                    }
                }
            }
        return false;
    }
};

struct EpiUkv {
    bf16 *KB, *VB; const float *stat_ckv, *gkn;
    __device__ __forceinline__ bool operator()(Acc& acc, const Unit& u, int wr, int wc, int fr_, int fq_) const {
        int fr = fr_, fq = fq_; asm volatile("" : "+v"(fr), "+v"(fq));
        const RowInfo ri = row_info(u.pm);
        f32x4 g[2][2];
#pragma unroll
        for (int bj = 0; bj < 2; ++bj)
#pragma unroll
            for (int n = 0; n < 2; ++n) g[bj][n] = *(const f32x4*)(gkn + 32 * bj + 16 * n + 4 * fq);
#pragma unroll
        for (int ai = 0; ai < 2; ++ai)
#pragma unroll
            for (int m = 0; m < 4; ++m) {
                const int rt = 128 * ai + 64 * wr + 16 * m + fr; const size_t row = (size_t)u.pm * 256 + rt;
                const f32x4 s0 = *(const f32x4*)(stat_ckv + row * 4);
                const float rs = rsqrtf(((s0[0] + s0[1]) + (s0[2] + s0[3])) * (1.0f / 256.0f) + EPS);
                const size_t key = (size_t)ri.b * NKEY + (ri.ctx ? rt : 256 + ri.tok0 + rt);
                f32x4 a[2][2], o[2][2];
#pragma unroll
                for (int bj = 0; bj < 2; ++bj)
#pragma unroll
                    for (int n = 0; n < 2; ++n) a[bj][n] = acc[ai][bj][m][n] * rs;
                bf16* dst;
                if (u.pn < 2) { head64<true>(a, g, 1.0f, false, 0, 0, gkn, fq, o); dst = KB + key * 768 + (4 * u.pn + wc) * 96; }
                else { head64<false>(a, g, 1.0f, false, 0, 0, gkn, fq, o); dst = VB + key * 512 + (4 * (u.pn - 2) + wc) * 64; }
#pragma unroll
                for (int bj = 0; bj < 2; ++bj)
#pragma unroll
                    for (int n = 0; n < 2; ++n) *(u32x2*)(dst + 32 * bj + 16 * n + 4 * fq) = pk4(o[bj][n]);
            }
        return false;
    }
};

struct EpiStore {
    bf16* O; int ld;
    __device__ __forceinline__ bool operator()(Acc& acc, const Unit& u, int wr, int wc, int fr_, int fq_) const {
        int fr = fr_, fq = fq_; asm volatile("" : "+v"(fr), "+v"(fq));
#pragma unroll
        for (int ai = 0; ai < 2; ++ai)
#pragma unroll
            for (int m = 0; m < 4; ++m) {
                const size_t row = (size_t)u.pm * 256 + 128 * ai + 64 * wr + 16 * m + fr;
#pragma unroll
                for (int bj = 0; bj < 2; ++bj)
#pragma unroll
                    for (int n = 0; n < 2; ++n) *(u32x2*)(O + row * ld + u.pn * 256 + 128 * bj + 32 * wc + 16 * n + 4 * fq) = pk4(acc[ai][bj][m][n]);
            }
        return false;
    }
};

struct EpiF1 {
    bf16* ZT; int NP;
    __device__ __forceinline__ bool operator()(Acc& acc, const Unit& u, int wr, int wc, int fr_, int fq_) const {
        int fr = fr_, fq = fq_; asm volatile("" : "+v"(fr), "+v"(fq));
        const int b = u.pm >> 2, gch = u.pm & 3;
#pragma unroll
        for (int ai = 0; ai < 2; ++ai)
#pragma unroll
            for (int m = 0; m < 4; ++m) {
                const int ch = gch * 128 + 64 * wr + 16 * m + fr;
                bf16* dst = ZT + ((size_t)b * 512 + ch) * (2 * NP) + ai * NP + u.pn * 256;
#pragma unroll
                for (int bj = 0; bj < 2; ++bj)
#pragma unroll
                    for (int n = 0; n < 2; ++n) *(u32x2*)(dst + 128 * bj + 32 * wc + 16 * n + 4 * fq) = pk4(acc[ai][bj][m][n]);
            }
        return false;
    }
};

struct EpiMerge {
    const unsigned char* G8; bf16* MB;
    __device__ __forceinline__ bool operator()(Acc& acc, const Unit& u, int wr, int wc, int fr_, int fq_) const {
        int fr = fr_, fq = fq_; asm volatile("" : "+v"(fr), "+v"(fq));
        const int kb = u.kb; const int c0 = u.pn * 256 + 32 * wc + 8 * fq;
#pragma unroll
        for (int ai = 0; ai < 2; ++ai)
#pragma unroll
            for (int m = 0; m < 4; ++m) {
                const size_t row = (size_t)u.pm * 256 + 128 * ai + 64 * wr + 16 * m + fr;
                const unsigned char* gp = G8 + row * 3072 + c0;
#pragma unroll
                for (int bj = 0; bj < 2; ++bj) {
                    if (kb < 2) { const u32x2 wa = *(const u32x2*)(gp + kb * 1024 + 128 * bj), wb = *(const u32x2*)(gp + (kb + 1) * 1024 + 128 * bj);
#pragma unroll
                        for (int n = 0; n < 2; ++n) { const f32x4 ga = uq8x4(n ? wa.y : wa.x), gb = uq8x4(n ? wb.y : wb.x);
                            f32x4 r; r[0] = ga[0] * __builtin_amdgcn_rcpf(gb[0]); r[1] = ga[1] * __builtin_amdgcn_rcpf(gb[1]); r[2] = ga[2] * __builtin_amdgcn_rcpf(gb[2]); r[3] = ga[3] * __builtin_amdgcn_rcpf(gb[3]); acc[ai][bj][m][n] *= r; } }
                    else { const u32x2 wc2 = *(const u32x2*)(gp + 2048 + 128 * bj);
                        const f32x4 g0 = uq8x4(wc2.x) * (1.0f / 255.0f), g1 = uq8x4(wc2.y) * (1.0f / 255.0f);
                        *(u32x4*)(MB + row * 1024 + c0 + 128 * bj) = pk8(acc[ai][bj][m][0] * g0, acc[ai][bj][m][1] * g1); }
                }
            }
        return kb < 2;
    }
};

struct EpiRes {
    const float *xin_lat, *xin_ctx; float *xout_lat, *xout_ctx; const float* gate;
    __device__ __forceinline__ bool operator()(Acc& acc, const Unit& u, int wr, int wc, int fr_, int fq_) const {
        int fr = fr_, fq = fq_; asm volatile("" : "+v"(fr), "+v"(fq));
        const RowInfo ri = row_info(u.pm); const int s = ri.ctx ? 8 : ri.b;
        const int c0 = u.pn * 256 + 32 * wc + 4 * fq;
        const float* xin = ri.ctx ? xin_ctx + (size_t)(u.pm - 64) * 256 * 1024 : xin_lat + (size_t)u.pm * 256 * 1024;
        float* xout = ri.ctx ? xout_ctx + (size_t)(u.pm - 64) * 256 * 1024 : xout_lat + (size_t)u.pm * 256 * 1024;
        f32x4 gv[2][2];
#pragma unroll
        for (int bj = 0; bj < 2; ++bj)
#pragma unroll
            for (int n = 0; n < 2; ++n) gv[bj][n] = *(const f32x4*)(gate + s * 6144 + c0 + 128 * bj + 16 * n);
#pragma unroll
        for (int ai = 0; ai < 2; ++ai)
#pragma unroll
            for (int m = 0; m < 4; ++m) {
                const size_t off = (size_t)(128 * ai + 64 * wr + 16 * m + fr) * 1024 + c0;
#pragma unroll
                for (int bj = 0; bj < 2; ++bj)
#pragma unroll
                    for (int n = 0; n < 2; ++n) { const f32x4 xi = *(const f32x4*)(xin + off + 128 * bj + 16 * n); *(f32x4*)(xout + off + 128 * bj + 16 * n) = xi + gv[bj][n] * acc[ai][bj][m][n]; }
                asm volatile("" ::: "memory");
            }
        return false;
    }
};

struct EpiSwiglu {
    bf16* ACT;
    __device__ __forceinline__ bool operator()(Acc& acc, const Unit& u, int wr, int wc, int fr_, int fq_) const {
        int fr = fr_, fq = fq_; asm volatile("" : "+v"(fr), "+v"(fq));
#pragma unroll
        for (int ai = 0; ai < 2; ++ai)
#pragma unroll
            for (int m = 0; m < 4; ++m) {
                const size_t row = (size_t)u.pm * 256 + 128 * ai + 64 * wr + 16 * m + fr;
                f32x4 o[2];
#pragma unroll
                for (int n = 0; n < 2; ++n) { const f32x4 gt = acc[ai][0][m][n], up = acc[ai][1][m][n];
                    o[n][0] = gt[0] * sigmoidf_(gt[0]) * up[0]; o[n][1] = gt[1] * sigmoidf_(gt[1]) * up[1]; o[n][2] = gt[2] * sigmoidf_(gt[2]) * up[2]; o[n][3] = gt[3] * sigmoidf_(gt[3]) * up[3]; }
                *(u32x4*)(ACT + row * FFH + u.pn * 128 + 32 * wc + 8 * fq) = pk8(o[0], o[1]);
            }
        return false;
    }
};

namespace att {
constexpr int KSLOT = 12288, VSLOT = 8192;
constexpr int L_K = 0, L_V = 2 * KSLOT, L_WS = L_V + 2 * VSLOT, L_OST = L_WS + NWAVES * 64 * 4, L_BYTES = L_OST + NWAVES * 4096;
__device__ __forceinline__ int crow(int r, int hi) { return (r & 3) + 8 * (r >> 2) + 4 * hi; }
__device__ __forceinline__ float max3f(float a, float b, float c) { return __builtin_fmaxf(__builtin_fmaxf(a, b), c); }
__device__ __forceinline__ float rowmax(const f32x16& p0, const f32x16& p1) {
    float a = max3f(p0[0], p0[1], p1[0]), b = max3f(p0[2], p0[3], p1[1]); a = max3f(a, p1[2], p1[3]);
#pragma unroll
    for (int r = 4; r < 16; r += 4) { a = max3f(a, p0[r], p0[r + 1]); b = max3f(b, p0[r + 2], p0[r + 3]); a = max3f(a, p1[r], p1[r + 1]); b = max3f(b, p1[r + 2], p1[r + 3]); }
    const float m = __builtin_fmaxf(a, b);
    auto rr = __builtin_amdgcn_permlane32_swap(__float_as_uint(m), __float_as_uint(m), false, false);
    return __builtin_fmaxf(__uint_as_float(rr[0]), __uint_as_float(rr[1]));
}
__device__ __forceinline__ void pv(f32x16* o, int vb, bf16x8 pa0, bf16x8 pa1, bf16x8 pa2, bf16x8 pa3) {
#pragma unroll
    for (int d0 = 0; d0 < 2; ++d0) { s16x4 lo[4], hi[4];
#pragma unroll
        for (int ks = 0; ks < 4; ++ks) {
            asm volatile("ds_read_b64_tr_b16 %0,%1 offset:%c2" : "=&v"(lo[ks]) : "v"(vb), "i"(d0 * 4096 + ks * 1024) : "memory");
            asm volatile("ds_read_b64_tr_b16 %0,%1 offset:%c2" : "=&v"(hi[ks]) : "v"(vb), "i"(d0 * 4096 + ks * 1024 + 512) : "memory"); }
        asm volatile("s_waitcnt lgkmcnt(0)" ::: "memory"); __builtin_amdgcn_sched_barrier(0);
#define PK(k) (bf16x8){lo[k][0], lo[k][1], lo[k][2], lo[k][3], hi[k][0], hi[k][1], hi[k][2], hi[k][3]}
        o[d0] = __builtin_amdgcn_mfma_f32_32x32x16_bf16(pa0, PK(0), o[d0], 0, 0, 0);
        o[d0] = __builtin_amdgcn_mfma_f32_32x32x16_bf16(pa1, PK(1), o[d0], 0, 0, 0);
        o[d0] = __builtin_amdgcn_mfma_f32_32x32x16_bf16(pa2, PK(2), o[d0], 0, 0, 0);
        o[d0] = __builtin_amdgcn_mfma_f32_32x32x16_bf16(pa3, PK(3), o[d0], 0, 0, 0);
#undef PK
    }
}
template <int DQK>
__device__ __forceinline__ void attn_unit(const bf16* Qn, int pqn, const bf16* Qr, int pqr, const bf16* Kh, int pk, const bf16* Vh, int pv_, bf16* O, int po, int NT, LAS unsigned char* shm) {
    constexpr int ND = DQK / 16, NCH = DQK / 8;
    int tid = threadIdx.x; asm volatile("" : "+v"(tid));
    const int lane = tid & 63, r32 = lane & 31, hi = lane >> 5; const int wid = __builtin_amdgcn_readfirstlane(tid >> 6);
    LAS float* wsf = (LAS float*)(shm + L_WS) + wid * 64;
    const bf16* ksrc = Kh + (size_t)lane * pk + wid * 8;
    const bf16* vsrc = Vh + (size_t)(16 * (wid & 3) + (lane >> 2)) * pv_ + (wid >> 2) * 32 + (lane & 3) * 8;
    const int vb0 = (int)(unsigned)(uintptr_t)(shm + L_V) + ((lane >> 4) & 1) * 32 + (lane & 3) * 8 + (4 * hi + ((lane & 15) >> 2)) * 64;
    const LAS unsigned char* kp0 = shm + L_K + hi * 1024 + r32 * 16;
#define DMA_TILE(t, buf) do { \
        __builtin_amdgcn_global_load_lds((const unsigned*)(ksrc + (size_t)(t) * 64 * pk), (LAS unsigned*)(shm + L_K + (buf) * KSLOT + wid * 1024), 16, 0, 0); \
        if (NCH > 8 && wid < NCH - 8) __builtin_amdgcn_global_load_lds((const unsigned*)(ksrc + (size_t)(t) * 64 * pk + 64), (LAS unsigned*)(shm + L_K + (buf) * KSLOT + (wid + 8) * 1024), 16, 0, 0); \
        __builtin_amdgcn_global_load_lds((const unsigned*)(vsrc + (size_t)(t) * 64 * pv_), (LAS unsigned*)(shm + L_V + (buf) * VSLOT + wid * 1024), 16, 0, 0); } while (0)
    DMA_TILE(0, 0);
    bf16x8 qr[ND];
#pragma unroll
    for (int d0 = 0; d0 < 4; ++d0) qr[d0] = *(const bf16x8*)(Qn + (size_t)(wid * 32 + r32) * pqn + d0 * 16 + hi * 8);
    if (ND > 4) {
#pragma unroll
        for (int d0 = 4; d0 < ND; ++d0) qr[d0] = *(const bf16x8*)(Qr + (size_t)(wid * 32 + r32) * pqr + (d0 - 4) * 16 + hi * 8);
    }
    float mrun = -1e30f, l_reg = 0.f; f32x16 o[2]; o[0] = f32x16{}; o[1] = f32x16{};
    for (int t = 0; t < NT; ++t) {
        const int buf = t & 1;
        asm volatile("s_waitcnt vmcnt(0)" ::: "memory");
        __syncthreads();
        if (t + 1 < NT) DMA_TILE(t + 1, buf ^ 1);
        f32x16 p0 = f32x16{}, p1 = f32x16{};
        const LAS unsigned char* kp = kp0 + buf * KSLOT;
#pragma unroll
        for (int d0 = 0; d0 < ND; ++d0) {
            const bf16x8 b0 = *(const LAS bf16x8*)(kp + d0 * 2048), b1 = *(const LAS bf16x8*)(kp + d0 * 2048 + 512);
            p0 = __builtin_amdgcn_mfma_f32_32x32x16_bf16(b0, qr[d0], p0, 0, 0, 0); p1 = __builtin_amdgcn_mfma_f32_32x32x16_bf16(b1, qr[d0], p1, 0, 0, 0);
        }
        const float rm = rowmax(p0, p1);
        if (__any(rm > mrun)) {
            const float mn = __builtin_fmaxf(mrun, rm), al = __builtin_amdgcn_exp2f(mrun - mn); mrun = mn; l_reg *= al;
            if (hi == 0) wsf[r32] = al;
            asm volatile("s_waitcnt lgkmcnt(0)" ::: "memory");
#pragma unroll
            for (int r = 0; r < 16; ++r) { const float f = wsf[crow(r, hi)]; o[0][r] *= f; o[1][r] *= f; }
        }
        float sacc = 0.f;
#pragma unroll
        for (int r = 0; r < 16; ++r) { p0[r] = __builtin_amdgcn_exp2f(p0[r] - mrun); p1[r] = __builtin_amdgcn_exp2f(p1[r] - mrun); sacc += p0[r] + p1[r]; }
        l_reg += sacc;
        u32x4 w0, w1, w2, w3;
        w0 = (u32x4){cvtpk(p0[0], p0[1]), cvtpk(p0[2], p0[3]), cvtpk(p0[4], p0[5]), cvtpk(p0[6], p0[7])};
        w1 = (u32x4){cvtpk(p0[8], p0[9]), cvtpk(p0[10], p0[11]), cvtpk(p0[12], p0[13]), cvtpk(p0[14], p0[15])};
        w2 = (u32x4){cvtpk(p1[0], p1[1]), cvtpk(p1[2], p1[3]), cvtpk(p1[4], p1[5]), cvtpk(p1[6], p1[7])};
        w3 = (u32x4){cvtpk(p1[8], p1[9]), cvtpk(p1[10], p1[11]), cvtpk(p1[12], p1[13]), cvtpk(p1[14], p1[15])};
        pv(o, vb0 + buf * VSLOT, __builtin_bit_cast(bf16x8, w0), __builtin_bit_cast(bf16x8, w1), __builtin_bit_cast(bf16x8, w2), __builtin_bit_cast(bf16x8, w3));
    }
#undef DMA_TILE
    { auto rr = __builtin_amdgcn_permlane32_swap(__float_as_uint(l_reg), __float_as_uint(l_reg), false, false); l_reg = __uint_as_float(rr[0]) + __uint_as_float(rr[1]); }
    if (hi == 0) wsf[32 + r32] = l_reg;
    asm volatile("s_waitcnt lgkmcnt(0)" ::: "memory");
    float rli[16];
#pragma unroll
    for (int r = 0; r < 16; ++r) rli[r] = __builtin_amdgcn_rcpf(wsf[32 + crow(r, hi)]);
    LAS bf16* stg = (LAS bf16*)(shm + L_OST) + wid * 2048;
#pragma unroll
    for (int r = 0; r < 16; ++r) { const int orow = crow(r, hi);
#pragma unroll
        for (int d0 = 0; d0 < 2; ++d0) stg[orow * 64 + d0 * 32 + r32] = (bf16)(cvtpk(o[d0][r] * rli[r], 0.f) & 0xffffu); }
    asm volatile("s_waitcnt lgkmcnt(0)" ::: "memory");
    bf16* Ow = O + (size_t)(wid * 32) * po;
#pragma unroll
    for (int i = 0; i < 4; ++i) { const int row = i * 8 + (lane >> 3), ch = lane & 7; const u32x4 v = *(const LAS u32x4*)(stg + row * 64 + ch * 8); *(u32x4*)(Ow + (size_t)row * po + ch * 8) = v; }
    asm volatile("s_waitcnt lgkmcnt(0)" ::: "memory");
    __syncthreads();
}
}


namespace attq {
using att::crow;
constexpr int NSLOT = 3;
#define SBAR() __builtin_amdgcn_sched_barrier(0)
__device__ __forceinline__ void glds16(const void* gsrc, unsigned lds_dst) { unsigned keep;
    asm volatile("s_mov_b32 %0, m0\n\ts_mov_b32 m0, %2\n\ts_nop 0\n\tglobal_load_lds_dwordx4 %1, off\n\ts_mov_b32 m0, %0" : "=&s"(keep) : "v"(gsrc), "s"(lds_dst) : "memory"); }
__device__ __forceinline__ float max3f(float a, float b, float c) { float r; asm("v_max3_f32 %0, %1, %2, %3" : "=v"(r) : "v"(a), "v"(b), "v"(c)); return r; }
__device__ __forceinline__ float max2f(float a, float b) { float r; asm("v_max_f32_e32 %0, %1, %2" : "=v"(r) : "v"(a), "v"(b)); return r; }
__device__ __forceinline__ float fadd_s(float a, float b) { float r; asm("v_add_f32_e32 %0, %1, %2" : "=v"(r) : "v"(a), "v"(b)); return r; }
__device__ __forceinline__ float fsub_s(float a, float b) { float r; asm("v_sub_f32_e32 %0, %1, %2" : "=v"(r) : "v"(a), "v"(b)); return r; }
template <int N> __device__ __forceinline__ void wait_bar() { asm volatile("s_waitcnt vmcnt(%0) lgkmcnt(0)\n\ts_barrier" :: "n"(N) : "memory"); }
#define WAIT_BAR(N) wait_bar<(N)>()
template <int ND> __device__ __forceinline__ void qkt(f32x16& p0, f32x16& p1, const char* Kslot, const bf16x8* qr, const f32x16& negm, int r32, int hi) {
    const char* kb = Kslot + hi * 1024 + r32 * 16;
#pragma unroll
    for (int d0 = 0; d0 < ND; ++d0) {
        const bf16x8 b0 = *reinterpret_cast<const bf16x8*>(kb + d0 * 2048);
        const bf16x8 b1 = *reinterpret_cast<const bf16x8*>(kb + d0 * 2048 + 512);
        if (d0 == 0) { p0 = __builtin_amdgcn_mfma_f32_32x32x16_bf16(b0, qr[0], negm, 0, 0, 0); p1 = __builtin_amdgcn_mfma_f32_32x32x16_bf16(b1, qr[0], negm, 0, 0, 0); }
        else { p0 = __builtin_amdgcn_mfma_f32_32x32x16_bf16(b0, qr[d0], p0, 0, 0, 0); p1 = __builtin_amdgcn_mfma_f32_32x32x16_bf16(b1, qr[d0], p1, 0, 0, 0); } }
}
typedef __attribute__((address_space(3))) const char* lds_cptr;
typedef short v4i16_t __attribute__((ext_vector_type(4)));
template <int ND> __device__ __forceinline__ void kloadall(bf16x8* kf, lds_cptr kp) {
    kf[0] = *(const LAS bf16x8*)(kp);        kf[1] = *(const LAS bf16x8*)(kp + 512);
    kf[2] = *(const LAS bf16x8*)(kp + 2048); kf[3] = *(const LAS bf16x8*)(kp + 2560);
    kf[4] = *(const LAS bf16x8*)(kp + 4096); kf[5] = *(const LAS bf16x8*)(kp + 4608);
    kf[6] = *(const LAS bf16x8*)(kp + 6144); kf[7] = *(const LAS bf16x8*)(kp + 6656);
    if constexpr (ND == 6) { kf[8] = *(const LAS bf16x8*)(kp + 8192); kf[9] = *(const LAS bf16x8*)(kp + 8704); kf[10] = *(const LAS bf16x8*)(kp + 10240); kf[11] = *(const LAS bf16x8*)(kp + 10752); }
}
__device__ __forceinline__ void kload2(bf16x8* kf, lds_cptr kp, int j) { kf[2 * j] = *(const LAS bf16x8*)(kp + j * 2048); kf[2 * j + 1] = *(const LAS bf16x8*)(kp + j * 2048 + 512); }
__device__ __forceinline__ s16x4 vtr(lds_cptr p) { return __builtin_bit_cast(s16x4, __builtin_amdgcn_ds_read_tr16_b64_v4i16((LAS v4i16_t*)p)); }
__device__ __forceinline__ float rowmax(const f32x16& p0, const f32x16& p1) {
    float a = max3f(p0[0], p0[1], p1[0]), b = max3f(p0[2], p0[3], p1[1]); a = max3f(a, p1[2], p1[3]);
#pragma unroll
    for (int r = 4; r < 16; r += 4) { a = max3f(a, p0[r], p0[r + 1]); b = max3f(b, p0[r + 2], p0[r + 3]); a = max3f(a, p1[r], p1[r + 1]); b = max3f(b, p1[r + 2], p1[r + 3]); }
    const float m = max2f(a, b);
    auto rr = __builtin_amdgcn_permlane32_swap(__float_as_uint(m), __float_as_uint(m), false, false);
    return max2f(__uint_as_float(rr[0]), __uint_as_float(rr[1]));
}
template <int ND, int THRL>
__device__ __forceinline__ void attn_unit(const bf16* Q, int pq, const bf16* Qr, int pqr, const bf16* __restrict__ Kh, int pk, const bf16* __restrict__ Vh, int pkv, bf16* O, int po, int NT, char* shm) {
    constexpr int SLOTB = (ND == 6) ? 12288 : 8192, KD = (ND == 6) ? 2 : 1;
    constexpr int LDS_K = 0, LDS_V = NSLOT * SLOTB, LDS_WS = 2 * NSLOT * SLOTB, LDS_OST = LDS_WS + NWAVES * 64 * 4;
    int tid = threadIdx.x; asm volatile("" : "+v"(tid));
    const int lane = tid & 63, r32 = lane & 31, hi = lane >> 5; const int wid = __builtin_amdgcn_readfirstlane(tid >> 6);
    const bf16* Qw = Q + (size_t)(wid * 32) * pq;
    const unsigned lds0 = (unsigned)(uintptr_t)shm;
    float* wsf = (float*)(shm + LDS_WS) + wid * 64;
    const bf16* ksrc = Kh + (size_t)lane * pk + wid * 8;
    const bf16* ksrc2 = Kh + (size_t)lane * pk + (8 + (wid & 3)) * 8;
    const unsigned kdst2 = lds0 + LDS_K + (8 + (wid & 3)) * 1024; (void)ksrc2; (void)kdst2;
    const bf16* vsrc = Vh + (size_t)(16 * (wid & 3) + (lane >> 2)) * pkv + (wid >> 2) * 32 + (lane & 3) * 8;
    const unsigned kdst = lds0 + LDS_K + wid * 1024, vdst = lds0 + LDS_V + wid * 1024;
#define DMA_K(t, slot) do { glds16(ksrc + (size_t)(t) * 64 * pk, (unsigned)__builtin_amdgcn_readfirstlane(kdst + (slot))); if constexpr (ND == 6) glds16(ksrc2 + (size_t)(t) * 64 * pk, (unsigned)__builtin_amdgcn_readfirstlane(kdst2 + (slot))); } while (0)
#define DMA_V(t, slot) glds16(vsrc + (size_t)(t) * 64 * pkv, (unsigned)__builtin_amdgcn_readfirstlane(vdst + (slot)))
    const int vb0 = (int)(lds0 + LDS_V) + ((lane >> 4) & 1) * 32 + (lane & 3) * 8 + (4 * hi + ((lane & 15) >> 2)) * 64;
    const char* Kbase = shm + LDS_K; bf16x8 kf[2 * ND];
    const lds_cptr shm3 = (lds_cptr)shm; const lds_cptr kp0 = shm3 + LDS_K + hi * 1024 + r32 * 16; const lds_cptr vp0 = shm3 + LDS_V + ((lane >> 4) & 1) * 32 + (lane & 3) * 8 + (4 * hi + ((lane & 15) >> 2)) * 64;
    DMA_K(0, 0); DMA_V(0, 0); DMA_K(1, SLOTB);
    bf16x8 qr[ND];
#pragma unroll
    for (int d0 = 0; d0 < 4; ++d0) qr[d0] = *reinterpret_cast<const bf16x8*>(&Qw[(size_t)r32 * pq + d0 * 16 + hi * 8]);
    if constexpr (ND == 6) {
#pragma unroll
        for (int d0 = 4; d0 < 6; ++d0) qr[d0] = *reinterpret_cast<const bf16x8*>(&Qr[(size_t)(wid * 32 + r32) * pqr + (d0 - 4) * 16 + hi * 8]); }
    float mhat = 0.f, l_reg = 0.f; f32x16 o[2]; o[0] = f32x16{}; o[1] = f32x16{}; f32x16 negm = f32x16{}; asm volatile("" : "+v"(negm));
    bool resc = false;
#define START(P0, P1) do { const float rm = rowmax(P0, P1); resc = false; \
    { const float dl = rm; mhat = fadd_s(mhat, dl); \
      _Pragma("unroll") for (int r = 0; r < 16; ++r) { P0[r] = fsub_s(P0[r], dl); P1[r] = fsub_s(P1[r], dl); } \
      _Pragma("unroll") for (int r = 0; r < 16; ++r) negm[r] = -mhat; asm volatile("" : "+v"(negm)); } \
    _Pragma("unroll") for (int r = 0; r < 16; ++r) P0[r] = __builtin_amdgcn_exp2f(P0[r]); } while (0)
#define RESC() do { if (resc) { asm volatile("s_waitcnt lgkmcnt(0)" ::: "memory"); \
      _Pragma("unroll") for (int d_ = 0; d_ < 2; ++d_) _Pragma("unroll") for (int r = 0; r < 16; ++r) o[d_][r] *= wsf[crow(r, hi)]; } } while (0)
    f32x16 pA0, pA1, pB0, pB1;
    int sl_prev = 0, sl_cur = 0, sl_next = SLOTB;
#define ROT() do { sl_prev = sl_cur; sl_cur = sl_next; sl_next = (sl_next == (NSLOT - 1) * SLOTB) ? 0 : sl_next + SLOTB; } while (0)
    DMA_K(2, 2 * SLOTB);
    WAIT_BAR(1 + 2 * KD);
    qkt<ND>(pA0, pA1, Kbase, qr, negm, r32, hi); asm volatile("s_nop 15\n\ts_nop 7" : "+v"(pA0), "+v"(pA1));
    START(pA0, pA1);
    _Pragma("unroll") for (int r = 0; r < 16; ++r) pA1[r] = __builtin_amdgcn_exp2f(pA1[r]);
    WAIT_BAR(0);
    DMA_K(3, 0); DMA_V(1, SLOTB);
    ROT();
    kloadall<ND>(kf, kp0 + sl_cur);
    WAIT_BAR(KD + 1);
    s16x4 vlo[8], vhi[8]; u32x4 pw0, pw1, pw2, pw3;
#define PKW(P, B) cvtpk(P[B], P[B + 1])
#define PAF(k) __builtin_bit_cast(bf16x8, pw##k)
#define VFR(i) (bf16x8){vlo[i][0], vlo[i][1], vlo[i][2], vlo[i][3], vhi[i][0], vhi[i][1], vhi[i][2], vhi[i][3]}
#define PIN(x) asm volatile("" : "+v"(x))
#define MX3(a, b, c) __builtin_fmaxf(__builtin_fmaxf((a), (b)), (c))
#define GAPA(MF, A0, A1, A2, A3, W0, W1, PW) do { MF; sacc += A0; sacc += A1; sacc += A2; sacc += A3; PIN(sacc); W0; W1; PIN(PW); SBAR(); } while (0)
#define EX(v) __builtin_amdgcn_exp2f(v)
#define GAPB(MF, X, B) do { MF; X[B] = EX(X[B]); X[B + 1] = EX(X[B + 1]); X[B + 2] = EX(X[B + 2]); X[B + 3] = EX(X[B + 3]); PIN(X); SBAR(); } while (0)
#define VRD(i) do { vlo[i] = vtr(vp_ + (((i) >> 2) * 4096 + ((i) & 3) * 1024)); vhi[i] = vtr(vp_ + (((i) >> 2) * 4096 + ((i) & 3) * 1024 + 512)); } while (0)
#define KRD(G, j) do { if (G) { kload2(kf, kp0 + sl_next, j); SBAR(); } } while (0)
#define STEP(C0, C1, P0, P1, t, GK, GV, GL) do { SBAR(); \
    const lds_cptr vp_ = vp0 + sl_prev; \
    VRD(0); SBAR(); float sacc = (P0[0] + P0[1]); \
    GAPA(C0 = __builtin_amdgcn_mfma_f32_32x32x16_bf16(kf[0], qr[0], negm, 0, 0, 0), P0[2], P0[3], P0[4], P0[5],     pw0[0] = PKW(P0, 0), pw0[1] = PKW(P0, 2), pw0); \
    VRD(4); SBAR(); GAPA(C1 = __builtin_amdgcn_mfma_f32_32x32x16_bf16(kf[1], qr[0], negm, 0, 0, 0), P0[6], P0[7], P0[8], P0[9],     pw0[2] = PKW(P0, 4), pw0[3] = PKW(P0, 6), pw0); \
    VRD(1); SBAR(); GAPA(C0 = __builtin_amdgcn_mfma_f32_32x32x16_bf16(kf[2], qr[1], C0, 0, 0, 0),   P0[10], P0[11], P0[12], P0[13], pw1[0] = PKW(P0, 8), pw1[1] = PKW(P0, 10), pw1); \
    VRD(5); SBAR(); GAPA(C1 = __builtin_amdgcn_mfma_f32_32x32x16_bf16(kf[3], qr[1], C1, 0, 0, 0),   P0[14], P0[15], P1[0], P1[1],   pw1[2] = PKW(P0, 12), pw1[3] = PKW(P0, 14), pw1); \
    VRD(2); SBAR(); GAPA(C0 = __builtin_amdgcn_mfma_f32_32x32x16_bf16(kf[4], qr[2], C0, 0, 0, 0),   P1[2], P1[3], P1[4], P1[5],     pw2[0] = PKW(P1, 0), pw2[1] = PKW(P1, 2), pw2); \
    VRD(6); SBAR(); GAPA(C1 = __builtin_amdgcn_mfma_f32_32x32x16_bf16(kf[5], qr[2], C1, 0, 0, 0),   P1[6], P1[7], P1[8], P1[9],     pw2[2] = PKW(P1, 4), pw2[3] = PKW(P1, 6), pw2); \
    VRD(3); SBAR(); GAPA(C0 = __builtin_amdgcn_mfma_f32_32x32x16_bf16(kf[6], qr[3], C0, 0, 0, 0),   P1[10], P1[11], P1[12], P1[13], pw3[0] = PKW(P1, 8), pw3[1] = PKW(P1, 10), pw3); \
    VRD(7); SBAR(); GAPA(C1 = __builtin_amdgcn_mfma_f32_32x32x16_bf16(kf[7], qr[3], C1, 0, 0, 0),   P1[14], P1[15], 0.f, 0.f,       pw3[2] = PKW(P1, 12), pw3[3] = PKW(P1, 14), pw3); \
    if constexpr (ND == 6) { C0 = __builtin_amdgcn_mfma_f32_32x32x16_bf16(kf[8], qr[4], C0, 0, 0, 0); SBAR(); C1 = __builtin_amdgcn_mfma_f32_32x32x16_bf16(kf[9], qr[4], C1, 0, 0, 0); SBAR(); \
      C0 = __builtin_amdgcn_mfma_f32_32x32x16_bf16(kf[10], qr[5], C0, 0, 0, 0); SBAR(); C1 = __builtin_amdgcn_mfma_f32_32x32x16_bf16(kf[11], qr[5], C1, 0, 0, 0); SBAR(); } \
    l_reg += sacc; \
    if (GK) { DMA_K((t) + 3, sl_cur); } if (GV) { DMA_V((t) + 1, sl_next); } \
    { float a = MX3(C0[0], C0[1], C1[0]), b = MX3(C0[2], C0[3], C1[1]); a = MX3(a, C1[2], C1[3]); \
      _Pragma("unroll") for (int r = 4; r < 16; r += 4) { a = MX3(a, C0[r], C0[r + 1]); b = MX3(b, C0[r + 2], C0[r + 3]); a = MX3(a, C1[r], C1[r + 1]); b = MX3(b, C1[r + 2], C1[r + 3]); } \
      float rm = __builtin_fmaxf(a, b); { auto rr = __builtin_amdgcn_permlane32_swap(__float_as_uint(rm), __float_as_uint(rm), false, false); rm = __builtin_fmaxf(__uint_as_float(rr[0]), __uint_as_float(rr[1])); } \
      resc = false; \
      if (__builtin_expect(__any(rm > (float)THRL), 0)) { const float dl = __builtin_fmaxf(rm, 0.f); mhat += dl; \
        _Pragma("unroll") for (int r = 0; r < 16; ++r) { C0[r] -= dl; C1[r] -= dl; } \
        _Pragma("unroll") for (int r = 0; r < 16; ++r) negm[r] = -mhat; asm volatile("" : "+v"(negm)); \
        const float f = __builtin_amdgcn_exp2f(-dl); l_reg *= f; if (hi == 0) wsf[r32] = f; resc = true; } } \
    SBAR(); \
    GAPB(o[0] = __builtin_amdgcn_mfma_f32_32x32x16_bf16(PAF(0), VFR(0), o[0], 0, 0, 0), C0, 0); \
    GAPB(o[1] = __builtin_amdgcn_mfma_f32_32x32x16_bf16(PAF(0), VFR(4), o[1], 0, 0, 0), C0, 4); \
    KRD(GL, 0); GAPB(o[0] = __builtin_amdgcn_mfma_f32_32x32x16_bf16(PAF(1), VFR(1), o[0], 0, 0, 0), C0, 8); \
    KRD(GL, 1); GAPB(o[1] = __builtin_amdgcn_mfma_f32_32x32x16_bf16(PAF(1), VFR(5), o[1], 0, 0, 0), C0, 12); \
    KRD(GL, 2); GAPB(o[0] = __builtin_amdgcn_mfma_f32_32x32x16_bf16(PAF(2), VFR(2), o[0], 0, 0, 0), C1, 0); \
    KRD(GL, 3); GAPB(o[1] = __builtin_amdgcn_mfma_f32_32x32x16_bf16(PAF(2), VFR(6), o[1], 0, 0, 0), C1, 4); \
    if constexpr (ND == 6) { KRD(GL, 4); } GAPB(o[0] = __builtin_amdgcn_mfma_f32_32x32x16_bf16(PAF(3), VFR(3), o[0], 0, 0, 0), C1, 8); \
    if constexpr (ND == 6) { KRD(GL, 5); } GAPB(o[1] = __builtin_amdgcn_mfma_f32_32x32x16_bf16(PAF(3), VFR(7), o[1], 0, 0, 0), C1, 12); \
    } while (0)
    int t = 1;
    for (; t + 5 < NT; t += 2) {
        STEP(pB0, pB1, pA0, pA1, t, true, true, true);     WAIT_BAR(KD + 1); RESC(); ROT();
        STEP(pA0, pA1, pB0, pB1, t + 1, true, true, true); WAIT_BAR(KD + 1); RESC(); ROT();
    }
#define ENDW(tt) do { if ((tt) + 3 < NT) { WAIT_BAR(KD + 1); } else if ((tt) + 2 < NT) { WAIT_BAR(1); } else { WAIT_BAR(0); } } while (0)
    for (; t + 1 < NT; t += 2) {
        STEP(pB0, pB1, pA0, pA1, t, (t + 3 < NT), (t + 1 < NT), (t + 1 < NT));     ENDW(t);     RESC(); ROT();
        STEP(pA0, pA1, pB0, pB1, t + 1, (t + 4 < NT), (t + 2 < NT), (t + 2 < NT)); ENDW(t + 1); RESC(); ROT();
    }
    STEP(pB0, pB1, pA0, pA1, NT - 1, false, false, false); RESC();
    { float sacc = pB0[0] + pB0[1]; _Pragma("unroll") for (int r = 2; r < 16; ++r) sacc += pB0[r]; _Pragma("unroll") for (int r = 0; r < 16; ++r) sacc += pB1[r]; l_reg += sacc;
      pw0 = (u32x4){PKW(pB0, 0), PKW(pB0, 2), PKW(pB0, 4), PKW(pB0, 6)}; pw1 = (u32x4){PKW(pB0, 8), PKW(pB0, 10), PKW(pB0, 12), PKW(pB0, 14)}; pw2 = (u32x4){PKW(pB1, 0), PKW(pB1, 2), PKW(pB1, 4), PKW(pB1, 6)}; pw3 = (u32x4){PKW(pB1, 8), PKW(pB1, 10), PKW(pB1, 12), PKW(pB1, 14)};
      SBAR(); att::pv(o, vb0 + sl_cur, PAF(0), PAF(1), PAF(2), PAF(3)); }
#undef PKW
#undef PAF
#undef VFR
#undef PIN
#undef MX3
#undef GAPA
#undef GAPB
#undef EX
#undef VRD
#undef KRD
#undef STEP
#undef ENDW
    { auto rr = __builtin_amdgcn_permlane32_swap(__float_as_uint(l_reg), __float_as_uint(l_reg), false, false); l_reg = __uint_as_float(rr[0]) + __uint_as_float(rr[1]); }
    if (hi == 0) wsf[32 + r32] = l_reg; asm volatile("s_waitcnt lgkmcnt(0)" ::: "memory");
    float rli[16];
#pragma unroll
    for (int r = 0; r < 16; ++r) rli[r] = __builtin_amdgcn_rcpf(wsf[32 + crow(r, hi)]);
    bf16* Ow = O + (size_t)(wid * 32) * po;
    { bf16* stg = (bf16*)(shm + LDS_OST) + wid * 2048;
#pragma unroll
      for (int r = 0; r < 16; ++r) { const int orow = crow(r, hi);
#pragma unroll
        for (int d0 = 0; d0 < 2; ++d0) stg[orow * 64 + d0 * 32 + r32] = (bf16)(cvtpk(o[d0][r] * rli[r], 0.f) & 0xffffu); }
      asm volatile("s_waitcnt lgkmcnt(0)" ::: "memory");
#pragma unroll
      for (int i = 0; i < 4; ++i) { const int row = i * 8 + (lane >> 3), ch = lane & 7; const u32x4 v = *(const u32x4*)(stg + row * 64 + ch * 8); *(u32x4*)(Ow + (size_t)row * po + ch * 8) = v; } }
    asm volatile("s_waitcnt lgkmcnt(0)\n\ts_barrier" ::: "memory");
#undef DMA_K
#undef DMA_V
#undef START
#undef RESC
#undef ROT
}
#undef SBAR
#undef WAIT_BAR
}

#define RLX_AGENT __ATOMIC_RELAXED, __HIP_MEMORY_SCOPE_AGENT
#define XB_TMO      128
#define XB_XCNT(j)  (256  + 64 * (j))
#define XB_XSUB(j)  (1280 + 64 * (j))
#define XB_XGEN(j)  (2304 + 64 * (j))
#define XB_TOP      3328
#define XB_TOPGEN   3392
#define XCD_BAR_WORDS 3456
#define XB_SPIN_CAP (1u << 18)
__device__ __forceinline__ unsigned xb_ld(unsigned* p)              { return __hip_atomic_load(p, __ATOMIC_RELAXED, __HIP_MEMORY_SCOPE_AGENT); }
__device__ __forceinline__ unsigned xb_add(unsigned* p, unsigned v) { return __hip_atomic_fetch_add(p, v, __ATOMIC_RELAXED, __HIP_MEMORY_SCOPE_AGENT); }
__device__ __forceinline__ unsigned xb_xcc_id() { return (unsigned)__builtin_amdgcn_s_getreg((3 << 11) | 20) & 0xFu; }
#define XB_SPIN(cond, bar) do { unsigned _sp = 0; while (cond) { __builtin_amdgcn_s_sleep(1); \
    if ((++_sp & 255u) == 0u) { if (xb_ld(&(bar)[XB_TMO])) break; if (_sp > XB_SPIN_CAP) { atomicAdd(&(bar)[XB_TMO], 1u); break; } } } } while (0)
struct XcdBarrier { unsigned* bar; unsigned x; volatile LAS unsigned* st; };
__device__ __forceinline__ XcdBarrier xcd_barrier_post(unsigned* bar, volatile LAS unsigned* st) {
    XcdBarrier b; b.bar = bar; b.x = xb_xcc_id(); b.st = st;
    if (threadIdx.x == 0) (void)xb_add(&bar[XB_XCNT(b.x)], 1u);
    return b;
}
__device__ __forceinline__ void xcd_barrier_complete(unsigned* bar, unsigned x, unsigned& nloc, unsigned& nx) {
    const unsigned G = gridDim.x * gridDim.y * gridDim.z;
    unsigned sum, cnt, mine, sp = 0u;
    for (;;) {
        sum = 0u; cnt = 0u; mine = 0u;
#pragma unroll
        for (unsigned j = 0; j < 16; ++j) { const unsigned c = xb_ld(&bar[XB_XCNT(j)]); sum += c; cnt += (c > 0u) ? 1u : 0u; mine = (j == x) ? c : mine; }
        if (sum == G) break;
        __builtin_amdgcn_s_sleep(1);
        if ((++sp & 255u) == 0u) { if (xb_ld(&bar[XB_TMO])) break; if (sp > XB_SPIN_CAP) { atomicAdd(&bar[XB_TMO], 1u); break; } }
    }
    nloc = mine > 0u ? mine : 1u; nx = cnt > 0u ? cnt : 1u;
}
__device__ __forceinline__ void xcd_barrier(const XcdBarrier& b) {
    asm volatile("s_waitcnt vmcnt(0)" ::: "memory");
    __syncthreads();
    if (threadIdx.x == 0) {
        unsigned* bar = b.bar;
        __builtin_amdgcn_s_waitcnt(0);
        unsigned nloc = b.st[0], nx = b.st[1];
        if (nloc == 0u) { xcd_barrier_complete(bar, b.x, nloc, nx); b.st[0] = nloc; b.st[1] = nx; }
        const unsigned old = xb_add(&bar[XB_XSUB(b.x)], 1u);
        const unsigned gen = old / nloc;
        if (old + 1u == (gen + 1u) * nloc) {
            __builtin_amdgcn_fence(__ATOMIC_RELEASE, "agent");
            asm volatile("s_waitcnt vmcnt(0)" ::: "memory");
            const unsigned og = xb_add(&bar[XB_TOP], 1u);
            const unsigned tg = og / nx;
            if (og + 1u == (tg + 1u) * nx) xb_add(&bar[XB_TOPGEN], 1u);
            else XB_SPIN(xb_ld(&bar[XB_TOPGEN]) == tg, bar);
            __builtin_amdgcn_fence(__ATOMIC_ACQUIRE, "agent");
            xb_add(&bar[XB_XGEN(b.x)], 1u);
            asm volatile("s_waitcnt vmcnt(0)" ::: "memory");
        } else {
            XB_SPIN(xb_ld(&bar[XB_XGEN(b.x)]) == gen, bar);
            __builtin_amdgcn_fence(__ATOMIC_ACQUIRE, "agent");
            asm volatile("s_waitcnt vmcnt(0)" ::: "memory");
        }
    }
    __syncthreads();
}
constexpr int LDS_MISC = 131072 + 1024;
constexpr size_t CTL_ZERO_BYTES = 64 * KiB;

struct Args { const float* in[26]; float* out; unsigned char* ws; int ph_lo, ph_hi; };
constexpr int LDS_BYTES = 147456;
constexpr int NPHASE = 21;

typedef const __attribute__((address_space(4))) unsigned char* KP;
__device__ __forceinline__ const float* kin(KP kp, int k) { return *(const float* const __attribute__((address_space(4)))*)(kp + 8 * k); }
__device__ __forceinline__ float* kout(KP kp) { return *(float* const __attribute__((address_space(4)))*)(kp + 208); }
__device__ __forceinline__ unsigned char* kws(KP kp) { return *(unsigned char* const __attribute__((address_space(4)))*)(kp + 216); }
static_assert(sizeof(Args) == 232, "Args layout");
struct Ctx {
    LAS unsigned char* lds; int tid, lane, wave, vcu, G; unsigned char* ws; int cv_rank, cv_n;
};

enum MatId { M_WIN = 0, M_WUQ, M_WUKV, M_NAT, M_FFI, M_NATP };
__device__ __forceinline__ int rope_perm(int p) { const int n = p >> 4, fq = (p >> 2) & 3, j = p & 3; return 16 * (fq >> 1) + 8 * n + 4 * (fq & 1) + j; }
__device__ __forceinline__ int head_perm(int pc, int& wc) { wc = (pc >> 5) & 3; return 32 * (pc >> 7) + (pc & 31); }
__device__ __forceinline__ int pg32(int x) { const int p = x & 31; return (x & ~31) | (8 * ((p >> 2) & 3) + 4 * (p >> 4) + (p & 3)); }
__device__ __forceinline__ int src_col(int mat, int n) {
    const int t = n >> 8, pc = n & 255; int wc;
    switch (mat) {
    case M_WIN:
        if (t < 2) { const int d = head_perm(pc, wc); return (4 * t + wc) * 64 + d; }
        if (t == 2) { const int d = head_perm(pc, wc); return wc < 2 ? 512 + wc * 64 + d : 640 + (wc - 2) * 64 + d; }
        if (t == 3) return 768 + pg32(pc);
        if (t == 4) { if (pc < 128) return 768 + 256 + pg32(pc); if (pc < 160) return 1408 + rope_perm(pc - 128); return -1; }
        if (t == 5) return 1152 + pg32(pc);
        if (t < 8) return 1440 + (t - 6) * 256 + pg32(pc);
        return 1952 + (t - 8) * 256 + pg32(pc);
    case M_WUQ:
        if (t < 2) { const int d = head_perm(pc, wc); return (4 * t + wc) * 96 + d; }
        { const int bj = pc >> 7, w2 = (pc >> 5) & 3; return (4 * bj + w2) * 96 + 64 + rope_perm(pc & 31); }
    case M_WUKV:
        { const int d = head_perm(pc, wc); return t < 2 ? (4 * t + wc) * 128 + d : (4 * (t - 2) + wc) * 128 + 64 + d; }
    case M_FFI:
        return pc < 128 ? t * 128 + pg32(pc) : FFH + t * 128 + pg32(pc - 128);
    case M_NATP: return pg32(n);
    default: return n;
    }
}
__device__ __forceinline__ void xpose_item(const float* W, int ldw, const float* kscale, bf16* WT, int ldo, int kcol0, int mat, int nblk, int item, LAS float* scr, int lane) {
    const int kb = item / nblk, nb = item % nblk, k0 = 64 * kb, n0 = 32 * nb;
    const int sc = src_col(mat, n0 + (lane & 31));
#pragma unroll 8
    for (int i = 0; i < 32; ++i) { const int kk = 2 * i + (lane >> 5); float v = 0.f; if (sc >= 0) { v = W[(size_t)(k0 + kk) * ldw + sc]; if (kscale) v *= kscale[k0 + kk]; } scr[kk * 33 + (lane & 31)] = v; }
    asm volatile("s_waitcnt lgkmcnt(0)" ::: "memory");
    const int c = lane & 7;
#pragma unroll
    for (int j = 0; j < 4; ++j) { const int n = (lane >> 3) + 8 * j; const LAS float* s = scr + (8 * c) * 33 + n;
        u32x4 o; o.x = cvtpk(s[0 * 33], s[1 * 33]); o.y = cvtpk(s[2 * 33], s[3 * 33]); o.z = cvtpk(s[4 * 33], s[5 * 33]); o.w = cvtpk(s[6 * 33], s[7 * 33]);
        *(u32x4*)(WT + (size_t)(n0 + n) * ldo + kcol0 + k0 + 8 * c) = o; }
    asm volatile("s_waitcnt lgkmcnt(0)" ::: "memory");
}
__device__ __forceinline__ void run_xjob(const Ctx& F, int& base, const float* W, int ldw, const float* kscale, bf16* WT, int ldo, int kcol0, int mat, int K, int N) {
    LAS float* scr = (LAS float*)(F.lds + F.wave * 16384);
    const int gw = F.cv_rank * NWAVES + F.wave, NGW = F.cv_n * NWAVES;
    const int nblk = N / 32, nit = (K / 64) * nblk;
    int first = gw - (base % NGW); if (first < 0) first += NGW;
    for (int it = first; it < nit; it += NGW) xpose_item(W, ldw, kscale, WT, ldo, kcol0, mat, nblk, it, scr, F.lane);
    base += nit;
}

__device__ __forceinline__ void norm_pass(const Ctx& F, const float* x_lat, const float* x_ctx, bf16* HB, const float* gnorm, const float* mod_l, int shift_off, int nrows) {
    const int gw = F.vcu * NWAVES + F.wave, NGW = F.G * NWAVES;
    const int per = (nrows + NGW - 1) / NGW; const int r0 = gw * per, r1 = min(nrows, r0 + per);
    int cur_s = -1; f32x4 ca[4], cb[4];
    for (int r = r0; r < r1; ++r) {
        const bool ctx = r >= ML; const int s = ctx ? 8 : r >> 11;
        if (s != cur_s) { cur_s = s; const float* sh = mod_l + s * 6144 + shift_off; const float* scl = sh + 1024;
#pragma unroll
            for (int j = 0; j < 4; ++j) { const f32x4 g = *(const f32x4*)(gnorm + 256 * j + 4 * F.lane); const f32x4 sc1 = *(const f32x4*)(scl + 256 * j + 4 * F.lane); ca[j] = g * (sc1 + 1.0f); cb[j] = *(const f32x4*)(sh + 256 * j + 4 * F.lane); } }
        const float* xr = ctx ? x_ctx + (size_t)(r - ML) * 1024 : x_lat + (size_t)r * 1024;
        f32x4 v[4]; float ss = 0.f;
#pragma unroll
        for (int j = 0; j < 4; ++j) { v[j] = *(const f32x4*)(xr + 256 * j + 4 * F.lane); ss += (v[j][0] * v[j][0] + v[j][1] * v[j][1]) + (v[j][2] * v[j][2] + v[j][3] * v[j][3]); }
        const float rstd = rsqrtf(wave_sum(ss) * (1.0f / 1024.0f) + EPS);
#pragma unroll
        for (int j = 0; j < 4; ++j) *(u32x2*)(HB + (size_t)r * 1024 + 256 * j + 4 * F.lane) = pk4(v[j] * rstd * ca[j] + cb[j]);
    }
}

__device__ __forceinline__ void mod_items(const Ctx& F, KP kp) {
    const float* c = kin(kp, 1); const float* cc = kin(kp, 3); const float* wmod = kin(kp, 4); const float* bmod = kin(kp, 5);
    float* mod = (float*)(F.ws + O_MOD);
    LAS float* sl = (LAS float*)F.lds;
    LAS float* red = sl + 9 * 1024;
    for (int it = F.vcu; it < 192; it += F.G) {
        const int l = it / 96, n0 = (it % 96) * 64;
        __syncthreads();
        for (int i = F.tid; i < 9 * 1024; i += NTHR) { const float v = (i < 8192) ? c[i] : cc[i - 8192]; sl[i] = v * sigmoidf_(v); }
        __syncthreads();
        float acc[9];
#pragma unroll
        for (int s = 0; s < 9; ++s) acc[s] = 0.f;
        const float* wp = wmod + (size_t)l * 1024 * 6144 + n0 + F.lane;
        for (int k = F.wave * 128; k < F.wave * 128 + 128; ++k) { const float w = wp[(size_t)k * 6144];
#pragma unroll
            for (int s = 0; s < 9; ++s) acc[s] += sl[s * 1024 + k] * w; }
#pragma unroll
        for (int s = 0; s < 9; ++s) red[(F.wave * 9 + s) * 64 + F.lane] = acc[s];
        __syncthreads();
        for (int i = F.tid; i < 9 * 64; i += NTHR) { float t = 0.f;
#pragma unroll
            for (int w = 0; w < 8; ++w) t += red[w * 576 + i];
            const int s = i / 64, n = n0 + (i & 63); mod[(l * 9 + s) * 6144 + n] = t + bmod[l * 6144 + n]; }
    }
    __syncthreads();
}
__device__ __forceinline__ void table_items(const Ctx& F) {
    const int gt = (F.vcu * NTHR) + F.tid, NT_ = F.G * NTHR;
    float* ra = (float*)(F.ws + O_ROPEA); float* rb = (float*)(F.ws + O_ROPEB);
    for (int i = gt; i < 1024; i += NT_) { const int pos = i >> 4, f = i & 15; const float fr = powf(10000.0f, -(float)(2 * f) / 32.0f); const float ang = (float)pos * fr; ra[i] = cosf(ang); ra[1024 + i] = sinf(ang); }
    for (int i = gt; i < 512; i += NT_) { const int pos = i >> 3, f = i & 7; const float fr = powf(10000.0f, -(float)(2 * f) / 16.0f); const float ang = (float)pos * fr; rb[i] = cosf(ang); rb[512 + i] = sinf(ang); }
    bf16* DN = (bf16*)(F.ws + O_DN); bf16* DN2 = (bf16*)(F.ws + O_DN256); bf16* DC = (bf16*)(F.ws + O_DFTC);
    { const float sc = 0.022097086912079608f;
      for (int i = gt; i < 2048 * 2048 / 2; i += NT_) { const int n = i >> 10, k = (i & 1023) * 2; float s0, c0, s1, c1;
          sincospif((float)((n * k) & 2047) * (1.0f / 1024.0f), &s0, &c0); sincospif((float)((n * (k + 1)) & 2047) * (1.0f / 1024.0f), &s1, &c1);
          *(unsigned*)(DN + (size_t)n * 4096 + k) = cvtpk(c0 * sc, c1 * sc); *(unsigned*)(DN + (size_t)n * 4096 + 2048 + k) = cvtpk(-s0 * sc, -s1 * sc); } }
    { const float sc = 0.0625f;
      for (int i = gt; i < 256 * 256; i += NT_) { const int n = i >> 8, k = i & 255; float s0, c0; sincospif((float)((n * k) & 255) * (1.0f / 128.0f), &s0, &c0);
          DN2[n * 512 + k] = (bf16)(cvtpk(c0 * sc, 0.f) & 0xffff); DN2[n * 512 + 256 + k] = (bf16)(cvtpk(-s0 * sc, 0.f) & 0xffff); } }
    { const float sc = 0.08838834764831845f;
      for (int i = gt; i < 256 * 128; i += NT_) { const int r = i >> 7, k = i & 127; float s0, c0; sincospif((float)(((r & 127) * k) & 127) * (1.0f / 64.0f), &s0, &c0);
          DC[i] = (bf16)(cvtpk((r < 128 ? c0 : s0) * sc, 0.f) & 0xffff); } }
}
__device__ __forceinline__ void convert_weights_main(const Ctx& F, KP kp, int l) {
    int base = 0;
    run_xjob(F, base, kin(kp, 8) + (size_t)l * 1024 * INW, INW, nullptr, (bf16*)(F.ws + O_WIN), 1024, 0, M_WIN, 1024, NINP);
    run_xjob(F, base, kin(kp, 13) + (size_t)l * 384 * 768, 768, kin(kp, 11) + l * 384, (bf16*)(F.ws + O_WUQ), 384, 0, M_WUQ, 384, 768);
    run_xjob(F, base, kin(kp, 14) + (size_t)l * 256 * 1024, 1024, kin(kp, 12) + l * 256, (bf16*)(F.ws + O_WUKV), 256, 0, M_WUKV, 256, 1024);
    run_xjob(F, base, kin(kp, 20) + (size_t)l * 512 * 1024, 1024, nullptr, (bf16*)(F.ws + O_WBR), 1536, 0, M_NATP, 512, 1024);
    run_xjob(F, base, kin(kp, 21) + (size_t)l * 512 * 1024, 1024, nullptr, (bf16*)(F.ws + O_WBR), 1536, 512, M_NATP, 512, 1024);
    run_xjob(F, base, kin(kp, 22) + (size_t)l * 512 * 1024, 1024, nullptr, (bf16*)(F.ws + O_WBR), 1536, 1024, M_NATP, 512, 1024);
    run_xjob(F, base, kin(kp, 23) + (size_t)l * 1024 * 1024, 1024, nullptr, (bf16*)(F.ws + O_WOUT), 1024, 0, M_NAT, 1024, 1024);
}
__device__ __forceinline__ void convert_weights_ffn(const Ctx& F, KP kp, int l) {
    int base = 0;
    run_xjob(F, base, kin(kp, 24) + (size_t)l * 1024 * 2 * FFH, 2 * FFH, nullptr, (bf16*)(F.ws + O_WFI), 1024, 0, M_FFI, 1024, 2 * FFH);
    run_xjob(F, base, kin(kp, 25) + (size_t)l * FFH * 1024, 1024, nullptr, (bf16*)(F.ws + O_WFO), FFH, 0, M_NAT, FFH, 1024);
}

struct F1Sched {
    int nb_tok, G, c, row0, rows_per_b, nunits; const char* A; const char* PF;
    __device__ __forceinline__ bool next(int i, Unit& u) const {
        const long L = (long)i * G + c; if (L >= nunits) return false;
        const int j = (int)L % nb_tok, bg = (int)L / nb_tok, gch = bg & 3, b = bg >> 2;
        u.pm = b * 4 + gch; u.pn = j; u.kb = 0; u.A = A; u.B = PF + ((size_t)(row0 + b * rows_per_b + j * 256) * 512 + gch * 128) * 2; return true;
    }
};
struct F2Sched {
    int nM, G, c, row0, rows_per_b, nunits; const char* DN; const char* ZT; size_t K2;
    __device__ __forceinline__ bool next(int i, Unit& u) const {
        const long L = (long)i * G + c; if (L >= nunits) return false;
        const int pn = (int)L & 1, r = (int)L >> 1, pm = r % nM, b = r / nM;
        u.pm = (row0 + b * rows_per_b) / 256 + pm; u.pn = pn; u.kb = 0;
        u.A = DN + (size_t)pm * 256 * K2 * 2; u.B = ZT + ((size_t)b * 512 + pn * 256) * K2 * 2; return true;
    }
};

#ifndef DIAG_SUB
#define DIAG_SUB -1
#endif
#ifndef TIME_REP
#define TIME_REP 0
#endif
#define REP(b) ((TIME_REP & (b)) ? 2 : 1)
#define SUB_ON(k) (DIAG_SUB < 0 || DIAG_SUB == (k))
#ifndef DIAG_PART
#define DIAG_PART 0xffff
#endif
#define PART_ON(b) ((DIAG_PART & (b)) != 0)
__global__ void __launch_bounds__(NTHR, 2) fwd_kernel(Args args) {
    extern __shared__ __attribute__((aligned(16))) unsigned char lds_raw[];
    const int c = (int)blockIdx.x, G = (int)gridDim.x;
#if !MK_MULTI
    cg::grid_group grid = cg::this_grid();
    if (threadIdx.x < 2) ((volatile LAS unsigned*)((LAS unsigned char*)lds_raw + LDS_MISC))[threadIdx.x] = 0u;
    __syncthreads();
    const XcdBarrier xbar = xcd_barrier_post((unsigned*)(*(unsigned char* const __attribute__((address_space(4)))*)((KP)__builtin_amdgcn_kernarg_segment_ptr() + 216) + O_CTL) + 1024, (volatile LAS unsigned*)((LAS unsigned char*)lds_raw + LDS_MISC));
#define GRID_SYNC(first) do { if (first) grid.sync(); else xcd_barrier(xbar); } while (0)
#else
#define GRID_SYNC(first) do {} while (0)
#endif
    for (int ph = args.ph_lo; ph < args.ph_hi; ++ph) {
        KP kp = (KP)__builtin_amdgcn_kernarg_segment_ptr(); asm volatile("" : "+s"(kp));
        int tid_ = threadIdx.x; asm volatile("" : "+v"(tid_));
        Ctx F; F.lds = (LAS unsigned char*)lds_raw; F.tid = tid_; F.lane = tid_ & 63; F.wave = __builtin_amdgcn_readfirstlane(tid_ >> 6);
        F.G = G; F.vcu = (G % 8 == 0) ? (c % 8) * (G / 8) + c / 8 : c; F.cv_rank = F.vcu; F.cv_n = G;
        unsigned char* ws = kws(kp); F.ws = ws; float* const outp = kout(kp);
        const float* mod = (const float*)(ws + O_MOD);
        const float* ropeA = (const float*)(ws + O_ROPEA); const float* ropeB = (const float*)(ws + O_ROPEB);
        float* stat_cq = (float*)(ws + O_STATCQ); float* stat_ckv = (float*)(ws + O_STATCKV);
        bf16* HB = (bf16*)(ws + O_HB); bf16* PF = (bf16*)(ws + O_PF); bf16* QA = (bf16*)(ws + O_QA); bf16* QBN = (bf16*)(ws + O_QBN); bf16* QBR = (bf16*)(ws + O_QBR);
        bf16* CQ = (bf16*)(ws + O_CQ); bf16* CKV = (bf16*)(ws + O_CKV); bf16* KA = (bf16*)(ws + O_KA); bf16* VA = (bf16*)(ws + O_VA); bf16* KB = (bf16*)(ws + O_KB); bf16* VB = (bf16*)(ws + O_VB);
        bf16* GT = (bf16*)(ws + O_G); bf16* ACT = (bf16*)(ws + O_G); bf16* MB = HB; bf16* YC = PF;
        float* XC = (float*)(ws + O_XC);
        if (ph == 0) { if (SUB_ON(10))
            for (int rep_ = 0; rep_ < REP(1); ++rep_) { mod_items(F, kp); table_items(F); convert_weights_main(F, kp, 0); }
        } else {
            const int l = (ph - 1) / 10, sub = (ph - 1) % 10;
            const bool L1 = (l == 1);
            const int nMt = L1 ? 64 : 72;
            const float* xin_lat = L1 ? outp : kin(kp, 0); const float* xin_ctx = L1 ? XC : kin(kp, 2);
            const float* mod_l = mod + (size_t)l * 9 * 6144;
            bf16* ZT = L1 ? (bf16*)(ws + O_ZT1) : (bf16*)outp; bf16* ZTC = (bf16*)outp + (size_t)8 * 512 * 4096;
            switch (sub) {
            case 0: if (SUB_ON(0)) {
                if (L1 && G != 256) convert_weights_main(F, kp, 1);
                for (int rep_ = 0; rep_ < REP(2); ++rep_) norm_pass(F, xin_lat, xin_ctx, HB, kin(kp, 6) + l * 1024, mod_l, 0, MT);
            } break;
            case 1: if (SUB_ON(1)) {
                EpiIn E{QA, KA, VA, CQ, CKV, KB, PF, GT, stat_cq, stat_ckv, kin(kp, 9) + l * 64, kin(kp, 10) + l * 64, kin(kp, 18) + l * 32, kin(kp, 19) + l * 3072, ropeA, ropeB};
                const Gemm g{1024, 1024, 1024};
                RectSched S{L1 ? 64 : 72, 8, 0, G, c, 1, ~0ull, (const char*)HB, 0, 0, (const char*)(ws + O_WIN), (size_t)256 * 1024 * 2, (size_t)256 * 1024 * 2, 0};
                pg8::gemm_phase(F.lds, g, S, E);
                if (L1) { RectSched S2{8, 3, 64, G, c, 1, 0x542ull, (const char*)HB, 0, 0, (const char*)(ws + O_WIN), (size_t)256 * 1024 * 2, (size_t)256 * 1024 * 2, 0};
                    pg8::gemm_phase(F.lds, g, S2, E); }
            } break;
            case 2: if (SUB_ON(2)) {
                for (int rep_ = 0; rep_ < REP(4); ++rep_) { EpiUq E{QBN, QBR, stat_cq, kin(kp, 15) + l * 64, kin(kp, 17) + l * 32, ropeB}; const Gemm g{384, 384, 384};
                  RectSched S{L1 ? 64 : 72, 3, 0, G, c, 1, ~0ull, (const char*)CQ, 0, 0, (const char*)(ws + O_WUQ), (size_t)256 * 384 * 2, (size_t)256 * 384 * 2, 0};
                  pg8::gemm_phase(F.lds, g, S, E); }
                for (int rep_ = 0; rep_ < REP(8); ++rep_) { EpiUkv E{KB, VB, stat_ckv, kin(kp, 16) + l * 64}; const Gemm g{256, 256, 256};
                  RectSched S{72, 4, 0, G, c, 1, ~0ull, (const char*)CKV, 0, 0, (const char*)(ws + O_WUKV), (size_t)256 * 256 * 2, (size_t)256 * 256 * 2, 0};
                  pg8::gemm_phase(F.lds, g, S, E); }
                for (int rep_ = 0; rep_ < REP(16); ++rep_) { EpiF1 E{ZT, 2048}; const Gemm g{128, 512, 128};
                  F1Sched S{8, G, c, 0, 2048, 256, (const char*)(ws + O_DFTC), (const char*)PF};
                  pg8::gemm_phase(F.lds, g, S, E); }
                if (!L1) { EpiF1 E{ZTC, 256}; const Gemm g{128, 512, 128};
                  F1Sched S{1, G, c, ML, 256, 32, (const char*)(ws + O_DFTC), (const char*)PF};
                  pg8::gemm_phase(F.lds, g, S, E); }
            } break;
            case 3: if (SUB_ON(3)) {
                LAS unsigned char* shm = F.lds;
                if (TIME_REP & 32) for (int i = 0;; ++i) {
                    const int L = i * G + c; if (L >= 512) break; const int qb = L & 7, h = (L >> 3) & 7, b = L >> 6;
                    const size_t row0 = (size_t)b * SEQ + qb * 256; const size_t key0 = (size_t)b * NKEY;
                    attq::attn_unit<4, 8>(QA + row0 * 512 + h * 64, 512, nullptr, 0, KA + key0 * 128 + (h >> 2) * 64, 128, VA + key0 * 128 + (h >> 2) * 64, 128, CQ + row0 * 512 + h * 64, 512, NKEY / 64, (char*)lds_raw);
                }
                if (TIME_REP & 64) for (int i = 0;; ++i) {
                    const int L = i * G + c; if (L >= 512) break; const int qb = L & 7, h = (L >> 3) & 7, b = L >> 6;
                    const size_t row0 = (size_t)b * SEQ + qb * 256; const size_t key0 = (size_t)b * NKEY;
                    attq::attn_unit<6, 8>(QBN + row0 * 512 + h * 64, 512, QBR + row0 * 256 + h * 32, 256, KB + key0 * 768 + h * 96, 768, VB + key0 * 512 + h * 64, 512, CQ + row0 * 512 + h * 64, 512, NKEY / 64, (char*)lds_raw);
                }
                for (int i = 0;; ++i) {
                    int L; if (G == 256) { if (c < 128) { if (i >= 3) break; L = c + 128 * i; } else { if (i >= 1) break; L = 384 + (c - 128); } } else { L = i * G + c; if (L >= 512) break; }
                    const int qb = L & 7, h = (L >> 3) & 7, b = L >> 6;
                    const size_t row0 = (size_t)b * SEQ + qb * 256; const size_t key0 = (size_t)b * NKEY;
                    attq::attn_unit<4, 8>(QA + row0 * 512 + h * 64, 512, nullptr, 0, KA + key0 * 128 + (h >> 2) * 64, 128, VA + key0 * 128 + (h >> 2) * 64, 128, QA + row0 * 512 + h * 64, 512, NKEY / 64, (char*)lds_raw);
                }
                for (int i = 0;; ++i) {
                    const int L = i * G + c; if (L >= 512) break; const int qb = L & 7, h = (L >> 3) & 7, b = L >> 6;
                    const size_t row0 = (size_t)b * SEQ + qb * 256; const size_t key0 = (size_t)b * NKEY;
                    attq::attn_unit<6, 8>(QBN + row0 * 512 + h * 64, 512, QBR + row0 * 256 + h * 32, 256, KB + key0 * 768 + h * 96, 768, VB + key0 * 512 + h * 64, 512, QBN + row0 * 512 + h * 64, 512, NKEY / 64, (char*)lds_raw);
                }
                if (!L1) {
                    for (int i = 0;; ++i) {
                        const int L = i * G + ((c + 128) % G); if (L >= 128) break; const int h = L & 7, b = (L >> 3) & 7; const bool mla = L >= 64;
                        const size_t row0 = (size_t)ML + b * CTX; const size_t key0 = (size_t)b * NKEY;
                        if (!mla) attq::attn_unit<4, 8>(QA + row0 * 512 + h * 64, 512, nullptr, 0, KA + key0 * 128 + (h >> 2) * 64, 128, VA + key0 * 128 + (h >> 2) * 64, 128, QA + row0 * 512 + h * 64, 512, CTX / 64, (char*)lds_raw);
                        else attq::attn_unit<6, 8>(QBN + row0 * 512 + h * 64, 512, QBR + row0 * 256 + h * 32, 256, KB + key0 * 768 + h * 96, 768, VB + key0 * 512 + h * 64, 512, QBN + row0 * 512 + h * 64, 512, CTX / 64, (char*)lds_raw);
                    }
                }
                for (int rep_ = 0; rep_ < REP(128); ++rep_) { EpiStore E{YC, 512}; const Gemm g{4096, 4096, 4096};
                  F2Sched S{8, G, (c + 128) % G, 0, 2048, 128, (const char*)(ws + O_DN), (const char*)ZT, 4096};
                  pg8::gemm_phase(F.lds, g, S, E); }
                if (!L1) { EpiStore E{YC, 512}; const Gemm g{512, 512, 512};
                  F2Sched S{1, G, c, ML, 256, 16, (const char*)(ws + O_DN256), (const char*)ZTC, 512};
                  pg8::gemm_phase(F.lds, g, S, E); }
            } break;
            case 4: if (SUB_ON(4)) {
                EpiIn E{QA, KA, VA, CQ, CKV, KB, PF, GT, stat_cq, stat_ckv, kin(kp, 9) + l * 64, kin(kp, 10) + l * 64, kin(kp, 18) + l * 32, kin(kp, 19) + l * 3072, ropeA, ropeB};
                const Gemm g{1024, 1024, 1024};
                RectSched S{nMt, 12, 0, G, c, 1, ~0ull, (const char*)HB, 0, 0, (const char*)(ws + O_WIN) + (size_t)8 * 256 * 1024 * 2, (size_t)256 * 1024 * 2, (size_t)256 * 1024 * 2, 0};
                struct PnShift { RectSched s; __device__ __forceinline__ bool next(int i, Unit& u) const { if (!s.next(i, u)) return false; u.pn += 8; return true; } } S8{S};
                for (int rep_ = 0; rep_ < REP(256); ++rep_) pg8::gemm_phase(F.lds, g, S8, E);
            } break;
            case 5: if (SUB_ON(5)) {
                for (int rep_ = 0; rep_ < REP(512); ++rep_) { EpiMerge E{(const unsigned char*)GT, MB}; const Gemm g{512, 1536, 512};
                RectSched S{nMt, 4, 0, G, c, 3, ~0ull, (const char*)QA, (size_t)((const char*)QBN - (const char*)QA), (size_t)((const char*)YC - (const char*)QA), (const char*)(ws + O_WBR), (size_t)256 * 512 * 2, (size_t)256 * 1536 * 2, (size_t)512 * 2};
                pg8::gemm_phase(F.lds, g, S, E); }
            } break;
            case 6: if (SUB_ON(6)) {
                EpiRes E{xin_lat, xin_ctx, outp, XC, mod_l + 2048}; const Gemm g{1024, 1024, 1024};
                RectSched S{nMt, 4, 0, G, c, 1, ~0ull, (const char*)MB, 0, 0, (const char*)(ws + O_WOUT), (size_t)256 * 1024 * 2, (size_t)256 * 1024 * 2, 0};
                pg8::gemm_phase(F.lds, g, S, E);
                if (!L1 && G == 256 && c >= 32) { F.cv_rank = c - 32; F.cv_n = 224; convert_weights_ffn(F, kp, 0); }
            } break;
            case 7: if (SUB_ON(7)) {
                if (L1 || G != 256) for (int rep_ = 0; rep_ < REP(1024); ++rep_) convert_weights_ffn(F, kp, l);
                for (int rep_ = 0; rep_ < REP(2048); ++rep_) norm_pass(F, outp, XC, HB, kin(kp, 7) + l * 1024, mod_l, 3072, L1 ? ML : MT);
            } break;
            case 8: if (SUB_ON(8)) {
                for (int rep_ = 0; rep_ < REP(4096); ++rep_) { EpiSwiglu E{ACT}; const Gemm g{1024, 1024, 1024};
                RectSched S{nMt, 22, 0, G, c, 1, ~0ull, (const char*)HB, 0, 0, (const char*)(ws + O_WFI), (size_t)256 * 1024 * 2, (size_t)256 * 1024 * 2, 0};
                pg8::gemm_phase(F.lds, g, S, E); }
            } break;
            case 9: if (SUB_ON(9)) {
                EpiRes E{outp, XC, outp, XC, mod_l + 5120}; const Gemm g{FFH, FFH, FFH};
                RectSched S{nMt, 4, 0, G, c, 1, ~0ull, (const char*)ACT, 0, 0, (const char*)(ws + O_WFO), (size_t)256 * FFH * 2, (size_t)256 * FFH * 2, 0};
                pg8::gemm_phase(F.lds, g, S, E);
                if (!L1 && G == 256 && c >= 32) { F.cv_rank = c - 32; F.cv_n = 224; convert_weights_main(F, kp, 1); }
            } break;
            }
        }
        if (ph + 1 < args.ph_hi) { GRID_SYNC(ph == 0); }
    }
}

extern "C" void kernel_launch(void* const* d_in, const int* in_sizes, int n_in, void* d_out, int out_size, void* d_ws, size_t ws_size, hipStream_t stream) {
    static int grid = 0;
    if (grid == 0) {
        if (n_in != 26 || out_size != ML * DM || ws_size < O_END) { fprintf(stderr, "kernel_launch: unexpected shapes (n_in %d out %d ws %zu)\n", n_in, out_size, ws_size); grid = -1; return; }
        int dev = 0, cus = 0, per_cu = 0;
        hipGetDevice(&dev); hipDeviceGetAttribute(&cus, hipDeviceAttributeMultiprocessorCount, dev);
        if (hipFuncSetAttribute((const void*)fwd_kernel, hipFuncAttributeMaxDynamicSharedMemorySize, LDS_BYTES) != hipSuccess) { fprintf(stderr, "kernel_launch: hipFuncSetAttribute failed\n"); grid = -1; return; }
        hipOccupancyMaxActiveBlocksPerMultiprocessor(&per_cu, (const void*)fwd_kernel, NTHR, LDS_BYTES);
        if (per_cu < 1) { fprintf(stderr, "kernel_launch: occupancy query says %d blocks/CU\n", per_cu); per_cu = 1; }
        (void)hipGetLastError();
        grid = cus;
        if (grid > 256) grid = 256;
    }
    if (grid < 0) return;
    (void)hipMemsetAsync((char*)d_ws + O_CTL, 0, CTL_ZERO_BYTES, stream);
    Args a{};
    for (int i = 0; i < 26; ++i) a.in[i] = (const float*)d_in[i];
    a.out = (float*)d_out; a.ws = (unsigned char*)d_ws;
#if MK_MULTI
    for (int ph = 0; ph < NPHASE; ++ph) { a.ph_lo = ph; a.ph_hi = ph + 1; hipLaunchKernelGGL(fwd_kernel, dim3(grid), dim3(NTHR), LDS_BYTES, stream, a); }
#else
    a.ph_lo = 0; a.ph_hi = NPHASE;
    void* kargs[] = {&a};
    hipError_t e = hipLaunchCooperativeKernel((const void*)fwd_kernel, dim3(grid), dim3(NTHR), kargs, LDS_BYTES, stream);
    if (e != hipSuccess) fprintf(stderr, "cooperative launch failed: %s (grid %d)\n", hipGetErrorString(e), grid);
#endif
}
```

```cpp
#include <hip/hip_runtime.h>
#include <hip/hip_cooperative_groups.h>
#include <cstdint>
#include <cstdio>
namespace cg = cooperative_groups;

#ifndef MK_MULTI
#define MK_MULTI 0
#endif

#define LAS __attribute__((address_space(3)))
typedef unsigned short bf16;
typedef short bf16x8 __attribute__((ext_vector_type(8)));
typedef short s16x4 __attribute__((ext_vector_type(4)));
typedef float f32x2 __attribute__((ext_vector_type(2)));
typedef float f32x4 __attribute__((ext_vector_type(4)));
typedef float f32x16 __attribute__((ext_vector_type(16)));
typedef unsigned u32x2 __attribute__((ext_vector_type(2)));
typedef unsigned u32x4 __attribute__((ext_vector_type(4)));
typedef __bf16 bf16x2_t __attribute__((ext_vector_type(2)));

constexpr int DM = 1024, NB = 8, SEQ = 2048, CTX = 256, NKEY = CTX + SEQ;
constexpr int ML = NB * SEQ, MC = NB * CTX, MT = ML + MC;
constexpr int INW = 5024, NINP = 5120;
constexpr int FFH = 2816;
constexpr float EPS = 1e-6f;
constexpr float LOG2E = 1.4426950408889634f;
constexpr float C2A = 0.125f * LOG2E;
constexpr float C2B = 0.10206207261596577f * LOG2E;
constexpr int NWAVES = 8, NTHR = 512;

constexpr size_t MiB = 1u << 20, KiB = 1024;
constexpr size_t O_CTL = 0;
constexpr size_t O_MOD = 256 * KiB;
constexpr size_t O_ROPEA = 704 * KiB;
constexpr size_t O_ROPEB = 712 * KiB;
constexpr size_t O_STATCQ = 1 * MiB;
constexpr size_t O_STATCKV = O_STATCQ + (size_t)MT * 8 * 4;
constexpr size_t O_DN = 2 * MiB;
constexpr size_t O_DN256 = O_DN + 16 * MiB;
constexpr size_t O_DFTC = O_DN256 + 256 * KiB;
constexpr size_t O_W = O_DN + 16 * MiB + 512 * KiB;
constexpr size_t O_WIN = O_W;
constexpr size_t O_WUQ = O_WIN + (size_t)NINP * 1024 * 2;
constexpr size_t O_WUKV = O_WUQ + 768 * 384 * 2;
constexpr size_t O_WBR = O_WUKV + 1024 * 256 * 2;
constexpr size_t O_WOUT = O_WBR + 1024 * 1536 * 2;
constexpr size_t O_XC = O_W + 16 * MiB + 256 * KiB;
constexpr size_t O_HB = O_XC + 8 * MiB;
constexpr size_t O_PF = O_HB + 36 * MiB;
constexpr size_t O_QA = O_PF + 18 * MiB;
constexpr size_t O_QBN = O_QA + 18 * MiB;
constexpr size_t O_QBR = O_QBN + 18 * MiB;
constexpr size_t O_WFI = O_QA;
constexpr size_t O_WFO = O_WFI + (size_t)5632 * 1024 * 2;
constexpr size_t O_G = O_QBR + 9 * MiB;
constexpr size_t O_CQ = O_G;
constexpr size_t O_CKV = O_CQ + (size_t)MT * 384 * 2;
constexpr size_t O_KA = O_CKV + (size_t)MT * 256 * 2;
constexpr size_t O_VA = O_KA + (size_t)NB * NKEY * 128 * 2;
constexpr size_t O_KB = O_VA + (size_t)NB * NKEY * 128 * 2;
constexpr size_t O_VB = O_KB + (size_t)NB * NKEY * 768 * 2;
constexpr size_t O_ZT1 = O_VB + (size_t)NB * NKEY * 512 * 2;
constexpr size_t O_END = O_ZT1 + 32 * MiB;
static_assert(O_END <= 256 * MiB, "d_ws map exceeds 256 MiB");
static_assert(O_WOUT + 2 * MiB <= O_XC, "W region");
static_assert(O_WFO + (size_t)1024 * 2816 * 2 <= O_G, "ffn weights overlay");
static_assert(O_G + (size_t)MT * 3072 * 2 <= O_END, "gates overlay");
static_assert(O_DFTC + 64 * KiB <= O_W, "dft region");
static_assert(O_STATCKV + (size_t)MT * 4 * 4 <= O_DN, "stats region");

__device__ __forceinline__ unsigned cvtpk(float lo, float hi) { f32x2 v = {lo, hi}; bf16x2_t b = __builtin_convertvector(v, bf16x2_t); return __builtin_bit_cast(unsigned, b); }
__device__ __forceinline__ u32x2 pk4(f32x4 v) { u32x2 r; r.x = cvtpk(v[0], v[1]); r.y = cvtpk(v[2], v[3]); return r; }
__device__ __forceinline__ float bf2f(unsigned short h) { return __uint_as_float((unsigned)h << 16); }
__device__ __forceinline__ f32x4 unpk4(u32x2 w) { f32x4 r; r[0] = __uint_as_float(w.x << 16); r[1] = __uint_as_float(w.x & 0xffff0000u); r[2] = __uint_as_float(w.y << 16); r[3] = __uint_as_float(w.y & 0xffff0000u); return r; }
__device__ __forceinline__ u32x4 pk8(f32x4 a, f32x4 b) { u32x4 r; r.x = cvtpk(a[0], a[1]); r.y = cvtpk(a[2], a[3]); r.z = cvtpk(b[0], b[1]); r.w = cvtpk(b[2], b[3]); return r; }
__device__ __forceinline__ unsigned q8(float g) { return (unsigned)__builtin_rintf(__builtin_fminf(__builtin_fmaxf(g * 255.0f, 1.0f), 255.0f)); }
__device__ __forceinline__ unsigned q8x4(f32x4 g) { return q8(g[0]) | (q8(g[1]) << 8) | (q8(g[2]) << 16) | (q8(g[3]) << 24); }
__device__ __forceinline__ f32x4 uq8x4(unsigned w) { f32x4 r; r[0] = (float)(w & 0xffu); r[1] = (float)((w >> 8) & 0xffu); r[2] = (float)((w >> 16) & 0xffu); r[3] = (float)(w >> 24); return r; }
__device__ __forceinline__ float wave_sum(float v) {
#pragma unroll
    for (int o = 1; o < 64; o <<= 1) v += __shfl_xor(v, o);
    return v;
}
__device__ __forceinline__ float fq_sum(float v) { v += __shfl_xor(v, 16); v += __shfl_xor(v, 32); return v; }
__device__ __forceinline__ float sigmoidf_(float x) { return __builtin_amdgcn_rcpf(1.0f + __expf(-x)); }

namespace pg8 {
constexpr int BM = 256, BK = 64, HALF = 128, HTB = HALF * BK * 2, STAGE_BYTES = 8 * HTB, NXCD = 8, WGM = 8;
__host__ __device__ __forceinline__ int lds_byte(int r, int c) { const int st = (r >> 4) * 2 + (c >> 5), rr = r & 15, cc = c & 31, ob = rr * 64 + cc * 2; return st * 1024 + (ob ^ (((ob >> 9) & 1) << 5)); }
__host__ __device__ __forceinline__ void stage_rc(int b, int& R, int& C) { const int st = b / 1024, sb = b % 1024, swz = sb ^ (((sb >> 9) & 1) << 5); R = (st >> 1) * 16 + swz / 64; C = (st & 1) * 32 + (swz % 64) / 2; }

struct Unit { int pm, pn, kb, epi; const char* A; const char* B; int lda, ldb, nt; };
struct Gemm { int lda, ldb, K; };

__device__ __forceinline__ void tile_order(int L, int nM, int nN, int& pm, int& pn) {
    const int nwg = nM * nN; int wgid = L;
    { const int q = nwg / NXCD, r = nwg % NXCD, xcd = wgid % NXCD, off = wgid / NXCD; wgid = (xcd < r ? xcd * (q + 1) : r * (q + 1) + (xcd - r) * q) + off; }
    const int nig = WGM * nN, gid = wgid / nig, fm = gid * WGM, gsz = (nM - fm) < WGM ? (nM - fm) : WGM;
    pm = fm + ((wgid % nig) % gsz); pn = (wgid % nig) / gsz;
}

template <class Epi, class Sched>
__device__ __forceinline__ void gemm_phase(LAS unsigned char* lds, const Gemm g, const Sched& S, const Epi& E) {
    int tid = threadIdx.x; asm volatile("" : "+v"(tid));
    const int wid = __builtin_amdgcn_readfirstlane(tid >> 6), lane = tid & 63, wr = wid >> 2, wc = wid & 3, fr = lane & 15, fq = lane >> 4;
    unsigned Rv, Cv;
    { int R, C; stage_rc(tid * 16, R, C); Rv = (unsigned)R * 2u; Cv = (unsigned)C * 2u; }
    const size_t kstep = (size_t)(BK * 2);
    const unsigned ldsw = (unsigned)wid * 1024u;
    const int aoff = lds_byte(wr * 64 + fr, fq * 8), boff = lds_byte(wc * 32 + fr, fq * 8);
#define PG8_SA(b, h) (((b) * 2 + (h)) * HTB)
#define PG8_SB(b, h) ((4 + (b) * 2 + (h)) * HTB)
#define PG8_STAGE(bufoff, gbase, voff, piece) do { _Pragma("unroll") for (int _i = 0; _i < 2; ++_i) \
        __builtin_amdgcn_global_load_lds((const unsigned*)((const char*)(gbase) + (size_t)_i * (piece) + (voff)), (LAS unsigned*)(lds + (bufoff) + ldsw + _i * 8192), 16, 0, 0); } while (0)
#define PG8_LDA(dst, b, h) do { _Pragma("unroll") for (int m = 0; m < 4; ++m) _Pragma("unroll") for (int k = 0; k < 2; ++k) dst[m][k] = *(const LAS bf16x8*)(lds + PG8_SA(b, h) + aoff + m * 2048 + k * 1024); } while (0)
#define PG8_LDB(dst, b, h) do { _Pragma("unroll") for (int n = 0; n < 2; ++n) _Pragma("unroll") for (int k = 0; k < 2; ++k) dst[n][k] = *(const LAS bf16x8*)(lds + PG8_SB(b, h) + boff + n * 2048 + k * 1024); } while (0)
#define PG8_MMA(ai, bj, At, Bt) do { __builtin_amdgcn_s_setprio(1); _Pragma("unroll") for (int m = 0; m < 4; ++m) _Pragma("unroll") for (int n = 0; n < 2; ++n) _Pragma("unroll") for (int k = 0; k < 2; ++k) \
        acc[ai][bj][m][n] = __builtin_amdgcn_mfma_f32_16x16x32_bf16(Bt[n][k], At[m][k], acc[ai][bj][m][n], 0, 0, 0); __builtin_amdgcn_s_setprio(0); } while (0)
#define PG8_WAIT_V(n) asm volatile("s_waitcnt vmcnt(" #n ")" ::: "memory")
#define PG8_WAIT_L(n) asm volatile("s_waitcnt lgkmcnt(" #n ")" ::: "memory")
#define PG8_BAR __builtin_amdgcn_s_barrier()
#define PG8_SCHED __builtin_amdgcn_sched_barrier(0)
#define PG8_NEXT(i, u) ((u).lda = g.lda, (u).ldb = g.ldb, (u).nt = g.K / BK, (u).epi = 0, S.next((i), (u)))
    Unit cur, nxt; int ui = 0;
    if (!PG8_NEXT(0, cur)) return;
    f32x4 acc[2][2][4][2];
#pragma unroll
    for (int a = 0; a < 2; ++a)
#pragma unroll
        for (int b = 0; b < 2; ++b)
#pragma unroll
            for (int m = 0; m < 4; ++m)
#pragma unroll
                for (int n = 0; n < 2; ++n) acc[a][b][m][n] = (f32x4){0.f, 0.f, 0.f, 0.f};
    bf16x8 At[4][2], B0[2][2], B1[2][2];
    const char* cA = cur.A; const char* cB = cur.B;
    unsigned vAc = Rv * (unsigned)cur.lda + Cv, vBc = Rv * (unsigned)cur.ldb + Cv;
    size_t pAc = (size_t)128 * cur.lda, pBc = (size_t)128 * cur.ldb;
    PG8_STAGE(PG8_SB(0, 0), cB, vBc, pBc); PG8_STAGE(PG8_SB(0, 1), cB + 2 * pBc, vBc, pBc); PG8_STAGE(PG8_SA(0, 0), cA, vAc, pAc); PG8_STAGE(PG8_SA(0, 1), cA + 2 * pAc, vAc, pAc);
    if (wr == 1) PG8_BAR;
    PG8_WAIT_V(2); PG8_BAR;
    PG8_STAGE(PG8_SB(1, 0), cB + kstep, vBc, pBc); PG8_STAGE(PG8_SA(1, 0), cA + kstep, vAc, pAc); PG8_STAGE(PG8_SB(1, 1), cB + 2 * pBc + kstep, vBc, pBc);
    PG8_WAIT_V(6); PG8_BAR;
    for (;;) {
        const bool has_next = PG8_NEXT(ui + 1, nxt);
        if (!has_next) nxt = cur;
        const char* nA = nxt.A; const char* nB = nxt.B;
        const unsigned vAn = Rv * (unsigned)nxt.lda + Cv, vBn = Rv * (unsigned)nxt.ldb + Cv;
        const size_t pAn = (size_t)128 * nxt.lda, pBn = (size_t)128 * nxt.ldb;
        int nt = cur.nt; asm volatile("" : "+s"(nt));
        for (int t = 0; t < nt; t += 2) {
            const bool last = (t == nt - 2);
            const char* a1 = cA + (size_t)(t + 1) * kstep;
            const char* a2 = last ? nA : cA + (size_t)(t + 2) * kstep; const char* b2 = last ? nB : cB + (size_t)(t + 2) * kstep;
            const char* a3 = a2 + kstep; const char* b3 = b2 + kstep;
            const unsigned vA2 = last ? vAn : vAc, vB2 = last ? vBn : vBc; const size_t pA2 = last ? pAn : pAc, pB2 = last ? pBn : pBc;
            PG8_LDB(B0, 0, 0); PG8_LDB(B1, 0, 1); PG8_SCHED; PG8_LDA(At, 0, 0); PG8_STAGE(PG8_SA(1, 1), a1 + 2 * pAc, vAc, pAc);
            PG8_WAIT_V(8); PG8_WAIT_L(0); PG8_BAR; PG8_MMA(0, 0, At, B0); PG8_MMA(0, 1, At, B1); PG8_BAR; PG8_SCHED;
            PG8_LDA(At, 0, 1); PG8_STAGE(PG8_SB(0, 0), b2, vB2, pB2); PG8_STAGE(PG8_SB(0, 1), b2 + 2 * pB2, vB2, pB2); PG8_STAGE(PG8_SA(0, 0), a2, vA2, pA2);
            PG8_WAIT_V(8); PG8_WAIT_L(0); PG8_BAR; PG8_MMA(1, 0, At, B0); PG8_MMA(1, 1, At, B1); PG8_BAR; PG8_SCHED;
            PG8_LDB(B0, 1, 0); PG8_LDB(B1, 1, 1); PG8_SCHED; PG8_LDA(At, 1, 0); PG8_STAGE(PG8_SA(0, 1), a2 + 2 * pA2, vA2, pA2);
            PG8_WAIT_V(8); PG8_WAIT_L(0); PG8_BAR; PG8_MMA(0, 0, At, B0); PG8_MMA(0, 1, At, B1); PG8_BAR; PG8_SCHED;
            PG8_LDA(At, 1, 1); PG8_STAGE(PG8_SB(1, 0), b3, vB2, pB2); PG8_STAGE(PG8_SB(1, 1), b3 + 2 * pB2, vB2, pB2); PG8_STAGE(PG8_SA(1, 0), a3, vA2, pA2);
            PG8_WAIT_V(8); PG8_WAIT_L(0); PG8_BAR; PG8_MMA(1, 0, At, B0); PG8_MMA(1, 1, At, B1); PG8_BAR; PG8_SCHED;
        }
        if (wr == 0) PG8_BAR;
        const bool carry = E(acc, cur, wr, wc, fr, fq);
        if (!has_next) break;
        if (!carry) {
#pragma unroll
            for (int a = 0; a < 2; ++a)
#pragma unroll
                for (int b = 0; b < 2; ++b)
#pragma unroll
                    for (int m = 0; m < 4; ++m)
#pragma unroll
                        for (int n = 0; n < 2; ++n) acc[a][b][m][n] = (f32x4){0.f, 0.f, 0.f, 0.f};
        }
        cur = nxt; cA = nA; cB = nB; vAc = vAn; vBc = vBn; pAc = pAn; pBc = pBn; ++ui;
        if (wr == 1) PG8_BAR;
    }
    PG8_WAIT_V(0);
    PG8_BAR;
#undef PG8_SA
#undef PG8_SB
#undef PG8_STAGE
#undef PG8_LDA
#undef PG8_LDB
#undef PG8_MMA
#undef PG8_WAIT_V
#undef PG8_WAIT_L
#undef PG8_BAR
#undef PG8_SCHED
#undef PG8_NEXT
}
}
using pg8::Unit; using pg8::Gemm;

typedef f32x4 Acc[2][2][4][2];

struct RectSched {
    int nM, nN, pm0, G, c, nkb; unsigned long long pnmap;
    const char* A0; size_t dA1, dA2; const char* B; size_t strideAm, strideBn, strideBk;
    __device__ __forceinline__ int count() const { return nM * nN; }
    __device__ __forceinline__ bool next(int i, Unit& u) const { const int ti = i / nkb, kb = i - ti * nkb; return at((long)ti * G + c, kb, u); }
    __device__ __forceinline__ bool at(long L, int kb, Unit& u) const {
        if (L >= (long)nM * nN) return false;
        int pm, pn; pg8::tile_order((int)L, nM, nN, pm, pn);
        if (pnmap != ~0ull) pn = (int)((pnmap >> (4 * pn)) & 15ull);
        u.pm = pm + pm0; u.pn = pn; u.kb = kb;
        u.A = A0 + (size_t)(kb == 1) * dA1 + (size_t)(kb == 2) * dA2 + (size_t)u.pm * strideAm; u.B = B + (size_t)pn * strideBn + (size_t)kb * strideBk; return true;
    }
};

struct RowInfo { bool ctx; int b; int tok0; };
__device__ __forceinline__ RowInfo row_info(int pm) { RowInfo r; r.ctx = pm >= 64; r.b = r.ctx ? pm - 64 : pm >> 3; r.tok0 = r.ctx ? 0 : (pm & 7) * 256; return r; }

template <bool NORM>
__device__ __forceinline__ void head64(const f32x4 (&a)[2][2], const f32x4 (&g)[2][2], float scale, bool rope, int row_id, int col_id, const float* ropeA, int fq, f32x4 (&o)[2][2]) {
    f32x4 v[2][2];
    if (NORM) {
        float ss = 0.f;
#pragma unroll
        for (int bj = 0; bj < 2; ++bj)
#pragma unroll
            for (int n = 0; n < 2; ++n) { const f32x4 x = a[bj][n]; ss += (x[0] * x[0] + x[1] * x[1]) + (x[2] * x[2] + x[3] * x[3]); }
        ss = fq_sum(ss);
        const float rstd = rsqrtf(ss * (1.0f / 64.0f) + EPS);
#pragma unroll
        for (int bj = 0; bj < 2; ++bj)
#pragma unroll
            for (int n = 0; n < 2; ++n) v[bj][n] = a[bj][n] * rstd * g[bj][n];
    } else {
#pragma unroll
        for (int bj = 0; bj < 2; ++bj)
#pragma unroll
            for (int n = 0; n < 2; ++n) v[bj][n] = a[bj][n];
    }
    if (rope) {
#pragma unroll
        for (int bj = 0; bj < 2; ++bj) {
            const int pos = bj ? col_id : row_id;
            const f32x4 cs = *(const f32x4*)(ropeA + pos * 16 + 4 * fq), sn = *(const f32x4*)(ropeA + 1024 + pos * 16 + 4 * fq);
            o[bj][0] = (v[bj][0] * cs - v[bj][1] * sn) * scale; o[bj][1] = (v[bj][1] * cs + v[bj][0] * sn) * scale;
        }
    } else {
#pragma unroll
        for (int bj = 0; bj < 2; ++bj)
#pragma unroll
            for (int n = 0; n < 2; ++n) o[bj][n] = v[bj][n] * scale;
    }
}
__device__ __forceinline__ void rope32(const f32x4 (&a)[2], const float* g, float scale, bool rope, int row_id, int col_id, const float* ropeB, int fq, f32x4 (&o)[2]) {
    float ss = 0.f;
#pragma unroll
    for (int n = 0; n < 2; ++n) { const f32x4 x = a[n]; ss += (x[0] * x[0] + x[1] * x[1]) + (x[2] * x[2] + x[3] * x[3]); }
    ss = fq_sum(ss);
    const float rstd = rsqrtf(ss * (1.0f / 32.0f) + EPS);
    const int d0 = 16 * (fq >> 1) + 4 * (fq & 1);
    f32x4 v[2];
#pragma unroll
    for (int n = 0; n < 2; ++n) v[n] = a[n] * rstd * *(const f32x4*)(g + d0 + 8 * n);
    if (rope) {
        const int pos = (fq >> 1) ? col_id : row_id;
        const f32x4 cs = *(const f32x4*)(ropeB + pos * 8 + 4 * (fq & 1)), sn = *(const f32x4*)(ropeB + 512 + pos * 8 + 4 * (fq & 1));
        o[0] = (v[0] * cs - v[1] * sn) * scale; o[1] = (v[1] * cs + v[0] * sn) * scale;
    } else { o[0] = v[0] * scale; o[1] = v[1] * scale; }
}

struct EpiIn {
    bf16 *QA, *KA, *VA, *CQ, *CKV, *KB, *PF, *G; float *stat_cq, *stat_ckv;
    const float *gq, *gk, *gkr, *bgate, *ropeA, *ropeB;
    __device__ __forceinline__ bool operator()(Acc& acc, const Unit& u, int wr, int wc, int fr_, int fq_) const {
        int fr = fr_, fq = fq_; asm volatile("" : "+v"(fr), "+v"(fq));
        const RowInfo ri = row_info(u.pm); const bool rope = !ri.ctx;
        const int pn = u.pn;
        if (pn <= 2) {
            const bool isv = (pn == 2 && wc >= 2), isk = (pn == 2 && wc < 2);
            const float* gsrc = (pn < 2) ? gq : gk;
            f32x4 g[2][2];
#pragma unroll
            for (int bj = 0; bj < 2; ++bj)
#pragma unroll
                for (int n = 0; n < 2; ++n) g[bj][n] = *(const f32x4*)(gsrc + 32 * bj + 16 * n + 4 * fq);
#pragma unroll
            for (int ai = 0; ai < 2; ++ai)
#pragma unroll
                for (int m = 0; m < 4; ++m) {
                    const int rt = 128 * ai + 64 * wr + 16 * m + fr;
                    const int row_id = (ri.tok0 + 128 * ai + 64 * wr) >> 6, col_id = 16 * m + fr;
                    f32x4 a[2][2], o[2][2];
#pragma unroll
                    for (int bj = 0; bj < 2; ++bj)
#pragma unroll
                        for (int n = 0; n < 2; ++n) a[bj][n] = acc[ai][bj][m][n];
                    bf16* dst;
                    if (pn < 2) { head64<true>(a, g, C2A, rope, row_id, col_id, ropeA, fq, o); dst = QA + (size_t)(u.pm * 256 + rt) * 512 + (4 * pn + wc) * 64; }
                    else {
                        const size_t key = (size_t)ri.b * NKEY + (ri.ctx ? rt : 256 + ri.tok0 + rt);
                        if (isk) { head64<true>(a, g, 1.0f, rope, row_id, col_id, ropeA, fq, o); dst = KA + key * 128 + wc * 64; }
                        else { head64<false>(a, g, 1.0f, false, 0, 0, ropeA, fq, o); dst = VA + key * 128 + (wc - 2) * 64; }
                    }
#pragma unroll
                    for (int bj = 0; bj < 2; ++bj)
#pragma unroll
                        for (int n = 0; n < 2; ++n) *(u32x2*)(dst + 32 * bj + 16 * n + 4 * fq) = pk4(o[bj][n]);
                }
            (void)isv;
        } else if (pn == 3 || pn == 5) {
            bf16* dstb = (pn == 3) ? CQ : CKV; const int ld = (pn == 3) ? 384 : 256;
            float* st = (pn == 3) ? stat_cq : stat_ckv; const int sld = (pn == 3) ? 8 : 4;
#pragma unroll
            for (int ai = 0; ai < 2; ++ai)
#pragma unroll
                for (int m = 0; m < 4; ++m) {
                    const size_t row = (size_t)u.pm * 256 + 128 * ai + 64 * wr + 16 * m + fr; float ss = 0.f;
#pragma unroll
                    for (int bj = 0; bj < 2; ++bj) { const f32x4 x = acc[ai][bj][m][0], y = acc[ai][bj][m][1];
                        ss += (x[0] * x[0] + x[1] * x[1]) + (x[2] * x[2] + x[3] * x[3]) + (y[0] * y[0] + y[1] * y[1]) + (y[2] * y[2] + y[3] * y[3]);
                        *(u32x4*)(dstb + row * ld + 128 * bj + 32 * wc + 8 * fq) = pk8(x, y); }
                    ss = fq_sum(ss);
                    if (fq == 0) st[row * sld + wc] = ss;
                }
        } else if (pn == 4) {
            f32x4 gk0[2]; (void)gk0;
#pragma unroll
            for (int ai = 0; ai < 2; ++ai)
#pragma unroll
                for (int m = 0; m < 4; ++m) {
                    const int rt = 128 * ai + 64 * wr + 16 * m + fr; const size_t row = (size_t)u.pm * 256 + rt; float ss = 0.f;
                    { const f32x4 x = acc[ai][0][m][0], y = acc[ai][0][m][1];
                      ss += (x[0] * x[0] + x[1] * x[1]) + (x[2] * x[2] + x[3] * x[3]) + (y[0] * y[0] + y[1] * y[1]) + (y[2] * y[2] + y[3] * y[3]);
                      *(u32x4*)(CQ + row * 384 + 256 + 32 * wc + 8 * fq) = pk8(x, y); }
                    ss = fq_sum(ss);
                    if (fq == 0) stat_cq[row * 8 + 4 + wc] = ss;
                    if (wc == 0) {
                        const int row_id = (ri.tok0 + 128 * ai + 64 * wr) >> 6, col_id = 16 * m + fr;
                        f32x4 a[2], o[2]; a[0] = acc[ai][1][m][0]; a[1] = acc[ai][1][m][1];
                        rope32(a, gkr, 1.0f, rope, row_id, col_id, ropeB, fq, o);
                        const size_t key = (size_t)ri.b * NKEY + (ri.ctx ? rt : 256 + ri.tok0 + rt);
                        bf16* dst = KB + key * 768 + 64 + 16 * (fq >> 1) + 4 * (fq & 1);
                        const u32x2 w0 = pk4(o[0]), w1 = pk4(o[1]);
#pragma unroll
                        for (int h = 0; h < 8; ++h) { *(u32x2*)(dst + h * 96) = w0; *(u32x2*)(dst + h * 96 + 8) = w1; }
                    }
                }
        } else if (pn < 8) {
#pragma unroll
            for (int ai = 0; ai < 2; ++ai)
#pragma unroll
                for (int m = 0; m < 4; ++m) {
                    const size_t row = (size_t)u.pm * 256 + 128 * ai + 64 * wr + 16 * m + fr;
#pragma unroll
                    for (int bj = 0; bj < 2; ++bj) *(u32x4*)(PF + row * 512 + (pn - 6) * 256 + 128 * bj + 32 * wc + 8 * fq) = pk8(acc[ai][bj][m][0], acc[ai][bj][m][1]);
                }
        } else {
            const int c0 = (pn - 8) * 256 + 32 * wc + 8 * fq;
            f32x4 bv[2][2];
#pragma unroll
            for (int bj = 0; bj < 2; ++bj)
#pragma unroll
                for (int n = 0; n < 2; ++n) bv[bj][n] = *(const f32x4*)(bgate + c0 + 128 * bj + 4 * n);
            unsigned char* G8 = (unsigned char*)G;
#pragma unroll
            for (int ai = 0; ai < 2; ++ai)
#pragma unroll
                for (int m = 0; m < 4; ++m) {
                    const size_t row = (size_t)u.pm * 256 + 128 * ai + 64 * wr + 16 * m + fr;
#pragma unroll
                    for (int bj = 0; bj < 2; ++bj) { u32x2 w;
#pragma unroll
                        for (int n = 0; n < 2; ++n) { f32x4 x = acc[ai][bj][m][n] + bv[bj][n];
                            x[0] = sigmoidf_(x[0]); x[1] = sigmoidf_(x[1]); x[2] = sigmoidf_(x[2]); x[3] = sigmoidf_(x[3]);
                            if (n == 0) w.x = q8x4(x); else w.y = q8x4(x); }
                        *(u32x2*)(G8 + row * 3072 + c0 + 128 * bj) = w; }
                }
        }
        return false;
    }
};

struct EpiUq {
    bf16 *QBN, *QBR; const float *stat_cq, *gqn, *gqr, *ropeB;
    __device__ __forceinline__ bool operator()(Acc& acc, const Unit& u, int wr, int wc, int fr_, int fq_) const {
        int fr = fr_, fq = fq_; asm volatile("" : "+v"(fr), "+v"(fq));
        const RowInfo ri = row_info(u.pm); const bool rope = !ri.ctx;
        f32x4 g[2][2];
#pragma unroll
        for (int bj = 0; bj < 2; ++bj)
#pragma unroll
            for (int n = 0; n < 2; ++n) g[bj][n] = *(const f32x4*)(gqn + 32 * bj + 16 * n + 4 * fq);
        f32x2 stv[2][4];
#pragma unroll
        for (int ai = 0; ai < 2; ++ai)
#pragma unroll
            for (int m = 0; m < 4; ++m) stv[ai][m] = *(const f32x2*)(stat_cq + ((size_t)u.pm * 256 + 128 * ai + 64 * wr + 16 * m + fr) * 8 + 2 * fq);
#pragma unroll
        for (int ai = 0; ai < 2; ++ai)
#pragma unroll
            for (int m = 0; m < 4; ++m) {
                const int rt = 128 * ai + 64 * wr + 16 * m + fr; const size_t row = (size_t)u.pm * 256 + rt;
                const float rs = rsqrtf(fq_sum(stv[ai][m][0] + stv[ai][m][1]) * (1.0f / 384.0f) + EPS);
                if (u.pn < 2) {
                    f32x4 a[2][2], o[2][2];
#pragma unroll
                    for (int bj = 0; bj < 2; ++bj)
#pragma unroll
                        for (int n = 0; n < 2; ++n) a[bj][n] = acc[ai][bj][m][n] * rs;
                    head64<true>(a, g, C2B, false, 0, 0, ropeB, fq, o);
                    bf16* dst = QBN + row * 512 + (4 * u.pn + wc) * 64;
#pragma unroll
                    for (int bj = 0; bj < 2; ++bj)
#pragma unroll
                        for (int n = 0; n < 2; ++n) *(u32x2*)(dst + 32 * bj + 16 * n + 4 * fq) = pk4(o[bj][n]);
                } else {
                    const int row_id = (ri.tok0 + 128 * ai + 64 * wr) >> 6, col_id = 16 * m + fr;
#pragma unroll
                    for (int bj = 0; bj < 2; ++bj) {
                        f32x4 a[2], o[2]; a[0] = acc[ai][bj][m][0] * rs; a[1] = acc[ai][bj][m][1] * rs;
                        rope32(a, gqr, C2B, rope, row_id, col_id, ropeB, fq, o);
                        bf16* dst = QBR + row * 256 + (4 * bj + wc) * 32 + 16 * (fq >> 1) + 4 * (fq & 1);
                        *(u32x2*)(dst) = pk4(o[0]); *(u32x2*)(dst + 8) = pk4(o[1]);
                    }
                }
            }
        return false;
    }
};

struct EpiUkv {
    bf16 *KB, *VB; const float *stat_ckv, *gkn;
    __device__ __forceinline__ bool operator()(Acc& acc, const Unit& u, int wr, int wc, int fr_, int fq_) const {
        int fr = fr_, fq = fq_; asm volatile("" : "+v"(fr), "+v"(fq));
        const RowInfo ri = row_info(u.pm);
        f32x4 g[2][2];
#pragma unroll
        for (int bj = 0; bj < 2; ++bj)
#pragma unroll
            for (int n = 0; n < 2; ++n) g[bj][n] = *(const f32x4*)(gkn + 32 * bj + 16 * n + 4 * fq);
        float stv[2][4];
#pragma unroll
        for (int ai = 0; ai < 2; ++ai)
#pragma unroll
            for (int m = 0; m < 4; ++m) stv[ai][m] = stat_ckv[((size_t)u.pm * 256 + 128 * ai + 64 * wr + 16 * m + fr) * 4 + fq];
#pragma unroll
        for (int ai = 0; ai < 2; ++ai)
#pragma unroll
            for (int m = 0; m < 4; ++m) {
                const int rt = 128 * ai + 64 * wr + 16 * m + fr; const size_t row = (size_t)u.pm * 256 + rt;
                const float rs = rsqrtf(fq_sum(stv[ai][m]) * (1.0f / 256.0f) + EPS);
                const size_t key = (size_t)ri.b * NKEY + (ri.ctx ? rt : 256 + ri.tok0 + rt);
                f32x4 a[2][2], o[2][2];
#pragma unroll
                for (int bj = 0; bj < 2; ++bj)
#pragma unroll
                    for (int n = 0; n < 2; ++n) a[bj][n] = acc[ai][bj][m][n] * rs;
                bf16* dst;
                if (u.pn < 2) { head64<true>(a, g, 1.0f, false, 0, 0, gkn, fq, o); dst = KB + key * 768 + (4 * u.pn + wc) * 96; }
                else { head64<false>(a, g, 1.0f, false, 0, 0, gkn, fq, o); dst = VB + key * 512 + (4 * (u.pn - 2) + wc) * 64; }
#pragma unroll
                for (int bj = 0; bj < 2; ++bj)
#pragma unroll
                    for (int n = 0; n < 2; ++n) *(u32x2*)(dst + 32 * bj + 16 * n + 4 * fq) = pk4(o[bj][n]);
            }
        return false;
    }
};

struct EpiStore {
    bf16* O; int ld;
    __device__ __forceinline__ bool operator()(Acc& acc, const Unit& u, int wr, int wc, int fr_, int fq_) const {
        int fr = fr_, fq = fq_; asm volatile("" : "+v"(fr), "+v"(fq));
#pragma unroll
        for (int ai = 0; ai < 2; ++ai)
#pragma unroll
            for (int m = 0; m < 4; ++m) {
                const size_t row = (size_t)u.pm * 256 + 128 * ai + 64 * wr + 16 * m + fr;
#pragma unroll
                for (int bj = 0; bj < 2; ++bj)
#pragma unroll
                    for (int n = 0; n < 2; ++n) *(u32x2*)(O + row * ld + u.pn * 256 + 128 * bj + 32 * wc + 16 * n + 4 * fq) = pk4(acc[ai][bj][m][n]);
            }
        return false;
    }
};

struct EpiF1 {
    bf16* ZT; int NP;
    __device__ __forceinline__ bool operator()(Acc& acc, const Unit& u, int wr, int wc, int fr_, int fq_) const {
        int fr = fr_, fq = fq_; asm volatile("" : "+v"(fr), "+v"(fq));
        const int b = u.pm >> 2, gch = u.pm & 3;
#pragma unroll
        for (int ai = 0; ai < 2; ++ai)
#pragma unroll
            for (int m = 0; m < 4; ++m) {
                const int ch = gch * 128 + 64 * wr + 16 * m + fr;
                bf16* dst = ZT + ((size_t)b * 512 + ch) * (2 * NP) + ai * NP + u.pn * 256;
#pragma unroll
                for (int bj = 0; bj < 2; ++bj)
#pragma unroll
                    for (int n = 0; n < 2; ++n) *(u32x2*)(dst + 128 * bj + 32 * wc + 16 * n + 4 * fq) = pk4(acc[ai][bj][m][n]);
            }
        return false;
    }
};

struct EpiMerge {
    const unsigned char* G8; bf16* MB;
    __device__ __forceinline__ bool operator()(Acc& acc, const Unit& u, int wr, int wc, int fr_, int fq_) const {
        int fr = fr_, fq = fq_; asm volatile("" : "+v"(fr), "+v"(fq));
        const int kb = u.kb; const int c0 = u.pn * 256 + 32 * wc + 8 * fq;
        const unsigned char* gp0 = G8 + ((size_t)u.pm * 256 + 64 * wr + fr) * 3072 + c0;
        if (kb < 2) {
            u32x2 wa[2][4][2], wb[2][4][2];
#pragma unroll
            for (int ai = 0; ai < 2; ++ai)
#pragma unroll
                for (int m = 0; m < 4; ++m)
#pragma unroll
                    for (int bj = 0; bj < 2; ++bj) { const unsigned char* gp = gp0 + (size_t)(128 * ai + 16 * m) * 3072 + 128 * bj;
                        wa[ai][m][bj] = *(const u32x2*)(gp + kb * 1024); wb[ai][m][bj] = *(const u32x2*)(gp + (kb + 1) * 1024); }
#pragma unroll
            for (int ai = 0; ai < 2; ++ai)
#pragma unroll
                for (int m = 0; m < 4; ++m)
#pragma unroll
                    for (int bj = 0; bj < 2; ++bj)
#pragma unroll
                        for (int n = 0; n < 2; ++n) { const f32x4 ga = uq8x4(n ? wa[ai][m][bj].y : wa[ai][m][bj].x), gb = uq8x4(n ? wb[ai][m][bj].y : wb[ai][m][bj].x);
                            f32x4 r; r[0] = ga[0] * __builtin_amdgcn_rcpf(gb[0]); r[1] = ga[1] * __builtin_amdgcn_rcpf(gb[1]); r[2] = ga[2] * __builtin_amdgcn_rcpf(gb[2]); r[3] = ga[3] * __builtin_amdgcn_rcpf(gb[3]); acc[ai][bj][m][n] *= r; }
            return true;
        }
        u32x2 wg[2][4][2];
#pragma unroll
        for (int ai = 0; ai < 2; ++ai)
#pragma unroll
            for (int m = 0; m < 4; ++m)
#pragma unroll
                for (int bj = 0; bj < 2; ++bj) wg[ai][m][bj] = *(const u32x2*)(gp0 + (size_t)(128 * ai + 16 * m) * 3072 + 128 * bj + 2048);
#pragma unroll
        for (int ai = 0; ai < 2; ++ai)
#pragma unroll
            for (int m = 0; m < 4; ++m) {
                const size_t row = (size_t)u.pm * 256 + 128 * ai + 64 * wr + 16 * m + fr;
#pragma unroll
                for (int bj = 0; bj < 2; ++bj) { const f32x4 g0 = uq8x4(wg[ai][m][bj].x) * (1.0f / 255.0f), g1 = uq8x4(wg[ai][m][bj].y) * (1.0f / 255.0f);
                    *(u32x4*)(MB + row * 1024 + c0 + 128 * bj) = pk8(acc[ai][bj][m][0] * g0, acc[ai][bj][m][1] * g1); }
            }
        return false;
    }
};

struct EpiRes {
    const float *xin_lat, *xin_ctx; float *xout_lat, *xout_ctx; const float* gate;
    __device__ __forceinline__ bool operator()(Acc& acc, const Unit& u, int wr, int wc, int fr_, int fq_) const {
        int fr = fr_, fq = fq_; asm volatile("" : "+v"(fr), "+v"(fq));
        const RowInfo ri = row_info(u.pm); const int s = ri.ctx ? 8 : ri.b;
        const int c0 = u.pn * 256 + 32 * wc + 4 * fq;
        const float* xin = ri.ctx ? xin_ctx + (size_t)(u.pm - 64) * 256 * 1024 : xin_lat + (size_t)u.pm * 256 * 1024;
        float* xout = ri.ctx ? xout_ctx + (size_t)(u.pm - 64) * 256 * 1024 : xout_lat + (size_t)u.pm * 256 * 1024;
        f32x4 gv[2][2];
#pragma unroll
        for (int bj = 0; bj < 2; ++bj)
#pragma unroll
            for (int n = 0; n < 2; ++n) gv[bj][n] = *(const f32x4*)(gate + s * 6144 + c0 + 128 * bj + 16 * n);
#pragma unroll
        for (int ai = 0; ai < 2; ++ai) {
            f32x4 xi[4][2][2];
#pragma unroll
            for (int m = 0; m < 4; ++m)
#pragma unroll
                for (int bj = 0; bj < 2; ++bj)
#pragma unroll
                    for (int n = 0; n < 2; ++n) xi[m][bj][n] = *(const f32x4*)(xin + (size_t)(128 * ai + 64 * wr + 16 * m + fr) * 1024 + c0 + 128 * bj + 16 * n);
#pragma unroll
            for (int m = 0; m < 4; ++m)
#pragma unroll
                for (int bj = 0; bj < 2; ++bj)
#pragma unroll
                    for (int n = 0; n < 2; ++n) *(f32x4*)(xout + (size_t)(128 * ai + 64 * wr + 16 * m + fr) * 1024 + c0 + 128 * bj + 16 * n) = xi[m][bj][n] + gv[bj][n] * acc[ai][bj][m][n];
            asm volatile("" ::: "memory");
        }
        return false;
    }
};

struct EpiSwiglu {
    bf16* ACT;
    __device__ __forceinline__ bool operator()(Acc& acc, const Unit& u, int wr, int wc, int fr_, int fq_) const {
        int fr = fr_, fq = fq_; asm volatile("" : "+v"(fr), "+v"(fq));
#pragma unroll
        for (int ai = 0; ai < 2; ++ai)
#pragma unroll
            for (int m = 0; m < 4; ++m) {
                const size_t row = (size_t)u.pm * 256 + 128 * ai + 64 * wr + 16 * m + fr;
                f32x4 o[2];
#pragma unroll
                for (int n = 0; n < 2; ++n) { const f32x4 gt = acc[ai][0][m][n], up = acc[ai][1][m][n];
                    o[n][0] = gt[0] * sigmoidf_(gt[0]) * up[0]; o[n][1] = gt[1] * sigmoidf_(gt[1]) * up[1]; o[n][2] = gt[2] * sigmoidf_(gt[2]) * up[2]; o[n][3] = gt[3] * sigmoidf_(gt[3]) * up[3]; }
                *(u32x4*)(ACT + row * FFH + u.pn * 128 + 32 * wc + 8 * fq) = pk8(o[0], o[1]);
            }
        return false;
    }
};

namespace att {
constexpr int KSLOT = 12288, VSLOT = 8192;
constexpr int L_K = 0, L_V = 2 * KSLOT, L_WS = L_V + 2 * VSLOT, L_OST = L_WS + NWAVES * 64 * 4, L_BYTES = L_OST + NWAVES * 4096;
__device__ __forceinline__ int crow(int r, int hi) { return (r & 3) + 8 * (r >> 2) + 4 * hi; }
__device__ __forceinline__ float max3f(float a, float b, float c) { return __builtin_fmaxf(__builtin_fmaxf(a, b), c); }
__device__ __forceinline__ float rowmax(const f32x16& p0, const f32x16& p1) {
    float a = max3f(p0[0], p0[1], p1[0]), b = max3f(p0[2], p0[3], p1[1]); a = max3f(a, p1[2], p1[3]);
#pragma unroll
    for (int r = 4; r < 16; r += 4) { a = max3f(a, p0[r], p0[r + 1]); b = max3f(b, p0[r + 2], p0[r + 3]); a = max3f(a, p1[r], p1[r + 1]); b = max3f(b, p1[r + 2], p1[r + 3]); }
    const float m = __builtin_fmaxf(a, b);
    auto rr = __builtin_amdgcn_permlane32_swap(__float_as_uint(m), __float_as_uint(m), false, false);
    return __builtin_fmaxf(__uint_as_float(rr[0]), __uint_as_float(rr[1]));
}
__device__ __forceinline__ void pv(f32x16* o, int vb, bf16x8 pa0, bf16x8 pa1, bf16x8 pa2, bf16x8 pa3) {
#pragma unroll
    for (int d0 = 0; d0 < 2; ++d0) { s16x4 lo[4], hi[4];
#pragma unroll
        for (int ks = 0; ks < 4; ++ks) {
            asm volatile("ds_read_b64_tr_b16 %0,%1 offset:%c2" : "=&v"(lo[ks]) : "v"(vb), "i"(d0 * 4096 + ks * 1024) : "memory");
            asm volatile("ds_read_b64_tr_b16 %0,%1 offset:%c2" : "=&v"(hi[ks]) : "v"(vb), "i"(d0 * 4096 + ks * 1024 + 512) : "memory"); }
        asm volatile("s_waitcnt lgkmcnt(0)" ::: "memory"); __builtin_amdgcn_sched_barrier(0);
#define PK(k) (bf16x8){lo[k][0], lo[k][1], lo[k][2], lo[k][3], hi[k][0], hi[k][1], hi[k][2], hi[k][3]}
        o[d0] = __builtin_amdgcn_mfma_f32_32x32x16_bf16(pa0, PK(0), o[d0], 0, 0, 0);
        o[d0] = __builtin_amdgcn_mfma_f32_32x32x16_bf16(pa1, PK(1), o[d0], 0, 0, 0);
        o[d0] = __builtin_amdgcn_mfma_f32_32x32x16_bf16(pa2, PK(2), o[d0], 0, 0, 0);
        o[d0] = __builtin_amdgcn_mfma_f32_32x32x16_bf16(pa3, PK(3), o[d0], 0, 0, 0);
#undef PK
    }
}
template <int DQK>
__device__ __forceinline__ void attn_unit(const bf16* Qn, int pqn, const bf16* Qr, int pqr, const bf16* Kh, int pk, const bf16* Vh, int pv_, bf16* O, int po, int NT, LAS unsigned char* shm) {
    constexpr int ND = DQK / 16, NCH = DQK / 8;
    int tid = threadIdx.x; asm volatile("" : "+v"(tid));
    const int lane = tid & 63, r32 = lane & 31, hi = lane >> 5; const int wid = __builtin_amdgcn_readfirstlane(tid >> 6);
    LAS float* wsf = (LAS float*)(shm + L_WS) + wid * 64;
    const bf16* ksrc = Kh + (size_t)lane * pk + wid * 8;
    const bf16* vsrc = Vh + (size_t)(16 * (wid & 3) + (lane >> 2)) * pv_ + (wid >> 2) * 32 + (lane & 3) * 8;
    const int vb0 = (int)(unsigned)(uintptr_t)(shm + L_V) + ((lane >> 4) & 1) * 32 + (lane & 3) * 8 + (4 * hi + ((lane & 15) >> 2)) * 64;
    const LAS unsigned char* kp0 = shm + L_K + hi * 1024 + r32 * 16;
#define DMA_TILE(t, buf) do { \
        __builtin_amdgcn_global_load_lds((const unsigned*)(ksrc + (size_t)(t) * 64 * pk), (LAS unsigned*)(shm + L_K + (buf) * KSLOT + wid * 1024), 16, 0, 0); \
        if (NCH > 8 && wid < NCH - 8) __builtin_amdgcn_global_load_lds((const unsigned*)(ksrc + (size_t)(t) * 64 * pk + 64), (LAS unsigned*)(shm + L_K + (buf) * KSLOT + (wid + 8) * 1024), 16, 0, 0); \
        __builtin_amdgcn_global_load_lds((const unsigned*)(vsrc + (size_t)(t) * 64 * pv_), (LAS unsigned*)(shm + L_V + (buf) * VSLOT + wid * 1024), 16, 0, 0); } while (0)
    DMA_TILE(0, 0);
    bf16x8 qr[ND];
#pragma unroll
    for (int d0 = 0; d0 < 4; ++d0) qr[d0] = *(const bf16x8*)(Qn + (size_t)(wid * 32 + r32) * pqn + d0 * 16 + hi * 8);
    if (ND > 4) {
#pragma unroll
        for (int d0 = 4; d0 < ND; ++d0) qr[d0] = *(const bf16x8*)(Qr + (size_t)(wid * 32 + r32) * pqr + (d0 - 4) * 16 + hi * 8);
    }
    float mrun = -1e30f, l_reg = 0.f; f32x16 o[2]; o[0] = f32x16{}; o[1] = f32x16{};
    for (int t = 0; t < NT; ++t) {
        const int buf = t & 1;
        asm volatile("s_waitcnt vmcnt(0)" ::: "memory");
        __syncthreads();
        if (t + 1 < NT) DMA_TILE(t + 1, buf ^ 1);
        f32x16 p0 = f32x16{}, p1 = f32x16{};
        const LAS unsigned char* kp = kp0 + buf * KSLOT;
#pragma unroll
        for (int d0 = 0; d0 < ND; ++d0) {
            const bf16x8 b0 = *(const LAS bf16x8*)(kp + d0 * 2048), b1 = *(const LAS bf16x8*)(kp + d0 * 2048 + 512);
            p0 = __builtin_amdgcn_mfma_f32_32x32x16_bf16(b0, qr[d0], p0, 0, 0, 0); p1 = __builtin_amdgcn_mfma_f32_32x32x16_bf16(b1, qr[d0], p1, 0, 0, 0);
        }
        const float rm = rowmax(p0, p1);
        if (__any(rm > mrun)) {
            const float mn = __builtin_fmaxf(mrun, rm), al = __builtin_amdgcn_exp2f(mrun - mn); mrun = mn; l_reg *= al;
            if (hi == 0) wsf[r32] = al;
            asm volatile("s_waitcnt lgkmcnt(0)" ::: "memory");
#pragma unroll
            for (int r = 0; r < 16; ++r) { const float f = wsf[crow(r, hi)]; o[0][r] *= f; o[1][r] *= f; }
        }
        float sacc = 0.f;
#pragma unroll
        for (int r = 0; r < 16; ++r) { p0[r] = __builtin_amdgcn_exp2f(p0[r] - mrun); p1[r] = __builtin_amdgcn_exp2f(p1[r] - mrun); sacc += p0[r] + p1[r]; }
        l_reg += sacc;
        u32x4 w0, w1, w2, w3;
        w0 = (u32x4){cvtpk(p0[0], p0[1]), cvtpk(p0[2], p0[3]), cvtpk(p0[4], p0[5]), cvtpk(p0[6], p0[7])};
        w1 = (u32x4){cvtpk(p0[8], p0[9]), cvtpk(p0[10], p0[11]), cvtpk(p0[12], p0[13]), cvtpk(p0[14], p0[15])};
        w2 = (u32x4){cvtpk(p1[0], p1[1]), cvtpk(p1[2], p1[3]), cvtpk(p1[4], p1[5]), cvtpk(p1[6], p1[7])};
        w3 = (u32x4){cvtpk(p1[8], p1[9]), cvtpk(p1[10], p1[11]), cvtpk(p1[12], p1[13]), cvtpk(p1[14], p1[15])};
        pv(o, vb0 + buf * VSLOT, __builtin_bit_cast(bf16x8, w0), __builtin_bit_cast(bf16x8, w1), __builtin_bit_cast(bf16x8, w2), __builtin_bit_cast(bf16x8, w3));
    }
#undef DMA_TILE
    { auto rr = __builtin_amdgcn_permlane32_swap(__float_as_uint(l_reg), __float_as_uint(l_reg), false, false); l_reg = __uint_as_float(rr[0]) + __uint_as_float(rr[1]); }
    if (hi == 0) wsf[32 + r32] = l_reg;
    asm volatile("s_waitcnt lgkmcnt(0)" ::: "memory");
    float rli[16];
#pragma unroll
    for (int r = 0; r < 16; ++r) rli[r] = __builtin_amdgcn_rcpf(wsf[32 + crow(r, hi)]);
    LAS bf16* stg = (LAS bf16*)(shm + L_OST) + wid * 2048;
#pragma unroll
    for (int r = 0; r < 16; ++r) { const int orow = crow(r, hi);
#pragma unroll
        for (int d0 = 0; d0 < 2; ++d0) stg[orow * 64 + d0 * 32 + r32] = (bf16)(cvtpk(o[d0][r] * rli[r], 0.f) & 0xffffu); }
    asm volatile("s_waitcnt lgkmcnt(0)" ::: "memory");
    bf16* Ow = O + (size_t)(wid * 32) * po;
#pragma unroll
    for (int i = 0; i < 4; ++i) { const int row = i * 8 + (lane >> 3), ch = lane & 7; const u32x4 v = *(const LAS u32x4*)(stg + row * 64 + ch * 8); *(u32x4*)(Ow + (size_t)row * po + ch * 8) = v; }
    asm volatile("s_waitcnt lgkmcnt(0)" ::: "memory");
    __syncthreads();
}
}


namespace attq {
using att::crow;
constexpr int NSLOT = 3;
#define SBAR() __builtin_amdgcn_sched_barrier(0)
__device__ __forceinline__ void glds16(const void* gsrc, unsigned lds_dst) { unsigned keep;
    asm volatile("s_mov_b32 %0, m0\n\ts_mov_b32 m0, %2\n\ts_nop 0\n\tglobal_load_lds_dwordx4 %1, off\n\ts_mov_b32 m0, %0" : "=&s"(keep) : "v"(gsrc), "s"(lds_dst) : "memory"); }
__device__ __forceinline__ float max3f(float a, float b, float c) { float r; asm("v_max3_f32 %0, %1, %2, %3" : "=v"(r) : "v"(a), "v"(b), "v"(c)); return r; }
__device__ __forceinline__ float max2f(float a, float b) { float r; asm("v_max_f32_e32 %0, %1, %2" : "=v"(r) : "v"(a), "v"(b)); return r; }
__device__ __forceinline__ float fadd_s(float a, float b) { float r; asm("v_add_f32_e32 %0, %1, %2" : "=v"(r) : "v"(a), "v"(b)); return r; }
__device__ __forceinline__ float fsub_s(float a, float b) { float r; asm("v_sub_f32_e32 %0, %1, %2" : "=v"(r) : "v"(a), "v"(b)); return r; }
template <int N> __device__ __forceinline__ void wait_bar() { asm volatile("s_waitcnt vmcnt(%0) lgkmcnt(0)\n\ts_barrier" :: "n"(N) : "memory"); }
#define WAIT_BAR(N) wait_bar<(N)>()
template <int ND> __device__ __forceinline__ void qkt(f32x16& p0, f32x16& p1, const char* Kslot, const bf16x8* qr, const f32x16& negm, int r32, int hi) {
    const char* kb = Kslot + hi * 1024 + r32 * 16;
#pragma unroll
    for (int d0 = 0; d0 < ND; ++d0) {
        const bf16x8 b0 = *reinterpret_cast<const bf16x8*>(kb + d0 * 2048);
        const bf16x8 b1 = *reinterpret_cast<const bf16x8*>(kb + d0 * 2048 + 512);
        if (d0 == 0) { p0 = __builtin_amdgcn_mfma_f32_32x32x16_bf16(b0, qr[0], negm, 0, 0, 0); p1 = __builtin_amdgcn_mfma_f32_32x32x16_bf16(b1, qr[0], negm, 0, 0, 0); }
        else { p0 = __builtin_amdgcn_mfma_f32_32x32x16_bf16(b0, qr[d0], p0, 0, 0, 0); p1 = __builtin_amdgcn_mfma_f32_32x32x16_bf16(b1, qr[d0], p1, 0, 0, 0); } }
}
typedef __attribute__((address_space(3))) const char* lds_cptr;
typedef short v4i16_t __attribute__((ext_vector_type(4)));
template <int ND> __device__ __forceinline__ void kloadall(bf16x8* kf, lds_cptr kp) {
    kf[0] = *(const LAS bf16x8*)(kp);        kf[1] = *(const LAS bf16x8*)(kp + 512);
    kf[2] = *(const LAS bf16x8*)(kp + 2048); kf[3] = *(const LAS bf16x8*)(kp + 2560);
    kf[4] = *(const LAS bf16x8*)(kp + 4096); kf[5] = *(const LAS bf16x8*)(kp + 4608);
    kf[6] = *(const LAS bf16x8*)(kp + 6144); kf[7] = *(const LAS bf16x8*)(kp + 6656);
    if constexpr (ND == 6) { kf[8] = *(const LAS bf16x8*)(kp + 8192); kf[9] = *(const LAS bf16x8*)(kp + 8704); kf[10] = *(const LAS bf16x8*)(kp + 10240); kf[11] = *(const LAS bf16x8*)(kp + 10752); }
}
__device__ __forceinline__ void kload2(bf16x8* kf, lds_cptr kp, int j) { kf[2 * j] = *(const LAS bf16x8*)(kp + j * 2048); kf[2 * j + 1] = *(const LAS bf16x8*)(kp + j * 2048 + 512); }
__device__ __forceinline__ s16x4 vtr(lds_cptr p) { return __builtin_bit_cast(s16x4, __builtin_amdgcn_ds_read_tr16_b64_v4i16((LAS v4i16_t*)p)); }
__device__ __forceinline__ float rowmax(const f32x16& p0, const f32x16& p1) {
    float a = max3f(p0[0], p0[1], p1[0]), b = max3f(p0[2], p0[3], p1[1]); a = max3f(a, p1[2], p1[3]);
#pragma unroll
    for (int r = 4; r < 16; r += 4) { a = max3f(a, p0[r], p0[r + 1]); b = max3f(b, p0[r + 2], p0[r + 3]); a = max3f(a, p1[r], p1[r + 1]); b = max3f(b, p1[r + 2], p1[r + 3]); }
    const float m = max2f(a, b);
    auto rr = __builtin_amdgcn_permlane32_swap(__float_as_uint(m), __float_as_uint(m), false, false);
    return max2f(__uint_as_float(rr[0]), __uint_as_float(rr[1]));
}
template <int ND, int THRL>
__device__ __forceinline__ void attn_unit(const bf16* Q, int pq, const bf16* Qr, int pqr, const bf16* __restrict__ Kh, int pk, const bf16* __restrict__ Vh, int pkv, bf16* O, int po, int NT, char* shm) {
    constexpr int SLOTB = (ND == 6) ? 12288 : 8192, KD = (ND == 6) ? 2 : 1;
    constexpr int LDS_K = 0, LDS_V = NSLOT * SLOTB, LDS_WS = 2 * NSLOT * SLOTB, LDS_OST = LDS_WS + NWAVES * 64 * 4;
    int tid = threadIdx.x; asm volatile("" : "+v"(tid));
    const int lane = tid & 63, r32 = lane & 31, hi = lane >> 5; const int wid = __builtin_amdgcn_readfirstlane(tid >> 6);
    const bf16* Qw = Q + (size_t)(wid * 32) * pq;
    const unsigned lds0 = (unsigned)(uintptr_t)shm;
    float* wsf = (float*)(shm + LDS_WS) + wid * 64;
    const bf16* ksrc = Kh + (size_t)lane * pk + wid * 8;
    const bf16* ksrc2 = Kh + (size_t)lane * pk + (8 + (wid & 3)) * 8;
    const unsigned kdst2 = lds0 + LDS_K + (8 + (wid & 3)) * 1024; (void)ksrc2; (void)kdst2;
    const bf16* vsrc = Vh + (size_t)(16 * (wid & 3) + (lane >> 2)) * pkv + (wid >> 2) * 32 + (lane & 3) * 8;
    const unsigned kdst = lds0 + LDS_K + wid * 1024, vdst = lds0 + LDS_V + wid * 1024;
#define DMA_K(t, slot) do { glds16(ksrc + (size_t)(t) * 64 * pk, (unsigned)__builtin_amdgcn_readfirstlane(kdst + (slot))); if constexpr (ND == 6) glds16(ksrc2 + (size_t)(t) * 64 * pk, (unsigned)__builtin_amdgcn_readfirstlane(kdst2 + (slot))); } while (0)
#define DMA_V(t, slot) glds16(vsrc + (size_t)(t) * 64 * pkv, (unsigned)__builtin_amdgcn_readfirstlane(vdst + (slot)))
    const int vb0 = (int)(lds0 + LDS_V) + ((lane >> 4) & 1) * 32 + (lane & 3) * 8 + (4 * hi + ((lane & 15) >> 2)) * 64;
    const char* Kbase = shm + LDS_K; bf16x8 kf[2 * ND];
    const lds_cptr shm3 = (lds_cptr)shm; const lds_cptr kp0 = shm3 + LDS_K + hi * 1024 + r32 * 16; const lds_cptr vp0 = shm3 + LDS_V + ((lane >> 4) & 1) * 32 + (lane & 3) * 8 + (4 * hi + ((lane & 15) >> 2)) * 64;
    DMA_K(0, 0); DMA_V(0, 0); DMA_K(1, SLOTB);
    bf16x8 qr[ND];
#pragma unroll
    for (int d0 = 0; d0 < 4; ++d0) qr[d0] = *reinterpret_cast<const bf16x8*>(&Qw[(size_t)r32 * pq + d0 * 16 + hi * 8]);
    if constexpr (ND == 6) {
#pragma unroll
        for (int d0 = 4; d0 < 6; ++d0) qr[d0] = *reinterpret_cast<const bf16x8*>(&Qr[(size_t)(wid * 32 + r32) * pqr + (d0 - 4) * 16 + hi * 8]); }
    float mhat = 0.f, l_reg = 0.f; f32x16 o[2]; o[0] = f32x16{}; o[1] = f32x16{}; f32x16 negm = f32x16{}; asm volatile("" : "+v"(negm));
    bool resc = false;
#define START(P0, P1) do { const float rm = rowmax(P0, P1); resc = false; \
    { const float dl = rm; mhat = fadd_s(mhat, dl); \
      _Pragma("unroll") for (int r = 0; r < 16; ++r) { P0[r] = fsub_s(P0[r], dl); P1[r] = fsub_s(P1[r], dl); } \
      _Pragma("unroll") for (int r = 0; r < 16; ++r) negm[r] = -mhat; asm volatile("" : "+v"(negm)); } \
    _Pragma("unroll") for (int r = 0; r < 16; ++r) P0[r] = __builtin_amdgcn_exp2f(P0[r]); } while (0)
#define RESC() do { if (resc) { asm volatile("s_waitcnt lgkmcnt(0)" ::: "memory"); \
      _Pragma("unroll") for (int d_ = 0; d_ < 2; ++d_) _Pragma("unroll") for (int r = 0; r < 16; ++r) o[d_][r] *= wsf[crow(r, hi)]; } } while (0)
    f32x16 pA0, pA1, pB0, pB1;
    int sl_prev = 0, sl_cur = 0, sl_next = SLOTB;
#define ROT() do { sl_prev = sl_cur; sl_cur = sl_next; sl_next = (sl_next == (NSLOT - 1) * SLOTB) ? 0 : sl_next + SLOTB; } while (0)
    DMA_K(2, 2 * SLOTB);
    WAIT_BAR(1 + 2 * KD);
    qkt<ND>(pA0, pA1, Kbase, qr, negm, r32, hi); asm volatile("s_nop 15\n\ts_nop 7" : "+v"(pA0), "+v"(pA1));
    START(pA0, pA1);
    _Pragma("unroll") for (int r = 0; r < 16; ++r) pA1[r] = __builtin_amdgcn_exp2f(pA1[r]);
    WAIT_BAR(0);
    DMA_K(3, 0); DMA_V(1, SLOTB);
    ROT();
    kloadall<ND>(kf, kp0 + sl_cur);
    WAIT_BAR(KD + 1);
    s16x4 vlo[8], vhi[8]; u32x4 pw0, pw1, pw2, pw3;
#define PKW(P, B) cvtpk(P[B], P[B + 1])
#define PAF(k) __builtin_bit_cast(bf16x8, pw##k)
#define VFR(i) (bf16x8){vlo[i][0], vlo[i][1], vlo[i][2], vlo[i][3], vhi[i][0], vhi[i][1], vhi[i][2], vhi[i][3]}
#define PIN(x) asm volatile("" : "+v"(x))
#define MX3(a, b, c) __builtin_fmaxf(__builtin_fmaxf((a), (b)), (c))
#define GAPA(MF, A0, A1, A2, A3, W0, W1, PW) do { MF; sacc += A0; sacc += A1; sacc += A2; sacc += A3; PIN(sacc); W0; W1; PIN(PW); SBAR(); } while (0)
#define EX(v) __builtin_amdgcn_exp2f(v)
#define GAPB(MF, X, B) do { MF; X[B] = EX(X[B]); X[B + 1] = EX(X[B + 1]); X[B + 2] = EX(X[B + 2]); X[B + 3] = EX(X[B + 3]); PIN(X); SBAR(); } while (0)
#define VRD(i) do { vlo[i] = vtr(vp_ + (((i) >> 2) * 4096 + ((i) & 3) * 1024)); vhi[i] = vtr(vp_ + (((i) >> 2) * 4096 + ((i) & 3) * 1024 + 512)); } while (0)
#define KRD(G, j) do { if (G) { kload2(kf, kp0 + sl_next, j); SBAR(); } } while (0)
#define STEP(C0, C1, P0, P1, t, GK, GV, GL) do { SBAR(); \
    const lds_cptr vp_ = vp0 + sl_prev; \
    VRD(0); SBAR(); float sacc = (P0[0] + P0[1]); \
    GAPA(C0 = __builtin_amdgcn_mfma_f32_32x32x16_bf16(kf[0], qr[0], negm, 0, 0, 0), P0[2], P0[3], P0[4], P0[5],     pw0[0] = PKW(P0, 0), pw0[1] = PKW(P0, 2), pw0); \
    VRD(4); SBAR(); GAPA(C1 = __builtin_amdgcn_mfma_f32_32x32x16_bf16(kf[1], qr[0], negm, 0, 0, 0), P0[6], P0[7], P0[8], P0[9],     pw0[2] = PKW(P0, 4), pw0[3] = PKW(P0, 6), pw0); \
    VRD(1); SBAR(); GAPA(C0 = __builtin_amdgcn_mfma_f32_32x32x16_bf16(kf[2], qr[1], C0, 0, 0, 0),   P0[10], P0[11], P0[12], P0[13], pw1[0] = PKW(P0, 8), pw1[1] = PKW(P0, 10), pw1); \
    VRD(5); SBAR(); GAPA(C1 = __builtin_amdgcn_mfma_f32_32x32x16_bf16(kf[3], qr[1], C1, 0, 0, 0),   P0[14], P0[15], P1[0], P1[1],   pw1[2] = PKW(P0, 12), pw1[3] = PKW(P0, 14), pw1); \
    VRD(2); SBAR(); GAPA(C0 = __builtin_amdgcn_mfma_f32_32x32x16_bf16(kf[4], qr[2], C0, 0, 0, 0),   P1[2], P1[3], P1[4], P1[5],     pw2[0] = PKW(P1, 0), pw2[1] = PKW(P1, 2), pw2); \
    VRD(6); SBAR(); GAPA(C1 = __builtin_amdgcn_mfma_f32_32x32x16_bf16(kf[5], qr[2], C1, 0, 0, 0),   P1[6], P1[7], P1[8], P1[9],     pw2[2] = PKW(P1, 4), pw2[3] = PKW(P1, 6), pw2); \
    VRD(3); SBAR(); GAPA(C0 = __builtin_amdgcn_mfma_f32_32x32x16_bf16(kf[6], qr[3], C0, 0, 0, 0),   P1[10], P1[11], P1[12], P1[13], pw3[0] = PKW(P1, 8), pw3[1] = PKW(P1, 10), pw3); \
    VRD(7); SBAR(); GAPA(C1 = __builtin_amdgcn_mfma_f32_32x32x16_bf16(kf[7], qr[3], C1, 0, 0, 0),   P1[14], P1[15], 0.f, 0.f,       pw3[2] = PKW(P1, 12), pw3[3] = PKW(P1, 14), pw3); \
    if constexpr (ND == 6) { C0 = __builtin_amdgcn_mfma_f32_32x32x16_bf16(kf[8], qr[4], C0, 0, 0, 0); SBAR(); C1 = __builtin_amdgcn_mfma_f32_32x32x16_bf16(kf[9], qr[4], C1, 0, 0, 0); SBAR(); \
      C0 = __builtin_amdgcn_mfma_f32_32x32x16_bf16(kf[10], qr[5], C0, 0, 0, 0); SBAR(); C1 = __builtin_amdgcn_mfma_f32_32x32x16_bf16(kf[11], qr[5], C1, 0, 0, 0); SBAR(); } \
    l_reg += sacc; \
    if (GK) { DMA_K((t) + 3, sl_cur); } if (GV) { DMA_V((t) + 1, sl_next); } \
    { float a = MX3(C0[0], C0[1], C1[0]), b = MX3(C0[2], C0[3], C1[1]); a = MX3(a, C1[2], C1[3]); \
      _Pragma("unroll") for (int r = 4; r < 16; r += 4) { a = MX3(a, C0[r], C0[r + 1]); b = MX3(b, C0[r + 2], C0[r + 3]); a = MX3(a, C1[r], C1[r + 1]); b = MX3(b, C1[r + 2], C1[r + 3]); } \
      float rm = __builtin_fmaxf(a, b); { auto rr = __builtin_amdgcn_permlane32_swap(__float_as_uint(rm), __float_as_uint(rm), false, false); rm = __builtin_fmaxf(__uint_as_float(rr[0]), __uint_as_float(rr[1])); } \
      resc = false; \
      if (__builtin_expect(__any(rm > (float)THRL), 0)) { const float dl = __builtin_fmaxf(rm, 0.f); mhat += dl; \
        _Pragma("unroll") for (int r = 0; r < 16; ++r) { C0[r] -= dl; C1[r] -= dl; } \
        _Pragma("unroll") for (int r = 0; r < 16; ++r) negm[r] = -mhat; asm volatile("" : "+v"(negm)); \
        const float f = __builtin_amdgcn_exp2f(-dl); l_reg *= f; if (hi == 0) wsf[r32] = f; resc = true; } } \
    SBAR(); \
    GAPB(o[0] = __builtin_amdgcn_mfma_f32_32x32x16_bf16(PAF(0), VFR(0), o[0], 0, 0, 0), C0, 0); \
    GAPB(o[1] = __builtin_amdgcn_mfma_f32_32x32x16_bf16(PAF(0), VFR(4), o[1], 0, 0, 0), C0, 4); \
    KRD(GL, 0); GAPB(o[0] = __builtin_amdgcn_mfma_f32_32x32x16_bf16(PAF(1), VFR(1), o[0], 0, 0, 0), C0, 8); \
    KRD(GL, 1); GAPB(o[1] = __builtin_amdgcn_mfma_f32_32x32x16_bf16(PAF(1), VFR(5), o[1], 0, 0, 0), C0, 12); \
    KRD(GL, 2); GAPB(o[0] = __builtin_amdgcn_mfma_f32_32x32x16_bf16(PAF(2), VFR(2), o[0], 0, 0, 0), C1, 0); \
    KRD(GL, 3); GAPB(o[1] = __builtin_amdgcn_mfma_f32_32x32x16_bf16(PAF(2), VFR(6), o[1], 0, 0, 0), C1, 4); \
    if constexpr (ND == 6) { KRD(GL, 4); } GAPB(o[0] = __builtin_amdgcn_mfma_f32_32x32x16_bf16(PAF(3), VFR(3), o[0], 0, 0, 0), C1, 8); \
    if constexpr (ND == 6) { KRD(GL, 5); } GAPB(o[1] = __builtin_amdgcn_mfma_f32_32x32x16_bf16(PAF(3), VFR(7), o[1], 0, 0, 0), C1, 12); \
    } while (0)
    int t = 1;
    for (; t + 5 < NT; t += 2) {
        STEP(pB0, pB1, pA0, pA1, t, true, true, true);     WAIT_BAR(KD + 1); RESC(); ROT();
        STEP(pA0, pA1, pB0, pB1, t + 1, true, true, true); WAIT_BAR(KD + 1); RESC(); ROT();
    }
#define ENDW(tt) do { if ((tt) + 3 < NT) { WAIT_BAR(KD + 1); } else if ((tt) + 2 < NT) { WAIT_BAR(1); } else { WAIT_BAR(0); } } while (0)
    for (; t + 1 < NT; t += 2) {
        STEP(pB0, pB1, pA0, pA1, t, (t + 3 < NT), (t + 1 < NT), (t + 1 < NT));     ENDW(t);     RESC(); ROT();
        STEP(pA0, pA1, pB0, pB1, t + 1, (t + 4 < NT), (t + 2 < NT), (t + 2 < NT)); ENDW(t + 1); RESC(); ROT();
    }
    STEP(pB0, pB1, pA0, pA1, NT - 1, false, false, false); RESC();
    { float sacc = pB0[0] + pB0[1]; _Pragma("unroll") for (int r = 2; r < 16; ++r) sacc += pB0[r]; _Pragma("unroll") for (int r = 0; r < 16; ++r) sacc += pB1[r]; l_reg += sacc;
      pw0 = (u32x4){PKW(pB0, 0), PKW(pB0, 2), PKW(pB0, 4), PKW(pB0, 6)}; pw1 = (u32x4){PKW(pB0, 8), PKW(pB0, 10), PKW(pB0, 12), PKW(pB0, 14)}; pw2 = (u32x4){PKW(pB1, 0), PKW(pB1, 2), PKW(pB1, 4), PKW(pB1, 6)}; pw3 = (u32x4){PKW(pB1, 8), PKW(pB1, 10), PKW(pB1, 12), PKW(pB1, 14)};
      SBAR(); att::pv(o, vb0 + sl_cur, PAF(0), PAF(1), PAF(2), PAF(3)); }
#undef PKW
#undef PAF
#undef VFR
#undef PIN
#undef MX3
#undef GAPA
#undef GAPB
#undef EX
#undef VRD
#undef KRD
#undef STEP
#undef ENDW
    { auto rr = __builtin_amdgcn_permlane32_swap(__float_as_uint(l_reg), __float_as_uint(l_reg), false, false); l_reg = __uint_as_float(rr[0]) + __uint_as_float(rr[1]); }
    if (hi == 0) wsf[32 + r32] = l_reg; asm volatile("s_waitcnt lgkmcnt(0)" ::: "memory");
    float rli[16];
#pragma unroll
    for (int r = 0; r < 16; ++r) rli[r] = __builtin_amdgcn_rcpf(wsf[32 + crow(r, hi)]);
    bf16* Ow = O + (size_t)(wid * 32) * po;
    { bf16* stg = (bf16*)(shm + LDS_OST) + wid * 2048;
#pragma unroll
      for (int r = 0; r < 16; ++r) { const int orow = crow(r, hi);
#pragma unroll
        for (int d0 = 0; d0 < 2; ++d0) stg[orow * 64 + d0 * 32 + r32] = (bf16)(cvtpk(o[d0][r] * rli[r], 0.f) & 0xffffu); }
      asm volatile("s_waitcnt lgkmcnt(0)" ::: "memory");
#pragma unroll
      for (int i = 0; i < 4; ++i) { const int row = i * 8 + (lane >> 3), ch = lane & 7; const u32x4 v = *(const u32x4*)(stg + row * 64 + ch * 8); *(u32x4*)(Ow + (size_t)row * po + ch * 8) = v; } }
    asm volatile("s_waitcnt lgkmcnt(0)\n\ts_barrier" ::: "memory");
#undef DMA_K
#undef DMA_V
#undef START
#undef RESC
#undef ROT
}
#undef SBAR
#undef WAIT_BAR
}

#define RLX_AGENT __ATOMIC_RELAXED, __HIP_MEMORY_SCOPE_AGENT
#define XB_TMO      128
#define XB_XCNT(j)  (256  + 64 * (j))
#define XB_XSUB(j)  (1280 + 64 * (j))
#define XB_XGEN(j)  (2304 + 64 * (j))
#define XB_TOP      3328
#define XB_TOPGEN   3392
#define XCD_BAR_WORDS 3456
#define XB_SPIN_CAP (1u << 18)
__device__ __forceinline__ unsigned xb_ld(unsigned* p)              { return __hip_atomic_load(p, __ATOMIC_RELAXED, __HIP_MEMORY_SCOPE_AGENT); }
__device__ __forceinline__ unsigned xb_add(unsigned* p, unsigned v) { return __hip_atomic_fetch_add(p, v, __ATOMIC_RELAXED, __HIP_MEMORY_SCOPE_AGENT); }
__device__ __forceinline__ unsigned xb_xcc_id() { return (unsigned)__builtin_amdgcn_s_getreg((3 << 11) | 20) & 0xFu; }
#define XB_SPIN(cond, bar) do { unsigned _sp = 0; while (cond) { __builtin_amdgcn_s_sleep(1); \
    if ((++_sp & 255u) == 0u) { if (xb_ld(&(bar)[XB_TMO])) break; if (_sp > XB_SPIN_CAP) { atomicAdd(&(bar)[XB_TMO], 1u); break; } } } } while (0)
struct XcdBarrier { unsigned* bar; unsigned x; volatile LAS unsigned* st; };
__device__ __forceinline__ XcdBarrier xcd_barrier_post(unsigned* bar, volatile LAS unsigned* st) {
    XcdBarrier b; b.bar = bar; b.x = xb_xcc_id(); b.st = st;
    if (threadIdx.x == 0) (void)xb_add(&bar[XB_XCNT(b.x)], 1u);
    return b;
}
__device__ __forceinline__ void xcd_barrier_complete(unsigned* bar, unsigned x, unsigned& nloc, unsigned& nx) {
    const unsigned G = gridDim.x * gridDim.y * gridDim.z;
    unsigned sum, cnt, mine, sp = 0u;
    for (;;) {
        sum = 0u; cnt = 0u; mine = 0u;
#pragma unroll
        for (unsigned j = 0; j < 16; ++j) { const unsigned c = xb_ld(&bar[XB_XCNT(j)]); sum += c; cnt += (c > 0u) ? 1u : 0u; mine = (j == x) ? c : mine; }
        if (sum == G) break;
        __builtin_amdgcn_s_sleep(1);
        if ((++sp & 255u) == 0u) { if (xb_ld(&bar[XB_TMO])) break; if (sp > XB_SPIN_CAP) { atomicAdd(&bar[XB_TMO], 1u); break; } }
    }
    nloc = mine > 0u ? mine : 1u; nx = cnt > 0u ? cnt : 1u;
}
__device__ __forceinline__ void xcd_barrier(const XcdBarrier& b) {
    asm volatile("s_waitcnt vmcnt(0)" ::: "memory");
    __syncthreads();
    if (threadIdx.x == 0) {
        unsigned* bar = b.bar;
        __builtin_amdgcn_s_waitcnt(0);
        unsigned nloc = b.st[0], nx = b.st[1];
        if (nloc == 0u) { xcd_barrier_complete(bar, b.x, nloc, nx); b.st[0] = nloc; b.st[1] = nx; }
        const unsigned old = xb_add(&bar[XB_XSUB(b.x)], 1u);
        const unsigned gen = old / nloc;
        if (old + 1u == (gen + 1u) * nloc) {
            __builtin_amdgcn_fence(__ATOMIC_RELEASE, "agent");
            asm volatile("s_waitcnt vmcnt(0)" ::: "memory");
            const unsigned og = xb_add(&bar[XB_TOP], 1u);
            const unsigned tg = og / nx;
            if (og + 1u == (tg + 1u) * nx) xb_add(&bar[XB_TOPGEN], 1u);
            else XB_SPIN(xb_ld(&bar[XB_TOPGEN]) == tg, bar);
            __builtin_amdgcn_fence(__ATOMIC_ACQUIRE, "agent");
            xb_add(&bar[XB_XGEN(b.x)], 1u);
            asm volatile("s_waitcnt vmcnt(0)" ::: "memory");
        } else {
            XB_SPIN(xb_ld(&bar[XB_XGEN(b.x)]) == gen, bar);
            __builtin_amdgcn_fence(__ATOMIC_ACQUIRE, "agent");
            asm volatile("s_waitcnt vmcnt(0)" ::: "memory");
        }
    }
    __syncthreads();
}
constexpr int LDS_MISC = 131072 + 1024;
constexpr size_t CTL_ZERO_BYTES = 64 * KiB;

struct Args { const float* in[26]; float* out; unsigned char* ws; int ph_lo, ph_hi; };
constexpr int LDS_BYTES = 147456;
constexpr int NPHASE = 21;

typedef const __attribute__((address_space(4))) unsigned char* KP;
__device__ __forceinline__ const float* kin(KP kp, int k) { return *(const float* const __attribute__((address_space(4)))*)(kp + 8 * k); }
__device__ __forceinline__ float* kout(KP kp) { return *(float* const __attribute__((address_space(4)))*)(kp + 208); }
__device__ __forceinline__ unsigned char* kws(KP kp) { return *(unsigned char* const __attribute__((address_space(4)))*)(kp + 216); }
static_assert(sizeof(Args) == 232, "Args layout");
struct Ctx {
    LAS unsigned char* lds; int tid, lane, wave, vcu, G; unsigned char* ws; int cv_rank, cv_n;
};

enum MatId { M_WIN = 0, M_WUQ, M_WUKV, M_NAT, M_FFI, M_NATP };
__device__ __forceinline__ int rope_perm(int p) { const int n = p >> 4, fq = (p >> 2) & 3, j = p & 3; return 16 * (fq >> 1) + 8 * n + 4 * (fq & 1) + j; }
__device__ __forceinline__ int head_perm(int pc, int& wc) { wc = (pc >> 5) & 3; return 32 * (pc >> 7) + (pc & 31); }
__device__ __forceinline__ int pg32(int x) { const int p = x & 31; return (x & ~31) | (8 * ((p >> 2) & 3) + 4 * (p >> 4) + (p & 3)); }
__device__ __forceinline__ int src_col(int mat, int n) {
    const int t = n >> 8, pc = n & 255; int wc;
    switch (mat) {
    case M_WIN:
        if (t < 2) { const int d = head_perm(pc, wc); return (4 * t + wc) * 64 + d; }
        if (t == 2) { const int d = head_perm(pc, wc); return wc < 2 ? 512 + wc * 64 + d : 640 + (wc - 2) * 64 + d; }
        if (t == 3) return 768 + pg32(pc);
        if (t == 4) { if (pc < 128) return 768 + 256 + pg32(pc); if (pc < 160) return 1408 + rope_perm(pc - 128); return -1; }
        if (t == 5) return 1152 + pg32(pc);
        if (t < 8) return 1440 + (t - 6) * 256 + pg32(pc);
        return 1952 + (t - 8) * 256 + pg32(pc);
    case M_WUQ:
        if (t < 2) { const int d = head_perm(pc, wc); return (4 * t + wc) * 96 + d; }
        { const int bj = pc >> 7, w2 = (pc >> 5) & 3; return (4 * bj + w2) * 96 + 64 + rope_perm(pc & 31); }
    case M_WUKV:
        { const int d = head_perm(pc, wc); return t < 2 ? (4 * t + wc) * 128 + d : (4 * (t - 2) + wc) * 128 + 64 + d; }
    case M_FFI:
        return pc < 128 ? t * 128 + pg32(pc) : FFH + t * 128 + pg32(pc - 128);
    case M_NATP: return pg32(n);
    default: return n;
    }
}
__device__ __forceinline__ void xpose_item(const float* W, int ldw, const float* kscale, bf16* WT, int ldo, int kcol0, int mat, int nblk, int item, LAS float* scr, int lane) {
    const int kb = item / nblk, nb = item % nblk, k0 = 64 * kb, n0 = 32 * nb;
    const int sc = src_col(mat, n0 + (lane & 31));
#pragma unroll 8
    for (int i = 0; i < 32; ++i) { const int kk = 2 * i + (lane >> 5); float v = 0.f; if (sc >= 0) { v = W[(size_t)(k0 + kk) * ldw + sc]; if (kscale) v *= kscale[k0 + kk]; } scr[kk * 33 + (lane & 31)] = v; }
    asm volatile("s_waitcnt lgkmcnt(0)" ::: "memory");
    const int c = lane & 7;
#pragma unroll
    for (int j = 0; j < 4; ++j) { const int n = (lane >> 3) + 8 * j; const LAS float* s = scr + (8 * c) * 33 + n;
        u32x4 o; o.x = cvtpk(s[0 * 33], s[1 * 33]); o.y = cvtpk(s[2 * 33], s[3 * 33]); o.z = cvtpk(s[4 * 33], s[5 * 33]); o.w = cvtpk(s[6 * 33], s[7 * 33]);
        *(u32x4*)(WT + (size_t)(n0 + n) * ldo + kcol0 + k0 + 8 * c) = o; }
    asm volatile("s_waitcnt lgkmcnt(0)" ::: "memory");
}
__device__ __forceinline__ void run_xjob(const Ctx& F, int& base, const float* W, int ldw, const float* kscale, bf16* WT, int ldo, int kcol0, int mat, int K, int N) {
    LAS float* scr = (LAS float*)(F.lds + F.wave * 16384);
    const int gw = F.cv_rank * NWAVES + F.wave, NGW = F.cv_n * NWAVES;
    const int nblk = N / 32, nit = (K / 64) * nblk;
    int first = gw - (base % NGW); if (first < 0) first += NGW;
    for (int it = first; it < nit; it += NGW) xpose_item(W, ldw, kscale, WT, ldo, kcol0, mat, nblk, it, scr, F.lane);
    base += nit;
}

__device__ __forceinline__ void norm_pass(const Ctx& F, const float* x_lat, const float* x_ctx, bf16* HB, const float* gnorm, const float* mod_l, int shift_off, int nrows) {
    const int gw = F.vcu * NWAVES + F.wave, NGW = F.G * NWAVES;
    const int per = (nrows + NGW - 1) / NGW; const int r0 = gw * per, r1 = min(nrows, r0 + per);
    int cur_s = -1; f32x4 ca[4], cb[4];
    for (int r = r0; r < r1; ++r) {
        const bool ctx = r >= ML; const int s = ctx ? 8 : r >> 11;
        if (s != cur_s) { cur_s = s; const float* sh = mod_l + s * 6144 + shift_off; const float* scl = sh + 1024;
#pragma unroll
            for (int j = 0; j < 4; ++j) { const f32x4 g = *(const f32x4*)(gnorm + 256 * j + 4 * F.lane); const f32x4 sc1 = *(const f32x4*)(scl + 256 * j + 4 * F.lane); ca[j] = g * (sc1 + 1.0f); cb[j] = *(const f32x4*)(sh + 256 * j + 4 * F.lane); } }
        const float* xr = ctx ? x_ctx + (size_t)(r - ML) * 1024 : x_lat + (size_t)r * 1024;
        f32x4 v[4]; float ss = 0.f;
#pragma unroll
        for (int j = 0; j < 4; ++j) { v[j] = *(const f32x4*)(xr + 256 * j + 4 * F.lane); ss += (v[j][0] * v[j][0] + v[j][1] * v[j][1]) + (v[j][2] * v[j][2] + v[j][3] * v[j][3]); }
        const float rstd = rsqrtf(wave_sum(ss) * (1.0f / 1024.0f) + EPS);
#pragma unroll
        for (int j = 0; j < 4; ++j) *(u32x2*)(HB + (size_t)r * 1024 + 256 * j + 4 * F.lane) = pk4(v[j] * rstd * ca[j] + cb[j]);
    }
}

__device__ __forceinline__ void mod_items(const Ctx& F, KP kp) {
    const float* c = kin(kp, 1); const float* cc = kin(kp, 3); const float* wmod = kin(kp, 4); const float* bmod = kin(kp, 5);
    float* mod = (float*)(F.ws + O_MOD);
    LAS float* sl = (LAS float*)F.lds;
    LAS float* red = sl + 9 * 1024;
    for (int it = F.vcu; it < 192; it += F.G) {
        const int l = it / 96, n0 = (it % 96) * 64;
        __syncthreads();
        for (int i = F.tid; i < 9 * 1024; i += NTHR) { const float v = (i < 8192) ? c[i] : cc[i - 8192]; sl[i] = v * sigmoidf_(v); }
        __syncthreads();
        float acc[9];
#pragma unroll
        for (int s = 0; s < 9; ++s) acc[s] = 0.f;
        const float* wp = wmod + (size_t)l * 1024 * 6144 + n0 + F.lane;
        for (int k0 = F.wave * 128; k0 < F.wave * 128 + 128; k0 += 16) { float w[16];
#pragma unroll
            for (int j = 0; j < 16; ++j) w[j] = wp[(size_t)(k0 + j) * 6144];
#pragma unroll
            for (int j = 0; j < 16; ++j)
#pragma unroll
                for (int s = 0; s < 9; ++s) acc[s] += sl[s * 1024 + k0 + j] * w[j]; }
#pragma unroll
        for (int s = 0; s < 9; ++s) red[(F.wave * 9 + s) * 64 + F.lane] = acc[s];
        __syncthreads();
        for (int i = F.tid; i < 9 * 64; i += NTHR) { float t = 0.f;
#pragma unroll
            for (int w = 0; w < 8; ++w) t += red[w * 576 + i];
            const int s = i / 64, n = n0 + (i & 63); mod[(l * 9 + s) * 6144 + n] = t + bmod[l * 6144 + n]; }
    }
    __syncthreads();
}
__device__ __forceinline__ void table_items(const Ctx& F) {
    const int gt = (F.vcu * NTHR) + F.tid, NT_ = F.G * NTHR;
    float* ra = (float*)(F.ws + O_ROPEA); float* rb = (float*)(F.ws + O_ROPEB);
    for (int i = gt; i < 1024; i += NT_) { const int pos = i >> 4, f = i & 15; const float fr = powf(10000.0f, -(float)(2 * f) / 32.0f); const float ang = (float)pos * fr; ra[i] = cosf(ang); ra[1024 + i] = sinf(ang); }
    for (int i = gt; i < 512; i += NT_) { const int pos = i >> 3, f = i & 7; const float fr = powf(10000.0f, -(float)(2 * f) / 16.0f); const float ang = (float)pos * fr; rb[i] = cosf(ang); rb[512 + i] = sinf(ang); }
    bf16* DN = (bf16*)(F.ws + O_DN); bf16* DN2 = (bf16*)(F.ws + O_DN256); bf16* DC = (bf16*)(F.ws + O_DFTC);
    { const float sc = 0.022097086912079608f;
      for (int i = gt; i < 2048 * 2048 / 2; i += NT_) { const int n = i >> 10, k = (i & 1023) * 2; float s0, c0, s1, c1;
          sincospif((float)((n * k) & 2047) * (1.0f / 1024.0f), &s0, &c0); sincospif((float)((n * (k + 1)) & 2047) * (1.0f / 1024.0f), &s1, &c1);
          *(unsigned*)(DN + (size_t)n * 4096 + k) = cvtpk(c0 * sc, c1 * sc); *(unsigned*)(DN + (size_t)n * 4096 + 2048 + k) = cvtpk(-s0 * sc, -s1 * sc); } }
    { const float sc = 0.0625f;
      for (int i = gt; i < 256 * 256; i += NT_) { const int n = i >> 8, k = i & 255; float s0, c0; sincospif((float)((n * k) & 255) * (1.0f / 128.0f), &s0, &c0);
          DN2[n * 512 + k] = (bf16)(cvtpk(c0 * sc, 0.f) & 0xffff); DN2[n * 512 + 256 + k] = (bf16)(cvtpk(-s0 * sc, 0.f) & 0xffff); } }
    { const float sc = 0.08838834764831845f;
      for (int i = gt; i < 256 * 128; i += NT_) { const int r = i >> 7, k = i & 127; float s0, c0; sincospif((float)(((r & 127) * k) & 127) * (1.0f / 64.0f), &s0, &c0);
          DC[i] = (bf16)(cvtpk((r < 128 ? c0 : s0) * sc, 0.f) & 0xffff); } }
}
__device__ __forceinline__ void convert_weights_main(const Ctx& F, KP kp, int l) {
    int base = 0;
    run_xjob(F, base, kin(kp, 8) + (size_t)l * 1024 * INW, INW, nullptr, (bf16*)(F.ws + O_WIN), 1024, 0, M_WIN, 1024, NINP);
    run_xjob(F, base, kin(kp, 13) + (size_t)l * 384 * 768, 768, kin(kp, 11) + l * 384, (bf16*)(F.ws + O_WUQ), 384, 0, M_WUQ, 384, 768);
    run_xjob(F, base, kin(kp, 14) + (size_t)l * 256 * 1024, 1024, kin(kp, 12) + l * 256, (bf16*)(F.ws + O_WUKV), 256, 0, M_WUKV, 256, 1024);
    run_xjob(F, base, kin(kp, 20) + (size_t)l * 512 * 1024, 1024, nullptr, (bf16*)(F.ws + O_WBR), 1536, 0, M_NATP, 512, 1024);
    run_xjob(F, base, kin(kp, 21) + (size_t)l * 512 * 1024, 1024, nullptr, (bf16*)(F.ws + O_WBR), 1536, 512, M_NATP, 512, 1024);
    run_xjob(F, base, kin(kp, 22) + (size_t)l * 512 * 1024, 1024, nullptr, (bf16*)(F.ws + O_WBR), 1536, 1024, M_NATP, 512, 1024);
    run_xjob(F, base, kin(kp, 23) + (size_t)l * 1024 * 1024, 1024, nullptr, (bf16*)(F.ws + O_WOUT), 1024, 0, M_NAT, 1024, 1024);
}
__device__ __forceinline__ void convert_weights_ffn(const Ctx& F, KP kp, int l) {
    int base = 0;
    run_xjob(F, base, kin(kp, 24) + (size_t)l * 1024 * 2 * FFH, 2 * FFH, nullptr, (bf16*)(F.ws + O_WFI), 1024, 0, M_FFI, 1024, 2 * FFH);
    run_xjob(F, base, kin(kp, 25) + (size_t)l * FFH * 1024, 1024, nullptr, (bf16*)(F.ws + O_WFO), FFH, 0, M_NAT, FFH, 1024);
}

struct F1Sched {
    int nb_tok, G, c, row0, rows_per_b, nunits; const char* A; const char* PF;
    __device__ __forceinline__ bool next(int i, Unit& u) const { return at((long)i * G + c, u); }
    __device__ __forceinline__ bool at(long L, Unit& u) const {
        if (L >= nunits) return false;
        const int j = (int)L % nb_tok, bg = (int)L / nb_tok, gch = bg & 3, b = bg >> 2;
        u.pm = b * 4 + gch; u.pn = j; u.kb = 0; u.A = A; u.B = PF + ((size_t)(row0 + b * rows_per_b + j * 256) * 512 + gch * 128) * 2; return true;
    }
};
struct F2Sched {
    int nM, G, c, row0, rows_per_b, nunits; const char* DN; const char* ZT; size_t K2;
    __device__ __forceinline__ bool next(int i, Unit& u) const {
        const long L = (long)i * G + c; if (L >= nunits) return false;
        const int pn = (int)L & 1, r = (int)L >> 1, pm = r % nM, b = r / nM;
        u.pm = (row0 + b * rows_per_b) / 256 + pm; u.pn = pn; u.kb = 0;
        u.A = DN + (size_t)pm * 256 * K2 * 2; u.B = ZT + ((size_t)b * 512 + pn * 256) * K2 * 2; return true;
    }
};


struct P2Sched {
    RectSched sq, suq, sukv; F1Sched sf1, sf1c; int n0, n1, n2, n3, n4, G, c;
    __device__ __forceinline__ bool next(int i, Unit& u) const {
        const long L = (long)i * G + ((i & 1) ? (G - 1 - c) : c);
        if (L >= n4) return false;
        if (L < n0) { u.lda = 1024; u.ldb = 1024; u.nt = 16; u.epi = 0; return sq.at(L, 0, u); }
        if (L < n1) { u.lda = 384; u.ldb = 384; u.nt = 6; u.epi = 1; return suq.at(L - n0, 0, u); }
        if (L < n2) { u.lda = 256; u.ldb = 256; u.nt = 4; u.epi = 2; return sukv.at(L - n1, 0, u); }
        if (L < n3) { u.lda = 128; u.ldb = 512; u.nt = 2; u.epi = 3; return sf1.at(L - n2, u); }
        u.lda = 128; u.ldb = 512; u.nt = 2; u.epi = 4; return sf1c.at(L - n3, u);
    }
};
struct P2Epi {
    EpiIn e0; EpiUq e1; EpiUkv e2; EpiF1 e3, e4;
    __device__ __forceinline__ bool operator()(Acc& acc, const Unit& u, int wr, int wc, int fr, int fq) const {
        switch (u.epi) {
        case 0: return e0(acc, u, wr, wc, fr, fq);
        case 1: return e1(acc, u, wr, wc, fr, fq);
        case 2: return e2(acc, u, wr, wc, fr, fq);
        case 3: return e3(acc, u, wr, wc, fr, fq);
        default: return e4(acc, u, wr, wc, fr, fq);
        }
    }
};

#ifndef DIAG_SUB
#define DIAG_SUB -1
#endif
#ifndef TIME_REP
#define TIME_REP 0
#endif
#ifndef TIME_PH
#define TIME_PH -1
#endif
#define REP(b) ((TIME_REP & (b)) ? 2 : 1)
#define SUB_ON(k) (DIAG_SUB < 0 || DIAG_SUB == (k))
#ifndef DIAG_PART
#define DIAG_PART 0xffff
#endif
#define PART_ON(b) ((DIAG_PART & (b)) != 0)
__global__ void __launch_bounds__(NTHR, 2) fwd_kernel(Args args) {
    extern __shared__ __attribute__((aligned(16))) unsigned char lds_raw[];
    const int c = (int)blockIdx.x;
#if !MK_MULTI
    cg::grid_group grid = cg::this_grid();
    if (threadIdx.x < 2) ((volatile LAS unsigned*)((LAS unsigned char*)lds_raw + LDS_MISC))[threadIdx.x] = 0u;
    __syncthreads();
    const XcdBarrier xbar = xcd_barrier_post((unsigned*)(*(unsigned char* const __attribute__((address_space(4)))*)((KP)__builtin_amdgcn_kernarg_segment_ptr() + 216) + O_CTL) + 1024, (volatile LAS unsigned*)((LAS unsigned char*)lds_raw + LDS_MISC));
#define GRID_SYNC(first) do { if (first) grid.sync(); else xcd_barrier(xbar); } while (0)
#else
#define GRID_SYNC(first) do {} while (0)
#endif
    bool rep_done = false;
    for (int ph = args.ph_lo; ph < args.ph_hi; ++ph) {
        KP kp = (KP)__builtin_amdgcn_kernarg_segment_ptr(); asm volatile("" : "+s"(kp));
        int G = (int)gridDim.x; asm volatile("" : "+s"(G));
        int tid_ = threadIdx.x; asm volatile("" : "+v"(tid_));
        Ctx F; F.lds = (LAS unsigned char*)lds_raw; F.tid = tid_; F.lane = tid_ & 63; F.wave = __builtin_amdgcn_readfirstlane(tid_ >> 6);
        F.G = G; F.vcu = (G % 8 == 0) ? (c % 8) * (G / 8) + c / 8 : c; F.cv_rank = F.vcu; F.cv_n = G;
        unsigned char* ws = kws(kp); F.ws = ws; float* const outp = kout(kp);
#define mod ((const float*)(ws + O_MOD))
#define ropeA ((const float*)(ws + O_ROPEA))
#define ropeB ((const float*)(ws + O_ROPEB))
#define stat_cq ((float*)(ws + O_STATCQ))
#define stat_ckv ((float*)(ws + O_STATCKV))
#define HB ((bf16*)(ws + O_HB))
#define PF ((bf16*)(ws + O_PF))
#define QA ((bf16*)(ws + O_QA))
#define QBN ((bf16*)(ws + O_QBN))
#define QBR ((bf16*)(ws + O_QBR))
#define CQ ((bf16*)(ws + O_CQ))
#define CKV ((bf16*)(ws + O_CKV))
#define KA ((bf16*)(ws + O_KA))
#define VA ((bf16*)(ws + O_VA))
#define KB ((bf16*)(ws + O_KB))
#define VB ((bf16*)(ws + O_VB))
#define GT ((bf16*)(ws + O_G))
#define ACT ((bf16*)(ws + O_G))
#define MB HB
#define YC PF
#define XC ((float*)(ws + O_XC))
        if (ph == 0) { if (SUB_ON(10))
            for (int rep_ = 0; rep_ < REP(1); ++rep_) { mod_items(F, kp); table_items(F); convert_weights_main(F, kp, 0); }
        } else {
            const int l = (ph - 1) / 10, sub = (ph - 1) % 10;
            const bool L1 = (l == 1);
            const int nMt = L1 ? 64 : 72;
            const float* xin_lat = L1 ? outp : kin(kp, 0); const float* xin_ctx = L1 ? XC : kin(kp, 2);
            const float* mod_l = mod + (size_t)l * 9 * 6144;
            bf16* ZT = L1 ? (bf16*)(ws + O_ZT1) : (bf16*)outp; bf16* ZTC = (bf16*)outp + (size_t)8 * 512 * 4096;
            switch (sub) {
            case 0: if (SUB_ON(0)) {
                if (L1 && G != 256) convert_weights_main(F, kp, 1);
                for (int rep_ = 0; rep_ < REP(2); ++rep_) norm_pass(F, xin_lat, xin_ctx, HB, kin(kp, 6) + l * 1024, mod_l, 0, MT);
            } break;
            case 1: if (SUB_ON(1)) {
                EpiIn E{QA, KA, VA, CQ, CKV, KB, PF, GT, stat_cq, stat_ckv, kin(kp, 9) + l * 64, kin(kp, 10) + l * 64, kin(kp, 18) + l * 32, kin(kp, 19) + l * 3072, ropeA, ropeB};
                const Gemm g{1024, 1024, 1024};
                RectSched S{L1 ? 64 : 72, 6, 0, G, c, 1, 0x765432ull, (const char*)HB, 0, 0, (const char*)(ws + O_WIN), (size_t)256 * 1024 * 2, (size_t)256 * 1024 * 2, 0};
                pg8::gemm_phase(F.lds, g, S, E);
                if (L1) { RectSched S2{8, 3, 64, G, (c + 128) % G, 1, 0x542ull, (const char*)HB, 0, 0, (const char*)(ws + O_WIN), (size_t)256 * 1024 * 2, (size_t)256 * 1024 * 2, 0};
                    pg8::gemm_phase(F.lds, g, S2, E); }
            } break;
            case 2: if (SUB_ON(2)) {
                const int nMl = L1 ? 64 : 72;
                P2Sched S;
                S.sq = RectSched{nMl, 2, 0, G, c, 1, ~0ull, (const char*)HB, 0, 0, (const char*)(ws + O_WIN), (size_t)256 * 1024 * 2, (size_t)256 * 1024 * 2, 0};
                S.suq = RectSched{nMl, 3, 0, G, c, 1, ~0ull, (const char*)CQ, 0, 0, (const char*)(ws + O_WUQ), (size_t)256 * 384 * 2, (size_t)256 * 384 * 2, 0};
                S.sukv = RectSched{72, 4, 0, G, c, 1, ~0ull, (const char*)CKV, 0, 0, (const char*)(ws + O_WUKV), (size_t)256 * 256 * 2, (size_t)256 * 256 * 2, 0};
                S.sf1 = F1Sched{8, G, c, 0, 2048, 256, (const char*)(ws + O_DFTC), (const char*)PF};
                S.sf1c = F1Sched{1, G, c, ML, 256, L1 ? 0 : 32, (const char*)(ws + O_DFTC), (const char*)PF};
                S.n0 = nMl * 2; S.n1 = S.n0 + nMl * 3; S.n2 = S.n1 + 72 * 4; S.n3 = S.n2 + 256; S.n4 = S.n3 + (L1 ? 0 : 32); S.G = G; S.c = c;
                P2Epi E{EpiIn{QA, KA, VA, CQ, CKV, KB, PF, GT, stat_cq, stat_ckv, kin(kp, 9) + l * 64, kin(kp, 10) + l * 64, kin(kp, 18) + l * 32, kin(kp, 19) + l * 3072, ropeA, ropeB},
                        EpiUq{QBN, QBR, stat_cq, kin(kp, 15) + l * 64, kin(kp, 17) + l * 32, ropeB}, EpiUkv{KB, VB, stat_ckv, kin(kp, 16) + l * 64}, EpiF1{ZT, 2048}, EpiF1{ZTC, 256}};
                const Gemm g{1024, 1024, 1024};
                pg8::gemm_phase(F.lds, g, S, E);
            } break;
            case 3: if (SUB_ON(3)) {
                LAS unsigned char* shm = F.lds;
                if (TIME_REP & 32) for (int i = 0;; ++i) {
                    const int L = i * G + c; if (L >= 512) break; const int qb = L & 7, h = (L >> 3) & 7, b = L >> 6;
                    const size_t row0 = (size_t)b * SEQ + qb * 256; const size_t key0 = (size_t)b * NKEY;
                    attq::attn_unit<4, 8>(QA + row0 * 512 + h * 64, 512, nullptr, 0, KA + key0 * 128 + (h >> 2) * 64, 128, VA + key0 * 128 + (h >> 2) * 64, 128, CQ + row0 * 512 + h * 64, 512, NKEY / 64, (char*)lds_raw);
                }
                if (TIME_REP & 64) for (int i = 0;; ++i) {
                    const int L = i * G + c; if (L >= 512) break; const int qb = L & 7, h = (L >> 3) & 7, b = L >> 6;
                    const size_t row0 = (size_t)b * SEQ + qb * 256; const size_t key0 = (size_t)b * NKEY;
                    attq::attn_unit<6, 8>(QBN + row0 * 512 + h * 64, 512, QBR + row0 * 256 + h * 32, 256, KB + key0 * 768 + h * 96, 768, VB + key0 * 512 + h * 64, 512, CQ + row0 * 512 + h * 64, 512, NKEY / 64, (char*)lds_raw);
                }
                for (int i = 0;; ++i) {
                    int L; if (G == 256) { if (c < 128) { if (i >= 3) break; L = c + 128 * i; } else { if (i >= 1) break; L = 384 + (c - 128); } } else { L = i * G + c; if (L >= 512) break; }
                    const int qb = L & 7, h = (L >> 3) & 7, b = L >> 6;
                    const size_t row0 = (size_t)b * SEQ + qb * 256; const size_t key0 = (size_t)b * NKEY;
                    attq::attn_unit<4, 8>(QA + row0 * 512 + h * 64, 512, nullptr, 0, KA + key0 * 128 + (h >> 2) * 64, 128, VA + key0 * 128 + (h >> 2) * 64, 128, QA + row0 * 512 + h * 64, 512, NKEY / 64, (char*)lds_raw);
                }
                for (int i = 0;; ++i) {
                    const int L = i * G + c; if (L >= 512) break; const int qb = L & 7, h = (L >> 3) & 7, b = L >> 6;
                    const size_t row0 = (size_t)b * SEQ + qb * 256; const size_t key0 = (size_t)b * NKEY;
                    attq::attn_unit<6, 8>(QBN + row0 * 512 + h * 64, 512, QBR + row0 * 256 + h * 32, 256, KB + key0 * 768 + h * 96, 768, VB + key0 * 512 + h * 64, 512, QBN + row0 * 512 + h * 64, 512, NKEY / 64, (char*)lds_raw);
                }
                if (!L1) {
                    for (int i = 0;; ++i) {
                        const int L = i * G + ((c + 128) % G); if (L >= 128) break; const int h = L & 7, b = (L >> 3) & 7; const bool mla = L >= 64;
                        const size_t row0 = (size_t)ML + b * CTX; const size_t key0 = (size_t)b * NKEY;
                        if (!mla) attq::attn_unit<4, 8>(QA + row0 * 512 + h * 64, 512, nullptr, 0, KA + key0 * 128 + (h >> 2) * 64, 128, VA + key0 * 128 + (h >> 2) * 64, 128, QA + row0 * 512 + h * 64, 512, CTX / 64, (char*)lds_raw);
                        else attq::attn_unit<6, 8>(QBN + row0 * 512 + h * 64, 512, QBR + row0 * 256 + h * 32, 256, KB + key0 * 768 + h * 96, 768, VB + key0 * 512 + h * 64, 512, QBN + row0 * 512 + h * 64, 512, CTX / 64, (char*)lds_raw);
                    }
                }
                for (int rep_ = 0; rep_ < REP(128); ++rep_) { EpiStore E{YC, 512}; const Gemm g{4096, 4096, 4096};
                  F2Sched S{8, G, (c + 128) % G, 0, 2048, 128, (const char*)(ws + O_DN), (const char*)ZT, 4096};
                  pg8::gemm_phase(F.lds, g, S, E); }
                if (!L1) { EpiStore E{YC, 512}; const Gemm g{512, 512, 512};
                  F2Sched S{1, G, c, ML, 256, 16, (const char*)(ws + O_DN256), (const char*)ZTC, 512};
                  pg8::gemm_phase(F.lds, g, S, E); }
            } break;
            case 4: if (SUB_ON(4)) {
                EpiIn E{QA, KA, VA, CQ, CKV, KB, PF, GT, stat_cq, stat_ckv, kin(kp, 9) + l * 64, kin(kp, 10) + l * 64, kin(kp, 18) + l * 32, kin(kp, 19) + l * 3072, ropeA, ropeB};
                const Gemm g{1024, 1024, 1024};
                RectSched S{nMt, 12, 0, G, c, 1, ~0ull, (const char*)HB, 0, 0, (const char*)(ws + O_WIN) + (size_t)8 * 256 * 1024 * 2, (size_t)256 * 1024 * 2, (size_t)256 * 1024 * 2, 0};
                struct PnShift { RectSched s; __device__ __forceinline__ bool next(int i, Unit& u) const { if (!s.next(i, u)) return false; u.pn += 8; return true; } } S8{S};
                for (int rep_ = 0; rep_ < REP(256); ++rep_) pg8::gemm_phase(F.lds, g, S8, E);
            } break;
            case 5: if (SUB_ON(5)) {
                for (int rep_ = 0; rep_ < REP(512); ++rep_) { EpiMerge E{(const unsigned char*)GT, MB}; const Gemm g{512, 1536, 512};
                RectSched S{nMt, 4, 0, G, c, 3, ~0ull, (const char*)QA, (size_t)((const char*)QBN - (const char*)QA), (size_t)((const char*)YC - (const char*)QA), (const char*)(ws + O_WBR), (size_t)256 * 512 * 2, (size_t)256 * 1536 * 2, (size_t)512 * 2};
                pg8::gemm_phase(F.lds, g, S, E); }
            } break;
            case 6: if (SUB_ON(6)) {
                EpiRes E{xin_lat, xin_ctx, outp, XC, mod_l + 2048}; const Gemm g{1024, 1024, 1024};
                RectSched S{nMt, 4, 0, G, c, 1, ~0ull, (const char*)MB, 0, 0, (const char*)(ws + O_WOUT), (size_t)256 * 1024 * 2, (size_t)256 * 1024 * 2, 0};
                pg8::gemm_phase(F.lds, g, S, E);
                if (!L1 && G == 256 && c >= 32) { F.cv_rank = c - 32; F.cv_n = 224; convert_weights_ffn(F, kp, 0); }
            } break;
            case 7: if (SUB_ON(7)) {
                if (L1 || G != 256) for (int rep_ = 0; rep_ < REP(1024); ++rep_) convert_weights_ffn(F, kp, l);
                for (int rep_ = 0; rep_ < REP(2048); ++rep_) norm_pass(F, outp, XC, HB, kin(kp, 7) + l * 1024, mod_l, 3072, L1 ? ML : MT);
            } break;
            case 8: if (SUB_ON(8)) {
                for (int rep_ = 0; rep_ < REP(4096); ++rep_) { EpiSwiglu E{ACT}; const Gemm g{1024, 1024, 1024};
                RectSched S{nMt, 22, 0, G, c, 1, ~0ull, (const char*)HB, 0, 0, (const char*)(ws + O_WFI), (size_t)256 * 1024 * 2, (size_t)256 * 1024 * 2, 0};
                pg8::gemm_phase(F.lds, g, S, E); }
            } break;
            case 9: if (SUB_ON(9)) {
                EpiRes E{outp, XC, outp, XC, mod_l + 5120}; const Gemm g{FFH, FFH, FFH};
                RectSched S{nMt, 4, 0, G, c, 1, ~0ull, (const char*)ACT, 0, 0, (const char*)(ws + O_WFO), (size_t)256 * FFH * 2, (size_t)256 * FFH * 2, 0};
                pg8::gemm_phase(F.lds, g, S, E);
                if (!L1 && G == 256 && c >= 32) { F.cv_rank = c - 32; F.cv_n = 224; convert_weights_main(F, kp, 1); }
            } break;
            }
        }
        if (ph + 1 < args.ph_hi) { GRID_SYNC(ph == 0); }
        if (TIME_PH >= 0 && ph == TIME_PH && !rep_done) { rep_done = true; --ph; }
    }
}

extern "C" void kernel_launch(void* const* d_in, const int* in_sizes, int n_in, void* d_out, int out_size, void* d_ws, size_t ws_size, hipStream_t stream) {
    static int grid = 0;
    if (grid == 0) {
        if (n_in != 26 || out_size != ML * DM || ws_size < O_END) { fprintf(stderr, "kernel_launch: unexpected shapes (n_in %d out %d ws %zu)\n", n_in, out_size, ws_size); grid = -1; return; }
        int dev = 0, cus = 0, per_cu = 0;
        hipGetDevice(&dev); hipDeviceGetAttribute(&cus, hipDeviceAttributeMultiprocessorCount, dev);
        if (hipFuncSetAttribute((const void*)fwd_kernel, hipFuncAttributeMaxDynamicSharedMemorySize, LDS_BYTES) != hipSuccess) { fprintf(stderr, "kernel_launch: hipFuncSetAttribute failed\n"); grid = -1; return; }
        hipOccupancyMaxActiveBlocksPerMultiprocessor(&per_cu, (const void*)fwd_kernel, NTHR, LDS_BYTES);
        if (per_cu < 1) { fprintf(stderr, "kernel_launch: occupancy query says %d blocks/CU\n", per_cu); per_cu = 1; }
        (void)hipGetLastError();
        grid = cus;
        if (grid > 256) grid = 256;
    }
    if (grid < 0) return;
    (void)hipMemsetAsync((char*)d_ws + O_CTL, 0, CTL_ZERO_BYTES, stream);
    Args a{};
    for (int i = 0; i < 26; ++i) a.in[i] = (const float*)d_in[i];
    a.out = (float*)d_out; a.ws = (unsigned char*)d_ws;
#if MK_MULTI
    for (int ph = 0; ph < NPHASE; ++ph) { a.ph_lo = ph; a.ph_hi = ph + 1; hipLaunchKernelGGL(fwd_kernel, dim3(grid), dim3(NTHR), LDS_BYTES, stream, a); }
#else
    a.ph_lo = 0; a.ph_hi = NPHASE;
    void* kargs[] = {&a};
    hipError_t e = hipLaunchCooperativeKernel((const void*)fwd_kernel, dim3(grid), dim3(NTHR), kargs, LDS_BYTES, stream);
    if (e != hipSuccess) fprintf(stderr, "cooperative launch failed: %s (grid %d)\n", hipGetErrorString(e), grid);
#endif
}
```

```cpp
#include <hip/hip_runtime.h>
#include <hip/hip_cooperative_groups.h>
#include <cstdint>
#include <cstdio>
namespace cg = cooperative_groups;

#ifndef MK_MULTI
#define MK_MULTI 0
#endif

#define LAS __attribute__((address_space(3)))
typedef unsigned short bf16;
typedef short bf16x8 __attribute__((ext_vector_type(8)));
typedef short s16x4 __attribute__((ext_vector_type(4)));
typedef float f32x2 __attribute__((ext_vector_type(2)));
typedef float f32x4 __attribute__((ext_vector_type(4)));
typedef float f32x16 __attribute__((ext_vector_type(16)));
typedef unsigned u32x2 __attribute__((ext_vector_type(2)));
typedef unsigned u32x4 __attribute__((ext_vector_type(4)));
typedef __bf16 bf16x2_t __attribute__((ext_vector_type(2)));

constexpr int DM = 1024, NB = 8, SEQ = 2048, CTX = 256, NKEY = CTX + SEQ;
constexpr int ML = NB * SEQ, MC = NB * CTX, MT = ML + MC;
constexpr int INW = 5024, NINP = 5120;
constexpr int FFH = 2816;
constexpr float EPS = 1e-6f;
constexpr float LOG2E = 1.4426950408889634f;
constexpr float C2A = 0.125f * LOG2E;
constexpr float C2B = 0.10206207261596577f * LOG2E;
constexpr int NWAVES = 8, NTHR = 512;

constexpr size_t MiB = 1u << 20, KiB = 1024;
constexpr size_t O_CTL = 0;
constexpr size_t O_MOD = 256 * KiB;
constexpr size_t O_ROPEA = 704 * KiB;
constexpr size_t O_ROPEB = 712 * KiB;
constexpr size_t O_STATCQ = 1 * MiB;
constexpr size_t O_STATCKV = O_STATCQ + (size_t)MT * 8 * 4;
constexpr size_t O_DN = 2 * MiB;
constexpr size_t O_DN256 = O_DN + 16 * MiB;
constexpr size_t O_DFTC = O_DN256 + 256 * KiB;
constexpr size_t O_W = O_DN + 16 * MiB + 512 * KiB;
constexpr size_t O_WIN = O_W;
constexpr size_t O_WUQ = O_WIN + (size_t)NINP * 1024 * 2;
constexpr size_t O_WUKV = O_WUQ + 768 * 384 * 2;
constexpr size_t O_WBR = O_WUKV + 1024 * 256 * 2;
constexpr size_t O_WOUT = O_WBR + 1024 * 1536 * 2;
constexpr size_t O_XC = O_W + 16 * MiB + 256 * KiB;
constexpr size_t O_HB = O_XC + 8 * MiB;
constexpr size_t O_PF = O_HB + 36 * MiB;
constexpr size_t O_QA = O_PF + 18 * MiB;
constexpr size_t O_QBN = O_QA + 18 * MiB;
constexpr size_t O_QBR = O_QBN + 18 * MiB;
constexpr size_t O_WFI = O_QA;
constexpr size_t O_WFO = O_WFI + (size_t)5632 * 1024 * 2;
constexpr size_t O_G = O_QBR + 9 * MiB;
constexpr size_t O_CQ = O_G;
constexpr size_t O_CKV = O_CQ + (size_t)MT * 384 * 2;
constexpr size_t O_KA = O_CKV + (size_t)MT * 256 * 2;
constexpr size_t O_VA = O_KA + (size_t)NB * NKEY * 128 * 2;
constexpr size_t O_KB = O_VA + (size_t)NB * NKEY * 128 * 2;
constexpr size_t O_VB = O_KB + (size_t)NB * NKEY * 768 * 2;
constexpr size_t O_ZT1 = O_VB + (size_t)NB * NKEY * 512 * 2;
constexpr size_t O_END = O_ZT1 + 32 * MiB;
static_assert(O_END <= 256 * MiB, "d_ws map exceeds 256 MiB");
static_assert(O_WOUT + 2 * MiB <= O_XC, "W region");
static_assert(O_WFO + (size_t)1024 * 2816 * 2 <= O_G, "ffn weights overlay");
static_assert(O_G + (size_t)MT * 3072 * 2 <= O_END, "gates overlay");
static_assert(O_DFTC + 64 * KiB <= O_W, "dft region");
static_assert(O_STATCKV + (size_t)MT * 4 * 4 <= O_DN, "stats region");

__device__ __forceinline__ unsigned cvtpk(float lo, float hi) { f32x2 v = {lo, hi}; bf16x2_t b = __builtin_convertvector(v, bf16x2_t); return __builtin_bit_cast(unsigned, b); }
__device__ __forceinline__ u32x2 pk4(f32x4 v) { u32x2 r; r.x = cvtpk(v[0], v[1]); r.y = cvtpk(v[2], v[3]); return r; }
__device__ __forceinline__ float bf2f(unsigned short h) { return __uint_as_float((unsigned)h << 16); }
__device__ __forceinline__ f32x4 unpk4(u32x2 w) { f32x4 r; r[0] = __uint_as_float(w.x << 16); r[1] = __uint_as_float(w.x & 0xffff0000u); r[2] = __uint_as_float(w.y << 16); r[3] = __uint_as_float(w.y & 0xffff0000u); return r; }
__device__ __forceinline__ u32x4 pk8(f32x4 a, f32x4 b) { u32x4 r; r.x = cvtpk(a[0], a[1]); r.y = cvtpk(a[2], a[3]); r.z = cvtpk(b[0], b[1]); r.w = cvtpk(b[2], b[3]); return r; }
__device__ __forceinline__ unsigned q8x4(f32x4 g) {
    unsigned w = 0;
    w = __builtin_amdgcn_cvt_pk_u8_f32(__builtin_fmaxf(g[0] * 255.0f, 1.0f), 0, w);
    w = __builtin_amdgcn_cvt_pk_u8_f32(__builtin_fmaxf(g[1] * 255.0f, 1.0f), 1, w);
    w = __builtin_amdgcn_cvt_pk_u8_f32(__builtin_fmaxf(g[2] * 255.0f, 1.0f), 2, w);
    w = __builtin_amdgcn_cvt_pk_u8_f32(__builtin_fmaxf(g[3] * 255.0f, 1.0f), 3, w);
    return w; }
__device__ __forceinline__ f32x4 uq8x4(unsigned w) { f32x4 r; r[0] = (float)(w & 0xffu); r[1] = (float)((w >> 8) & 0xffu); r[2] = (float)((w >> 16) & 0xffu); r[3] = (float)(w >> 24); return r; }
__device__ __forceinline__ float wave_sum(float v) {
#pragma unroll
    for (int o = 1; o < 64; o <<= 1) v += __shfl_xor(v, o);
    return v;
}
__device__ __forceinline__ float fq_sum(float v) { v += __shfl_xor(v, 16); v += __shfl_xor(v, 32); return v; }
__device__ __forceinline__ float sigmoidf_(float x) { return __builtin_amdgcn_rcpf(1.0f + __expf(-x)); }

namespace pg8 {
constexpr int BM = 256, BK = 64, HALF = 128, HTB = HALF * BK * 2, STAGE_BYTES = 8 * HTB, NXCD = 8, WGM = 8;
__host__ __device__ __forceinline__ int lds_byte(int r, int c) { const int st = (r >> 4) * 2 + (c >> 5), rr = r & 15, cc = c & 31, ob = rr * 64 + cc * 2; return st * 1024 + (ob ^ (((ob >> 9) & 1) << 5)); }
__host__ __device__ __forceinline__ void stage_rc(int b, int& R, int& C) { const int st = b / 1024, sb = b % 1024, swz = sb ^ (((sb >> 9) & 1) << 5); R = (st >> 1) * 16 + swz / 64; C = (st & 1) * 32 + (swz % 64) / 2; }

struct Unit { int pm, pn, kb, epi; const char* A; const char* B; int lda, ldb, nt; };
struct Gemm { int lda, ldb, K; };

__device__ __forceinline__ void tile_order(int L, int nM, int nN, int& pm, int& pn) {
    const int nwg = nM * nN; int wgid = L;
    { const int q = nwg / NXCD, r = nwg % NXCD, xcd = wgid % NXCD, off = wgid / NXCD; wgid = (xcd < r ? xcd * (q + 1) : r * (q + 1) + (xcd - r) * q) + off; }
    const int nig = WGM * nN, gid = wgid / nig, fm = gid * WGM, gsz = (nM - fm) < WGM ? (nM - fm) : WGM;
    pm = fm + ((wgid % nig) % gsz); pn = (wgid % nig) / gsz;
}

template <class Epi, class Sched>
__device__ __forceinline__ void gemm_phase(LAS unsigned char* lds, const Gemm g, const Sched& S, const Epi& E) {
    int tid = threadIdx.x; asm volatile("" : "+v"(tid));
    const int wid = __builtin_amdgcn_readfirstlane(tid >> 6), lane = tid & 63, wr = wid >> 2, wc = wid & 3, fr = lane & 15, fq = lane >> 4;
    unsigned Rv, Cv;
    { int R, C; stage_rc(tid * 16, R, C); Rv = (unsigned)R * 2u; Cv = (unsigned)C * 2u; }
    const size_t kstep = (size_t)(BK * 2);
    const unsigned ldsw = (unsigned)wid * 1024u;
    const int aoff = lds_byte(wr * 64 + fr, fq * 8), boff = lds_byte(wc * 32 + fr, fq * 8);
#define PG8_SA(b, h) (((b) * 2 + (h)) * HTB)
#define PG8_SB(b, h) ((4 + (b) * 2 + (h)) * HTB)
#define PG8_STAGE(bufoff, gbase, voff, piece) do { _Pragma("unroll") for (int _i = 0; _i < 2; ++_i) \
        __builtin_amdgcn_global_load_lds((const unsigned*)((const char*)(gbase) + (size_t)_i * (piece) + (voff)), (LAS unsigned*)(lds + (bufoff) + ldsw + _i * 8192), 16, 0, 0); } while (0)
#define PG8_LDA(dst, b, h) do { _Pragma("unroll") for (int m = 0; m < 4; ++m) _Pragma("unroll") for (int k = 0; k < 2; ++k) dst[m][k] = *(const LAS bf16x8*)(lds + PG8_SA(b, h) + aoff + m * 2048 + k * 1024); } while (0)
#define PG8_LDB(dst, b, h) do { _Pragma("unroll") for (int n = 0; n < 2; ++n) _Pragma("unroll") for (int k = 0; k < 2; ++k) dst[n][k] = *(const LAS bf16x8*)(lds + PG8_SB(b, h) + boff + n * 2048 + k * 1024); } while (0)
#define PG8_MMA(ai, bj, At, Bt) do { __builtin_amdgcn_s_setprio(1); _Pragma("unroll") for (int m = 0; m < 4; ++m) _Pragma("unroll") for (int n = 0; n < 2; ++n) _Pragma("unroll") for (int k = 0; k < 2; ++k) \
        acc[ai][bj][m][n] = __builtin_amdgcn_mfma_f32_16x16x32_bf16(Bt[n][k], At[m][k], acc[ai][bj][m][n], 0, 0, 0); __builtin_amdgcn_s_setprio(0); } while (0)
#define PG8_WAIT_V(n) asm volatile("s_waitcnt vmcnt(" #n ")" ::: "memory")
#define PG8_WAIT_L(n) asm volatile("s_waitcnt lgkmcnt(" #n ")" ::: "memory")
#define PG8_BAR __builtin_amdgcn_s_barrier()
#define PG8_SCHED __builtin_amdgcn_sched_barrier(0)
#define PG8_NEXT(i, u) ((u).lda = g.lda, (u).ldb = g.ldb, (u).nt = g.K / BK, (u).epi = 0, S.next((i), (u)))
    Unit cur, nxt; int ui = 0;
    if (!PG8_NEXT(0, cur)) return;
    f32x4 acc[2][2][4][2];
#pragma unroll
    for (int a = 0; a < 2; ++a)
#pragma unroll
        for (int b = 0; b < 2; ++b)
#pragma unroll
            for (int m = 0; m < 4; ++m)
#pragma unroll
                for (int n = 0; n < 2; ++n) acc[a][b][m][n] = (f32x4){0.f, 0.f, 0.f, 0.f};
    bf16x8 At[4][2], B0[2][2], B1[2][2];
    const char* cA = cur.A; const char* cB = cur.B;
    unsigned vAc = Rv * (unsigned)cur.lda + Cv, vBc = Rv * (unsigned)cur.ldb + Cv;
    size_t pAc = (size_t)128 * cur.lda, pBc = (size_t)128 * cur.ldb;
    PG8_STAGE(PG8_SB(0, 0), cB, vBc, pBc); PG8_STAGE(PG8_SB(0, 1), cB + 2 * pBc, vBc, pBc); PG8_STAGE(PG8_SA(0, 0), cA, vAc, pAc); PG8_STAGE(PG8_SA(0, 1), cA + 2 * pAc, vAc, pAc);
    if (wr == 1) PG8_BAR;
    PG8_WAIT_V(2); PG8_BAR;
    PG8_STAGE(PG8_SB(1, 0), cB + kstep, vBc, pBc); PG8_STAGE(PG8_SA(1, 0), cA + kstep, vAc, pAc); PG8_STAGE(PG8_SB(1, 1), cB + 2 * pBc + kstep, vBc, pBc);
    PG8_WAIT_V(6); PG8_BAR;
    for (;;) {
        const bool has_next = PG8_NEXT(ui + 1, nxt);
        if (!has_next) nxt = cur;
        const char* nA = nxt.A; const char* nB = nxt.B;
        const unsigned vAn = Rv * (unsigned)nxt.lda + Cv, vBn = Rv * (unsigned)nxt.ldb + Cv;
        const size_t pAn = (size_t)128 * nxt.lda, pBn = (size_t)128 * nxt.ldb;
        int nt = cur.nt; asm volatile("" : "+s"(nt));
        for (int t = 0; t < nt; t += 2) {
            const bool last = (t == nt - 2);
            const char* a1 = cA + (size_t)(t + 1) * kstep;
            const char* a2 = last ? nA : cA + (size_t)(t + 2) * kstep; const char* b2 = last ? nB : cB + (size_t)(t + 2) * kstep;
            const char* a3 = a2 + kstep; const char* b3 = b2 + kstep;
            const unsigned vA2 = last ? vAn : vAc, vB2 = last ? vBn : vBc; const size_t pA2 = last ? pAn : pAc, pB2 = last ? pBn : pBc;
            PG8_LDB(B0, 0, 0); PG8_LDB(B1, 0, 1); PG8_SCHED; PG8_LDA(At, 0, 0); PG8_STAGE(PG8_SA(1, 1), a1 + 2 * pAc, vAc, pAc);
            PG8_WAIT_V(8); PG8_WAIT_L(0); PG8_BAR; PG8_MMA(0, 0, At, B0); PG8_MMA(0, 1, At, B1); PG8_BAR; PG8_SCHED;
            PG8_LDA(At, 0, 1); PG8_STAGE(PG8_SB(0, 0), b2, vB2, pB2); PG8_STAGE(PG8_SB(0, 1), b2 + 2 * pB2, vB2, pB2); PG8_STAGE(PG8_SA(0, 0), a2, vA2, pA2);
            PG8_WAIT_V(8); PG8_WAIT_L(0); PG8_BAR; PG8_MMA(1, 0, At, B0); PG8_MMA(1, 1, At, B1); PG8_BAR; PG8_SCHED;
            PG8_LDB(B0, 1, 0); PG8_LDB(B1, 1, 1); PG8_SCHED; PG8_LDA(At, 1, 0); PG8_STAGE(PG8_SA(0, 1), a2 + 2 * pA2, vA2, pA2);
            PG8_WAIT_V(8); PG8_WAIT_L(0); PG8_BAR; PG8_MMA(0, 0, At, B0); PG8_MMA(0, 1, At, B1); PG8_BAR; PG8_SCHED;
            PG8_LDA(At, 1, 1); PG8_STAGE(PG8_SB(1, 0), b3, vB2, pB2); PG8_STAGE(PG8_SB(1, 1), b3 + 2 * pB2, vB2, pB2); PG8_STAGE(PG8_SA(1, 0), a3, vA2, pA2);
            PG8_WAIT_V(8); PG8_WAIT_L(0); PG8_BAR; PG8_MMA(1, 0, At, B0); PG8_MMA(1, 1, At, B1); PG8_BAR; PG8_SCHED;
        }
        if (wr == 0) PG8_BAR;
        const bool carry = E(acc, cur, wr, wc, fr, fq);
        if (!has_next) break;
        if (!carry) {
#pragma unroll
            for (int a = 0; a < 2; ++a)
#pragma unroll
                for (int b = 0; b < 2; ++b)
#pragma unroll
                    for (int m = 0; m < 4; ++m)
#pragma unroll
                        for (int n = 0; n < 2; ++n) acc[a][b][m][n] = (f32x4){0.f, 0.f, 0.f, 0.f};
        }
        cur = nxt; cA = nA; cB = nB; vAc = vAn; vBc = vBn; pAc = pAn; pBc = pBn; ++ui;
        if (wr == 1) PG8_BAR;
    }
    PG8_WAIT_V(0);
    PG8_BAR;
#undef PG8_SA
#undef PG8_SB
#undef PG8_STAGE
#undef PG8_LDA
#undef PG8_LDB
#undef PG8_MMA
#undef PG8_WAIT_V
#undef PG8_WAIT_L
#undef PG8_BAR
#undef PG8_SCHED
#undef PG8_NEXT
}
}
using pg8::Unit; using pg8::Gemm;

typedef f32x4 Acc[2][2][4][2];

struct RectSched {
    int nM, nN, pm0, G, c, nkb; unsigned long long pnmap;
    const char* A0; size_t dA1, dA2; const char* B; size_t strideAm, strideBn, strideBk;
    __device__ __forceinline__ int count() const { return nM * nN; }
    __device__ __forceinline__ bool next(int i, Unit& u) const { const int ti = i / nkb, kb = i - ti * nkb; return at((long)ti * G + c, kb, u); }
    __device__ __forceinline__ bool at(long L, int kb, Unit& u) const {
        if (L >= (long)nM * nN) return false;
        int pm, pn; pg8::tile_order((int)L, nM, nN, pm, pn);
        if (pnmap != ~0ull) pn = (int)((pnmap >> (4 * pn)) & 15ull);
        u.pm = pm + pm0; u.pn = pn; u.kb = kb;
        u.A = A0 + (size_t)(kb == 1) * dA1 + (size_t)(kb == 2) * dA2 + (size_t)u.pm * strideAm; u.B = B + (size_t)pn * strideBn + (size_t)kb * strideBk; return true;
    }
};

struct RowInfo { bool ctx; int b; int tok0; };
__device__ __forceinline__ RowInfo row_info(int pm) { RowInfo r; r.ctx = pm >= 64; r.b = r.ctx ? pm - 64 : pm >> 3; r.tok0 = r.ctx ? 0 : (pm & 7) * 256; return r; }

template <bool NORM>
__device__ __forceinline__ void head64(const f32x4 (&a)[2][2], const f32x4 (&g)[2][2], float scale, bool rope, int row_id, int col_id, const float* ropeA, int fq, f32x4 (&o)[2][2]) {
    f32x4 v[2][2];
    if (NORM) {
        float ss = 0.f;
#pragma unroll
        for (int bj = 0; bj < 2; ++bj)
#pragma unroll
            for (int n = 0; n < 2; ++n) { const f32x4 x = a[bj][n]; ss += (x[0] * x[0] + x[1] * x[1]) + (x[2] * x[2] + x[3] * x[3]); }
        ss = fq_sum(ss);
        const float rstd = rsqrtf(ss * (1.0f / 64.0f) + EPS);
#pragma unroll
        for (int bj = 0; bj < 2; ++bj)
#pragma unroll
            for (int n = 0; n < 2; ++n) v[bj][n] = a[bj][n] * rstd * g[bj][n];
    } else {
#pragma unroll
        for (int bj = 0; bj < 2; ++bj)
#pragma unroll
            for (int n = 0; n < 2; ++n) v[bj][n] = a[bj][n];
    }
    if (rope) {
#pragma unroll
        for (int bj = 0; bj < 2; ++bj) {
            const int pos = bj ? col_id : row_id;
            const f32x4 cs = *(const f32x4*)(ropeA + pos * 16 + 4 * fq), sn = *(const f32x4*)(ropeA + 1024 + pos * 16 + 4 * fq);
            o[bj][0] = (v[bj][0] * cs - v[bj][1] * sn) * scale; o[bj][1] = (v[bj][1] * cs + v[bj][0] * sn) * scale;
        }
    } else {
#pragma unroll
        for (int bj = 0; bj < 2; ++bj)
#pragma unroll
            for (int n = 0; n < 2; ++n) o[bj][n] = v[bj][n] * scale;
    }
}
__device__ __forceinline__ void rope32(const f32x4 (&a)[2], const float* g, float scale, bool rope, int row_id, int col_id, const float* ropeB, int fq, f32x4 (&o)[2]) {
    float ss = 0.f;
#pragma unroll
    for (int n = 0; n < 2; ++n) { const f32x4 x = a[n]; ss += (x[0] * x[0] + x[1] * x[1]) + (x[2] * x[2] + x[3] * x[3]); }
    ss = fq_sum(ss);
    const float rstd = rsqrtf(ss * (1.0f / 32.0f) + EPS);
    const int d0 = 16 * (fq >> 1) + 4 * (fq & 1);
    f32x4 v[2];
#pragma unroll
    for (int n = 0; n < 2; ++n) v[n] = a[n] * rstd * *(const f32x4*)(g + d0 + 8 * n);
    if (rope) {
        const int pos = (fq >> 1) ? col_id : row_id;
        const f32x4 cs = *(const f32x4*)(ropeB + pos * 8 + 4 * (fq & 1)), sn = *(const f32x4*)(ropeB + 512 + pos * 8 + 4 * (fq & 1));
        o[0] = (v[0] * cs - v[1] * sn) * scale; o[1] = (v[1] * cs + v[0] * sn) * scale;
    } else { o[0] = v[0] * scale; o[1] = v[1] * scale; }
}

struct EpiIn {
    bf16 *QA, *KA, *VA, *CQ, *CKV, *KB, *PF, *G; float *stat_cq, *stat_ckv;
    const float *gq, *gk, *gkr, *bgate, *ropeA, *ropeB; unsigned char* Gc;
    __device__ __forceinline__ bool operator()(Acc& acc, const Unit& u, int wr, int wc, int fr_, int fq_) const {
        int fr = fr_, fq = fq_; asm volatile("" : "+v"(fr), "+v"(fq));
        const RowInfo ri = row_info(u.pm); const bool rope = !ri.ctx;
        const int pn = u.pn;
        if (pn <= 2) {
            const bool isv = (pn == 2 && wc >= 2), isk = (pn == 2 && wc < 2);
            const float* gsrc = (pn < 2) ? gq : gk;
            f32x4 g[2][2];
#pragma unroll
            for (int bj = 0; bj < 2; ++bj)
#pragma unroll
                for (int n = 0; n < 2; ++n) g[bj][n] = *(const f32x4*)(gsrc + 32 * bj + 16 * n + 4 * fq);
#pragma unroll
            for (int ai = 0; ai < 2; ++ai)
#pragma unroll
                for (int m = 0; m < 4; ++m) {
                    const int rt = 128 * ai + 64 * wr + 16 * m + fr;
                    const int row_id = (ri.tok0 + 128 * ai + 64 * wr) >> 6, col_id = 16 * m + fr;
                    f32x4 a[2][2], o[2][2];
#pragma unroll
                    for (int bj = 0; bj < 2; ++bj)
#pragma unroll
                        for (int n = 0; n < 2; ++n) a[bj][n] = acc[ai][bj][m][n];
                    bf16* dst;
                    if (pn < 2) { head64<true>(a, g, C2A, rope, row_id, col_id, ropeA, fq, o); dst = QA + (size_t)(u.pm * 256 + rt) * 512 + (4 * pn + wc) * 64; }
                    else {
                        const size_t key = (size_t)ri.b * NKEY + (ri.ctx ? rt : 256 + ri.tok0 + rt);
                        if (isk) { head64<true>(a, g, 1.0f, rope, row_id, col_id, ropeA, fq, o); dst = KA + key * 128 + wc * 64; }
                        else { head64<false>(a, g, 1.0f, false, 0, 0, ropeA, fq, o); dst = VA + key * 128 + (wc - 2) * 64; }
                    }
#pragma unroll
                    for (int bj = 0; bj < 2; ++bj)
#pragma unroll
                        for (int n = 0; n < 2; ++n) *(u32x2*)(dst + 32 * bj + 16 * n + 4 * fq) = pk4(o[bj][n]);
                }
            (void)isv;
        } else if (pn == 3 || pn == 5) {
            bf16* dstb = (pn == 3) ? CQ : CKV; const int ld = (pn == 3) ? 384 : 256;
            float* st = (pn == 3) ? stat_cq : stat_ckv; const int sld = (pn == 3) ? 8 : 4;
#pragma unroll
            for (int ai = 0; ai < 2; ++ai)
#pragma unroll
                for (int m = 0; m < 4; ++m) {
                    const size_t row = (size_t)u.pm * 256 + 128 * ai + 64 * wr + 16 * m + fr; float ss = 0.f;
#pragma unroll
                    for (int bj = 0; bj < 2; ++bj) { const f32x4 x = acc[ai][bj][m][0], y = acc[ai][bj][m][1];
                        ss += (x[0] * x[0] + x[1] * x[1]) + (x[2] * x[2] + x[3] * x[3]) + (y[0] * y[0] + y[1] * y[1]) + (y[2] * y[2] + y[3] * y[3]);
                        *(u32x4*)(dstb + row * ld + 128 * bj + 32 * wc + 8 * fq) = pk8(x, y); }
                    ss = fq_sum(ss);
                    if (fq == 0) st[row * sld + wc] = ss;
                }
        } else if (pn == 4) {
            f32x4 gk0[2]; (void)gk0;
#pragma unroll
            for (int ai = 0; ai < 2; ++ai)
#pragma unroll
                for (int m = 0; m < 4; ++m) {
                    const int rt = 128 * ai + 64 * wr + 16 * m + fr; const size_t row = (size_t)u.pm * 256 + rt; float ss = 0.f;
                    { const f32x4 x = acc[ai][0][m][0], y = acc[ai][0][m][1];
                      ss += (x[0] * x[0] + x[1] * x[1]) + (x[2] * x[2] + x[3] * x[3]) + (y[0] * y[0] + y[1] * y[1]) + (y[2] * y[2] + y[3] * y[3]);
                      *(u32x4*)(CQ + row * 384 + 256 + 32 * wc + 8 * fq) = pk8(x, y); }
                    ss = fq_sum(ss);
                    if (fq == 0) stat_cq[row * 8 + 4 + wc] = ss;
                    if (wc == 0) {
                        const int row_id = (ri.tok0 + 128 * ai + 64 * wr) >> 6, col_id = 16 * m + fr;
                        f32x4 a[2], o[2]; a[0] = acc[ai][1][m][0]; a[1] = acc[ai][1][m][1];
                        rope32(a, gkr, 1.0f, rope, row_id, col_id, ropeB, fq, o);
                        const size_t key = (size_t)ri.b * NKEY + (ri.ctx ? rt : 256 + ri.tok0 + rt);
                        bf16* dst = KB + key * 768 + 64 + 16 * (fq >> 1) + 4 * (fq & 1);
                        const u32x2 w0 = pk4(o[0]), w1 = pk4(o[1]);
#pragma unroll
                        for (int h = 0; h < 8; ++h) { *(u32x2*)(dst + h * 96) = w0; *(u32x2*)(dst + h * 96 + 8) = w1; }
                    }
                }
        } else if (pn < 8) {
#pragma unroll
            for (int ai = 0; ai < 2; ++ai)
#pragma unroll
                for (int m = 0; m < 4; ++m) {
                    const size_t row = (size_t)u.pm * 256 + 128 * ai + 64 * wr + 16 * m + fr;
#pragma unroll
                    for (int bj = 0; bj < 2; ++bj) *(u32x4*)(PF + row * 512 + (pn - 6) * 256 + 128 * bj + 32 * wc + 8 * fq) = pk8(acc[ai][bj][m][0], acc[ai][bj][m][1]);
                }
        } else {
            const int c0 = (pn - 8) * 256 + 32 * wc + 8 * fq;
            f32x4 bv[2][2];
#pragma unroll
            for (int bj = 0; bj < 2; ++bj)
#pragma unroll
                for (int n = 0; n < 2; ++n) bv[bj][n] = *(const f32x4*)(bgate + c0 + 128 * bj + 4 * n);
            unsigned char* G8 = ri.ctx ? Gc : (unsigned char*)G;
#pragma unroll
            for (int ai = 0; ai < 2; ++ai)
#pragma unroll
                for (int m = 0; m < 4; ++m) {
                    const size_t row = (size_t)u.pm * 256 + 128 * ai + 64 * wr + 16 * m + fr;
#pragma unroll
                    for (int bj = 0; bj < 2; ++bj) { u32x2 w;
#pragma unroll
                        for (int n = 0; n < 2; ++n) { f32x4 x = acc[ai][bj][m][n] + bv[bj][n];
                            x[0] = sigmoidf_(x[0]); x[1] = sigmoidf_(x[1]); x[2] = sigmoidf_(x[2]); x[3] = sigmoidf_(x[3]);
                            if (n == 0) w.x = q8x4(x); else w.y = q8x4(x); }
                        *(u32x2*)(G8 + row * 3072 + c0 + 128 * bj) = w; }
                }
        }
        return false;
    }
};

struct EpiUq {
    bf16 *QBN, *QBR; const float *stat_cq, *gqn, *gqr, *ropeB;
    __device__ __forceinline__ bool operator()(Acc& acc, const Unit& u, int wr, int wc, int fr_, int fq_) const {
        int fr = fr_, fq = fq_; asm volatile("" : "+v"(fr), "+v"(fq));
        const RowInfo ri = row_info(u.pm); const bool rope = !ri.ctx;
        f32x4 g[2][2];
#pragma unroll
        for (int bj = 0; bj < 2; ++bj)
#pragma unroll
            for (int n = 0; n < 2; ++n) g[bj][n] = *(const f32x4*)(gqn + 32 * bj + 16 * n + 4 * fq);
        f32x2 stv[2][4];
#pragma unroll
        for (int ai = 0; ai < 2; ++ai)
#pragma unroll
            for (int m = 0; m < 4; ++m) stv[ai][m] = *(const f32x2*)(stat_cq + ((size_t)u.pm * 256 + 128 * ai + 64 * wr + 16 * m + fr) * 8 + 2 * fq);
#pragma unroll
        for (int ai = 0; ai < 2; ++ai)
#pragma unroll
            for (int m = 0; m < 4; ++m) {
                const int rt = 128 * ai + 64 * wr + 16 * m + fr; const size_t row = (size_t)u.pm * 256 + rt;
                const float rs = rsqrtf(fq_sum(stv[ai][m][0] + stv[ai][m][1]) * (1.0f / 384.0f) + EPS);
                if (u.pn < 2) {
                    f32x4 a[2][2], o[2][2];
#pragma unroll
                    for (int bj = 0; bj < 2; ++bj)
#pragma unroll
                        for (int n = 0; n < 2; ++n) a[bj][n] = acc[ai][bj][m][n] * rs;
                    head64<true>(a, g, C2B, false, 0, 0, ropeB, fq, o);
                    bf16* dst = QBN + row * 512 + (4 * u.pn + wc) * 64;
#pragma unroll
                    for (int bj = 0; bj < 2; ++bj)
#pragma unroll
                        for (int n = 0; n < 2; ++n) *(u32x2*)(dst + 32 * bj + 16 * n + 4 * fq) = pk4(o[bj][n]);
                } else {
                    const int row_id = (ri.tok0 + 128 * ai + 64 * wr) >> 6, col_id = 16 * m + fr;
#pragma unroll
                    for (int bj = 0; bj < 2; ++bj) {
                        f32x4 a[2], o[2]; a[0] = acc[ai][bj][m][0] * rs; a[1] = acc[ai][bj][m][1] * rs;
                        rope32(a, gqr, C2B, rope, row_id, col_id, ropeB, fq, o);
                        bf16* dst = QBR + row * 256 + (4 * bj + wc) * 32 + 16 * (fq >> 1) + 4 * (fq & 1);
                        *(u32x2*)(dst) = pk4(o[0]); *(u32x2*)(dst + 8) = pk4(o[1]);
                    }
                }
            }
        return false;
    }
};

struct EpiUkv {
    bf16 *KB, *VB; const float *stat_ckv, *gkn;
    __device__ __forceinline__ bool operator()(Acc& acc, const Unit& u, int wr, int wc, int fr_, int fq_) const {
        int fr = fr_, fq = fq_; asm volatile("" : "+v"(fr), "+v"(fq));
        const RowInfo ri = row_info(u.pm);
        f32x4 g[2][2];
#pragma unroll
        for (int bj = 0; bj < 2; ++bj)
#pragma unroll
            for (int n = 0; n < 2; ++n) g[bj][n] = *(const f32x4*)(gkn + 32 * bj + 16 * n + 4 * fq);
        float stv[2][4];
#pragma unroll
        for (int ai = 0; ai < 2; ++ai)
#pragma unroll
            for (int m = 0; m < 4; ++m) stv[ai][m] = stat_ckv[((size_t)u.pm * 256 + 128 * ai + 64 * wr + 16 * m + fr) * 4 + fq];
#pragma unroll
        for (int ai = 0; ai < 2; ++ai)
#pragma unroll
            for (int m = 0; m < 4; ++m) {
                const int rt = 128 * ai + 64 * wr + 16 * m + fr; const size_t row = (size_t)u.pm * 256 + rt;
                const float rs = rsqrtf(fq_sum(stv[ai][m]) * (1.0f / 256.0f) + EPS);
                const size_t key = (size_t)ri.b * NKEY + (ri.ctx ? rt : 256 + ri.tok0 + rt);
                f32x4 a[2][2], o[2][2];
#pragma unroll
                for (int bj = 0; bj < 2; ++bj)
#pragma unroll
                    for (int n = 0; n < 2; ++n) a[bj][n] = acc[ai][bj][m][n] * rs;
                bf16* dst;
                if (u.pn < 2) { head64<true>(a, g, 1.0f, false, 0, 0, gkn, fq, o); dst = KB + key * 768 + (4 * u.pn + wc) * 96; }
                else { head64<false>(a, g, 1.0f, false, 0, 0, gkn, fq, o); dst = VB + key * 512 + (4 * (u.pn - 2) + wc) * 64; }
#pragma unroll
                for (int bj = 0; bj < 2; ++bj)
#pragma unroll
                    for (int n = 0; n < 2; ++n) *(u32x2*)(dst + 32 * bj + 16 * n + 4 * fq) = pk4(o[bj][n]);
            }
        return false;
    }
};

struct EpiStore {
    bf16* O; int ld;
    __device__ __forceinline__ bool operator()(Acc& acc, const Unit& u, int wr, int wc, int fr_, int fq_) const {
        int fr = fr_, fq = fq_; asm volatile("" : "+v"(fr), "+v"(fq));
#pragma unroll
        for (int ai = 0; ai < 2; ++ai)
#pragma unroll
            for (int m = 0; m < 4; ++m) {
                const size_t row = (size_t)u.pm * 256 + 128 * ai + 64 * wr + 16 * m + fr;
#pragma unroll
                for (int bj = 0; bj < 2; ++bj)
#pragma unroll
                    for (int n = 0; n < 2; ++n) *(u32x2*)(O + row * ld + u.pn * 256 + 128 * bj + 32 * wc + 16 * n + 4 * fq) = pk4(acc[ai][bj][m][n]);
            }
        return false;
    }
};

struct EpiF1 {
    bf16* ZT; int NP;
    __device__ __forceinline__ bool operator()(Acc& acc, const Unit& u, int wr, int wc, int fr_, int fq_) const {
        int fr = fr_, fq = fq_; asm volatile("" : "+v"(fr), "+v"(fq));
        const int b = u.pm >> 2, gch = u.pm & 3;
#pragma unroll
        for (int ai = 0; ai < 2; ++ai)
#pragma unroll
            for (int m = 0; m < 4; ++m) {
                const int ch = gch * 128 + 64 * wr + 16 * m + fr;
                bf16* dst = ZT + ((size_t)b * 512 + ch) * (2 * NP) + ai * NP + u.pn * 256;
#pragma unroll
                for (int bj = 0; bj < 2; ++bj)
#pragma unroll
                    for (int n = 0; n < 2; ++n) *(u32x2*)(dst + 128 * bj + 32 * wc + 16 * n + 4 * fq) = pk4(acc[ai][bj][m][n]);
            }
        return false;
    }
};

struct EpiMerge {
    const unsigned char* G8; bf16* MB; const unsigned char* G8c;
    __device__ __forceinline__ bool operator()(Acc& acc, const Unit& u, int wr, int wc, int fr_, int fq_) const {
        int fr = fr_, fq = fq_; asm volatile("" : "+v"(fr), "+v"(fq));
        const int kb = u.kb; const int c0 = u.pn * 256 + 32 * wc + 8 * fq;
#pragma unroll
        for (int ai = 0; ai < 2; ++ai)
#pragma unroll
            for (int m = 0; m < 4; ++m) {
                const size_t row = (size_t)u.pm * 256 + 128 * ai + 64 * wr + 16 * m + fr;
                const unsigned char* gp = (u.pm >= 64 ? G8c : G8) + row * 3072 + c0;
#pragma unroll
                for (int bj = 0; bj < 2; ++bj) {
                    if (kb < 2) { const u32x2 wa = *(const u32x2*)(gp + kb * 1024 + 128 * bj), wb = *(const u32x2*)(gp + (kb + 1) * 1024 + 128 * bj);
#pragma unroll
                        for (int n = 0; n < 2; ++n) { const f32x4 ga = uq8x4(n ? wa.y : wa.x), gb = uq8x4(n ? wb.y : wb.x);
                            f32x4 r; r[0] = ga[0] * __builtin_amdgcn_rcpf(gb[0]); r[1] = ga[1] * __builtin_amdgcn_rcpf(gb[1]); r[2] = ga[2] * __builtin_amdgcn_rcpf(gb[2]); r[3] = ga[3] * __builtin_amdgcn_rcpf(gb[3]); acc[ai][bj][m][n] *= r; } }
                    else { const u32x2 wc2 = *(const u32x2*)(gp + 2048 + 128 * bj);
                        const f32x4 g0 = uq8x4(wc2.x) * (1.0f / 255.0f), g1 = uq8x4(wc2.y) * (1.0f / 255.0f);
                        *(u32x4*)(MB + row * 1024 + c0 + 128 * bj) = pk8(acc[ai][bj][m][0] * g0, acc[ai][bj][m][1] * g1); }
                }
            }
        return kb < 2;
    }
};

struct EpiRes {
    const float *xin_lat, *xin_ctx; float *xout_lat, *xout_ctx; const float* gate;
    __device__ __forceinline__ bool operator()(Acc& acc, const Unit& u, int wr, int wc, int fr_, int fq_) const {
        int fr = fr_, fq = fq_; asm volatile("" : "+v"(fr), "+v"(fq));
        const RowInfo ri = row_info(u.pm); const int s = ri.ctx ? 8 : ri.b;
        const int c0 = u.pn * 256 + 32 * wc + 4 * fq;
        const float* xin = ri.ctx ? xin_ctx + (size_t)(u.pm - 64) * 256 * 1024 : xin_lat + (size_t)u.pm * 256 * 1024;
        float* xout = ri.ctx ? xout_ctx + (size_t)(u.pm - 64) * 256 * 1024 : xout_lat + (size_t)u.pm * 256 * 1024;
        f32x4 gv[2][2];
#pragma unroll
        for (int bj = 0; bj < 2; ++bj)
#pragma unroll
            for (int n = 0; n < 2; ++n) gv[bj][n] = *(const f32x4*)(gate + s * 6144 + c0 + 128 * bj + 16 * n);
#pragma unroll
        for (int ai = 0; ai < 2; ++ai) {
            f32x4 xi[4][2][2];
#pragma unroll
            for (int m = 0; m < 4; ++m)
#pragma unroll
                for (int bj = 0; bj < 2; ++bj)
#pragma unroll
                    for (int n = 0; n < 2; ++n) xi[m][bj][n] = *(const f32x4*)(xin + (size_t)(128 * ai + 64 * wr + 16 * m + fr) * 1024 + c0 + 128 * bj + 16 * n);
#pragma unroll
            for (int m = 0; m < 4; ++m)
#pragma unroll
                for (int bj = 0; bj < 2; ++bj)
#pragma unroll
                    for (int n = 0; n < 2; ++n) *(f32x4*)(xout + (size_t)(128 * ai + 64 * wr + 16 * m + fr) * 1024 + c0 + 128 * bj + 16 * n) = xi[m][bj][n] + gv[bj][n] * acc[ai][bj][m][n];
            asm volatile("" ::: "memory");
        }
        return false;
    }
};

struct EpiSwiglu {
    bf16* ACT;
    __device__ __forceinline__ bool operator()(Acc& acc, const Unit& u, int wr, int wc, int fr_, int fq_) const {
        int fr = fr_, fq = fq_; asm volatile("" : "+v"(fr), "+v"(fq));
#pragma unroll
        for (int ai = 0; ai < 2; ++ai)
#pragma unroll
            for (int m = 0; m < 4; ++m) {
                const size_t row = (size_t)u.pm * 256 + 128 * ai + 64 * wr + 16 * m + fr;
                f32x4 o[2];
#pragma unroll
                for (int n = 0; n < 2; ++n) { const f32x4 gt = acc[ai][0][m][n], up = acc[ai][1][m][n];
                    o[n][0] = gt[0] * sigmoidf_(gt[0]) * up[0]; o[n][1] = gt[1] * sigmoidf_(gt[1]) * up[1]; o[n][2] = gt[2] * sigmoidf_(gt[2]) * up[2]; o[n][3] = gt[3] * sigmoidf_(gt[3]) * up[3]; }
                *(u32x4*)(ACT + row * FFH + u.pn * 128 + 32 * wc + 8 * fq) = pk8(o[0], o[1]);
            }
        return false;
    }
};

namespace att {
constexpr int KSLOT = 12288, VSLOT = 8192;
constexpr int L_K = 0, L_V = 2 * KSLOT, L_WS = L_V + 2 * VSLOT, L_OST = L_WS + NWAVES * 64 * 4, L_BYTES = L_OST + NWAVES * 4096;
__device__ __forceinline__ int crow(int r, int hi) { return (r & 3) + 8 * (r >> 2) + 4 * hi; }
__device__ __forceinline__ float max3f(float a, float b, float c) { return __builtin_fmaxf(__builtin_fmaxf(a, b), c); }
__device__ __forceinline__ float rowmax(const f32x16& p0, const f32x16& p1) {
    float a = max3f(p0[0], p0[1], p1[0]), b = max3f(p0[2], p0[3], p1[1]); a = max3f(a, p1[2], p1[3]);
#pragma unroll
    for (int r = 4; r < 16; r += 4) { a = max3f(a, p0[r], p0[r + 1]); b = max3f(b, p0[r + 2], p0[r + 3]); a = max3f(a, p1[r], p1[r + 1]); b = max3f(b, p1[r + 2], p1[r + 3]); }
    const float m = __builtin_fmaxf(a, b);
    auto rr = __builtin_amdgcn_permlane32_swap(__float_as_uint(m), __float_as_uint(m), false, false);
    return __builtin_fmaxf(__uint_as_float(rr[0]), __uint_as_float(rr[1]));
}
__device__ __forceinline__ void pv(f32x16* o, int vb, bf16x8 pa0, bf16x8 pa1, bf16x8 pa2, bf16x8 pa3) {
#pragma unroll
    for (int d0 = 0; d0 < 2; ++d0) { s16x4 lo[4], hi[4];
#pragma unroll
        for (int ks = 0; ks < 4; ++ks) {
            asm volatile("ds_read_b64_tr_b16 %0,%1 offset:%c2" : "=&v"(lo[ks]) : "v"(vb), "i"(d0 * 4096 + ks * 1024) : "memory");
            asm volatile("ds_read_b64_tr_b16 %0,%1 offset:%c2" : "=&v"(hi[ks]) : "v"(vb), "i"(d0 * 4096 + ks * 1024 + 512) : "memory"); }
        asm volatile("s_waitcnt lgkmcnt(0)" ::: "memory"); __builtin_amdgcn_sched_barrier(0);
#define PK(k) (bf16x8){lo[k][0], lo[k][1], lo[k][2], lo[k][3], hi[k][0], hi[k][1], hi[k][2], hi[k][3]}
        o[d0] = __builtin_amdgcn_mfma_f32_32x32x16_bf16(pa0, PK(0), o[d0], 0, 0, 0);
        o[d0] = __builtin_amdgcn_mfma_f32_32x32x16_bf16(pa1, PK(1), o[d0], 0, 0, 0);
        o[d0] = __builtin_amdgcn_mfma_f32_32x32x16_bf16(pa2, PK(2), o[d0], 0, 0, 0);
        o[d0] = __builtin_amdgcn_mfma_f32_32x32x16_bf16(pa3, PK(3), o[d0], 0, 0, 0);
#undef PK
    }
}
}


namespace attq {
using att::crow;
constexpr int NSLOT = 3;
#define SBAR() __builtin_amdgcn_sched_barrier(0)
__device__ __forceinline__ void glds16(const void* gsrc, unsigned lds_dst) { unsigned keep;
    asm volatile("s_mov_b32 %0, m0\n\ts_mov_b32 m0, %2\n\ts_nop 0\n\tglobal_load_lds_dwordx4 %1, off\n\ts_mov_b32 m0, %0" : "=&s"(keep) : "v"(gsrc), "s"(lds_dst) : "memory"); }
__device__ __forceinline__ float max3f(float a, float b, float c) { float r; asm("v_max3_f32 %0, %1, %2, %3" : "=v"(r) : "v"(a), "v"(b), "v"(c)); return r; }
__device__ __forceinline__ float max2f(float a, float b) { float r; asm("v_max_f32_e32 %0, %1, %2" : "=v"(r) : "v"(a), "v"(b)); return r; }
__device__ __forceinline__ float fadd_s(float a, float b) { float r; asm("v_add_f32_e32 %0, %1, %2" : "=v"(r) : "v"(a), "v"(b)); return r; }
__device__ __forceinline__ float fsub_s(float a, float b) { float r; asm("v_sub_f32_e32 %0, %1, %2" : "=v"(r) : "v"(a), "v"(b)); return r; }
template <int N> __device__ __forceinline__ void wait_bar() { asm volatile("s_waitcnt vmcnt(%0) lgkmcnt(0)\n\ts_barrier" :: "n"(N) : "memory"); }
#define WAIT_BAR(N) wait_bar<(N)>()
template <int ND> __device__ __forceinline__ void qkt(f32x16& p0, f32x16& p1, const char* Kslot, const bf16x8* qr, const f32x16& negm, int r32, int hi) {
    const char* kb = Kslot + hi * 1024 + r32 * 16;
#pragma unroll
    for (int d0 = 0; d0 < ND; ++d0) {
        const bf16x8 b0 = *reinterpret_cast<const bf16x8*>(kb + d0 * 2048);
        const bf16x8 b1 = *reinterpret_cast<const bf16x8*>(kb + d0 * 2048 + 512);
        if (d0 == 0) { p0 = __builtin_amdgcn_mfma_f32_32x32x16_bf16(b0, qr[0], negm, 0, 0, 0); p1 = __builtin_amdgcn_mfma_f32_32x32x16_bf16(b1, qr[0], negm, 0, 0, 0); }
        else { p0 = __builtin_amdgcn_mfma_f32_32x32x16_bf16(b0, qr[d0], p0, 0, 0, 0); p1 = __builtin_amdgcn_mfma_f32_32x32x16_bf16(b1, qr[d0], p1, 0, 0, 0); } }
}
typedef __attribute__((address_space(3))) const char* lds_cptr;
typedef short v4i16_t __attribute__((ext_vector_type(4)));
template <int ND> __device__ __forceinline__ void kloadall(bf16x8* kf, lds_cptr kp) {
    kf[0] = *(const LAS bf16x8*)(kp);        kf[1] = *(const LAS bf16x8*)(kp + 512);
    kf[2] = *(const LAS bf16x8*)(kp + 2048); kf[3] = *(const LAS bf16x8*)(kp + 2560);
    kf[4] = *(const LAS bf16x8*)(kp + 4096); kf[5] = *(const LAS bf16x8*)(kp + 4608);
    kf[6] = *(const LAS bf16x8*)(kp + 6144); kf[7] = *(const LAS bf16x8*)(kp + 6656);
    if constexpr (ND == 6) { kf[8] = *(const LAS bf16x8*)(kp + 8192); kf[9] = *(const LAS bf16x8*)(kp + 8704); kf[10] = *(const LAS bf16x8*)(kp + 10240); kf[11] = *(const LAS bf16x8*)(kp + 10752); }
}
__device__ __forceinline__ void kload2(bf16x8* kf, lds_cptr kp, int j) { kf[2 * j] = *(const LAS bf16x8*)(kp + j * 2048); kf[2 * j + 1] = *(const LAS bf16x8*)(kp + j * 2048 + 512); }
__device__ __forceinline__ s16x4 vtr(lds_cptr p) { return __builtin_bit_cast(s16x4, __builtin_amdgcn_ds_read_tr16_b64_v4i16((LAS v4i16_t*)p)); }
__device__ __forceinline__ float rowmax(const f32x16& p0, const f32x16& p1) {
    float a = max3f(p0[0], p0[1], p1[0]), b = max3f(p0[2], p0[3], p1[1]); a = max3f(a, p1[2], p1[3]);
#pragma unroll
    for (int r = 4; r < 16; r += 4) { a = max3f(a, p0[r], p0[r + 1]); b = max3f(b, p0[r + 2], p0[r + 3]); a = max3f(a, p1[r], p1[r + 1]); b = max3f(b, p1[r + 2], p1[r + 3]); }
    const float m = max2f(a, b);
    auto rr = __builtin_amdgcn_permlane32_swap(__float_as_uint(m), __float_as_uint(m), false, false);
    return max2f(__uint_as_float(rr[0]), __uint_as_float(rr[1]));
}
template <int ND, int THRL>
__device__ __forceinline__ void attn_unit(const bf16* Q, int pq, const bf16* Qr, int pqr, const bf16* __restrict__ Kh, int pk, const bf16* __restrict__ Vh, int pkv, bf16* O, int po, int NT, char* shm) {
    constexpr int SLOTB = (ND == 6) ? 12288 : 8192, KD = (ND == 6) ? 2 : 1;
    constexpr int LDS_K = 0, LDS_V = NSLOT * SLOTB, LDS_WS = 2 * NSLOT * SLOTB, LDS_OST = LDS_WS + NWAVES * 64 * 4;
    int tid = threadIdx.x; asm volatile("" : "+v"(tid));
    const int lane = tid & 63, r32 = lane & 31, hi = lane >> 5; const int wid = __builtin_amdgcn_readfirstlane(tid >> 6);
    const bf16* Qw = Q + (size_t)(wid * 32) * pq;
    const unsigned lds0 = (unsigned)(uintptr_t)shm;
    float* wsf = (float*)(shm + LDS_WS) + wid * 64;
    const bf16* ksrc = Kh + (size_t)lane * pk + wid * 8;
    const bf16* ksrc2 = Kh + (size_t)lane * pk + (8 + (wid & 3)) * 8;
    const unsigned kdst2 = lds0 + LDS_K + (8 + (wid & 3)) * 1024; (void)ksrc2; (void)kdst2;
    const bf16* vsrc = Vh + (size_t)(16 * (wid & 3) + (lane >> 2)) * pkv + (wid >> 2) * 32 + (lane & 3) * 8;
    const unsigned kdst = lds0 + LDS_K + wid * 1024, vdst = lds0 + LDS_V + wid * 1024;
#define DMA_K(t, slot) do { glds16(ksrc + (size_t)(t) * 64 * pk, (unsigned)__builtin_amdgcn_readfirstlane(kdst + (slot))); if constexpr (ND == 6) glds16(ksrc2 + (size_t)(t) * 64 * pk, (unsigned)__builtin_amdgcn_readfirstlane(kdst2 + (slot))); } while (0)
#define DMA_V(t, slot) glds16(vsrc + (size_t)(t) * 64 * pkv, (unsigned)__builtin_amdgcn_readfirstlane(vdst + (slot)))
    const int vb0 = (int)(lds0 + LDS_V) + ((lane >> 4) & 1) * 32 + (lane & 3) * 8 + (4 * hi + ((lane & 15) >> 2)) * 64;
    const char* Kbase = shm + LDS_K; bf16x8 kf[2 * ND];
    const lds_cptr shm3 = (lds_cptr)shm; const lds_cptr kp0 = shm3 + LDS_K + hi * 1024 + r32 * 16; const lds_cptr vp0 = shm3 + LDS_V + ((lane >> 4) & 1) * 32 + (lane & 3) * 8 + (4 * hi + ((lane & 15) >> 2)) * 64;
    DMA_K(0, 0); DMA_V(0, 0); DMA_K(1, SLOTB);
    bf16x8 qr[ND];
#pragma unroll
    for (int d0 = 0; d0 < 4; ++d0) qr[d0] = *reinterpret_cast<const bf16x8*>(&Qw[(size_t)r32 * pq + d0 * 16 + hi * 8]);
    if constexpr (ND == 6) {
#pragma unroll
        for (int d0 = 4; d0 < 6; ++d0) qr[d0] = *reinterpret_cast<const bf16x8*>(&Qr[(size_t)(wid * 32 + r32) * pqr + (d0 - 4) * 16 + hi * 8]); }
    float mhat = 0.f, l_reg = 0.f; f32x16 o[2]; o[0] = f32x16{}; o[1] = f32x16{}; f32x16 negm = f32x16{}; asm volatile("" : "+v"(negm));
    bool resc = false;
#define START(P0, P1) do { const float rm = rowmax(P0, P1); resc = false; \
    { const float dl = rm; mhat = fadd_s(mhat, dl); \
      _Pragma("unroll") for (int r = 0; r < 16; ++r) { P0[r] = fsub_s(P0[r], dl); P1[r] = fsub_s(P1[r], dl); } \
      _Pragma("unroll") for (int r = 0; r < 16; ++r) negm[r] = -mhat; asm volatile("" : "+v"(negm)); } \
    _Pragma("unroll") for (int r = 0; r < 16; ++r) P0[r] = __builtin_amdgcn_exp2f(P0[r]); } while (0)
#define RESC() do { if (resc) { asm volatile("s_waitcnt lgkmcnt(0)" ::: "memory"); \
      _Pragma("unroll") for (int d_ = 0; d_ < 2; ++d_) _Pragma("unroll") for (int r = 0; r < 16; ++r) o[d_][r] *= wsf[crow(r, hi)]; } } while (0)
    f32x16 pA0, pA1, pB0, pB1;
    int sl_prev = 0, sl_cur = 0, sl_next = SLOTB;
#define ROT() do { sl_prev = sl_cur; sl_cur = sl_next; sl_next = (sl_next == (NSLOT - 1) * SLOTB) ? 0 : sl_next + SLOTB; } while (0)
    DMA_K(2, 2 * SLOTB);
    WAIT_BAR(1 + 2 * KD);
    qkt<ND>(pA0, pA1, Kbase, qr, negm, r32, hi); asm volatile("s_nop 15\n\ts_nop 7" : "+v"(pA0), "+v"(pA1));
    START(pA0, pA1);
    _Pragma("unroll") for (int r = 0; r < 16; ++r) pA1[r] = __builtin_amdgcn_exp2f(pA1[r]);
    WAIT_BAR(0);
    DMA_K(3, 0); DMA_V(1, SLOTB);
    ROT();
    kloadall<ND>(kf, kp0 + sl_cur);
    WAIT_BAR(KD + 1);
    s16x4 vlo[8], vhi[8]; u32x4 pw0, pw1, pw2, pw3;
#define PKW(P, B) cvtpk(P[B], P[B + 1])
#define PAF(k) __builtin_bit_cast(bf16x8, pw##k)
#define VFR(i) (bf16x8){vlo[i][0], vlo[i][1], vlo[i][2], vlo[i][3], vhi[i][0], vhi[i][1], vhi[i][2], vhi[i][3]}
#define PIN(x) asm volatile("" : "+v"(x))
#define MX3(a, b, c) __builtin_fmaxf(__builtin_fmaxf((a), (b)), (c))
#define GAPA(MF, A0, A1, A2, A3, W0, W1, PW) do { MF; sacc += A0; sacc += A1; sacc += A2; sacc += A3; PIN(sacc); W0; W1; PIN(PW); SBAR(); } while (0)
#define EX(v) __builtin_amdgcn_exp2f(v)
#define GAPB(MF, X, B) do { MF; X[B] = EX(X[B]); X[B + 1] = EX(X[B + 1]); X[B + 2] = EX(X[B + 2]); X[B + 3] = EX(X[B + 3]); PIN(X); SBAR(); } while (0)
#define VRD(i) do { vlo[i] = vtr(vp_ + (((i) >> 2) * 4096 + ((i) & 3) * 1024)); vhi[i] = vtr(vp_ + (((i) >> 2) * 4096 + ((i) & 3) * 1024 + 512)); } while (0)
#define KRD(G, j) do { if (G) { kload2(kf, kp0 + sl_next, j); SBAR(); } } while (0)
#define STEP(C0, C1, P0, P1, t, GK, GV, GL) do { SBAR(); \
    const lds_cptr vp_ = vp0 + sl_prev; \
    VRD(0); SBAR(); float sacc = (P0[0] + P0[1]); \
    GAPA(C0 = __builtin_amdgcn_mfma_f32_32x32x16_bf16(kf[0], qr[0], negm, 0, 0, 0), P0[2], P0[3], P0[4], P0[5],     pw0[0] = PKW(P0, 0), pw0[1] = PKW(P0, 2), pw0); \
    VRD(4); SBAR(); GAPA(C1 = __builtin_amdgcn_mfma_f32_32x32x16_bf16(kf[1], qr[0], negm, 0, 0, 0), P0[6], P0[7], P0[8], P0[9],     pw0[2] = PKW(P0, 4), pw0[3] = PKW(P0, 6), pw0); \
    VRD(1); SBAR(); GAPA(C0 = __builtin_amdgcn_mfma_f32_32x32x16_bf16(kf[2], qr[1], C0, 0, 0, 0),   P0[10], P0[11], P0[12], P0[13], pw1[0] = PKW(P0, 8), pw1[1] = PKW(P0, 10), pw1); \
    VRD(5); SBAR(); GAPA(C1 = __builtin_amdgcn_mfma_f32_32x32x16_bf16(kf[3], qr[1], C1, 0, 0, 0),   P0[14], P0[15], P1[0], P1[1],   pw1[2] = PKW(P0, 12), pw1[3] = PKW(P0, 14), pw1); \
    VRD(2); SBAR(); GAPA(C0 = __builtin_amdgcn_mfma_f32_32x32x16_bf16(kf[4], qr[2], C0, 0, 0, 0),   P1[2], P1[3], P1[4], P1[5],     pw2[0] = PKW(P1, 0), pw2[1] = PKW(P1, 2), pw2); \
    VRD(6); SBAR(); GAPA(C1 = __builtin_amdgcn_mfma_f32_32x32x16_bf16(kf[5], qr[2], C1, 0, 0, 0),   P1[6], P1[7], P1[8], P1[9],     pw2[2] = PKW(P1, 4), pw2[3] = PKW(P1, 6), pw2); \
    VRD(3); SBAR(); GAPA(C0 = __builtin_amdgcn_mfma_f32_32x32x16_bf16(kf[6], qr[3], C0, 0, 0, 0),   P1[10], P1[11], P1[12], P1[13], pw3[0] = PKW(P1, 8), pw3[1] = PKW(P1, 10), pw3); \
    VRD(7); SBAR(); GAPA(C1 = __builtin_amdgcn_mfma_f32_32x32x16_bf16(kf[7], qr[3], C1, 0, 0, 0),   P1[14], P1[15], 0.f, 0.f,       pw3[2] = PKW(P1, 12), pw3[3] = PKW(P1, 14), pw3); \
    if constexpr (ND == 6) { C0 = __builtin_amdgcn_mfma_f32_32x32x16_bf16(kf[8], qr[4], C0, 0, 0, 0); SBAR(); C1 = __builtin_amdgcn_mfma_f32_32x32x16_bf16(kf[9], qr[4], C1, 0, 0, 0); SBAR(); \
      C0 = __builtin_amdgcn_mfma_f32_32x32x16_bf16(kf[10], qr[5], C0, 0, 0, 0); SBAR(); C1 = __builtin_amdgcn_mfma_f32_32x32x16_bf16(kf[11], qr[5], C1, 0, 0, 0); SBAR(); } \
    l_reg += sacc; \
    if (GK) { DMA_K((t) + 3, sl_cur); } if (GV) { DMA_V((t) + 1, sl_next); } \
    { float a = MX3(C0[0], C0[1], C1[0]), b = MX3(C0[2], C0[3], C1[1]); a = MX3(a, C1[2], C1[3]); \
      _Pragma("unroll") for (int r = 4; r < 16; r += 4) { a = MX3(a, C0[r], C0[r + 1]); b = MX3(b, C0[r + 2], C0[r + 3]); a = MX3(a, C1[r], C1[r + 1]); b = MX3(b, C1[r + 2], C1[r + 3]); } \
      float rm = __builtin_fmaxf(a, b); { auto rr = __builtin_amdgcn_permlane32_swap(__float_as_uint(rm), __float_as_uint(rm), false, false); rm = __builtin_fmaxf(__uint_as_float(rr[0]), __uint_as_float(rr[1])); } \
      resc = false; \
      if (__builtin_expect(__any(rm > (float)THRL), 0)) { const float dl = __builtin_fmaxf(rm, 0.f); mhat += dl; \
        _Pragma("unroll") for (int r = 0; r < 16; ++r) { C0[r] -= dl; C1[r] -= dl; } \
        _Pragma("unroll") for (int r = 0; r < 16; ++r) negm[r] = -mhat; asm volatile("" : "+v"(negm)); \
        const float f = __builtin_amdgcn_exp2f(-dl); l_reg *= f; if (hi == 0) wsf[r32] = f; resc = true; } } \
    SBAR(); \
    GAPB(o[0] = __builtin_amdgcn_mfma_f32_32x32x16_bf16(PAF(0), VFR(0), o[0], 0, 0, 0), C0, 0); \
    GAPB(o[1] = __builtin_amdgcn_mfma_f32_32x32x16_bf16(PAF(0), VFR(4), o[1], 0, 0, 0), C0, 4); \
    KRD(GL, 0); GAPB(o[0] = __builtin_amdgcn_mfma_f32_32x32x16_bf16(PAF(1), VFR(1), o[0], 0, 0, 0), C0, 8); \
    KRD(GL, 1); GAPB(o[1] = __builtin_amdgcn_mfma_f32_32x32x16_bf16(PAF(1), VFR(5), o[1], 0, 0, 0), C0, 12); \
    KRD(GL, 2); GAPB(o[0] = __builtin_amdgcn_mfma_f32_32x32x16_bf16(PAF(2), VFR(2), o[0], 0, 0, 0), C1, 0); \
    KRD(GL, 3); GAPB(o[1] = __builtin_amdgcn_mfma_f32_32x32x16_bf16(PAF(2), VFR(6), o[1], 0, 0, 0), C1, 4); \
    if constexpr (ND == 6) { KRD(GL, 4); } GAPB(o[0] = __builtin_amdgcn_mfma_f32_32x32x16_bf16(PAF(3), VFR(3), o[0], 0, 0, 0), C1, 8); \
    if constexpr (ND == 6) { KRD(GL, 5); } GAPB(o[1] = __builtin_amdgcn_mfma_f32_32x32x16_bf16(PAF(3), VFR(7), o[1], 0, 0, 0), C1, 12); \
    } while (0)
    int t = 1;
    for (; t + 5 < NT; t += 2) {
        STEP(pB0, pB1, pA0, pA1, t, true, true, true);     WAIT_BAR(KD + 1); RESC(); ROT();
        STEP(pA0, pA1, pB0, pB1, t + 1, true, true, true); WAIT_BAR(KD + 1); RESC(); ROT();
    }
#define ENDW(tt) do { if ((tt) + 3 < NT) { WAIT_BAR(KD + 1); } else if ((tt) + 2 < NT) { WAIT_BAR(1); } else { WAIT_BAR(0); } } while (0)
    for (; t + 1 < NT; t += 2) {
        STEP(pB0, pB1, pA0, pA1, t, (t + 3 < NT), (t + 1 < NT), (t + 1 < NT));     ENDW(t);     RESC(); ROT();
        STEP(pA0, pA1, pB0, pB1, t + 1, (t + 4 < NT), (t + 2 < NT), (t + 2 < NT)); ENDW(t + 1); RESC(); ROT();
    }
    STEP(pB0, pB1, pA0, pA1, NT - 1, false, false, false); RESC();
    { float sacc = pB0[0] + pB0[1]; _Pragma("unroll") for (int r = 2; r < 16; ++r) sacc += pB0[r]; _Pragma("unroll") for (int r = 0; r < 16; ++r) sacc += pB1[r]; l_reg += sacc;
      pw0 = (u32x4){PKW(pB0, 0), PKW(pB0, 2), PKW(pB0, 4), PKW(pB0, 6)}; pw1 = (u32x4){PKW(pB0, 8), PKW(pB0, 10), PKW(pB0, 12), PKW(pB0, 14)}; pw2 = (u32x4){PKW(pB1, 0), PKW(pB1, 2), PKW(pB1, 4), PKW(pB1, 6)}; pw3 = (u32x4){PKW(pB1, 8), PKW(pB1, 10), PKW(pB1, 12), PKW(pB1, 14)};
      SBAR(); att::pv(o, vb0 + sl_cur, PAF(0), PAF(1), PAF(2), PAF(3)); }
#undef PKW
#undef PAF
#undef VFR
#undef PIN
#undef MX3
#undef GAPA
#undef GAPB
#undef EX
#undef VRD
#undef KRD
#undef STEP
#undef ENDW
    { auto rr = __builtin_amdgcn_permlane32_swap(__float_as_uint(l_reg), __float_as_uint(l_reg), false, false); l_reg = __uint_as_float(rr[0]) + __uint_as_float(rr[1]); }
    if (hi == 0) wsf[32 + r32] = l_reg; asm volatile("s_waitcnt lgkmcnt(0)" ::: "memory");
    float rli[16];
#pragma unroll
    for (int r = 0; r < 16; ++r) rli[r] = __builtin_amdgcn_rcpf(wsf[32 + crow(r, hi)]);
    bf16* Ow = O + (size_t)(wid * 32) * po;
    { bf16* stg = (bf16*)(shm + LDS_OST) + wid * 2048;
#pragma unroll
      for (int r = 0; r < 16; ++r) { const int orow = crow(r, hi);
#pragma unroll
        for (int d0 = 0; d0 < 2; ++d0) stg[orow * 64 + d0 * 32 + r32] = (bf16)(cvtpk(o[d0][r] * rli[r], 0.f) & 0xffffu); }
      asm volatile("s_waitcnt lgkmcnt(0)" ::: "memory");
#pragma unroll
      for (int i = 0; i < 4; ++i) { const int row = i * 8 + (lane >> 3), ch = lane & 7; const u32x4 v = *(const u32x4*)(stg + row * 64 + ch * 8); *(u32x4*)(Ow + (size_t)row * po + ch * 8) = v; } }
    asm volatile("s_waitcnt lgkmcnt(0)\n\ts_barrier" ::: "memory");
#undef DMA_K
#undef DMA_V
#undef START
#undef RESC
#undef ROT
}
#undef SBAR
#undef WAIT_BAR
}

#define RLX_AGENT __ATOMIC_RELAXED, __HIP_MEMORY_SCOPE_AGENT
#define XB_TMO      128
#define XB_XCNT(j)  (256  + 64 * (j))
#define XB_XSUB(j)  (1280 + 64 * (j))
#define XB_XGEN(j)  (2304 + 64 * (j))
#define XB_TOP      3328
#define XB_TOPGEN   3392
#define XCD_BAR_WORDS 3456
#define XB_SPIN_CAP (1u << 18)
__device__ __forceinline__ unsigned xb_ld(unsigned* p)              { return __hip_atomic_load(p, __ATOMIC_RELAXED, __HIP_MEMORY_SCOPE_AGENT); }
__device__ __forceinline__ unsigned xb_add(unsigned* p, unsigned v) { return __hip_atomic_fetch_add(p, v, __ATOMIC_RELAXED, __HIP_MEMORY_SCOPE_AGENT); }
__device__ __forceinline__ unsigned xb_xcc_id() { return (unsigned)__builtin_amdgcn_s_getreg((3 << 11) | 20) & 0xFu; }
#define XB_SPIN(cond, bar) do { unsigned _sp = 0; while (cond) { __builtin_amdgcn_s_sleep(1); \
    if ((++_sp & 255u) == 0u) { if (xb_ld(&(bar)[XB_TMO])) break; if (_sp > XB_SPIN_CAP) { atomicAdd(&(bar)[XB_TMO], 1u); break; } } } } while (0)
struct XcdBarrier { unsigned* bar; unsigned x; volatile LAS unsigned* st; };
__device__ __forceinline__ XcdBarrier xcd_barrier_post(unsigned* bar, volatile LAS unsigned* st) {
    XcdBarrier b; b.bar = bar; b.x = xb_xcc_id(); b.st = st;
    if (threadIdx.x == 0) (void)xb_add(&bar[XB_XCNT(b.x)], 1u);
    return b;
}
__device__ __forceinline__ void xcd_barrier_complete(unsigned* bar, unsigned x, unsigned& nloc, unsigned& nx) {
    const unsigned G = gridDim.x * gridDim.y * gridDim.z;
    unsigned sum, cnt, mine, sp = 0u;
    for (;;) {
        sum = 0u; cnt = 0u; mine = 0u;
#pragma unroll
        for (unsigned j = 0; j < 16; ++j) { const unsigned c = xb_ld(&bar[XB_XCNT(j)]); sum += c; cnt += (c > 0u) ? 1u : 0u; mine = (j == x) ? c : mine; }
        if (sum == G) break;
        __builtin_amdgcn_s_sleep(1);
        if ((++sp & 255u) == 0u) { if (xb_ld(&bar[XB_TMO])) break; if (sp > XB_SPIN_CAP) { atomicAdd(&bar[XB_TMO], 1u); break; } }
    }
    nloc = mine > 0u ? mine : 1u; nx = cnt > 0u ? cnt : 1u;
}
__device__ __forceinline__ void xcd_barrier(const XcdBarrier& b) {
    asm volatile("s_waitcnt vmcnt(0)" ::: "memory");
    __syncthreads();
    if (threadIdx.x == 0) {
        unsigned* bar = b.bar;
        __builtin_amdgcn_s_waitcnt(0);
        unsigned nloc = b.st[0], nx = b.st[1];
        if (nloc == 0u) { xcd_barrier_complete(bar, b.x, nloc, nx); b.st[0] = nloc; b.st[1] = nx; }
        const unsigned old = xb_add(&bar[XB_XSUB(b.x)], 1u);
        const unsigned gen = old / nloc;
        if (old + 1u == (gen + 1u) * nloc) {
            __builtin_amdgcn_fence(__ATOMIC_RELEASE, "agent");
            asm volatile("s_waitcnt vmcnt(0)" ::: "memory");
            const unsigned og = xb_add(&bar[XB_TOP], 1u);
            const unsigned tg = og / nx;
            if (og + 1u == (tg + 1u) * nx) xb_add(&bar[XB_TOPGEN], 1u);
            else XB_SPIN(xb_ld(&bar[XB_TOPGEN]) == tg, bar);
            __builtin_amdgcn_fence(__ATOMIC_ACQUIRE, "agent");
            xb_add(&bar[XB_XGEN(b.x)], 1u);
            asm volatile("s_waitcnt vmcnt(0)" ::: "memory");
        } else {
            XB_SPIN(xb_ld(&bar[XB_XGEN(b.x)]) == gen, bar);
            __builtin_amdgcn_fence(__ATOMIC_ACQUIRE, "agent");
            asm volatile("s_waitcnt vmcnt(0)" ::: "memory");
        }
    }
    __syncthreads();
}
constexpr int LDS_MISC = 131072 + 1024;
constexpr size_t CTL_ZERO_BYTES = 64 * KiB;

struct Args { const float* in[26]; float* out; unsigned char* ws; int ph_lo, ph_hi; };
constexpr int LDS_BYTES = 147456;
constexpr int NPHASE = 21;

typedef const __attribute__((address_space(4))) unsigned char* KP;
__device__ __forceinline__ const float* kin(KP kp, int k) { return *(const float* const __attribute__((address_space(4)))*)(kp + 8 * k); }
__device__ __forceinline__ float* kout(KP kp) { return *(float* const __attribute__((address_space(4)))*)(kp + 208); }
__device__ __forceinline__ unsigned char* kws(KP kp) { return *(unsigned char* const __attribute__((address_space(4)))*)(kp + 216); }
static_assert(sizeof(Args) == 232, "Args layout");
struct Ctx {
    LAS unsigned char* lds; int tid, lane, wave, vcu, G; unsigned char* ws; int cv_rank, cv_n;
};

enum MatId { M_WIN = 0, M_WUQ, M_WUKV, M_NAT, M_FFI, M_NATP };
__device__ __forceinline__ int rope_perm(int p) { const int n = p >> 4, fq = (p >> 2) & 3, j = p & 3; return 16 * (fq >> 1) + 8 * n + 4 * (fq & 1) + j; }
__device__ __forceinline__ int head_perm(int pc, int& wc) { wc = (pc >> 5) & 3; return 32 * (pc >> 7) + (pc & 31); }
__device__ __forceinline__ int pg32(int x) { const int p = x & 31; return (x & ~31) | (8 * ((p >> 2) & 3) + 4 * (p >> 4) + (p & 3)); }
__device__ __forceinline__ int src_col(int mat, int n) {
    const int t = n >> 8, pc = n & 255; int wc;
    switch (mat) {
    case M_WIN:
        if (t < 2) { const int d = head_perm(pc, wc); return (4 * t + wc) * 64 + d; }
        if (t == 2) { const int d = head_perm(pc, wc); return wc < 2 ? 512 + wc * 64 + d : 640 + (wc - 2) * 64 + d; }
        if (t == 3) return 768 + pg32(pc);
        if (t == 4) { if (pc < 128) return 768 + 256 + pg32(pc); if (pc < 160) return 1408 + rope_perm(pc - 128); return -1; }
        if (t == 5) return 1152 + pg32(pc);
        if (t < 8) return 1440 + (t - 6) * 256 + pg32(pc);
        return 1952 + (t - 8) * 256 + pg32(pc);
    case M_WUQ:
        if (t < 2) { const int d = head_perm(pc, wc); return (4 * t + wc) * 96 + d; }
        { const int bj = pc >> 7, w2 = (pc >> 5) & 3; return (4 * bj + w2) * 96 + 64 + rope_perm(pc & 31); }
    case M_WUKV:
        { const int d = head_perm(pc, wc); return t < 2 ? (4 * t + wc) * 128 + d : (4 * (t - 2) + wc) * 128 + 64 + d; }
    case M_FFI:
        return pc < 128 ? t * 128 + pg32(pc) : FFH + t * 128 + pg32(pc - 128);
    case M_NATP: return pg32(n);
    default: return n;
    }
}
__device__ __forceinline__ void xpose_item(const float* W, int ldw, const float* kscale, bf16* WT, int ldo, int kcol0, int mat, int nblk, int item, LAS float* scr, int lane) {
    const int kb = item / nblk, nb = item % nblk, k0 = 64 * kb, n0 = 32 * nb;
    const int r = lane >> 3, g4 = 4 * (lane & 7);
    const int sc = src_col(mat, n0 + g4);
    f32x4 v[8];
#pragma unroll
    for (int i = 0; i < 8; ++i) { const int k = k0 + 8 * i + r; v[i] = (sc >= 0) ? *(const f32x4*)(W + (size_t)k * ldw + sc) : (f32x4){0.f, 0.f, 0.f, 0.f}; if (kscale) v[i] *= kscale[k]; }
#pragma unroll
    for (int i = 0; i < 8; ++i) { LAS float* d = scr + (8 * i + r) * 33 + g4; d[0] = v[i][0]; d[1] = v[i][1]; d[2] = v[i][2]; d[3] = v[i][3]; }
    asm volatile("s_waitcnt lgkmcnt(0)" ::: "memory");
    const int c = lane & 7;
#pragma unroll
    for (int j = 0; j < 4; ++j) { const int n = (lane >> 3) + 8 * j; const LAS float* s = scr + (8 * c) * 33 + n;
        u32x4 o; o.x = cvtpk(s[0 * 33], s[1 * 33]); o.y = cvtpk(s[2 * 33], s[3 * 33]); o.z = cvtpk(s[4 * 33], s[5 * 33]); o.w = cvtpk(s[6 * 33], s[7 * 33]);
        *(u32x4*)(WT + (size_t)(n0 + n) * ldo + kcol0 + k0 + 8 * c) = o; }
    asm volatile("s_waitcnt lgkmcnt(0)" ::: "memory");
}
__device__ __forceinline__ void run_xjob(const Ctx& F, int& base, const float* W, int ldw, const float* kscale, bf16* WT, int ldo, int kcol0, int mat, int K, int N) {
    LAS float* scr = (LAS float*)(F.lds + F.wave * 16384);
    const int gw = F.cv_rank * NWAVES + F.wave, NGW = F.cv_n * NWAVES;
    const int nblk = N / 32, nit = (K / 64) * nblk;
    int first = gw - (base % NGW); if (first < 0) first += NGW;
    for (int it = first; it < nit; it += NGW) xpose_item(W, ldw, kscale, WT, ldo, kcol0, mat, nblk, it, scr, F.lane);
    base += nit;
}

__device__ __forceinline__ void norm_pass(const Ctx& F, const float* x_lat, const float* x_ctx, bf16* HB, const float* gnorm, const float* mod_l, int shift_off, int nrows) {
    const int gw = F.vcu * NWAVES + F.wave, NGW = F.G * NWAVES;
    const int per = (nrows + NGW - 1) / NGW; const int r0 = gw * per, r1 = min(nrows, r0 + per);
    int cur_s = -1; f32x4 ca[4], cb[4];
    for (int r = r0; r < r1; ++r) {
        const bool ctx = r >= ML; const int s = ctx ? 8 : r >> 11;
        if (s != cur_s) { cur_s = s; const float* sh = mod_l + s * 6144 + shift_off; const float* scl = sh + 1024;
#pragma unroll
            for (int j = 0; j < 4; ++j) { const f32x4 g = *(const f32x4*)(gnorm + 256 * j + 4 * F.lane); const f32x4 sc1 = *(const f32x4*)(scl + 256 * j + 4 * F.lane); ca[j] = g * (sc1 + 1.0f); cb[j] = *(const f32x4*)(sh + 256 * j + 4 * F.lane); } }
        const float* xr = ctx ? x_ctx + (size_t)(r - ML) * 1024 : x_lat + (size_t)r * 1024;
        f32x4 v[4]; float ss = 0.f;
#pragma unroll
        for (int j = 0; j < 4; ++j) { v[j] = *(const f32x4*)(xr + 256 * j + 4 * F.lane); ss += (v[j][0] * v[j][0] + v[j][1] * v[j][1]) + (v[j][2] * v[j][2] + v[j][3] * v[j][3]); }
        const float rstd = rsqrtf(wave_sum(ss) * (1.0f / 1024.0f) + EPS);
#pragma unroll
        for (int j = 0; j < 4; ++j) *(u32x2*)(HB + (size_t)r * 1024 + 256 * j + 4 * F.lane) = pk4(v[j] * rstd * ca[j] + cb[j]);
    }
}

__device__ __forceinline__ void mod_items(const Ctx& F, KP kp) {
    const float* c = kin(kp, 1); const float* cc = kin(kp, 3); const float* wmod = kin(kp, 4); const float* bmod = kin(kp, 5);
    float* mod = (float*)(F.ws + O_MOD);
    LAS float* sl = (LAS float*)F.lds;
    LAS float* red = sl + 9 * 1024;
    for (int it = F.vcu; it < 192; it += F.G) {
        const int l = it / 96, n0 = (it % 96) * 64;
        __syncthreads();
        for (int i = F.tid; i < 9 * 1024; i += NTHR) { const float v = (i < 8192) ? c[i] : cc[i - 8192]; sl[i] = v * sigmoidf_(v); }
        __syncthreads();
        float acc[9];
#pragma unroll
        for (int s = 0; s < 9; ++s) acc[s] = 0.f;
        const float* wp = wmod + (size_t)l * 1024 * 6144 + n0 + F.lane;
        for (int k0 = F.wave * 128; k0 < F.wave * 128 + 128; k0 += 16) { float w[16];
#pragma unroll
            for (int j = 0; j < 16; ++j) w[j] = wp[(size_t)(k0 + j) * 6144];
#pragma unroll
            for (int j = 0; j < 16; ++j)
#pragma unroll
                for (int s = 0; s < 9; ++s) acc[s] += sl[s * 1024 + k0 + j] * w[j]; }
#pragma unroll
        for (int s = 0; s < 9; ++s) red[(F.wave * 9 + s) * 64 + F.lane] = acc[s];
        __syncthreads();
        for (int i = F.tid; i < 9 * 64; i += NTHR) { float t = 0.f;
#pragma unroll
            for (int w = 0; w < 8; ++w) t += red[w * 576 + i];
            const int s = i / 64, n = n0 + (i & 63); mod[(l * 9 + s) * 6144 + n] = t + bmod[l * 6144 + n]; }
    }
    __syncthreads();
}
__device__ __forceinline__ void table_items(const Ctx& F) {
    const int gt = (F.vcu * NTHR) + F.tid, NT_ = F.G * NTHR;
    float* ra = (float*)(F.ws + O_ROPEA); float* rb = (float*)(F.ws + O_ROPEB);
    for (int i = gt; i < 1024; i += NT_) { const int pos = i >> 4, f = i & 15; const float fr = powf(10000.0f, -(float)(2 * f) / 32.0f); const float ang = (float)pos * fr; ra[i] = cosf(ang); ra[1024 + i] = sinf(ang); }
    for (int i = gt; i < 512; i += NT_) { const int pos = i >> 3, f = i & 7; const float fr = powf(10000.0f, -(float)(2 * f) / 16.0f); const float ang = (float)pos * fr; rb[i] = cosf(ang); rb[512 + i] = sinf(ang); }
    bf16* DN = (bf16*)(F.ws + O_DN); bf16* DN2 = (bf16*)(F.ws + O_DN256); bf16* DC = (bf16*)(F.ws + O_DFTC);
    {
      LAS unsigned* tab = (LAS unsigned*)F.lds;
      const float sc = 0.022097086912079608f;
      __syncthreads();
      for (int m = F.tid; m < 2048; m += NTHR) { float s0, c0; sincospif((float)m * (1.0f / 1024.0f), &s0, &c0); tab[m] = cvtpk(c0 * sc, -s0 * sc); }
      __syncthreads();
      for (int i = gt; i < 2048 * 2048 / 8; i += NT_) { const int n = i >> 8, k = (i & 255) * 8; unsigned t[8];
#pragma unroll
          for (int j = 0; j < 8; ++j) t[j] = tab[(n * (k + j)) & 2047];
          u32x4 cw, sw;
          cw.x = (t[0] & 0xffffu) | (t[1] << 16); cw.y = (t[2] & 0xffffu) | (t[3] << 16); cw.z = (t[4] & 0xffffu) | (t[5] << 16); cw.w = (t[6] & 0xffffu) | (t[7] << 16);
          sw.x = (t[0] >> 16) | (t[1] & 0xffff0000u); sw.y = (t[2] >> 16) | (t[3] & 0xffff0000u); sw.z = (t[4] >> 16) | (t[5] & 0xffff0000u); sw.w = (t[6] >> 16) | (t[7] & 0xffff0000u);
          *(u32x4*)(DN + (size_t)n * 4096 + k) = cw; *(u32x4*)(DN + (size_t)n * 4096 + 2048 + k) = sw; }
      __syncthreads(); }
    { const float sc = 0.0625f;
      for (int i = gt; i < 256 * 256; i += NT_) { const int n = i >> 8, k = i & 255; float s0, c0; sincospif((float)((n * k) & 255) * (1.0f / 128.0f), &s0, &c0);
          DN2[n * 512 + k] = (bf16)(cvtpk(c0 * sc, 0.f) & 0xffff); DN2[n * 512 + 256 + k] = (bf16)(cvtpk(-s0 * sc, 0.f) & 0xffff); } }
    { const float sc = 0.08838834764831845f;
      for (int i = gt; i < 256 * 128; i += NT_) { const int r = i >> 7, k = i & 127; float s0, c0; sincospif((float)(((r & 127) * k) & 127) * (1.0f / 64.0f), &s0, &c0);
          DC[i] = (bf16)(cvtpk((r < 128 ? c0 : s0) * sc, 0.f) & 0xffff); } }
}
__device__ __forceinline__ void convert_weights_main(const Ctx& F, KP kp, int l, int parts = 3) {
    int base = 0;
    if (parts & 1) {
        run_xjob(F, base, kin(kp, 8) + (size_t)l * 1024 * INW, INW, nullptr, (bf16*)(F.ws + O_WIN), 1024, 0, M_WIN, 1024, NINP);
        run_xjob(F, base, kin(kp, 13) + (size_t)l * 384 * 768, 768, kin(kp, 11) + l * 384, (bf16*)(F.ws + O_WUQ), 384, 0, M_WUQ, 384, 768);
        run_xjob(F, base, kin(kp, 14) + (size_t)l * 256 * 1024, 1024, kin(kp, 12) + l * 256, (bf16*)(F.ws + O_WUKV), 256, 0, M_WUKV, 256, 1024);
    }
    if (parts & 2) {
        run_xjob(F, base, kin(kp, 20) + (size_t)l * 512 * 1024, 1024, nullptr, (bf16*)(F.ws + O_WBR), 1536, 0, M_NATP, 512, 1024);
        run_xjob(F, base, kin(kp, 21) + (size_t)l * 512 * 1024, 1024, nullptr, (bf16*)(F.ws + O_WBR), 1536, 512, M_NATP, 512, 1024);
        run_xjob(F, base, kin(kp, 22) + (size_t)l * 512 * 1024, 1024, nullptr, (bf16*)(F.ws + O_WBR), 1536, 1024, M_NATP, 512, 1024);
        run_xjob(F, base, kin(kp, 23) + (size_t)l * 1024 * 1024, 1024, nullptr, (bf16*)(F.ws + O_WOUT), 1024, 0, M_NAT, 1024, 1024);
    }
}
__device__ __forceinline__ void convert_weights_ffn(const Ctx& F, KP kp, int l) {
    int base = 0;
    run_xjob(F, base, kin(kp, 24) + (size_t)l * 1024 * 2 * FFH, 2 * FFH, nullptr, (bf16*)(F.ws + O_WFI), 1024, 0, M_FFI, 1024, 2 * FFH);
    run_xjob(F, base, kin(kp, 25) + (size_t)l * FFH * 1024, 1024, nullptr, (bf16*)(F.ws + O_WFO), FFH, 0, M_NAT, FFH, 1024);
}

struct F1Sched {
    int nb_tok, G, c, row0, rows_per_b, nunits; const char* A; const char* PF;
    __device__ __forceinline__ bool next(int i, Unit& u) const { return at((long)i * G + c, u); }
    __device__ __forceinline__ bool at(long L, Unit& u) const {
        if (L >= nunits) return false;
        const int j = (int)L % nb_tok, bg = (int)L / nb_tok, gch = bg & 3, b = bg >> 2;
        u.pm = b * 4 + gch; u.pn = j; u.kb = 0; u.A = A; u.B = PF + ((size_t)(row0 + b * rows_per_b + j * 256) * 512 + gch * 128) * 2; return true;
    }
};
struct F2Sched {
    int nM, G, c, row0, rows_per_b, nunits; const char* DN; const char* ZT; size_t K2;
    __device__ __forceinline__ bool next(int i, Unit& u) const {
        const long L = (long)i * G + c; if (L >= nunits) return false;
        const int pn = (int)L & 1, r = (int)L >> 1, pm = r % nM, b = r / nM;
        u.pm = (row0 + b * rows_per_b) / 256 + pm; u.pn = pn; u.kb = 0;
        u.A = DN + (size_t)pm * 256 * K2 * 2; u.B = ZT + ((size_t)b * 512 + pn * 256) * K2 * 2; return true;
    }
};


struct P1Sched { RectSched s, sc, sq; int n0, n1, n2, G, c;
    __device__ __forceinline__ bool next(int i, Unit& u) const {
        const long L = (long)i * G + c;
        if (L >= n2) return false;
        if (L < n0) return s.at(L, 0, u);
        if (L < n1) return sc.at(L - n0, 0, u);
        return sq.at(L - n1, 0, u); } };
struct P2Sched {
    RectSched sq, sg, suq, sukv; F1Sched sf1, sf1c; int n0, ng, n1, n2, n3, n4, G, c, qoff;
    __device__ __forceinline__ bool next(int i, Unit& u) const {
        const long L = (long)i * G + ((i & 1) ? (G - 1 - c) : c);
        if (L >= n4) return false;
        if (L < n0) { u.lda = 1024; u.ldb = 1024; u.nt = 16; u.epi = 0; return sq.at(L + qoff, 0, u); }
        if (L < ng) { u.lda = 1024; u.ldb = 1024; u.nt = 16; u.epi = 0; if (!sg.at(L - n0, 0, u)) return false; u.pn += 8; return true; }
        if (L < n1) { u.lda = 384; u.ldb = 384; u.nt = 6; u.epi = 1; return suq.at(L - ng, 0, u); }
        if (L < n2) { u.lda = 256; u.ldb = 256; u.nt = 4; u.epi = 2; return sukv.at(L - n1, 0, u); }
        if (L < n3) { u.lda = 128; u.ldb = 512; u.nt = 2; u.epi = 3; return sf1.at(L - n2, u); }
        u.lda = 128; u.ldb = 512; u.nt = 2; u.epi = 4; return sf1c.at(L - n3, u);
    }
};
struct P2Epi {
    EpiIn e0; EpiUq e1; EpiUkv e2; EpiF1 e3, e4;
    __device__ __forceinline__ bool operator()(Acc& acc, const Unit& u, int wr, int wc, int fr, int fq) const {
        switch (u.epi) {
        case 0: return e0(acc, u, wr, wc, fr, fq);
        case 1: return e1(acc, u, wr, wc, fr, fq);
        case 2: return e2(acc, u, wr, wc, fr, fq);
        case 3: return e3(acc, u, wr, wc, fr, fq);
        default: return e4(acc, u, wr, wc, fr, fq);
        }
    }
};


struct WinSched { RectSched s; int off, cnt, G, c;
    __device__ __forceinline__ bool next(int i, Unit& u) const { const long L = (long)i * G + c; if (L >= cnt) return false; return s.at(L + off, 0, u); } };
struct FfnBSched { RectSched so, si; int n0, n1, off, G, c;
    __device__ __forceinline__ bool next(int i, Unit& u) const {
        long L;
        if (c < 32) { if (i == 0) L = c; else if (i <= 2) L = n0 + (i - 1) * 32 + c; else return false; }
        else { if (i >= 5) return false; L = n0 + 64 + (long)i * 224 + (c - 32); if (L >= n1) return false; }
        if (L < n0) { u.lda = FFH; u.ldb = FFH; u.nt = FFH / 64; u.epi = 1; return so.at(L, 0, u); }
        u.lda = 1024; u.ldb = 1024; u.nt = 16; u.epi = 0; return si.at(L - n0 + off, 0, u); } };
struct FfnBEpi { EpiSwiglu e0; EpiRes e1;
    __device__ __forceinline__ bool operator()(Acc& acc, const Unit& u, int wr, int wc, int fr, int fq) const { return u.epi == 0 ? e0(acc, u, wr, wc, fr, fq) : e1(acc, u, wr, wc, fr, fq); } };


struct GateChainSched { const char *HBp, *WINp; int c, nu;
    __device__ __forceinline__ bool next(int i, Unit& u) const {
        if (i >= nu) return false;
        int pm, pn; pg8::tile_order(c, 64, 4, pm, pn);
        u.pm = pm; u.pn = 8 + 4 * i + pn; u.kb = 0; u.A = HBp + (size_t)pm * 256 * 1024 * 2; u.B = WINp + (size_t)u.pn * 256 * 1024 * 2; return true; } };

#ifndef DIAG_SUB
#define DIAG_SUB -1
#endif
#ifndef TIME_REP
#define TIME_REP 0
#endif
#ifndef DIAG_TS
#define DIAG_TS -1
#endif
#ifndef TIME_PH
#define TIME_PH -1
#endif
#define REP(b) ((TIME_REP & (b)) ? 2 : 1)
#define SUB_ON(k) (DIAG_SUB < 0 || DIAG_SUB == (k))
#ifndef DIAG_PART
#define DIAG_PART 0xffff
#endif
#define PART_ON(b) ((DIAG_PART & (b)) != 0)
__global__ void __launch_bounds__(NTHR, 2) fwd_kernel(Args args) {
    extern __shared__ __attribute__((aligned(16))) unsigned char lds_raw[];
#if !MK_MULTI
    if (threadIdx.x < 2) ((volatile LAS unsigned*)((LAS unsigned char*)lds_raw + LDS_MISC))[threadIdx.x] = 0u;
    __syncthreads();
    const XcdBarrier xbar = xcd_barrier_post((unsigned*)(*(unsigned char* const __attribute__((address_space(4)))*)((KP)__builtin_amdgcn_kernarg_segment_ptr() + 216) + O_CTL) + 1024, (volatile LAS unsigned*)((LAS unsigned char*)lds_raw + LDS_MISC));
#define GRID_SYNC(first) do { xcd_barrier(xbar); } while (0)
#else
#define GRID_SYNC(first) do {} while (0)
#endif
    bool rep_done = false;
    unsigned long long ts0 = 0, ts1 = 0;
    for (int ph = args.ph_lo; ph < args.ph_hi; ++ph) {
        if (DIAG_TS >= 0 && ph == DIAG_TS) ts0 = __builtin_amdgcn_s_memrealtime();
        KP kp = (KP)__builtin_amdgcn_kernarg_segment_ptr(); asm volatile("" : "+s"(kp));
        int c = (int)blockIdx.x; asm volatile("" : "+s"(c));
        int G = (int)gridDim.x; asm volatile("" : "+s"(G));
        int tid_ = threadIdx.x; asm volatile("" : "+v"(tid_));
        Ctx F; F.lds = (LAS unsigned char*)lds_raw; F.tid = tid_; F.lane = tid_ & 63; F.wave = __builtin_amdgcn_readfirstlane(tid_ >> 6);
        F.G = G; F.vcu = (G % 8 == 0) ? (c % 8) * (G / 8) + c / 8 : c; F.cv_rank = F.vcu; F.cv_n = G;
        unsigned char* ws = kws(kp); F.ws = ws; float* const outp = kout(kp);
#define mod ((const float*)(ws + O_MOD))
#define ropeA ((const float*)(ws + O_ROPEA))
#define ropeB ((const float*)(ws + O_ROPEB))
#define stat_cq ((float*)(ws + O_STATCQ))
#define stat_ckv ((float*)(ws + O_STATCKV))
#define HB ((bf16*)(ws + O_HB))
#define PF ((bf16*)(ws + O_PF))
#define QA ((bf16*)(ws + O_QA))
#define QBN ((bf16*)(ws + O_QBN))
#define QBR ((bf16*)(ws + O_QBR))
#define CQ ((bf16*)(ws + O_CQ))
#define CKV ((bf16*)(ws + O_CKV))
#define KA ((bf16*)(ws + O_KA))
#define VA ((bf16*)(ws + O_VA))
#define KB ((bf16*)(ws + O_KB))
#define VB ((bf16*)(ws + O_VB))
#define GT ((bf16*)(ws + O_G))
#define ACT ((bf16*)(ws + O_G))
#define MB HB
#define YC PF
#define XC ((float*)(ws + O_XC))
#define GC ((!L1 && G == 256) ? (unsigned char*)outp + (size_t)40 * MiB - (size_t)ML * 3072 : (unsigned char*)(ws + O_G))
        if (ph == 0) { if (SUB_ON(10))
            for (int rep_ = 0; rep_ < REP(1); ++rep_) { mod_items(F, kp); table_items(F); convert_weights_main(F, kp, 0); }
        } else {
            const int l = (ph - 1) / 10, sub = (ph - 1) % 10;
            const bool L1 = (l == 1);
            const int nMt = L1 ? 64 : 72;
            const float* xin_lat = L1 ? outp : kin(kp, 0); const float* xin_ctx = L1 ? XC : kin(kp, 2);
            const float* mod_l = mod + (size_t)l * 9 * 6144;
            bf16* ZT = L1 ? (bf16*)(ws + O_ZT1) : (bf16*)outp; bf16* ZTC = (bf16*)outp + (size_t)8 * 512 * 4096;
            switch (sub) {
            case 0: if (SUB_ON(0)) {
                if (L1 && G != 256) convert_weights_main(F, kp, 1);
                for (int rep_ = 0; rep_ < REP(2); ++rep_) norm_pass(F, xin_lat, xin_ctx, HB, kin(kp, 6) + l * 1024, mod_l, 0, MT);
            } break;
            case 1: if (SUB_ON(1)) {
                EpiIn E{QA, KA, VA, CQ, CKV, KB, PF, GT, stat_cq, stat_ckv, kin(kp, 9) + l * 64, kin(kp, 10) + l * 64, kin(kp, 18) + l * 32, kin(kp, 19) + l * 3072, ropeA, ropeB, GC};
                const Gemm g{1024, 1024, 1024};
                const int nlat = (L1 ? 64 : 72) * 6, nctx = L1 ? 24 : 0, nq_all = (L1 ? 64 : 72) * 2;
                int nq1 = ((nlat + nctx + G - 1) / G) * G - (nlat + nctx); if (nq1 > nq_all) nq1 = nq_all;
                P1Sched S{RectSched{L1 ? 64 : 72, 6, 0, G, c, 1, 0x765432ull, (const char*)HB, 0, 0, (const char*)(ws + O_WIN), (size_t)256 * 1024 * 2, (size_t)256 * 1024 * 2, 0},
                          RectSched{8, 3, 64, G, c, 1, 0x542ull, (const char*)HB, 0, 0, (const char*)(ws + O_WIN), (size_t)256 * 1024 * 2, (size_t)256 * 1024 * 2, 0},
                          RectSched{L1 ? 64 : 72, 2, 0, G, c, 1, ~0ull, (const char*)HB, 0, 0, (const char*)(ws + O_WIN), (size_t)256 * 1024 * 2, (size_t)256 * 1024 * 2, 0},
                          nlat, nlat + nctx, nlat + nctx + nq1, G, c};
                pg8::gemm_phase(F.lds, g, S, E);
            } break;
            case 2: if (SUB_ON(2)) {
                const int nMl = L1 ? 64 : 72;
                int nq1; { const int n1_ = nMl * 6 + (L1 ? 24 : 0); nq1 = ((n1_ + G - 1) / G) * G - n1_; if (nq1 > nMl * 2) nq1 = nMl * 2; }
                P2Sched S;
                S.sq = RectSched{nMl, 2, 0, G, c, 1, ~0ull, (const char*)HB, 0, 0, (const char*)(ws + O_WIN), (size_t)256 * 1024 * 2, (size_t)256 * 1024 * 2, 0};
                const int ngc = (!L1 && G == 256) ? 96 : 0;
                S.sg = RectSched{8, 12, 64, G, c, 1, ~0ull, (const char*)HB, 0, 0, (const char*)(ws + O_WIN) + (size_t)8 * 256 * 1024 * 2, (size_t)256 * 1024 * 2, (size_t)256 * 1024 * 2, 0};
                S.suq = RectSched{nMl, 3, 0, G, c, 1, ~0ull, (const char*)CQ, 0, 0, (const char*)(ws + O_WUQ), (size_t)256 * 384 * 2, (size_t)256 * 384 * 2, 0};
                S.sukv = RectSched{72, 4, 0, G, c, 1, ~0ull, (const char*)CKV, 0, 0, (const char*)(ws + O_WUKV), (size_t)256 * 256 * 2, (size_t)256 * 256 * 2, 0};
                S.sf1 = F1Sched{8, G, c, 0, 2048, 256, (const char*)(ws + O_DFTC), (const char*)PF};
                S.sf1c = F1Sched{1, G, c, ML, 256, L1 ? 0 : 32, (const char*)(ws + O_DFTC), (const char*)PF};
                S.qoff = nq1; S.n0 = nMl * 2 - nq1; S.ng = S.n0 + ngc; S.n1 = S.ng + nMl * 3; S.n2 = S.n1 + 72 * 4; S.n3 = S.n2 + 256; S.n4 = S.n3 + (L1 ? 0 : 32); S.G = G; S.c = c;
                P2Epi E{EpiIn{QA, KA, VA, CQ, CKV, KB, PF, GT, stat_cq, stat_ckv, kin(kp, 9) + l * 64, kin(kp, 10) + l * 64, kin(kp, 18) + l * 32, kin(kp, 19) + l * 3072, ropeA, ropeB, GC},
                        EpiUq{QBN, QBR, stat_cq, kin(kp, 15) + l * 64, kin(kp, 17) + l * 32, ropeB}, EpiUkv{KB, VB, stat_ckv, kin(kp, 16) + l * 64}, EpiF1{ZT, 2048}, EpiF1{ZTC, 256}};
                const Gemm g{1024, 1024, 1024};
                pg8::gemm_phase(F.lds, g, S, E);
            } break;
            case 3: if (SUB_ON(3)) {
                LAS unsigned char* shm = F.lds;
                if (TIME_REP & 32) for (int i = 0;; ++i) {
                    const int L = i * G + c; if (L >= 512) break; const int qb = L & 7, h = (L >> 3) & 7, b = L >> 6;
                    const size_t row0 = (size_t)b * SEQ + qb * 256; const size_t key0 = (size_t)b * NKEY;
                    attq::attn_unit<4, 8>(QA + row0 * 512 + h * 64, 512, nullptr, 0, KA + key0 * 128 + (h >> 2) * 64, 128, VA + key0 * 128 + (h >> 2) * 64, 128, CQ + row0 * 512 + h * 64, 512, NKEY / 64, (char*)lds_raw);
                }
                if (TIME_REP & 64) for (int i = 0;; ++i) {
                    const int L = i * G + c; if (L >= 512) break; const int qb = L & 7, h = (L >> 3) & 7, b = L >> 6;
                    const size_t row0 = (size_t)b * SEQ + qb * 256; const size_t key0 = (size_t)b * NKEY;
                    attq::attn_unit<6, 8>(QBN + row0 * 512 + h * 64, 512, QBR + row0 * 256 + h * 32, 256, KB + key0 * 768 + h * 96, 768, VB + key0 * 512 + h * 64, 512, CQ + row0 * 512 + h * 64, 512, NKEY / 64, (char*)lds_raw);
                }
                for (int i = 0;; ++i) {
                    int L; if (G == 256) { if (c < 128) { if (i >= 3) break; L = c + 128 * i; } else { if (i >= 1) break; L = 384 + (c - 128); } } else { L = i * G + c; if (L >= 512) break; }
                    const int qb = L & 7, h = (L >> 3) & 7, b = L >> 6;
                    const size_t row0 = (size_t)b * SEQ + qb * 256; const size_t key0 = (size_t)b * NKEY;
                    attq::attn_unit<4, 8>(QA + row0 * 512 + h * 64, 512, nullptr, 0, KA + key0 * 128 + (h >> 2) * 64, 128, VA + key0 * 128 + (h >> 2) * 64, 128, QA + row0 * 512 + h * 64, 512, NKEY / 64, (char*)lds_raw);
                }
                for (int i = 0;; ++i) {
                    const int L = i * G + c; if (L >= 512) break; const int qb = L & 7, h = (L >> 3) & 7, b = L >> 6;
                    const size_t row0 = (size_t)b * SEQ + qb * 256; const size_t key0 = (size_t)b * NKEY;
                    attq::attn_unit<6, 8>(QBN + row0 * 512 + h * 64, 512, QBR + row0 * 256 + h * 32, 256, KB + key0 * 768 + h * 96, 768, VB + key0 * 512 + h * 64, 512, QBN + row0 * 512 + h * 64, 512, NKEY / 64, (char*)lds_raw);
                }
                if (!L1) {
                    for (int i = 0;; ++i) {
                        const int L = i * G + ((c + 128) % G); if (L >= 128) break; const int h = L & 7, b = (L >> 3) & 7; const bool mla = L >= 64;
                        const size_t row0 = (size_t)ML + b * CTX; const size_t key0 = (size_t)b * NKEY;
                        if (!mla) attq::attn_unit<4, 8>(QA + row0 * 512 + h * 64, 512, nullptr, 0, KA + key0 * 128 + (h >> 2) * 64, 128, VA + key0 * 128 + (h >> 2) * 64, 128, QA + row0 * 512 + h * 64, 512, CTX / 64, (char*)lds_raw);
                        else attq::attn_unit<6, 8>(QBN + row0 * 512 + h * 64, 512, QBR + row0 * 256 + h * 32, 256, KB + key0 * 768 + h * 96, 768, VB + key0 * 512 + h * 64, 512, QBN + row0 * 512 + h * 64, 512, CTX / 64, (char*)lds_raw);
                    }
                }
                for (int rep_ = 0; rep_ < REP(128); ++rep_) { EpiStore E{YC, 512}; const Gemm g{4096, 4096, 4096};
                  F2Sched S{8, G, (c + 128) % G, 0, 2048, 128, (const char*)(ws + O_DN), (const char*)ZT, 4096};
                  pg8::gemm_phase(F.lds, g, S, E); }
                if (!L1) { EpiStore E{YC, 512}; const Gemm g{512, 512, 512};
                  F2Sched S{1, G, c, ML, 256, 16, (const char*)(ws + O_DN256), (const char*)ZTC, 512};
                  pg8::gemm_phase(F.lds, g, S, E); }
            } break;
            case 4: if (SUB_ON(4)) {
                EpiIn E{QA, KA, VA, CQ, CKV, KB, PF, GT, stat_cq, stat_ckv, kin(kp, 9) + l * 64, kin(kp, 10) + l * 64, kin(kp, 18) + l * 32, kin(kp, 19) + l * 3072, ropeA, ropeB, GC};
                const Gemm g{1024, 1024, 1024};
                RectSched S{(G == 256) ? 64 : nMt, 12, 0, G, c, 1, ~0ull, (const char*)HB, 0, 0, (const char*)(ws + O_WIN) + (size_t)8 * 256 * 1024 * 2, (size_t)256 * 1024 * 2, (size_t)256 * 1024 * 2, 0};
                struct PnShift { RectSched s; __device__ __forceinline__ bool next(int i, Unit& u) const { if (!s.next(i, u)) return false; u.pn += 8; return true; } } S8{S};
                if (L1 && G == 256) {
                    GateChainSched SC{(const char*)HB, (const char*)(ws + O_WIN), c, 0};
                    { int nu_ = 3; asm volatile("" : "+s"(nu_)); SC.nu = nu_; }
                    pg8::gemm_phase(F.lds, g, SC, E);
                    EpiMerge EM{(const unsigned char*)GT, MB, GC}; const Gemm gm{512, 1536, 512};
                    RectSched SM{64, 4, 0, G, c, 3, ~0ull, (const char*)QA, (size_t)((const char*)QBN - (const char*)QA), (size_t)((const char*)YC - (const char*)QA), (const char*)(ws + O_WBR), (size_t)256 * 512 * 2, (size_t)256 * 1536 * 2, (size_t)512 * 2};
                    pg8::gemm_phase(F.lds, gm, SM, EM);
                } else pg8::gemm_phase(F.lds, g, S8, E);
            } break;
            case 5: if (SUB_ON(5) && !(L1 && G == 256)) {
                for (int rep_ = 0; rep_ < REP(512); ++rep_) { EpiMerge E{(const unsigned char*)GT, MB, GC}; const Gemm g{512, 1536, 512};
                RectSched S{nMt, 4, 0, G, c, 3, ~0ull, (const char*)QA, (size_t)((const char*)QBN - (const char*)QA), (size_t)((const char*)YC - (const char*)QA), (const char*)(ws + O_WBR), (size_t)256 * 512 * 2, (size_t)256 * 1536 * 2, (size_t)512 * 2};
                pg8::gemm_phase(F.lds, g, S, E); }
                if (!L1 && G == 256 && c >= 32) { F.cv_rank = c - 32; F.cv_n = 224; convert_weights_main(F, kp, 1, 1); }
            } break;
            case 6: if (SUB_ON(6)) {
                EpiRes E{xin_lat, xin_ctx, outp, XC, mod_l + 2048}; const Gemm g{1024, 1024, 1024};
                RectSched S{nMt, 4, 0, G, c, 1, ~0ull, (const char*)MB, 0, 0, (const char*)(ws + O_WOUT), (size_t)256 * 1024 * 2, (size_t)256 * 1024 * 2, 0};
                pg8::gemm_phase(F.lds, g, S, E);
                if (!L1 && G == 256 && c >= 32) { F.cv_rank = c - 32; F.cv_n = 224; convert_weights_ffn(F, kp, 0); }
            } break;
            case 7: if (SUB_ON(7)) {
                if (L1 || G != 256) convert_weights_ffn(F, kp, l);
                if (!L1 && G == 256) convert_weights_main(F, kp, 1, 2);
                for (int rep_ = 0; rep_ < REP(2048); ++rep_) norm_pass(F, outp, XC, HB, kin(kp, 7) + l * 1024, mod_l, 3072, L1 ? ML : MT);
            } break;
            case 8: if (SUB_ON(8)) {
                EpiSwiglu E{ACT}; const Gemm g{1024, 1024, 1024};
                if (L1 || G != 256) {
                    RectSched S{nMt, 22, 0, G, c, 1, ~0ull, (const char*)HB, 0, 0, (const char*)(ws + O_WFI), (size_t)256 * 1024 * 2, (size_t)256 * 1024 * 2, 0};
                    pg8::gemm_phase(F.lds, g, S, E);
                } else {
                    const RectSched Slat{64, 22, 0, G, c, 1, ~0ull, (const char*)HB, 0, 0, (const char*)(ws + O_WFI), (size_t)256 * 1024 * 2, (size_t)256 * 1024 * 2, 0};
                    { RectSched Sc{8, 22, 64, G, c, 1, ~0ull, (const char*)HB, 0, 0, (const char*)(ws + O_WFI), (size_t)256 * 1024 * 2, (size_t)256 * 1024 * 2, 0};
                      struct ASched { RectSched sc; WinSched sl; int G, c; __device__ __forceinline__ bool next(int i, Unit& u) const { const long L = (long)i * G + c; if (L < 176) return sc.at(L, 0, u); if (L < 512) return sl.s.at(L - 176, 0, u); return false; } } SA{Sc, WinSched{Slat, 0, 336, G, c}, G, c};
                      pg8::gemm_phase(F.lds, g, SA, E); }
                    GRID_SYNC(false);
                    { FfnBSched SB{RectSched{8, 4, 64, G, c, 1, ~0ull, (const char*)ACT, 0, 0, (const char*)(ws + O_WFO), (size_t)256 * FFH * 2, (size_t)256 * FFH * 2, 0}, Slat, 32, 32 + 1072, 336, G, c};
                      FfnBEpi EB{E, EpiRes{outp, XC, outp, XC, mod_l + 5120}};
                      pg8::gemm_phase(F.lds, g, SB, EB); }
                }
            } break;
            case 9: if (SUB_ON(9)) {
                EpiRes E{outp, XC, outp, XC, mod_l + 5120}; const Gemm g{FFH, FFH, FFH};
                RectSched S{(L1 || G == 256) ? 64 : 72, 4, 0, G, c, 1, ~0ull, (const char*)ACT, 0, 0, (const char*)(ws + O_WFO), (size_t)256 * FFH * 2, (size_t)256 * FFH * 2, 0};
                pg8::gemm_phase(F.lds, g, S, E);
            } break;
            }
        }
        if (ph + 1 < args.ph_hi || DIAG_TS >= 0) { GRID_SYNC(ph == 0); }
        if (DIAG_TS >= 0 && ph == DIAG_TS) ts1 = __builtin_amdgcn_s_memrealtime();
        if (TIME_PH >= 0 && ph == TIME_PH && !rep_done) { rep_done = true; --ph; }
    }
    if (DIAG_TS >= 0 && blockIdx.x == 0 && threadIdx.x == 0) { float* o = kout((KP)__builtin_amdgcn_kernarg_segment_ptr()); o[0] = (float)(ts1 - ts0) * 0.01f; }
}

extern "C" void kernel_launch(void* const* d_in, const int* in_sizes, int n_in, void* d_out, int out_size, void* d_ws, size_t ws_size, hipStream_t stream) {
    static int grid = 0;
    if (grid == 0) {
        if (n_in != 26 || out_size != ML * DM || ws_size < O_END) { fprintf(stderr, "kernel_launch: unexpected shapes (n_in %d out %d ws %zu)\n", n_in, out_size, ws_size); grid = -1; return; }
        int dev = 0, cus = 0, per_cu = 0;
        hipGetDevice(&dev); hipDeviceGetAttribute(&cus, hipDeviceAttributeMultiprocessorCount, dev);
        if (hipFuncSetAttribute((const void*)fwd_kernel, hipFuncAttributeMaxDynamicSharedMemorySize, LDS_BYTES) != hipSuccess) { fprintf(stderr, "kernel_launch: hipFuncSetAttribute failed\n"); grid = -1; return; }
        hipOccupancyMaxActiveBlocksPerMultiprocessor(&per_cu, (const void*)fwd_kernel, NTHR, LDS_BYTES);
        if (per_cu < 1) { fprintf(stderr, "kernel_launch: occupancy query says %d blocks/CU\n", per_cu); per_cu = 1; }
        (void)hipGetLastError();
        grid = cus;
        if (grid > 256) grid = 256;
    }
    if (grid < 0) return;
    (void)hipMemsetAsync((char*)d_ws + O_CTL, 0, CTL_ZERO_BYTES, stream);
    Args a{};
    for (int i = 0; i < 26; ++i) a.in[i] = (const float*)d_in[i];
    a.out = (float*)d_out; a.ws = (unsigned char*)d_ws;
#if MK_MULTI
    for (int ph = 0; ph < NPHASE; ++ph) { a.ph_lo = ph; a.ph_hi = ph + 1; hipLaunchKernelGGL(fwd_kernel, dim3(grid), dim3(NTHR), LDS_BYTES, stream, a); }
#else
    a.ph_lo = 0; a.ph_hi = NPHASE;
    void* kargs[] = {&a};
    hipError_t e = hipLaunchCooperativeKernel((const void*)fwd_kernel, dim3(grid), dim3(NTHR), kargs, LDS_BYTES, stream);
    if (e != hipSuccess) fprintf(stderr, "cooperative launch failed: %s (grid %d)\n", hipGetErrorString(e), grid);
#endif
}
```

```cpp
#include <hip/hip_runtime.h>
#include <hip/hip_cooperative_groups.h>
#include <cstdint>
#include <cstdio>
namespace cg = cooperative_groups;

#ifndef MK_MULTI
#define MK_MULTI 0
#endif

#define LAS __attribute__((address_space(3)))
typedef unsigned short bf16;
typedef short bf16x8 __attribute__((ext_vector_type(8)));
typedef short s16x4 __attribute__((ext_vector_type(4)));
typedef float f32x2 __attribute__((ext_vector_type(2)));
typedef float f32x4 __attribute__((ext_vector_type(4)));
typedef float f32x16 __attribute__((ext_vector_type(16)));
typedef unsigned u32x2 __attribute__((ext_vector_type(2)));
typedef unsigned u32x4 __attribute__((ext_vector_type(4)));
typedef __bf16 bf16x2_t __attribute__((ext_vector_type(2)));

constexpr int DM = 1024, NB = 8, SEQ = 2048, CTX = 256, NKEY = CTX + SEQ;
constexpr int ML = NB * SEQ, MC = NB * CTX, MT = ML + MC;
constexpr int INW = 5024, NINP = 5120;
constexpr int FFH = 2816;
constexpr float EPS = 1e-6f;
constexpr float LOG2E = 1.4426950408889634f;
constexpr float C2A = 0.125f * LOG2E;
constexpr float C2B = 0.10206207261596577f * LOG2E;
constexpr int NWAVES = 8, NTHR = 512;

constexpr size_t MiB = 1u << 20, KiB = 1024;
constexpr size_t O_CTL = 0;
constexpr size_t O_MOD = 256 * KiB;
constexpr size_t O_ROPEA = 704 * KiB;
constexpr size_t O_ROPEB = 712 * KiB;
constexpr size_t O_STATCQ = 1 * MiB;
constexpr size_t O_STATCKV = O_STATCQ + (size_t)MT * 8 * 4;
constexpr size_t O_DN = 2 * MiB;
constexpr size_t O_DN256 = O_DN + 16 * MiB;
constexpr size_t O_DFTC = O_DN256 + 256 * KiB;
constexpr size_t O_W = O_DN + 16 * MiB + 512 * KiB;
constexpr size_t O_WIN = O_W;
constexpr size_t O_WUQ = O_WIN + (size_t)NINP * 1024 * 2;
constexpr size_t O_WUKV = O_WUQ + 768 * 384 * 2;
constexpr size_t O_WBR = O_WUKV + 1024 * 256 * 2;
constexpr size_t O_WOUT = O_WBR + 1024 * 1536 * 2;
constexpr size_t O_XC = O_W + 16 * MiB + 256 * KiB;
constexpr size_t O_HB = O_XC + 8 * MiB;
constexpr size_t O_PF = O_HB + 36 * MiB;
constexpr size_t O_QA = O_PF + 18 * MiB;
constexpr size_t O_QBN = O_QA + 18 * MiB;
constexpr size_t O_QBR = O_QBN + 18 * MiB;
constexpr size_t O_WFI = O_QA;
constexpr size_t O_WFO = O_WFI + (size_t)5632 * 1024 * 2;
constexpr size_t O_G = O_QBR + 9 * MiB;
constexpr size_t O_CQ = O_G;
constexpr size_t O_CKV = O_CQ + (size_t)MT * 384 * 2;
constexpr size_t O_KA = O_CKV + (size_t)MT * 256 * 2;
constexpr size_t O_VA = O_KA + (size_t)NB * NKEY * 128 * 2;
constexpr size_t O_KB = O_VA + (size_t)NB * NKEY * 128 * 2;
constexpr size_t O_VB = O_KB + (size_t)NB * NKEY * 768 * 2;
constexpr size_t O_ZT1 = O_VB + (size_t)NB * NKEY * 512 * 2;
constexpr size_t O_END = O_ZT1 + 32 * MiB;
static_assert(O_END <= 256 * MiB, "d_ws map exceeds 256 MiB");
static_assert(O_WOUT + 2 * MiB <= O_XC, "W region");
static_assert(O_WFO + (size_t)1024 * 2816 * 2 <= O_G, "ffn weights overlay");
static_assert(O_G + (size_t)MT * 3072 * 2 <= O_END, "gates overlay");
static_assert(O_DFTC + 64 * KiB <= O_W, "dft region");
static_assert(O_STATCKV + (size_t)MT * 4 * 4 <= O_DN, "stats region");

__device__ __forceinline__ unsigned cvtpk(float lo, float hi) { f32x2 v = {lo, hi}; bf16x2_t b = __builtin_convertvector(v, bf16x2_t); return __builtin_bit_cast(unsigned, b); }
__device__ __forceinline__ u32x2 pk4(f32x4 v) { u32x2 r; r.x = cvtpk(v[0], v[1]); r.y = cvtpk(v[2], v[3]); return r; }
__device__ __forceinline__ float bf2f(unsigned short h) { return __uint_as_float((unsigned)h << 16); }
__device__ __forceinline__ f32x4 unpk4(u32x2 w) { f32x4 r; r[0] = __uint_as_float(w.x << 16); r[1] = __uint_as_float(w.x & 0xffff0000u); r[2] = __uint_as_float(w.y << 16); r[3] = __uint_as_float(w.y & 0xffff0000u); return r; }
__device__ __forceinline__ u32x4 pk8(f32x4 a, f32x4 b) { u32x4 r; r.x = cvtpk(a[0], a[1]); r.y = cvtpk(a[2], a[3]); r.z = cvtpk(b[0], b[1]); r.w = cvtpk(b[2], b[3]); return r; }
__device__ __forceinline__ unsigned q8x4(f32x4 g) {
    unsigned w = 0;
    w = __builtin_amdgcn_cvt_pk_u8_f32(__builtin_fmaxf(g[0] * 255.0f, 1.0f), 0, w);
    w = __builtin_amdgcn_cvt_pk_u8_f32(__builtin_fmaxf(g[1] * 255.0f, 1.0f), 1, w);
    w = __builtin_amdgcn_cvt_pk_u8_f32(__builtin_fmaxf(g[2] * 255.0f, 1.0f), 2, w);
    w = __builtin_amdgcn_cvt_pk_u8_f32(__builtin_fmaxf(g[3] * 255.0f, 1.0f), 3, w);
    return w; }
__device__ __forceinline__ f32x4 uq8x4(unsigned w) { f32x4 r; r[0] = (float)(w & 0xffu); r[1] = (float)((w >> 8) & 0xffu); r[2] = (float)((w >> 16) & 0xffu); r[3] = (float)(w >> 24); return r; }
__device__ __forceinline__ float wave_sum(float v) {
#pragma unroll
    for (int o = 1; o < 64; o <<= 1) v += __shfl_xor(v, o);
    return v;
}
__device__ __forceinline__ float fq_sum(float v) { v += __shfl_xor(v, 16); v += __shfl_xor(v, 32); return v; }
__device__ __forceinline__ float sigmoidf_(float x) { return __builtin_amdgcn_rcpf(1.0f + __expf(-x)); }

namespace pg8 {
constexpr int BM = 256, BK = 64, HALF = 128, HTB = HALF * BK * 2, STAGE_BYTES = 8 * HTB, NXCD = 8, WGM = 8;
__host__ __device__ __forceinline__ int lds_byte(int r, int c) { const int st = (r >> 4) * 2 + (c >> 5), rr = r & 15, cc = c & 31, ob = rr * 64 + cc * 2; return st * 1024 + (ob ^ (((ob >> 9) & 1) << 5)); }
__host__ __device__ __forceinline__ void stage_rc(int b, int& R, int& C) { const int st = b / 1024, sb = b % 1024, swz = sb ^ (((sb >> 9) & 1) << 5); R = (st >> 1) * 16 + swz / 64; C = (st & 1) * 32 + (swz % 64) / 2; }

struct Unit { int pm, pn, kb, epi; const char* A; const char* B; int lda, ldb, nt; };
struct Gemm { int lda, ldb, K; };

__device__ __forceinline__ void tile_order(int L, int nM, int nN, int& pm, int& pn) {
    const int nwg = nM * nN; int wgid = L;
    { const int q = nwg / NXCD, r = nwg % NXCD, xcd = wgid % NXCD, off = wgid / NXCD; wgid = (xcd < r ? xcd * (q + 1) : r * (q + 1) + (xcd - r) * q) + off; }
    const int nig = WGM * nN, gid = wgid / nig, fm = gid * WGM, gsz = (nM - fm) < WGM ? (nM - fm) : WGM;
    pm = fm + ((wgid % nig) % gsz); pn = (wgid % nig) / gsz;
}

template <class Epi, class Sched>
__device__ __forceinline__ void gemm_phase(LAS unsigned char* lds, const Gemm g, const Sched& S, const Epi& E) {
    int tid = threadIdx.x; asm volatile("" : "+v"(tid));
    const int wid = __builtin_amdgcn_readfirstlane(tid >> 6), lane = tid & 63, wr = wid >> 2, wc = wid & 3, fr = lane & 15, fq = lane >> 4;
    unsigned Rv, Cv;
    { int R, C; stage_rc(tid * 16, R, C); Rv = (unsigned)R * 2u; Cv = (unsigned)C * 2u; }
    const size_t kstep = (size_t)(BK * 2);
    const unsigned ldsw = (unsigned)wid * 1024u;
    const int aoff = lds_byte(wr * 64 + fr, fq * 8), boff = lds_byte(wc * 32 + fr, fq * 8);
#define PG8_SA(b, h) (((b) * 2 + (h)) * HTB)
#define PG8_SB(b, h) ((4 + (b) * 2 + (h)) * HTB)
#define PG8_STAGE(bufoff, gbase, voff, piece) do { _Pragma("unroll") for (int _i = 0; _i < 2; ++_i) \
        __builtin_amdgcn_global_load_lds((const unsigned*)((const char*)(gbase) + (size_t)_i * (piece) + (voff)), (LAS unsigned*)(lds + (bufoff) + ldsw + _i * 8192), 16, 0, 0); } while (0)
#define PG8_LDA(dst, b, h) do { _Pragma("unroll") for (int m = 0; m < 4; ++m) _Pragma("unroll") for (int k = 0; k < 2; ++k) dst[m][k] = *(const LAS bf16x8*)(lds + PG8_SA(b, h) + aoff + m * 2048 + k * 1024); } while (0)
#define PG8_LDB(dst, b, h) do { _Pragma("unroll") for (int n = 0; n < 2; ++n) _Pragma("unroll") for (int k = 0; k < 2; ++k) dst[n][k] = *(const LAS bf16x8*)(lds + PG8_SB(b, h) + boff + n * 2048 + k * 1024); } while (0)
#define PG8_MMA(ai, bj, At, Bt) do { __builtin_amdgcn_s_setprio(1); _Pragma("unroll") for (int m = 0; m < 4; ++m) _Pragma("unroll") for (int n = 0; n < 2; ++n) _Pragma("unroll") for (int k = 0; k < 2; ++k) \
        acc[ai][bj][m][n] = __builtin_amdgcn_mfma_f32_16x16x32_bf16(Bt[n][k], At[m][k], acc[ai][bj][m][n], 0, 0, 0); __builtin_amdgcn_s_setprio(0); } while (0)
#define PG8_WAIT_V(n) asm volatile("s_waitcnt vmcnt(" #n ")" ::: "memory")
#define PG8_WAIT_L(n) asm volatile("s_waitcnt lgkmcnt(" #n ")" ::: "memory")
#define PG8_BAR __builtin_amdgcn_s_barrier()
#define PG8_SCHED __builtin_amdgcn_sched_barrier(0)
#define PG8_NEXT(i, u) ((u).lda = g.lda, (u).ldb = g.ldb, (u).nt = g.K / BK, (u).epi = 0, S.next((i), (u)))
    Unit cur, nxt; int ui = 0;
    if (!PG8_NEXT(0, cur)) return;
    f32x4 acc[2][2][4][2];
#pragma unroll
    for (int a = 0; a < 2; ++a)
#pragma unroll
        for (int b = 0; b < 2; ++b)
#pragma unroll
            for (int m = 0; m < 4; ++m)
#pragma unroll
                for (int n = 0; n < 2; ++n) acc[a][b][m][n] = (f32x4){0.f, 0.f, 0.f, 0.f};
    bf16x8 At[4][2], B0[2][2], B1[2][2];
    const char* cA = cur.A; const char* cB = cur.B;
    unsigned vAc = Rv * (unsigned)cur.lda + Cv, vBc = Rv * (unsigned)cur.ldb + Cv;
    size_t pAc = (size_t)128 * cur.lda, pBc = (size_t)128 * cur.ldb;
    PG8_STAGE(PG8_SB(0, 0), cB, vBc, pBc); PG8_STAGE(PG8_SB(0, 1), cB + 2 * pBc, vBc, pBc); PG8_STAGE(PG8_SA(0, 0), cA, vAc, pAc); PG8_STAGE(PG8_SA(0, 1), cA + 2 * pAc, vAc, pAc);
    if (wr == 1) PG8_BAR;
    PG8_WAIT_V(2); PG8_BAR;
    PG8_STAGE(PG8_SB(1, 0), cB + kstep, vBc, pBc); PG8_STAGE(PG8_SA(1, 0), cA + kstep, vAc, pAc); PG8_STAGE(PG8_SB(1, 1), cB + 2 * pBc + kstep, vBc, pBc);
    PG8_WAIT_V(6); PG8_BAR;
    for (;;) {
        const bool has_next = PG8_NEXT(ui + 1, nxt);
        if (!has_next) nxt = cur;
        const char* nA = nxt.A; const char* nB = nxt.B;
        const unsigned vAn = Rv * (unsigned)nxt.lda + Cv, vBn = Rv * (unsigned)nxt.ldb + Cv;
        const size_t pAn = (size_t)128 * nxt.lda, pBn = (size_t)128 * nxt.ldb;
        int nt = cur.nt; asm volatile("" : "+s"(nt));
        for (int t = 0; t < nt; t += 2) {
            const bool last = (t == nt - 2);
            const char* a1 = cA + (size_t)(t + 1) * kstep;
            const char* a2 = last ? nA : cA + (size_t)(t + 2) * kstep; const char* b2 = last ? nB : cB + (size_t)(t + 2) * kstep;
            const char* a3 = a2 + kstep; const char* b3 = b2 + kstep;
            const unsigned vA2 = last ? vAn : vAc, vB2 = last ? vBn : vBc; const size_t pA2 = last ? pAn : pAc, pB2 = last ? pBn : pBc;
            PG8_LDB(B0, 0, 0); PG8_LDB(B1, 0, 1); PG8_SCHED; PG8_LDA(At, 0, 0); PG8_STAGE(PG8_SA(1, 1), a1 + 2 * pAc, vAc, pAc);
            PG8_WAIT_V(8); PG8_WAIT_L(0); PG8_BAR; PG8_MMA(0, 0, At, B0); PG8_MMA(0, 1, At, B1); PG8_BAR; PG8_SCHED;
            PG8_LDA(At, 0, 1); PG8_STAGE(PG8_SB(0, 0), b2, vB2, pB2); PG8_STAGE(PG8_SB(0, 1), b2 + 2 * pB2, vB2, pB2); PG8_STAGE(PG8_SA(0, 0), a2, vA2, pA2);
            PG8_WAIT_V(8); PG8_WAIT_L(0); PG8_BAR; PG8_MMA(1, 0, At, B0); PG8_MMA(1, 1, At, B1); PG8_BAR; PG8_SCHED;
            PG8_LDB(B0, 1, 0); PG8_LDB(B1, 1, 1); PG8_SCHED; PG8_LDA(At, 1, 0); PG8_STAGE(PG8_SA(0, 1), a2 + 2 * pA2, vA2, pA2);
            PG8_WAIT_V(8); PG8_WAIT_L(0); PG8_BAR; PG8_MMA(0, 0, At, B0); PG8_MMA(0, 1, At, B1); PG8_BAR; PG8_SCHED;
            PG8_LDA(At, 1, 1); PG8_STAGE(PG8_SB(1, 0), b3, vB2, pB2); PG8_STAGE(PG8_SB(1, 1), b3 + 2 * pB2, vB2, pB2); PG8_STAGE(PG8_SA(1, 0), a3, vA2, pA2);
            PG8_WAIT_V(8); PG8_WAIT_L(0); PG8_BAR; PG8_MMA(1, 0, At, B0); PG8_MMA(1, 1, At, B1); PG8_BAR; PG8_SCHED;
        }
        if (wr == 0) PG8_BAR;
        const bool carry = E(acc, cur, wr, wc, fr, fq);
        if (!has_next) break;
        if (!carry) {
#pragma unroll
            for (int a = 0; a < 2; ++a)
#pragma unroll
                for (int b = 0; b < 2; ++b)
#pragma unroll
                    for (int m = 0; m < 4; ++m)
#pragma unroll
                        for (int n = 0; n < 2; ++n) acc[a][b][m][n] = (f32x4){0.f, 0.f, 0.f, 0.f};
        }
        cur = nxt; cA = nA; cB = nB; vAc = vAn; vBc = vBn; pAc = pAn; pBc = pBn; ++ui;
        if (wr == 1) PG8_BAR;
    }
    PG8_WAIT_V(0);
    PG8_BAR;
#undef PG8_SA
#undef PG8_SB
#undef PG8_STAGE
#undef PG8_LDA
#undef PG8_LDB
#undef PG8_MMA
#undef PG8_WAIT_V
#undef PG8_WAIT_L
#undef PG8_BAR
#undef PG8_SCHED
#undef PG8_NEXT
}
}
using pg8::Unit; using pg8::Gemm;

typedef f32x4 Acc[2][2][4][2];

struct RectSched {
    int nM, nN, pm0, G, c, nkb; unsigned long long pnmap;
    const char* A0; size_t dA1, dA2; const char* B; size_t strideAm, strideBn, strideBk;
    __device__ __forceinline__ int count() const { return nM * nN; }
    __device__ __forceinline__ bool next(int i, Unit& u) const { const int ti = i / nkb, kb = i - ti * nkb; return at((long)ti * G + c, kb, u); }
    __device__ __forceinline__ bool at(long L, int kb, Unit& u) const {
        if (L >= (long)nM * nN) return false;
        int pm, pn; pg8::tile_order((int)L, nM, nN, pm, pn);
        if (pnmap != ~0ull) pn = (int)((pnmap >> (4 * pn)) & 15ull);
        u.pm = pm + pm0; u.pn = pn; u.kb = kb;
        u.A = A0 + (size_t)(kb == 1) * dA1 + (size_t)(kb == 2) * dA2 + (size_t)u.pm * strideAm; u.B = B + (size_t)pn * strideBn + (size_t)kb * strideBk; return true;
    }
};

struct RowInfo { bool ctx; int b; int tok0; };
__device__ __forceinline__ RowInfo row_info(int pm) { RowInfo r; r.ctx = pm >= 64; r.b = r.ctx ? pm - 64 : pm >> 3; r.tok0 = r.ctx ? 0 : (pm & 7) * 256; return r; }

template <bool NORM>
__device__ __forceinline__ void head64(const f32x4 (&a)[2][2], const f32x4 (&g)[2][2], float scale, bool rope, int row_id, int col_id, const float* ropeA, int fq, f32x4 (&o)[2][2]) {
    f32x4 v[2][2];
    if (NORM) {
        float ss = 0.f;
#pragma unroll
        for (int bj = 0; bj < 2; ++bj)
#pragma unroll
            for (int n = 0; n < 2; ++n) { const f32x4 x = a[bj][n]; ss += (x[0] * x[0] + x[1] * x[1]) + (x[2] * x[2] + x[3] * x[3]); }
        ss = fq_sum(ss);
        const float rstd = rsqrtf(ss * (1.0f / 64.0f) + EPS);
#pragma unroll
        for (int bj = 0; bj < 2; ++bj)
#pragma unroll
            for (int n = 0; n < 2; ++n) v[bj][n] = a[bj][n] * rstd * g[bj][n];
    } else {
#pragma unroll
        for (int bj = 0; bj < 2; ++bj)
#pragma unroll
            for (int n = 0; n < 2; ++n) v[bj][n] = a[bj][n];
    }
    if (rope) {
#pragma unroll
        for (int bj = 0; bj < 2; ++bj) {
            const int pos = bj ? col_id : row_id;
            const f32x4 cs = *(const f32x4*)(ropeA + pos * 16 + 4 * fq), sn = *(const f32x4*)(ropeA + 1024 + pos * 16 + 4 * fq);
            o[bj][0] = (v[bj][0] * cs - v[bj][1] * sn) * scale; o[bj][1] = (v[bj][1] * cs + v[bj][0] * sn) * scale;
        }
    } else {
#pragma unroll
        for (int bj = 0; bj < 2; ++bj)
#pragma unroll
            for (int n = 0; n < 2; ++n) o[bj][n] = v[bj][n] * scale;
    }
}
__device__ __forceinline__ void rope32(const f32x4 (&a)[2], const float* g, float scale, bool rope, int row_id, int col_id, const float* ropeB, int fq, f32x4 (&o)[2]) {
    float ss = 0.f;
#pragma unroll
    for (int n = 0; n < 2; ++n) { const f32x4 x = a[n]; ss += (x[0] * x[0] + x[1] * x[1]) + (x[2] * x[2] + x[3] * x[3]); }
    ss = fq_sum(ss);
    const float rstd = rsqrtf(ss * (1.0f / 32.0f) + EPS);
    const int d0 = 16 * (fq >> 1) + 4 * (fq & 1);
    f32x4 v[2];
#pragma unroll
    for (int n = 0; n < 2; ++n) v[n] = a[n] * rstd * *(const f32x4*)(g + d0 + 8 * n);
    if (rope) {
        const int pos = (fq >> 1) ? col_id : row_id;
        const f32x4 cs = *(const f32x4*)(ropeB + pos * 8 + 4 * (fq & 1)), sn = *(const f32x4*)(ropeB + 512 + pos * 8 + 4 * (fq & 1));
        o[0] = (v[0] * cs - v[1] * sn) * scale; o[1] = (v[1] * cs + v[0] * sn) * scale;
    } else { o[0] = v[0] * scale; o[1] = v[1] * scale; }
}

struct EpiIn {
    bf16 *QA, *KA, *VA, *CQ, *CKV, *KB, *PF, *G; float *stat_cq, *stat_ckv;
    const float *gq, *gk, *gkr, *bgate, *ropeA, *ropeB; unsigned char* Gc;
    __device__ __forceinline__ bool operator()(Acc& acc, const Unit& u, int wr, int wc, int fr_, int fq_) const {
        int fr = fr_, fq = fq_; asm volatile("" : "+v"(fr), "+v"(fq));
        const RowInfo ri = row_info(u.pm); const bool rope = !ri.ctx;
        const int pn = u.pn;
        if (pn <= 2) {
            const bool isv = (pn == 2 && wc >= 2), isk = (pn == 2 && wc < 2);
            const float* gsrc = (pn < 2) ? gq : gk;
            f32x4 g[2][2];
#pragma unroll
            for (int bj = 0; bj < 2; ++bj)
#pragma unroll
                for (int n = 0; n < 2; ++n) g[bj][n] = *(const f32x4*)(gsrc + 32 * bj + 16 * n + 4 * fq);
#pragma unroll
            for (int ai = 0; ai < 2; ++ai)
#pragma unroll
                for (int m = 0; m < 4; ++m) {
                    const int rt = 128 * ai + 64 * wr + 16 * m + fr;
                    const int row_id = (ri.tok0 + 128 * ai + 64 * wr) >> 6, col_id = 16 * m + fr;
                    f32x4 a[2][2], o[2][2];
#pragma unroll
                    for (int bj = 0; bj < 2; ++bj)
#pragma unroll
                        for (int n = 0; n < 2; ++n) a[bj][n] = acc[ai][bj][m][n];
                    bf16* dst;
                    if (pn < 2) { head64<true>(a, g, C2A, rope, row_id, col_id, ropeA, fq, o); dst = QA + (size_t)(u.pm * 256 + rt) * 512 + (4 * pn + wc) * 64; }
                    else {
                        const size_t key = (size_t)ri.b * NKEY + (ri.ctx ? rt : 256 + ri.tok0 + rt);
                        if (isk) { head64<true>(a, g, 1.0f, rope, row_id, col_id, ropeA, fq, o); dst = KA + key * 128 + wc * 64; }
                        else { head64<false>(a, g, 1.0f, false, 0, 0, ropeA, fq, o); dst = VA + key * 128 + (wc - 2) * 64; }
                    }
#pragma unroll
                    for (int bj = 0; bj < 2; ++bj)
#pragma unroll
                        for (int n = 0; n < 2; ++n) *(u32x2*)(dst + 32 * bj + 16 * n + 4 * fq) = pk4(o[bj][n]);
                }
            (void)isv;
        } else if (pn == 3 || pn == 5) {
            bf16* dstb = (pn == 3) ? CQ : CKV; const int ld = (pn == 3) ? 384 : 256;
            float* st = (pn == 3) ? stat_cq : stat_ckv; const int sld = (pn == 3) ? 8 : 4;
#pragma unroll
            for (int ai = 0; ai < 2; ++ai)
#pragma unroll
                for (int m = 0; m < 4; ++m) {
                    const size_t row = (size_t)u.pm * 256 + 128 * ai + 64 * wr + 16 * m + fr; float ss = 0.f;
#pragma unroll
                    for (int bj = 0; bj < 2; ++bj) { const f32x4 x = acc[ai][bj][m][0], y = acc[ai][bj][m][1];
                        ss += (x[0] * x[0] + x[1] * x[1]) + (x[2] * x[2] + x[3] * x[3]) + (y[0] * y[0] + y[1] * y[1]) + (y[2] * y[2] + y[3] * y[3]);
                        *(u32x4*)(dstb + row * ld + 128 * bj + 32 * wc + 8 * fq) = pk8(x, y); }
                    ss = fq_sum(ss);
                    if (fq == 0) st[row * sld + wc] = ss;
                }
        } else if (pn == 4) {
            f32x4 gk0[2]; (void)gk0;
#pragma unroll
            for (int ai = 0; ai < 2; ++ai)
#pragma unroll
                for (int m = 0; m < 4; ++m) {
                    const int rt = 128 * ai + 64 * wr + 16 * m + fr; const size_t row = (size_t)u.pm * 256 + rt; float ss = 0.f;
                    { const f32x4 x = acc[ai][0][m][0], y = acc[ai][0][m][1];
                      ss += (x[0] * x[0] + x[1] * x[1]) + (x[2] * x[2] + x[3] * x[3]) + (y[0] * y[0] + y[1] * y[1]) + (y[2] * y[2] + y[3] * y[3]);
                      *(u32x4*)(CQ + row * 384 + 256 + 32 * wc + 8 * fq) = pk8(x, y); }
                    ss = fq_sum(ss);
                    if (fq == 0) stat_cq[row * 8 + 4 + wc] = ss;
                    if (wc == 0) {
                        const int row_id = (ri.tok0 + 128 * ai + 64 * wr) >> 6, col_id = 16 * m + fr;
                        f32x4 a[2], o[2]; a[0] = acc[ai][1][m][0]; a[1] = acc[ai][1][m][1];
                        rope32(a, gkr, 1.0f, rope, row_id, col_id, ropeB, fq, o);
                        const size_t key = (size_t)ri.b * NKEY + (ri.ctx ? rt : 256 + ri.tok0 + rt);
                        bf16* dst = KB + key * 768 + 64 + 16 * (fq >> 1) + 4 * (fq & 1);
                        const u32x2 w0 = pk4(o[0]), w1 = pk4(o[1]);
#pragma unroll
                        for (int h = 0; h < 8; ++h) { *(u32x2*)(dst + h * 96) = w0; *(u32x2*)(dst + h * 96 + 8) = w1; }
                    }
                }
        } else if (pn < 8) {
#pragma unroll
            for (int ai = 0; ai < 2; ++ai)
#pragma unroll
                for (int m = 0; m < 4; ++m) {
                    const size_t row = (size_t)u.pm * 256 + 128 * ai + 64 * wr + 16 * m + fr;
#pragma unroll
                    for (int bj = 0; bj < 2; ++bj) *(u32x4*)(PF + row * 512 + (pn - 6) * 256 + 128 * bj + 32 * wc + 8 * fq) = pk8(acc[ai][bj][m][0], acc[ai][bj][m][1]);
                }
        } else {
            const int c0 = (pn - 8) * 256 + 32 * wc + 8 * fq;
            f32x4 bv[2][2];
#pragma unroll
            for (int bj = 0; bj < 2; ++bj)
#pragma unroll
                for (int n = 0; n < 2; ++n) bv[bj][n] = *(const f32x4*)(bgate + c0 + 128 * bj + 4 * n);
            unsigned char* G8 = ri.ctx ? Gc : (unsigned char*)G;
#pragma unroll
            for (int ai = 0; ai < 2; ++ai)
#pragma unroll
                for (int m = 0; m < 4; ++m) {
                    const size_t row = (size_t)u.pm * 256 + 128 * ai + 64 * wr + 16 * m + fr;
#pragma unroll
                    for (int bj = 0; bj < 2; ++bj) { u32x2 w;
#pragma unroll
                        for (int n = 0; n < 2; ++n) { f32x4 x = acc[ai][bj][m][n] + bv[bj][n];
                            x[0] = sigmoidf_(x[0]); x[1] = sigmoidf_(x[1]); x[2] = sigmoidf_(x[2]); x[3] = sigmoidf_(x[3]);
                            if (n == 0) w.x = q8x4(x); else w.y = q8x4(x); }
                        *(u32x2*)(G8 + row * 3072 + c0 + 128 * bj) = w; }
                }
        }
        return false;
    }
};

struct EpiUq {
    bf16 *QBN, *QBR; const float *stat_cq, *gqn, *gqr, *ropeB;
    __device__ __forceinline__ bool operator()(Acc& acc, const Unit& u, int wr, int wc, int fr_, int fq_) const {
        int fr = fr_, fq = fq_; asm volatile("" : "+v"(fr), "+v"(fq));
        const RowInfo ri = row_info(u.pm); const bool rope = !ri.ctx;
        f32x4 g[2][2];
#pragma unroll
        for (int bj = 0; bj < 2; ++bj)
#pragma unroll
            for (int n = 0; n < 2; ++n) g[bj][n] = *(const f32x4*)(gqn + 32 * bj + 16 * n + 4 * fq);
        f32x2 stv[2][4];
#pragma unroll
        for (int ai = 0; ai < 2; ++ai)
#pragma unroll
            for (int m = 0; m < 4; ++m) stv[ai][m] = *(const f32x2*)(stat_cq + ((size_t)u.pm * 256 + 128 * ai + 64 * wr + 16 * m + fr) * 8 + 2 * fq);
#pragma unroll
        for (int ai = 0; ai < 2; ++ai)
#pragma unroll
            for (int m = 0; m < 4; ++m) {
                const int rt = 128 * ai + 64 * wr + 16 * m + fr; const size_t row = (size_t)u.pm * 256 + rt;
                const float rs = rsqrtf(fq_sum(stv[ai][m][0] + stv[ai][m][1]) * (1.0f / 384.0f) + EPS);
                if (u.pn < 2) {
                    f32x4 a[2][2], o[2][2];
#pragma unroll
                    for (int bj = 0; bj < 2; ++bj)
#pragma unroll
                        for (int n = 0; n < 2; ++n) a[bj][n] = acc[ai][bj][m][n] * rs;
                    head64<true>(a, g, C2B, false, 0, 0, ropeB, fq, o);
                    bf16* dst = QBN + row * 512 + (4 * u.pn + wc) * 64;
#pragma unroll
                    for (int bj = 0; bj < 2; ++bj)
#pragma unroll
                        for (int n = 0; n < 2; ++n) *(u32x2*)(dst + 32 * bj + 16 * n + 4 * fq) = pk4(o[bj][n]);
                } else {
                    const int row_id = (ri.tok0 + 128 * ai + 64 * wr) >> 6, col_id = 16 * m + fr;
#pragma unroll
                    for (int bj = 0; bj < 2; ++bj) {
                        f32x4 a[2], o[2]; a[0] = acc[ai][bj][m][0] * rs; a[1] = acc[ai][bj][m][1] * rs;
                        rope32(a, gqr, C2B, rope, row_id, col_id, ropeB, fq, o);
                        bf16* dst = QBR + row * 256 + (4 * bj + wc) * 32 + 16 * (fq >> 1) + 4 * (fq & 1);
                        *(u32x2*)(dst) = pk4(o[0]); *(u32x2*)(dst + 8) = pk4(o[1]);
                    }
                }
            }
        return false;
    }
};

struct EpiUkv {
    bf16 *KB, *VB; const float *stat_ckv, *gkn;
    __device__ __forceinline__ bool operator()(Acc& acc, const Unit& u, int wr, int wc, int fr_, int fq_) const {
        int fr = fr_, fq = fq_; asm volatile("" : "+v"(fr), "+v"(fq));
        const RowInfo ri = row_info(u.pm);
        f32x4 g[2][2];
#pragma unroll
        for (int bj = 0; bj < 2; ++bj)
#pragma unroll
            for (int n = 0; n < 2; ++n) g[bj][n] = *(const f32x4*)(gkn + 32 * bj + 16 * n + 4 * fq);
        float stv[2][4];
#pragma unroll
        for (int ai = 0; ai < 2; ++ai)
#pragma unroll
            for (int m = 0; m < 4; ++m) stv[ai][m] = stat_ckv[((size_t)u.pm * 256 + 128 * ai + 64 * wr + 16 * m + fr) * 4 + fq];
#pragma unroll
        for (int ai = 0; ai < 2; ++ai)
#pragma unroll
            for (int m = 0; m < 4; ++m) {
                const int rt = 128 * ai + 64 * wr + 16 * m + fr; const size_t row = (size_t)u.pm * 256 + rt;
                const float rs = rsqrtf(fq_sum(stv[ai][m]) * (1.0f / 256.0f) + EPS);
                const size_t key = (size_t)ri.b * NKEY + (ri.ctx ? rt : 256 + ri.tok0 + rt);
                f32x4 a[2][2], o[2][2];
#pragma unroll
                for (int bj = 0; bj < 2; ++bj)
#pragma unroll
                    for (int n = 0; n < 2; ++n) a[bj][n] = acc[ai][bj][m][n] * rs;
                bf16* dst;
                if (u.pn < 2) { head64<true>(a, g, 1.0f, false, 0, 0, gkn, fq, o); dst = KB + key * 768 + (4 * u.pn + wc) * 96; }
                else { head64<false>(a, g, 1.0f, false, 0, 0, gkn, fq, o); dst = VB + key * 512 + (4 * (u.pn - 2) + wc) * 64; }
#pragma unroll
                for (int bj = 0; bj < 2; ++bj)
#pragma unroll
                    for (int n = 0; n < 2; ++n) *(u32x2*)(dst + 32 * bj + 16 * n + 4 * fq) = pk4(o[bj][n]);
            }
        return false;
    }
};

struct EpiStore {
    bf16* O; int ld;
    __device__ __forceinline__ bool operator()(Acc& acc, const Unit& u, int wr, int wc, int fr_, int fq_) const {
        int fr = fr_, fq = fq_; asm volatile("" : "+v"(fr), "+v"(fq));
#pragma unroll
        for (int ai = 0; ai < 2; ++ai)
#pragma unroll
            for (int m = 0; m < 4; ++m) {
                const size_t row = (size_t)u.pm * 256 + 128 * ai + 64 * wr + 16 * m + fr;
#pragma unroll
                for (int bj = 0; bj < 2; ++bj)
#pragma unroll
                    for (int n = 0; n < 2; ++n) *(u32x2*)(O + row * ld + u.pn * 256 + 128 * bj + 32 * wc + 16 * n + 4 * fq) = pk4(acc[ai][bj][m][n]);
            }
        return false;
    }
};

struct EpiF1 {
    bf16* ZT; int NP;
    __device__ __forceinline__ bool operator()(Acc& acc, const Unit& u, int wr, int wc, int fr_, int fq_) const {
        int fr = fr_, fq = fq_; asm volatile("" : "+v"(fr), "+v"(fq));
        const int b = u.pm >> 2, gch = u.pm & 3;
#pragma unroll
        for (int ai = 0; ai < 2; ++ai)
#pragma unroll
            for (int m = 0; m < 4; ++m) {
                const int ch = gch * 128 + 64 * wr + 16 * m + fr;
                bf16* dst = ZT + ((size_t)b * 512 + ch) * (2 * NP) + ai * NP + u.pn * 256;
#pragma unroll
                for (int bj = 0; bj < 2; ++bj)
#pragma unroll
                    for (int n = 0; n < 2; ++n) *(u32x2*)(dst + 128 * bj + 32 * wc + 16 * n + 4 * fq) = pk4(acc[ai][bj][m][n]);
            }
        return false;
    }
};

struct EpiMerge {
    const unsigned char* G8; bf16* MB; const unsigned char* G8c;
    __device__ __forceinline__ bool operator()(Acc& acc, const Unit& u, int wr, int wc, int fr_, int fq_) const {
        int fr = fr_, fq = fq_; asm volatile("" : "+v"(fr), "+v"(fq));
        const int kb = u.kb; const int c0 = u.pn * 256 + 32 * wc + 8 * fq;
#pragma unroll
        for (int ai = 0; ai < 2; ++ai)
#pragma unroll
            for (int m = 0; m < 4; ++m) {
                const size_t row = (size_t)u.pm * 256 + 128 * ai + 64 * wr + 16 * m + fr;
                const unsigned char* gp = (u.pm >= 64 ? G8c : G8) + row * 3072 + c0;
#pragma unroll
                for (int bj = 0; bj < 2; ++bj) {
                    if (kb < 2) { const u32x2 wa = *(const u32x2*)(gp + kb * 1024 + 128 * bj), wb = *(const u32x2*)(gp + (kb + 1) * 1024 + 128 * bj);
#pragma unroll
                        for (int n = 0; n < 2; ++n) { const f32x4 ga = uq8x4(n ? wa.y : wa.x), gb = uq8x4(n ? wb.y : wb.x);
                            f32x4 r; r[0] = ga[0] * __builtin_amdgcn_rcpf(gb[0]); r[1] = ga[1] * __builtin_amdgcn_rcpf(gb[1]); r[2] = ga[2] * __builtin_amdgcn_rcpf(gb[2]); r[3] = ga[3] * __builtin_amdgcn_rcpf(gb[3]); acc[ai][bj][m][n] *= r; } }
                    else { const u32x2 wc2 = *(const u32x2*)(gp + 2048 + 128 * bj);
                        const f32x4 g0 = uq8x4(wc2.x) * (1.0f / 255.0f), g1 = uq8x4(wc2.y) * (1.0f / 255.0f);
                        *(u32x4*)(MB + row * 1024 + c0 + 128 * bj) = pk8(acc[ai][bj][m][0] * g0, acc[ai][bj][m][1] * g1); }
                }
            }
        return kb < 2;
    }
};

struct EpiRes {
    const float *xin_lat, *xin_ctx; float *xout_lat, *xout_ctx; const float* gate;
    __device__ __forceinline__ bool operator()(Acc& acc, const Unit& u, int wr, int wc, int fr_, int fq_) const {
        int fr = fr_, fq = fq_; asm volatile("" : "+v"(fr), "+v"(fq));
        const RowInfo ri = row_info(u.pm); const int s = ri.ctx ? 8 : ri.b;
        const int c0 = u.pn * 256 + 32 * wc + 4 * fq;
        const float* xin = ri.ctx ? xin_ctx + (size_t)(u.pm - 64) * 256 * 1024 : xin_lat + (size_t)u.pm * 256 * 1024;
        float* xout = ri.ctx ? xout_ctx + (size_t)(u.pm - 64) * 256 * 1024 : xout_lat + (size_t)u.pm * 256 * 1024;
        f32x4 gv[2][2];
#pragma unroll
        for (int bj = 0; bj < 2; ++bj)
#pragma unroll
            for (int n = 0; n < 2; ++n) gv[bj][n] = *(const f32x4*)(gate + s * 6144 + c0 + 128 * bj + 16 * n);
#pragma unroll
        for (int ai = 0; ai < 2; ++ai) {
            f32x4 xi[4][2][2];
#pragma unroll
            for (int m = 0; m < 4; ++m)
#pragma unroll
                for (int bj = 0; bj < 2; ++bj)
#pragma unroll
                    for (int n = 0; n < 2; ++n) xi[m][bj][n] = *(const f32x4*)(xin + (size_t)(128 * ai + 64 * wr + 16 * m + fr) * 1024 + c0 + 128 * bj + 16 * n);
#pragma unroll
            for (int m = 0; m < 4; ++m)
#pragma unroll
                for (int bj = 0; bj < 2; ++bj)
#pragma unroll
                    for (int n = 0; n < 2; ++n) *(f32x4*)(xout + (size_t)(128 * ai + 64 * wr + 16 * m + fr) * 1024 + c0 + 128 * bj + 16 * n) = xi[m][bj][n] + gv[bj][n] * acc[ai][bj][m][n];
            asm volatile("" ::: "memory");
        }
        return false;
    }
};

struct EpiSwiglu {
    bf16* ACT;
    __device__ __forceinline__ bool operator()(Acc& acc, const Unit& u, int wr, int wc, int fr_, int fq_) const {
        int fr = fr_, fq = fq_; asm volatile("" : "+v"(fr), "+v"(fq));
#pragma unroll
        for (int ai = 0; ai < 2; ++ai)
#pragma unroll
            for (int m = 0; m < 4; ++m) {
                const size_t row = (size_t)u.pm * 256 + 128 * ai + 64 * wr + 16 * m + fr;
                f32x4 o[2];
#pragma unroll
                for (int n = 0; n < 2; ++n) { const f32x4 gt = acc[ai][0][m][n], up = acc[ai][1][m][n];
                    o[n][0] = gt[0] * sigmoidf_(gt[0]) * up[0]; o[n][1] = gt[1] * sigmoidf_(gt[1]) * up[1]; o[n][2] = gt[2] * sigmoidf_(gt[2]) * up[2]; o[n][3] = gt[3] * sigmoidf_(gt[3]) * up[3]; }
                *(u32x4*)(ACT + row * FFH + u.pn * 128 + 32 * wc + 8 * fq) = pk8(o[0], o[1]);
            }
        return false;
    }
};

namespace att {
constexpr int KSLOT = 12288, VSLOT = 8192;
constexpr int L_K = 0, L_V = 2 * KSLOT, L_WS = L_V + 2 * VSLOT, L_OST = L_WS + NWAVES * 64 * 4, L_BYTES = L_OST + NWAVES * 4096;
__device__ __forceinline__ int crow(int r, int hi) { return (r & 3) + 8 * (r >> 2) + 4 * hi; }
__device__ __forceinline__ float max3f(float a, float b, float c) { return __builtin_fmaxf(__builtin_fmaxf(a, b), c); }
__device__ __forceinline__ float rowmax(const f32x16& p0, const f32x16& p1) {
    float a = max3f(p0[0], p0[1], p1[0]), b = max3f(p0[2], p0[3], p1[1]); a = max3f(a, p1[2], p1[3]);
#pragma unroll
    for (int r = 4; r < 16; r += 4) { a = max3f(a, p0[r], p0[r + 1]); b = max3f(b, p0[r + 2], p0[r + 3]); a = max3f(a, p1[r], p1[r + 1]); b = max3f(b, p1[r + 2], p1[r + 3]); }
    const float m = __builtin_fmaxf(a, b);
    auto rr = __builtin_amdgcn_permlane32_swap(__float_as_uint(m), __float_as_uint(m), false, false);
    return __builtin_fmaxf(__uint_as_float(rr[0]), __uint_as_float(rr[1]));
}
__device__ __forceinline__ void pv(f32x16* o, int vb, bf16x8 pa0, bf16x8 pa1, bf16x8 pa2, bf16x8 pa3) {
#pragma unroll
    for (int d0 = 0; d0 < 2; ++d0) { s16x4 lo[4], hi[4];
#pragma unroll
        for (int ks = 0; ks < 4; ++ks) {
            asm volatile("ds_read_b64_tr_b16 %0,%1 offset:%c2" : "=&v"(lo[ks]) : "v"(vb), "i"(d0 * 4096 + ks * 1024) : "memory");
            asm volatile("ds_read_b64_tr_b16 %0,%1 offset:%c2" : "=&v"(hi[ks]) : "v"(vb), "i"(d0 * 4096 + ks * 1024 + 512) : "memory"); }
        asm volatile("s_waitcnt lgkmcnt(0)" ::: "memory"); __builtin_amdgcn_sched_barrier(0);
#define PK(k) (bf16x8){lo[k][0], lo[k][1], lo[k][2], lo[k][3], hi[k][0], hi[k][1], hi[k][2], hi[k][3]}
        o[d0] = __builtin_amdgcn_mfma_f32_32x32x16_bf16(pa0, PK(0), o[d0], 0, 0, 0);
        o[d0] = __builtin_amdgcn_mfma_f32_32x32x16_bf16(pa1, PK(1), o[d0], 0, 0, 0);
        o[d0] = __builtin_amdgcn_mfma_f32_32x32x16_bf16(pa2, PK(2), o[d0], 0, 0, 0);
        o[d0] = __builtin_amdgcn_mfma_f32_32x32x16_bf16(pa3, PK(3), o[d0], 0, 0, 0);
#undef PK
    }
}
}


namespace attq {
using att::crow;
constexpr int NSLOT = 3;
#define SBAR() __builtin_amdgcn_sched_barrier(0)
__device__ __forceinline__ void glds16(const void* gsrc, unsigned lds_dst) { unsigned keep;
    asm volatile("s_mov_b32 %0, m0\n\ts_mov_b32 m0, %2\n\ts_nop 0\n\tglobal_load_lds_dwordx4 %1, off\n\ts_mov_b32 m0, %0" : "=&s"(keep) : "v"(gsrc), "s"(lds_dst) : "memory"); }
__device__ __forceinline__ float max3f(float a, float b, float c) { float r; asm("v_max3_f32 %0, %1, %2, %3" : "=v"(r) : "v"(a), "v"(b), "v"(c)); return r; }
__device__ __forceinline__ float max2f(float a, float b) { float r; asm("v_max_f32_e32 %0, %1, %2" : "=v"(r) : "v"(a), "v"(b)); return r; }
__device__ __forceinline__ float fadd_s(float a, float b) { float r; asm("v_add_f32_e32 %0, %1, %2" : "=v"(r) : "v"(a), "v"(b)); return r; }
__device__ __forceinline__ float fsub_s(float a, float b) { float r; asm("v_sub_f32_e32 %0, %1, %2" : "=v"(r) : "v"(a), "v"(b)); return r; }
template <int N> __device__ __forceinline__ void wait_bar() { asm volatile("s_waitcnt vmcnt(%0) lgkmcnt(0)\n\ts_barrier" :: "n"(N) : "memory"); }
#define WAIT_BAR(N) wait_bar<(N)>()
template <int ND> __device__ __forceinline__ void qkt(f32x16& p0, f32x16& p1, const char* Kslot, const bf16x8* qr, const f32x16& negm, int r32, int hi) {
    const char* kb = Kslot + hi * 1024 + r32 * 16;
#pragma unroll
    for (int d0 = 0; d0 < ND; ++d0) {
        const bf16x8 b0 = *reinterpret_cast<const bf16x8*>(kb + d0 * 2048);
        const bf16x8 b1 = *reinterpret_cast<const bf16x8*>(kb + d0 * 2048 + 512);
        if (d0 == 0) { p0 = __builtin_amdgcn_mfma_f32_32x32x16_bf16(b0, qr[0], negm, 0, 0, 0); p1 = __builtin_amdgcn_mfma_f32_32x32x16_bf16(b1, qr[0], negm, 0, 0, 0); }
        else { p0 = __builtin_amdgcn_mfma_f32_32x32x16_bf16(b0, qr[d0], p0, 0, 0, 0); p1 = __builtin_amdgcn_mfma_f32_32x32x16_bf16(b1, qr[d0], p1, 0, 0, 0); } }
}
typedef __attribute__((address_space(3))) const char* lds_cptr;
typedef short v4i16_t __attribute__((ext_vector_type(4)));
template <int ND> __device__ __forceinline__ void kloadall(bf16x8* kf, lds_cptr kp) {
    kf[0] = *(const LAS bf16x8*)(kp);        kf[1] = *(const LAS bf16x8*)(kp + 512);
    kf[2] = *(const LAS bf16x8*)(kp + 2048); kf[3] = *(const LAS bf16x8*)(kp + 2560);
    kf[4] = *(const LAS bf16x8*)(kp + 4096); kf[5] = *(const LAS bf16x8*)(kp + 4608);
    kf[6] = *(const LAS bf16x8*)(kp + 6144); kf[7] = *(const LAS bf16x8*)(kp + 6656);
    if constexpr (ND == 6) { kf[8] = *(const LAS bf16x8*)(kp + 8192); kf[9] = *(const LAS bf16x8*)(kp + 8704); kf[10] = *(const LAS bf16x8*)(kp + 10240); kf[11] = *(const LAS bf16x8*)(kp + 10752); }
}
__device__ __forceinline__ void kload2(bf16x8* kf, lds_cptr kp, int j) { kf[2 * j] = *(const LAS bf16x8*)(kp + j * 2048); kf[2 * j + 1] = *(const LAS bf16x8*)(kp + j * 2048 + 512); }
__device__ __forceinline__ s16x4 vtr(lds_cptr p) { return __builtin_bit_cast(s16x4, __builtin_amdgcn_ds_read_tr16_b64_v4i16((LAS v4i16_t*)p)); }
__device__ __forceinline__ float rowmax(const f32x16& p0, const f32x16& p1) {
    float a = max3f(p0[0], p0[1], p1[0]), b = max3f(p0[2], p0[3], p1[1]); a = max3f(a, p1[2], p1[3]);
#pragma unroll
    for (int r = 4; r < 16; r += 4) { a = max3f(a, p0[r], p0[r + 1]); b = max3f(b, p0[r + 2], p0[r + 3]); a = max3f(a, p1[r], p1[r + 1]); b = max3f(b, p1[r + 2], p1[r + 3]); }
    const float m = max2f(a, b);
    auto rr = __builtin_amdgcn_permlane32_swap(__float_as_uint(m), __float_as_uint(m), false, false);
    return max2f(__uint_as_float(rr[0]), __uint_as_float(rr[1]));
}
template <int ND, int THRL>
__device__ __forceinline__ void attn_unit(const bf16* Q, int pq, const bf16* Qr, int pqr, const bf16* __restrict__ Kh, int pk, const bf16* __restrict__ Vh, int pkv, bf16* O, int po, int NT, char* shm) {
    constexpr int SLOTB = (ND == 6) ? 12288 : 8192, KD = (ND == 6) ? 2 : 1;
    constexpr int LDS_K = 0, LDS_V = NSLOT * SLOTB, LDS_WS = 2 * NSLOT * SLOTB, LDS_OST = LDS_WS + NWAVES * 64 * 4;
    int tid = threadIdx.x; asm volatile("" : "+v"(tid));
    const int lane = tid & 63, r32 = lane & 31, hi = lane >> 5; const int wid = __builtin_amdgcn_readfirstlane(tid >> 6);
    const bf16* Qw = Q + (size_t)(wid * 32) * pq;
    const unsigned lds0 = (unsigned)(uintptr_t)shm;
    float* wsf = (float*)(shm + LDS_WS) + wid * 64;
    const bf16* ksrc = Kh + (size_t)lane * pk + wid * 8;
    const bf16* ksrc2 = Kh + (size_t)lane * pk + (8 + (wid & 3)) * 8;
    const unsigned kdst2 = lds0 + LDS_K + (8 + (wid & 3)) * 1024; (void)ksrc2; (void)kdst2;
    const bf16* vsrc = Vh + (size_t)(16 * (wid & 3) + (lane >> 2)) * pkv + (wid >> 2) * 32 + (lane & 3) * 8;
    const unsigned kdst = lds0 + LDS_K + wid * 1024, vdst = lds0 + LDS_V + wid * 1024;
#define DMA_K(t, slot) do { glds16(ksrc + (size_t)(t) * 64 * pk, (unsigned)__builtin_amdgcn_readfirstlane(kdst + (slot))); if constexpr (ND == 6) glds16(ksrc2 + (size_t)(t) * 64 * pk, (unsigned)__builtin_amdgcn_readfirstlane(kdst2 + (slot))); } while (0)
#define DMA_V(t, slot) glds16(vsrc + (size_t)(t) * 64 * pkv, (unsigned)__builtin_amdgcn_readfirstlane(vdst + (slot)))
    const int vb0 = (int)(lds0 + LDS_V) + ((lane >> 4) & 1) * 32 + (lane & 3) * 8 + (4 * hi + ((lane & 15) >> 2)) * 64;
    const char* Kbase = shm + LDS_K; bf16x8 kf[2 * ND];
    const lds_cptr shm3 = (lds_cptr)shm; const lds_cptr kp0 = shm3 + LDS_K + hi * 1024 + r32 * 16; const lds_cptr vp0 = shm3 + LDS_V + ((lane >> 4) & 1) * 32 + (lane & 3) * 8 + (4 * hi + ((lane & 15) >> 2)) * 64;
    DMA_K(0, 0); DMA_V(0, 0); DMA_K(1, SLOTB);
    bf16x8 qr[ND];
#pragma unroll
    for (int d0 = 0; d0 < 4; ++d0) qr[d0] = *reinterpret_cast<const bf16x8*>(&Qw[(size_t)r32 * pq + d0 * 16 + hi * 8]);
    if constexpr (ND == 6) {
#pragma unroll
        for (int d0 = 4; d0 < 6; ++d0) qr[d0] = *reinterpret_cast<const bf16x8*>(&Qr[(size_t)(wid * 32 + r32) * pqr + (d0 - 4) * 16 + hi * 8]); }
    float mhat = 0.f, l_reg = 0.f; f32x16 o[2]; o[0] = f32x16{}; o[1] = f32x16{}; f32x16 negm = f32x16{}; asm volatile("" : "+v"(negm));
    bool resc = false;
#define START(P0, P1) do { const float rm = rowmax(P0, P1); resc = false; \
    { const float dl = rm; mhat = fadd_s(mhat, dl); \
      _Pragma("unroll") for (int r = 0; r < 16; ++r) { P0[r] = fsub_s(P0[r], dl); P1[r] = fsub_s(P1[r], dl); } \
      _Pragma("unroll") for (int r = 0; r < 16; ++r) negm[r] = -mhat; asm volatile("" : "+v"(negm)); } \
    _Pragma("unroll") for (int r = 0; r < 16; ++r) P0[r] = __builtin_amdgcn_exp2f(P0[r]); } while (0)
#define RESC() do { if (resc) { asm volatile("s_waitcnt lgkmcnt(0)" ::: "memory"); \
      _Pragma("unroll") for (int d_ = 0; d_ < 2; ++d_) _Pragma("unroll") for (int r = 0; r < 16; ++r) o[d_][r] *= wsf[crow(r, hi)]; } } while (0)
    f32x16 pA0, pA1, pB0, pB1;
    int sl_prev = 0, sl_cur = 0, sl_next = SLOTB;
#define ROT() do { sl_prev = sl_cur; sl_cur = sl_next; sl_next = (sl_next == (NSLOT - 1) * SLOTB) ? 0 : sl_next + SLOTB; } while (0)
    DMA_K(2, 2 * SLOTB);
    WAIT_BAR(1 + 2 * KD);
    qkt<ND>(pA0, pA1, Kbase, qr, negm, r32, hi); asm volatile("s_nop 15\n\ts_nop 7" : "+v"(pA0), "+v"(pA1));
    START(pA0, pA1);
    _Pragma("unroll") for (int r = 0; r < 16; ++r) pA1[r] = __builtin_amdgcn_exp2f(pA1[r]);
    WAIT_BAR(0);
    DMA_K(3, 0); DMA_V(1, SLOTB);
    ROT();
    kloadall<ND>(kf, kp0 + sl_cur);
    WAIT_BAR(KD + 1);
    s16x4 vlo[8], vhi[8]; u32x4 pw0, pw1, pw2, pw3;
#define PKW(P, B) cvtpk(P[B], P[B + 1])
#define PAF(k) __builtin_bit_cast(bf16x8, pw##k)
#define VFR(i) (bf16x8){vlo[i][0], vlo[i][1], vlo[i][2], vlo[i][3], vhi[i][0], vhi[i][1], vhi[i][2], vhi[i][3]}
#define PIN(x) asm volatile("" : "+v"(x))
#define MX3(a, b, c) __builtin_fmaxf(__builtin_fmaxf((a), (b)), (c))
#define GAPA(MF, A0, A1, A2, A3, W0, W1, PW) do { MF; sacc += A0; sacc += A1; sacc += A2; sacc += A3; PIN(sacc); W0; W1; PIN(PW); SBAR(); } while (0)
#define EX(v) __builtin_amdgcn_exp2f(v)
#define GAPB(MF, X, B) do { MF; X[B] = EX(X[B]); X[B + 1] = EX(X[B + 1]); X[B + 2] = EX(X[B + 2]); X[B + 3] = EX(X[B + 3]); PIN(X); SBAR(); } while (0)
#define VRD(i) do { vlo[i] = vtr(vp_ + (((i) >> 2) * 4096 + ((i) & 3) * 1024)); vhi[i] = vtr(vp_ + (((i) >> 2) * 4096 + ((i) & 3) * 1024 + 512)); } while (0)
#define KRD(G, j) do { if (G) { kload2(kf, kp0 + sl_next, j); SBAR(); } } while (0)
#define STEP(C0, C1, P0, P1, t, GK, GV, GL) do { SBAR(); \
    const lds_cptr vp_ = vp0 + sl_prev; \
    VRD(0); SBAR(); float sacc = (P0[0] + P0[1]); \
    GAPA(C0 = __builtin_amdgcn_mfma_f32_32x32x16_bf16(kf[0], qr[0], negm, 0, 0, 0), P0[2], P0[3], P0[4], P0[5],     pw0[0] = PKW(P0, 0), pw0[1] = PKW(P0, 2), pw0); \
    VRD(4); SBAR(); GAPA(C1 = __builtin_amdgcn_mfma_f32_32x32x16_bf16(kf[1], qr[0], negm, 0, 0, 0), P0[6], P0[7], P0[8], P0[9],     pw0[2] = PKW(P0, 4), pw0[3] = PKW(P0, 6), pw0); \
    VRD(1); SBAR(); GAPA(C0 = __builtin_amdgcn_mfma_f32_32x32x16_bf16(kf[2], qr[1], C0, 0, 0, 0),   P0[10], P0[11], P0[12], P0[13], pw1[0] = PKW(P0, 8), pw1[1] = PKW(P0, 10), pw1); \
    VRD(5); SBAR(); GAPA(C1 = __builtin_amdgcn_mfma_f32_32x32x16_bf16(kf[3], qr[1], C1, 0, 0, 0),   P0[14], P0[15], P1[0], P1[1],   pw1[2] = PKW(P0, 12), pw1[3] = PKW(P0, 14), pw1); \
    VRD(2); SBAR(); GAPA(C0 = __builtin_amdgcn_mfma_f32_32x32x16_bf16(kf[4], qr[2], C0, 0, 0, 0),   P1[2], P1[3], P1[4], P1[5],     pw2[0] = PKW(P1, 0), pw2[1] = PKW(P1, 2), pw2); \
    VRD(6); SBAR(); GAPA(C1 = __builtin_amdgcn_mfma_f32_32x32x16_bf16(kf[5], qr[2], C1, 0, 0, 0),   P1[6], P1[7], P1[8], P1[9],     pw2[2] = PKW(P1, 4), pw2[3] = PKW(P1, 6), pw2); \
    VRD(3); SBAR(); GAPA(C0 = __builtin_amdgcn_mfma_f32_32x32x16_bf16(kf[6], qr[3], C0, 0, 0, 0),   P1[10], P1[11], P1[12], P1[13], pw3[0] = PKW(P1, 8), pw3[1] = PKW(P1, 10), pw3); \
    VRD(7); SBAR(); GAPA(C1 = __builtin_amdgcn_mfma_f32_32x32x16_bf16(kf[7], qr[3], C1, 0, 0, 0),   P1[14], P1[15], 0.f, 0.f,       pw3[2] = PKW(P1, 12), pw3[3] = PKW(P1, 14), pw3); \
    if constexpr (ND == 6) { C0 = __builtin_amdgcn_mfma_f32_32x32x16_bf16(kf[8], qr[4], C0, 0, 0, 0); SBAR(); C1 = __builtin_amdgcn_mfma_f32_32x32x16_bf16(kf[9], qr[4], C1, 0, 0, 0); SBAR(); \
      C0 = __builtin_amdgcn_mfma_f32_32x32x16_bf16(kf[10], qr[5], C0, 0, 0, 0); SBAR(); C1 = __builtin_amdgcn_mfma_f32_32x32x16_bf16(kf[11], qr[5], C1, 0, 0, 0); SBAR(); } \
    l_reg += sacc; \
    if (GK) { DMA_K((t) + 3, sl_cur); } if (GV) { DMA_V((t) + 1, sl_next); } \
    { float a = MX3(C0[0], C0[1], C1[0]), b = MX3(C0[2], C0[3], C1[1]); a = MX3(a, C1[2], C1[3]); \
      _Pragma("unroll") for (int r = 4; r < 16; r += 4) { a = MX3(a, C0[r], C0[r + 1]); b = MX3(b, C0[r + 2], C0[r + 3]); a = MX3(a, C1[r], C1[r + 1]); b = MX3(b, C1[r + 2], C1[r + 3]); } \
      float rm = __builtin_fmaxf(a, b); { auto rr = __builtin_amdgcn_permlane32_swap(__float_as_uint(rm), __float_as_uint(rm), false, false); rm = __builtin_fmaxf(__uint_as_float(rr[0]), __uint_as_float(rr[1])); } \
      resc = false; \
      if (__builtin_expect(__any(rm > (float)THRL), 0)) { const float dl = __builtin_fmaxf(rm, 0.f); mhat += dl; \
        _Pragma("unroll") for (int r = 0; r < 16; ++r) { C0[r] -= dl; C1[r] -= dl; } \
        _Pragma("unroll") for (int r = 0; r < 16; ++r) negm[r] = -mhat; asm volatile("" : "+v"(negm)); \
        const float f = __builtin_amdgcn_exp2f(-dl); l_reg *= f; if (hi == 0) wsf[r32] = f; resc = true; } } \
    SBAR(); \
    GAPB(o[0] = __builtin_amdgcn_mfma_f32_32x32x16_bf16(PAF(0), VFR(0), o[0], 0, 0, 0), C0, 0); \
    GAPB(o[1] = __builtin_amdgcn_mfma_f32_32x32x16_bf16(PAF(0), VFR(4), o[1], 0, 0, 0), C0, 4); \
    KRD(GL, 0); GAPB(o[0] = __builtin_amdgcn_mfma_f32_32x32x16_bf16(PAF(1), VFR(1), o[0], 0, 0, 0), C0, 8); \
    KRD(GL, 1); GAPB(o[1] = __builtin_amdgcn_mfma_f32_32x32x16_bf16(PAF(1), VFR(5), o[1], 0, 0, 0), C0, 12); \
    KRD(GL, 2); GAPB(o[0] = __builtin_amdgcn_mfma_f32_32x32x16_bf16(PAF(2), VFR(2), o[0], 0, 0, 0), C1, 0); \
    KRD(GL, 3); GAPB(o[1] = __builtin_amdgcn_mfma_f32_32x32x16_bf16(PAF(2), VFR(6), o[1], 0, 0, 0), C1, 4); \
    if constexpr (ND == 6) { KRD(GL, 4); } GAPB(o[0] = __builtin_amdgcn_mfma_f32_32x32x16_bf16(PAF(3), VFR(3), o[0], 0, 0, 0), C1, 8); \
    if constexpr (ND == 6) { KRD(GL, 5); } GAPB(o[1] = __builtin_amdgcn_mfma_f32_32x32x16_bf16(PAF(3), VFR(7), o[1], 0, 0, 0), C1, 12); \
    } while (0)
    int t = 1;
    for (; t + 5 < NT; t += 2) {
        STEP(pB0, pB1, pA0, pA1, t, true, true, true);     WAIT_BAR(KD + 1); RESC(); ROT();
        STEP(pA0, pA1, pB0, pB1, t + 1, true, true, true); WAIT_BAR(KD + 1); RESC(); ROT();
    }
#define ENDW(tt) do { if ((tt) + 3 < NT) { WAIT_BAR(KD + 1); } else if ((tt) + 2 < NT) { WAIT_BAR(1); } else { WAIT_BAR(0); } } while (0)
    for (; t + 1 < NT; t += 2) {
        STEP(pB0, pB1, pA0, pA1, t, (t + 3 < NT), (t + 1 < NT), (t + 1 < NT));     ENDW(t);     RESC(); ROT();
        STEP(pA0, pA1, pB0, pB1, t + 1, (t + 4 < NT), (t + 2 < NT), (t + 2 < NT)); ENDW(t + 1); RESC(); ROT();
    }
    STEP(pB0, pB1, pA0, pA1, NT - 1, false, false, false); RESC();
    { float sacc = pB0[0] + pB0[1]; _Pragma("unroll") for (int r = 2; r < 16; ++r) sacc += pB0[r]; _Pragma("unroll") for (int r = 0; r < 16; ++r) sacc += pB1[r]; l_reg += sacc;
      pw0 = (u32x4){PKW(pB0, 0), PKW(pB0, 2), PKW(pB0, 4), PKW(pB0, 6)}; pw1 = (u32x4){PKW(pB0, 8), PKW(pB0, 10), PKW(pB0, 12), PKW(pB0, 14)}; pw2 = (u32x4){PKW(pB1, 0), PKW(pB1, 2), PKW(pB1, 4), PKW(pB1, 6)}; pw3 = (u32x4){PKW(pB1, 8), PKW(pB1, 10), PKW(pB1, 12), PKW(pB1, 14)};
      SBAR(); att::pv(o, vb0 + sl_cur, PAF(0), PAF(1), PAF(2), PAF(3)); }
#undef PKW
#undef PAF
#undef VFR
#undef PIN
#undef MX3
#undef GAPA
#undef GAPB
#undef EX
#undef VRD
#undef KRD
#undef STEP
#undef ENDW
    { auto rr = __builtin_amdgcn_permlane32_swap(__float_as_uint(l_reg), __float_as_uint(l_reg), false, false); l_reg = __uint_as_float(rr[0]) + __uint_as_float(rr[1]); }
    if (hi == 0) wsf[32 + r32] = l_reg; asm volatile("s_waitcnt lgkmcnt(0)" ::: "memory");
    float rli[16];
#pragma unroll
    for (int r = 0; r < 16; ++r) rli[r] = __builtin_amdgcn_rcpf(wsf[32 + crow(r, hi)]);
    bf16* Ow = O + (size_t)(wid * 32) * po;
    { bf16* stg = (bf16*)(shm + LDS_OST) + wid * 2048;
#pragma unroll
      for (int r = 0; r < 16; ++r) { const int orow = crow(r, hi);
#pragma unroll
        for (int d0 = 0; d0 < 2; ++d0) stg[orow * 64 + d0 * 32 + r32] = (bf16)(cvtpk(o[d0][r] * rli[r], 0.f) & 0xffffu); }
      asm volatile("s_waitcnt lgkmcnt(0)" ::: "memory");
#pragma unroll
      for (int i = 0; i < 4; ++i) { const int row = i * 8 + (lane >> 3), ch = lane & 7; const u32x4 v = *(const u32x4*)(stg + row * 64 + ch * 8); *(u32x4*)(Ow + (size_t)row * po + ch * 8) = v; } }
    asm volatile("s_waitcnt lgkmcnt(0)\n\ts_barrier" ::: "memory");
#undef DMA_K
#undef DMA_V
#undef START
#undef RESC
#undef ROT
}
#undef SBAR
#undef WAIT_BAR
}

#define RLX_AGENT __ATOMIC_RELAXED, __HIP_MEMORY_SCOPE_AGENT
#define XB_TMO      128
#define XB_XCNT(j)  (256  + 64 * (j))
#define XB_XSUB(j)  (1280 + 64 * (j))
#define XB_XGEN(j)  (2304 + 64 * (j))
#define XB_TOP      3328
#define XB_TOPGEN   3392
#define XCD_BAR_WORDS 3456
#define XB_SPIN_CAP (1u << 18)
__device__ __forceinline__ unsigned xb_ld(unsigned* p)              { return __hip_atomic_load(p, __ATOMIC_RELAXED, __HIP_MEMORY_SCOPE_AGENT); }
__device__ __forceinline__ unsigned xb_add(unsigned* p, unsigned v) { return __hip_atomic_fetch_add(p, v, __ATOMIC_RELAXED, __HIP_MEMORY_SCOPE_AGENT); }
__device__ __forceinline__ unsigned xb_xcc_id() { return (unsigned)__builtin_amdgcn_s_getreg((3 << 11) | 20) & 0xFu; }
#define XB_SPIN(cond, bar) do { unsigned _sp = 0; while (cond) { __builtin_amdgcn_s_sleep(1); \
    if ((++_sp & 255u) == 0u) { if (xb_ld(&(bar)[XB_TMO])) break; if (_sp > XB_SPIN_CAP) { atomicAdd(&(bar)[XB_TMO], 1u); break; } } } } while (0)
struct XcdBarrier { unsigned* bar; unsigned x; volatile LAS unsigned* st; };
__device__ __forceinline__ XcdBarrier xcd_barrier_post(unsigned* bar, volatile LAS unsigned* st) {
    XcdBarrier b; b.bar = bar; b.x = xb_xcc_id(); b.st = st;
    if (threadIdx.x == 0) (void)xb_add(&bar[XB_XCNT(b.x)], 1u);
    return b;
}
__device__ __forceinline__ void xcd_barrier_complete(unsigned* bar, unsigned x, unsigned& nloc, unsigned& nx) {
    const unsigned G = gridDim.x * gridDim.y * gridDim.z;
    unsigned sum, cnt, mine, sp = 0u;
    for (;;) {
        sum = 0u; cnt = 0u; mine = 0u;
#pragma unroll
        for (unsigned j = 0; j < 16; ++j) { const unsigned c = xb_ld(&bar[XB_XCNT(j)]); sum += c; cnt += (c > 0u) ? 1u : 0u; mine = (j == x) ? c : mine; }
        if (sum == G) break;
        __builtin_amdgcn_s_sleep(1);
        if ((++sp & 255u) == 0u) { if (xb_ld(&bar[XB_TMO])) break; if (sp > XB_SPIN_CAP) { atomicAdd(&bar[XB_TMO], 1u); break; } }
    }
    nloc = mine > 0u ? mine : 1u; nx = cnt > 0u ? cnt : 1u;
}
__device__ __forceinline__ void xcd_barrier(const XcdBarrier& b) {
    asm volatile("s_waitcnt vmcnt(0)" ::: "memory");
    __syncthreads();
    if (threadIdx.x == 0) {
        unsigned* bar = b.bar;
        __builtin_amdgcn_s_waitcnt(0);
        unsigned nloc = b.st[0], nx = b.st[1];
        if (nloc == 0u) { xcd_barrier_complete(bar, b.x, nloc, nx); b.st[0] = nloc; b.st[1] = nx; }
        const unsigned old = xb_add(&bar[XB_XSUB(b.x)], 1u);
        const unsigned gen = old / nloc;
        if (old + 1u == (gen + 1u) * nloc) {
            __builtin_amdgcn_fence(__ATOMIC_RELEASE, "agent");
            asm volatile("s_waitcnt vmcnt(0)" ::: "memory");
            const unsigned og = xb_add(&bar[XB_TOP], 1u);
            const unsigned tg = og / nx;
            if (og + 1u == (tg + 1u) * nx) xb_add(&bar[XB_TOPGEN], 1u);
            else XB_SPIN(xb_ld(&bar[XB_TOPGEN]) == tg, bar);
            __builtin_amdgcn_fence(__ATOMIC_ACQUIRE, "agent");
            xb_add(&bar[XB_XGEN(b.x)], 1u);
            asm volatile("s_waitcnt vmcnt(0)" ::: "memory");
        } else {
            XB_SPIN(xb_ld(&bar[XB_XGEN(b.x)]) == gen, bar);
            __builtin_amdgcn_fence(__ATOMIC_ACQUIRE, "agent");
            asm volatile("s_waitcnt vmcnt(0)" ::: "memory");
        }
    }
    __syncthreads();
}
constexpr int LDS_MISC = 131072 + 1024;
constexpr size_t CTL_ZERO_BYTES = 64 * KiB;

struct Args { const float* in[26]; float* out; unsigned char* ws; int ph_lo, ph_hi; };
constexpr int LDS_BYTES = 147456;
constexpr int NPHASE = 21;

typedef const __attribute__((address_space(4))) unsigned char* KP;
__device__ __forceinline__ const float* kin(KP kp, int k) { return *(const float* const __attribute__((address_space(4)))*)(kp + 8 * k); }
__device__ __forceinline__ float* kout(KP kp) { return *(float* const __attribute__((address_space(4)))*)(kp + 208); }
__device__ __forceinline__ unsigned char* kws(KP kp) { return *(unsigned char* const __attribute__((address_space(4)))*)(kp + 216); }
static_assert(sizeof(Args) == 232, "Args layout");
struct Ctx {
    LAS unsigned char* lds; int tid, lane, wave, vcu, G; unsigned char* ws; int cv_rank, cv_n;
};

enum MatId { M_WIN = 0, M_WUQ, M_WUKV, M_NAT, M_FFI, M_NATP };
__device__ __forceinline__ int rope_perm(int p) { const int n = p >> 4, fq = (p >> 2) & 3, j = p & 3; return 16 * (fq >> 1) + 8 * n + 4 * (fq & 1) + j; }
__device__ __forceinline__ int head_perm(int pc, int& wc) { wc = (pc >> 5) & 3; return 32 * (pc >> 7) + (pc & 31); }
__device__ __forceinline__ int pg32(int x) { const int p = x & 31; return (x & ~31) | (8 * ((p >> 2) & 3) + 4 * (p >> 4) + (p & 3)); }
__device__ __forceinline__ int src_col(int mat, int n) {
    const int t = n >> 8, pc = n & 255; int wc;
    switch (mat) {
    case M_WIN:
        if (t < 2) { const int d = head_perm(pc, wc); return (4 * t + wc) * 64 + d; }
        if (t == 2) { const int d = head_perm(pc, wc); return wc < 2 ? 512 + wc * 64 + d : 640 + (wc - 2) * 64 + d; }
        if (t == 3) return 768 + pg32(pc);
        if (t == 4) { if (pc < 128) return 768 + 256 + pg32(pc); if (pc < 160) return 1408 + rope_perm(pc - 128); return -1; }
        if (t == 5) return 1152 + pg32(pc);
        if (t < 8) return 1440 + (t - 6) * 256 + pg32(pc);
        return 1952 + (t - 8) * 256 + pg32(pc);
    case M_WUQ:
        if (t < 2) { const int d = head_perm(pc, wc); return (4 * t + wc) * 96 + d; }
        { const int bj = pc >> 7, w2 = (pc >> 5) & 3; return (4 * bj + w2) * 96 + 64 + rope_perm(pc & 31); }
    case M_WUKV:
        { const int d = head_perm(pc, wc); return t < 2 ? (4 * t + wc) * 128 + d : (4 * (t - 2) + wc) * 128 + 64 + d; }
    case M_FFI:
        return pc < 128 ? t * 128 + pg32(pc) : FFH + t * 128 + pg32(pc - 128);
    case M_NATP: return pg32(n);
    default: return n;
    }
}
__device__ __forceinline__ void xpose_item(const float* W, int ldw, const float* kscale, bf16* WT, int ldo, int kcol0, int mat, int nblk, int item, LAS float* scr, int lane) {
    const int kb = item / nblk, nb = item % nblk, k0 = 64 * kb, n0 = 32 * nb;
    const int r = lane >> 3, g4 = 4 * (lane & 7);
    const int sc = src_col(mat, n0 + g4);
    f32x4 v[8];
#pragma unroll
    for (int i = 0; i < 8; ++i) { const int k = k0 + 8 * i + r; v[i] = (sc >= 0) ? *(const f32x4*)(W + (size_t)k * ldw + sc) : (f32x4){0.f, 0.f, 0.f, 0.f}; if (kscale) v[i] *= kscale[k]; }
#pragma unroll
    for (int i = 0; i < 8; ++i) { LAS float* d = scr + (8 * i + r) * 33 + g4; d[0] = v[i][0]; d[1] = v[i][1]; d[2] = v[i][2]; d[3] = v[i][3]; }
    asm volatile("s_waitcnt lgkmcnt(0)" ::: "memory");
    const int c = lane & 7;
#pragma unroll
    for (int j = 0; j < 4; ++j) { const int n = (lane >> 3) + 8 * j; const LAS float* s = scr + (8 * c) * 33 + n;
        u32x4 o; o.x = cvtpk(s[0 * 33], s[1 * 33]); o.y = cvtpk(s[2 * 33], s[3 * 33]); o.z = cvtpk(s[4 * 33], s[5 * 33]); o.w = cvtpk(s[6 * 33], s[7 * 33]);
        *(u32x4*)(WT + (size_t)(n0 + n) * ldo + kcol0 + k0 + 8 * c) = o; }
    asm volatile("s_waitcnt lgkmcnt(0)" ::: "memory");
}
__device__ __forceinline__ void run_xjob(const Ctx& F, int& base, const float* W, int ldw, const float* kscale, bf16* WT, int ldo, int kcol0, int mat, int K, int N) {
    LAS float* scr = (LAS float*)(F.lds + F.wave * 16384);
    const int gw = F.cv_rank * NWAVES + F.wave, NGW = F.cv_n * NWAVES;
    const int nblk = N / 32, nit = (K / 64) * nblk;
    int first = gw - (base % NGW); if (first < 0) first += NGW;
    for (int it = first; it < nit; it += NGW) xpose_item(W, ldw, kscale, WT, ldo, kcol0, mat, nblk, it, scr, F.lane);
    base += nit;
}

__device__ __forceinline__ void norm_pass(const Ctx& F, const float* x_lat, const float* x_ctx, bf16* HB, const float* gnorm, const float* mod_l, int shift_off, int nrows) {
    const int gw = F.vcu * NWAVES + F.wave, NGW = F.G * NWAVES;
    const int per = (nrows + NGW - 1) / NGW; const int r0 = gw * per, r1 = min(nrows, r0 + per);
    int cur_s = -1; f32x4 ca[4], cb[4];
    for (int r = r0; r < r1; ++r) {
        const bool ctx = r >= ML; const int s = ctx ? 8 : r >> 11;
        if (s != cur_s) { cur_s = s; const float* sh = mod_l + s * 6144 + shift_off; const float* scl = sh + 1024;
#pragma unroll
            for (int j = 0; j < 4; ++j) { const f32x4 g = *(const f32x4*)(gnorm + 256 * j + 4 * F.lane); const f32x4 sc1 = *(const f32x4*)(scl + 256 * j + 4 * F.lane); ca[j] = g * (sc1 + 1.0f); cb[j] = *(const f32x4*)(sh + 256 * j + 4 * F.lane); } }
        const float* xr = ctx ? x_ctx + (size_t)(r - ML) * 1024 : x_lat + (size_t)r * 1024;
        f32x4 v[4]; float ss = 0.f;
#pragma unroll
        for (int j = 0; j < 4; ++j) { v[j] = *(const f32x4*)(xr + 256 * j + 4 * F.lane); ss += (v[j][0] * v[j][0] + v[j][1] * v[j][1]) + (v[j][2] * v[j][2] + v[j][3] * v[j][3]); }
        const float rstd = rsqrtf(wave_sum(ss) * (1.0f / 1024.0f) + EPS);
#pragma unroll
        for (int j = 0; j < 4; ++j) *(u32x2*)(HB + (size_t)r * 1024 + 256 * j + 4 * F.lane) = pk4(v[j] * rstd * ca[j] + cb[j]);
    }
}

__device__ __forceinline__ void mod_items(const Ctx& F, KP kp) {
    const float* c = kin(kp, 1); const float* cc = kin(kp, 3); const float* wmod = kin(kp, 4); const float* bmod = kin(kp, 5);
    float* mod = (float*)(F.ws + O_MOD);
    LAS float* sl = (LAS float*)F.lds;
    LAS float* red = sl + 9 * 1024;
    for (int it = F.vcu; it < 192; it += F.G) {
        const int l = it / 96, n0 = (it % 96) * 64;
        __syncthreads();
        for (int i = F.tid; i < 9 * 1024; i += NTHR) { const float v = (i < 8192) ? c[i] : cc[i - 8192]; sl[i] = v * sigmoidf_(v); }
        __syncthreads();
        float acc[9];
#pragma unroll
        for (int s = 0; s < 9; ++s) acc[s] = 0.f;
        const float* wp = wmod + (size_t)l * 1024 * 6144 + n0 + F.lane;
        for (int k0 = F.wave * 128; k0 < F.wave * 128 + 128; k0 += 16) { float w[16];
#pragma unroll
            for (int j = 0; j < 16; ++j) w[j] = wp[(size_t)(k0 + j) * 6144];
#pragma unroll
            for (int j = 0; j < 16; ++j)
#pragma unroll
                for (int s = 0; s < 9; ++s) acc[s] += sl[s * 1024 + k0 + j] * w[j]; }
#pragma unroll
        for (int s = 0; s < 9; ++s) red[(F.wave * 9 + s) * 64 + F.lane] = acc[s];
        __syncthreads();
        for (int i = F.tid; i < 9 * 64; i += NTHR) { float t = 0.f;
#pragma unroll
            for (int w = 0; w < 8; ++w) t += red[w * 576 + i];
            const int s = i / 64, n = n0 + (i & 63); mod[(l * 9 + s) * 6144 + n] = t + bmod[l * 6144 + n]; }
    }
    __syncthreads();
}
__device__ __forceinline__ void table_items(const Ctx& F) {
    const int gt = (F.vcu * NTHR) + F.tid, NT_ = F.G * NTHR;
    float* ra = (float*)(F.ws + O_ROPEA); float* rb = (float*)(F.ws + O_ROPEB);
    for (int i = gt; i < 1024; i += NT_) { const int pos = i >> 4, f = i & 15; const float fr = powf(10000.0f, -(float)(2 * f) / 32.0f); const float ang = (float)pos * fr; ra[i] = cosf(ang); ra[1024 + i] = sinf(ang); }
    for (int i = gt; i < 512; i += NT_) { const int pos = i >> 3, f = i & 7; const float fr = powf(10000.0f, -(float)(2 * f) / 16.0f); const float ang = (float)pos * fr; rb[i] = cosf(ang); rb[512 + i] = sinf(ang); }
    bf16* DN = (bf16*)(F.ws + O_DN); bf16* DN2 = (bf16*)(F.ws + O_DN256); bf16* DC = (bf16*)(F.ws + O_DFTC);
    {
      LAS unsigned* tab = (LAS unsigned*)F.lds;
      const float sc = 0.022097086912079608f;
      __syncthreads();
      for (int m = F.tid; m < 2048; m += NTHR) { float s0, c0; sincospif((float)m * (1.0f / 1024.0f), &s0, &c0); tab[m] = cvtpk(c0 * sc, -s0 * sc); }
      __syncthreads();
      for (int i = gt; i < 2048 * 2048 / 8; i += NT_) { const int n = i >> 8, k = (i & 255) * 8; unsigned t[8];
#pragma unroll
          for (int j = 0; j < 8; ++j) t[j] = tab[(n * (k + j)) & 2047];
          u32x4 cw, sw;
          cw.x = (t[0] & 0xffffu) | (t[1] << 16); cw.y = (t[2] & 0xffffu) | (t[3] << 16); cw.z = (t[4] & 0xffffu) | (t[5] << 16); cw.w = (t[6] & 0xffffu) | (t[7] << 16);
          sw.x = (t[0] >> 16) | (t[1] & 0xffff0000u); sw.y = (t[2] >> 16) | (t[3] & 0xffff0000u); sw.z = (t[4] >> 16) | (t[5] & 0xffff0000u); sw.w = (t[6] >> 16) | (t[7] & 0xffff0000u);
          *(u32x4*)(DN + (size_t)n * 4096 + k) = cw; *(u32x4*)(DN + (size_t)n * 4096 + 2048 + k) = sw; }
      __syncthreads(); }
    { const float sc = 0.0625f;
      for (int i = gt; i < 256 * 256; i += NT_) { const int n = i >> 8, k = i & 255; float s0, c0; sincospif((float)((n * k) & 255) * (1.0f / 128.0f), &s0, &c0);
          DN2[n * 512 + k] = (bf16)(cvtpk(c0 * sc, 0.f) & 0xffff); DN2[n * 512 + 256 + k] = (bf16)(cvtpk(-s0 * sc, 0.f) & 0xffff); } }
    { const float sc = 0.08838834764831845f;
      for (int i = gt; i < 256 * 128; i += NT_) { const int r = i >> 7, k = i & 127; float s0, c0; sincospif((float)(((r & 127) * k) & 127) * (1.0f / 64.0f), &s0, &c0);
          DC[i] = (bf16)(cvtpk((r < 128 ? c0 : s0) * sc, 0.f) & 0xffff); } }
}
__device__ __forceinline__ void convert_weights_main(const Ctx& F, KP kp, int l, int parts = 3) {
    int base = 0;
    if (parts & 1) {
        run_xjob(F, base, kin(kp, 8) + (size_t)l * 1024 * INW, INW, nullptr, (bf16*)(F.ws + O_WIN), 1024, 0, M_WIN, 1024, NINP);
        run_xjob(F, base, kin(kp, 13) + (size_t)l * 384 * 768, 768, kin(kp, 11) + l * 384, (bf16*)(F.ws + O_WUQ), 384, 0, M_WUQ, 384, 768);
        run_xjob(F, base, kin(kp, 14) + (size_t)l * 256 * 1024, 1024, kin(kp, 12) + l * 256, (bf16*)(F.ws + O_WUKV), 256, 0, M_WUKV, 256, 1024);
    }
    if (parts & 2) {
        run_xjob(F, base, kin(kp, 20) + (size_t)l * 512 * 1024, 1024, nullptr, (bf16*)(F.ws + O_WBR), 1536, 0, M_NATP, 512, 1024);
        run_xjob(F, base, kin(kp, 21) + (size_t)l * 512 * 1024, 1024, nullptr, (bf16*)(F.ws + O_WBR), 1536, 512, M_NATP, 512, 1024);
        run_xjob(F, base, kin(kp, 22) + (size_t)l * 512 * 1024, 1024, nullptr, (bf16*)(F.ws + O_WBR), 1536, 1024, M_NATP, 512, 1024);
        run_xjob(F, base, kin(kp, 23) + (size_t)l * 1024 * 1024, 1024, nullptr, (bf16*)(F.ws + O_WOUT), 1024, 0, M_NAT, 1024, 1024);
    }
}
__device__ __forceinline__ void convert_weights_ffn(const Ctx& F, KP kp, int l) {
    int base = 0;
    run_xjob(F, base, kin(kp, 24) + (size_t)l * 1024 * 2 * FFH, 2 * FFH, nullptr, (bf16*)(F.ws + O_WFI), 1024, 0, M_FFI, 1024, 2 * FFH);
    run_xjob(F, base, kin(kp, 25) + (size_t)l * FFH * 1024, 1024, nullptr, (bf16*)(F.ws + O_WFO), FFH, 0, M_NAT, FFH, 1024);
}

struct F1Sched {
    int nb_tok, G, c, row0, rows_per_b, nunits; const char* A; const char* PF;
    __device__ __forceinline__ bool next(int i, Unit& u) const { return at((long)i * G + c, u); }
    __device__ __forceinline__ bool at(long L, Unit& u) const {
        if (L >= nunits) return false;
        const int j = (int)L % nb_tok, bg = (int)L / nb_tok, gch = bg & 3, b = bg >> 2;
        u.pm = b * 4 + gch; u.pn = j; u.kb = 0; u.A = A; u.B = PF + ((size_t)(row0 + b * rows_per_b + j * 256) * 512 + gch * 128) * 2; return true;
    }
};
struct F2Sched {
    int nM, G, c, row0, rows_per_b, nunits; const char* DN; const char* ZT; size_t K2;
    __device__ __forceinline__ bool next(int i, Unit& u) const {
        const long L = (long)i * G + c; if (L >= nunits) return false;
        const int pn = (int)L & 1, r = (int)L >> 1, pm = r % nM, b = r / nM;
        u.pm = (row0 + b * rows_per_b) / 256 + pm; u.pn = pn; u.kb = 0;
        u.A = DN + (size_t)pm * 256 * K2 * 2; u.B = ZT + ((size_t)b * 512 + pn * 256) * K2 * 2; return true;
    }
};


struct P1Sched { RectSched s, sc, sq; int n0, n1, n2, G, c;
    __device__ __forceinline__ bool next(int i, Unit& u) const {
        const long L = (long)i * G + c;
        if (L >= n2) return false;
        if (L < n0) return s.at(L, 0, u);
        if (L < n1) return sc.at(L - n0, 0, u);
        return sq.at(L - n1, 0, u); } };
struct P2Sched {
    RectSched sq, sg, suq, sukv; F1Sched sf1, sf1c; int n0, ng, n1, n2, n3, n4, G, c, qoff;
    __device__ __forceinline__ bool next(int i, Unit& u) const {
        const long L = (long)i * G + ((i & 1) ? (G - 1 - c) : c);
        if (L >= n4) return false;
        if (L < n0) { u.lda = 1024; u.ldb = 1024; u.nt = 16; u.epi = 0; return sq.at(L + qoff, 0, u); }
        if (L < ng) { u.lda = 1024; u.ldb = 1024; u.nt = 16; u.epi = 0; if (!sg.at(L - n0, 0, u)) return false; u.pn += 8; return true; }
        if (L < n1) { u.lda = 384; u.ldb = 384; u.nt = 6; u.epi = 1; return suq.at(L - ng, 0, u); }
        if (L < n2) { u.lda = 256; u.ldb = 256; u.nt = 4; u.epi = 2; return sukv.at(L - n1, 0, u); }
        if (L < n3) { u.lda = 128; u.ldb = 512; u.nt = 2; u.epi = 3; return sf1.at(L - n2, u); }
        u.lda = 128; u.ldb = 512; u.nt = 2; u.epi = 4; return sf1c.at(L - n3, u);
    }
};
struct P2Epi {
    EpiIn e0; EpiUq e1; EpiUkv e2; EpiF1 e3, e4;
    __device__ __forceinline__ bool operator()(Acc& acc, const Unit& u, int wr, int wc, int fr, int fq) const {
        switch (u.epi) {
        case 0: return e0(acc, u, wr, wc, fr, fq);
        case 1: return e1(acc, u, wr, wc, fr, fq);
        case 2: return e2(acc, u, wr, wc, fr, fq);
        case 3: return e3(acc, u, wr, wc, fr, fq);
        default: return e4(acc, u, wr, wc, fr, fq);
        }
    }
};


struct WinSched { RectSched s; int off, cnt, G, c;
    __device__ __forceinline__ bool next(int i, Unit& u) const { const long L = (long)i * G + c; if (L >= cnt) return false; return s.at(L + off, 0, u); } };
struct FfnBSched { RectSched so, si; int n0, n1, off, G, c;
    __device__ __forceinline__ bool next(int i, Unit& u) const {
        long L;
        if (c < 32) { if (i == 0) L = c; else if (i <= 2) L = n0 + (i - 1) * 32 + c; else return false; }
        else { if (i >= 5) return false; L = n0 + 64 + (long)i * 224 + (c - 32); if (L >= n1) return false; }
        if (L < n0) { u.lda = FFH; u.ldb = FFH; u.nt = FFH / 64; u.epi = 1; return so.at(L, 0, u); }
        u.lda = 1024; u.ldb = 1024; u.nt = 16; u.epi = 0; return si.at(L - n0 + off, 0, u); } };
struct FfnBEpi { EpiSwiglu e0; EpiRes e1;
    __device__ __forceinline__ bool operator()(Acc& acc, const Unit& u, int wr, int wc, int fr, int fq) const { return u.epi == 0 ? e0(acc, u, wr, wc, fr, fq) : e1(acc, u, wr, wc, fr, fq); } };


struct GateChainSched { const char *HBp, *WINp; int c, nu;
    __device__ __forceinline__ bool next(int i, Unit& u) const {
        if (i >= nu) return false;
        int pm, pn; pg8::tile_order(c, 64, 4, pm, pn);
        u.pm = pm; u.pn = 8 + 4 * i + pn; u.kb = 0; u.A = HBp + (size_t)pm * 256 * 1024 * 2; u.B = WINp + (size_t)u.pn * 256 * 1024 * 2; return true; } };

#ifndef DIAG_SUB
#define DIAG_SUB -1
#endif
#ifndef TIME_REP
#define TIME_REP 0
#endif
#ifndef DIAG_TS
#define DIAG_TS -1
#endif
#ifndef TIME_PH
#define TIME_PH -1
#endif
#define REP(b) ((TIME_REP & (b)) ? 2 : 1)
#define SUB_ON(k) (DIAG_SUB < 0 || DIAG_SUB == (k))
#ifndef DIAG_PART
#define DIAG_PART 0xffff
#endif
#define PART_ON(b) ((DIAG_PART & (b)) != 0)
__global__ void __launch_bounds__(NTHR, 2) fwd_kernel(Args args) {
    extern __shared__ __attribute__((aligned(16))) unsigned char lds_raw[];
#if !MK_MULTI
    if (threadIdx.x < 2) ((volatile LAS unsigned*)((LAS unsigned char*)lds_raw + LDS_MISC))[threadIdx.x] = 0u;
    __syncthreads();
    const XcdBarrier xbar = xcd_barrier_post((unsigned*)(*(unsigned char* const __attribute__((address_space(4)))*)((KP)__builtin_amdgcn_kernarg_segment_ptr() + 216) + O_CTL) + 1024, (volatile LAS unsigned*)((LAS unsigned char*)lds_raw + LDS_MISC));
#define GRID_SYNC(first) do { xcd_barrier(xbar); } while (0)
#else
#define GRID_SYNC(first) do {} while (0)
#endif
    bool rep_done = false;
    unsigned long long ts0 = 0, ts1 = 0;
    for (int ph = args.ph_lo; ph < args.ph_hi; ++ph) {
        if (DIAG_TS >= 0 && ph == DIAG_TS) ts0 = __builtin_amdgcn_s_memrealtime();
        KP kp = (KP)__builtin_amdgcn_kernarg_segment_ptr(); asm volatile("" : "+s"(kp));
        int c = (int)blockIdx.x; asm volatile("" : "+s"(c));
        int G = (int)gridDim.x; asm volatile("" : "+s"(G));
        int tid_ = threadIdx.x; asm volatile("" : "+v"(tid_));
        Ctx F; F.lds = (LAS unsigned char*)lds_raw; F.tid = tid_; F.lane = tid_ & 63; F.wave = __builtin_amdgcn_readfirstlane(tid_ >> 6);
        F.G = G; F.vcu = (G % 8 == 0) ? (c % 8) * (G / 8) + c / 8 : c; F.cv_rank = F.vcu; F.cv_n = G;
        unsigned char* ws = kws(kp); F.ws = ws; float* const outp = kout(kp);
#define mod ((const float*)(ws + O_MOD))
#define ropeA ((const float*)(ws + O_ROPEA))
#define ropeB ((const float*)(ws + O_ROPEB))
#define stat_cq ((float*)(ws + O_STATCQ))
#define stat_ckv ((float*)(ws + O_STATCKV))
#define HB ((bf16*)(ws + O_HB))
#define PF ((bf16*)(ws + O_PF))
#define QA ((bf16*)(ws + O_QA))
#define QBN ((bf16*)(ws + O_QBN))
#define QBR ((bf16*)(ws + O_QBR))
#define CQ ((bf16*)(ws + O_CQ))
#define CKV ((bf16*)(ws + O_CKV))
#define KA ((bf16*)(ws + O_KA))
#define VA ((bf16*)(ws + O_VA))
#define KB ((bf16*)(ws + O_KB))
#define VB ((bf16*)(ws + O_VB))
#define GT ((bf16*)(ws + O_G))
#define ACT ((bf16*)(ws + O_G))
#define MB HB
#define YC PF
#define XC ((float*)(ws + O_XC))
#define GC ((!L1 && G == 256) ? (unsigned char*)outp + (size_t)40 * MiB - (size_t)ML * 3072 : (unsigned char*)(ws + O_G))
        if (ph == 0) { if (SUB_ON(10))
            for (int rep_ = 0; rep_ < REP(1); ++rep_) { mod_items(F, kp); table_items(F); convert_weights_main(F, kp, 0); }
        } else {
            const int l = (ph - 1) / 10, sub = (ph - 1) % 10;
            const bool L1 = (l == 1);
            const int nMt = L1 ? 64 : 72;
            const float* xin_lat = L1 ? outp : kin(kp, 0); const float* xin_ctx = L1 ? XC : kin(kp, 2);
            const float* mod_l = mod + (size_t)l * 9 * 6144;
            bf16* ZT = L1 ? (bf16*)(ws + O_ZT1) : (bf16*)outp; bf16* ZTC = (bf16*)outp + (size_t)8 * 512 * 4096;
            switch (sub) {
            case 0: if (SUB_ON(0)) {
                if (L1 && G != 256) convert_weights_main(F, kp, 1);
                for (int rep_ = 0; rep_ < REP(2); ++rep_) norm_pass(F, xin_lat, xin_ctx, HB, kin(kp, 6) + l * 1024, mod_l, 0, MT);
            } break;
            case 1: if (SUB_ON(1)) {
                EpiIn E{QA, KA, VA, CQ, CKV, KB, PF, GT, stat_cq, stat_ckv, kin(kp, 9) + l * 64, kin(kp, 10) + l * 64, kin(kp, 18) + l * 32, kin(kp, 19) + l * 3072, ropeA, ropeB, GC};
                const Gemm g{1024, 1024, 1024};
                const int nlat = (L1 ? 64 : 72) * 6, nctx = L1 ? 24 : 0, nq_all = (L1 ? 64 : 72) * 2;
                int nq1 = ((nlat + nctx + G - 1) / G) * G - (nlat + nctx); if (nq1 > nq_all) nq1 = nq_all;
                P1Sched S{RectSched{L1 ? 64 : 72, 6, 0, G, c, 1, 0x765432ull, (const char*)HB, 0, 0, (const char*)(ws + O_WIN), (size_t)256 * 1024 * 2, (size_t)256 * 1024 * 2, 0},
                          RectSched{8, 3, 64, G, c, 1, 0x542ull, (const char*)HB, 0, 0, (const char*)(ws + O_WIN), (size_t)256 * 1024 * 2, (size_t)256 * 1024 * 2, 0},
                          RectSched{L1 ? 64 : 72, 2, 0, G, c, 1, ~0ull, (const char*)HB, 0, 0, (const char*)(ws + O_WIN), (size_t)256 * 1024 * 2, (size_t)256 * 1024 * 2, 0},
                          nlat, nlat + nctx, nlat + nctx + nq1, G, c};
                pg8::gemm_phase(F.lds, g, S, E);
            } break;
            case 2: if (SUB_ON(2)) {
                const int nMl = L1 ? 64 : 72;
                int nq1; { const int n1_ = nMl * 6 + (L1 ? 24 : 0); nq1 = ((n1_ + G - 1) / G) * G - n1_; if (nq1 > nMl * 2) nq1 = nMl * 2; }
                P2Sched S;
                S.sq = RectSched{nMl, 2, 0, G, c, 1, ~0ull, (const char*)HB, 0, 0, (const char*)(ws + O_WIN), (size_t)256 * 1024 * 2, (size_t)256 * 1024 * 2, 0};
                const int ngc = (!L1 && G == 256) ? 96 : 0;
                S.sg = RectSched{8, 12, 64, G, c, 1, ~0ull, (const char*)HB, 0, 0, (const char*)(ws + O_WIN) + (size_t)8 * 256 * 1024 * 2, (size_t)256 * 1024 * 2, (size_t)256 * 1024 * 2, 0};
                S.suq = RectSched{nMl, 3, 0, G, c, 1, ~0ull, (const char*)CQ, 0, 0, (const char*)(ws + O_WUQ), (size_t)256 * 384 * 2, (size_t)256 * 384 * 2, 0};
                S.sukv = RectSched{72, 4, 0, G, c, 1, ~0ull, (const char*)CKV, 0, 0, (const char*)(ws + O_WUKV), (size_t)256 * 256 * 2, (size_t)256 * 256 * 2, 0};
                S.sf1 = F1Sched{8, G, c, 0, 2048, 256, (const char*)(ws + O_DFTC), (const char*)PF};
                S.sf1c = F1Sched{1, G, c, ML, 256, L1 ? 0 : 32, (const char*)(ws + O_DFTC), (const char*)PF};
                S.qoff = nq1; S.n0 = nMl * 2 - nq1; S.ng = S.n0 + ngc; S.n1 = S.ng + nMl * 3; S.n2 = S.n1 + 72 * 4; S.n3 = S.n2 + 256; S.n4 = S.n3 + (L1 ? 0 : 32); S.G = G; S.c = c;
                P2Epi E{EpiIn{QA, KA, VA, CQ, CKV, KB, PF, GT, stat_cq, stat_ckv, kin(kp, 9) + l * 64, kin(kp, 10) + l * 64, kin(kp, 18) + l * 32, kin(kp, 19) + l * 3072, ropeA, ropeB, GC},
                        EpiUq{QBN, QBR, stat_cq, kin(kp, 15) + l * 64, kin(kp, 17) + l * 32, ropeB}, EpiUkv{KB, VB, stat_ckv, kin(kp, 16) + l * 64}, EpiF1{ZT, 2048}, EpiF1{ZTC, 256}};
                const Gemm g{1024, 1024, 1024};
                pg8::gemm_phase(F.lds, g, S, E);
            } break;
            case 3: if (SUB_ON(3)) {
                LAS unsigned char* shm = F.lds;
                if (TIME_REP & 32) for (int i = 0;; ++i) {
                    const int L = i * G + c; if (L >= 512) break; const int qb = L & 7, h = (L >> 3) & 7, b = L >> 6;
                    const size_t row0 = (size_t)b * SEQ + qb * 256; const size_t key0 = (size_t)b * NKEY;
                    attq::attn_unit<4, 8>(QA + row0 * 512 + h * 64, 512, nullptr, 0, KA + key0 * 128 + (h >> 2) * 64, 128, VA + key0 * 128 + (h >> 2) * 64, 128, CQ + row0 * 512 + h * 64, 512, NKEY / 64, (char*)lds_raw);
                }
                if (TIME_REP & 64) for (int i = 0;; ++i) {
                    const int L = i * G + c; if (L >= 512) break; const int qb = L & 7, h = (L >> 3) & 7, b = L >> 6;
                    const size_t row0 = (size_t)b * SEQ + qb * 256; const size_t key0 = (size_t)b * NKEY;
                    attq::attn_unit<6, 8>(QBN + row0 * 512 + h * 64, 512, QBR + row0 * 256 + h * 32, 256, KB + key0 * 768 + h * 96, 768, VB + key0 * 512 + h * 64, 512, CQ + row0 * 512 + h * 64, 512, NKEY / 64, (char*)lds_raw);
                }
                for (int i = 0;; ++i) {
                    int L; if (G == 256) { if (c < 128) { if (i >= 3) break; L = c + 128 * i; } else { if (i >= 1) break; L = 384 + (c - 128); } } else { L = i * G + c; if (L >= 512) break; }
                    const int qb = L & 7, h = (L >> 3) & 7, b = L >> 6;
                    const size_t row0 = (size_t)b * SEQ + qb * 256; const size_t key0 = (size_t)b * NKEY;
                    attq::attn_unit<4, 8>(QA + row0 * 512 + h * 64, 512, nullptr, 0, KA + key0 * 128 + (h >> 2) * 64, 128, VA + key0 * 128 + (h >> 2) * 64, 128, QA + row0 * 512 + h * 64, 512, NKEY / 64, (char*)lds_raw);
                }
                for (int i = 0;; ++i) {
                    const int L = i * G + c; if (L >= 512) break; const int qb = L & 7, h = (L >> 3) & 7, b = L >> 6;
                    const size_t row0 = (size_t)b * SEQ + qb * 256; const size_t key0 = (size_t)b * NKEY;
                    attq::attn_unit<6, 8>(QBN + row0 * 512 + h * 64, 512, QBR + row0 * 256 + h * 32, 256, KB + key0 * 768 + h * 96, 768, VB + key0 * 512 + h * 64, 512, QBN + row0 * 512 + h * 64, 512, NKEY / 64, (char*)lds_raw);
                }
                if (!L1) {
                    for (int i = 0;; ++i) {
                        const int L = i * G + c; if (L >= 128) break; const int h = L & 7, b = (L >> 3) & 7; const bool mla = L >= 64;
                        const size_t row0 = (size_t)ML + b * CTX; const size_t key0 = (size_t)b * NKEY;
                        if (!mla) attq::attn_unit<4, 8>(QA + row0 * 512 + h * 64, 512, nullptr, 0, KA + key0 * 128 + (h >> 2) * 64, 128, VA + key0 * 128 + (h >> 2) * 64, 128, QA + row0 * 512 + h * 64, 512, CTX / 64, (char*)lds_raw);
                        else attq::attn_unit<6, 8>(QBN + row0 * 512 + h * 64, 512, QBR + row0 * 256 + h * 32, 256, KB + key0 * 768 + h * 96, 768, VB + key0 * 512 + h * 64, 512, QBN + row0 * 512 + h * 64, 512, CTX / 64, (char*)lds_raw);
                    }
                }
                for (int rep_ = 0; rep_ < REP(128); ++rep_) { EpiStore E{YC, 512}; const Gemm g{4096, 4096, 4096};
                  F2Sched S{8, G, (c + 128) % G, 0, 2048, 128, (const char*)(ws + O_DN), (const char*)ZT, 4096};
                  pg8::gemm_phase(F.lds, g, S, E); }
                if (!L1) { EpiStore E{YC, 512}; const Gemm g{512, 512, 512};
                  F2Sched S{1, G, c, ML, 256, 16, (const char*)(ws + O_DN256), (const char*)ZTC, 512};
                  pg8::gemm_phase(F.lds, g, S, E); }
            } break;
            case 4: if (SUB_ON(4)) {
                EpiIn E{QA, KA, VA, CQ, CKV, KB, PF, GT, stat_cq, stat_ckv, kin(kp, 9) + l * 64, kin(kp, 10) + l * 64, kin(kp, 18) + l * 32, kin(kp, 19) + l * 3072, ropeA, ropeB, GC};
                const Gemm g{1024, 1024, 1024};
                RectSched S{(G == 256) ? 64 : nMt, 12, 0, G, c, 1, ~0ull, (const char*)HB, 0, 0, (const char*)(ws + O_WIN) + (size_t)8 * 256 * 1024 * 2, (size_t)256 * 1024 * 2, (size_t)256 * 1024 * 2, 0};
                struct PnShift { RectSched s; __device__ __forceinline__ bool next(int i, Unit& u) const { if (!s.next(i, u)) return false; u.pn += 8; return true; } } S8{S};
                if (L1 && G == 256) {
                    GateChainSched SC{(const char*)HB, (const char*)(ws + O_WIN), c, 0};
                    { int nu_ = 3; asm volatile("" : "+s"(nu_)); SC.nu = nu_; }
                    pg8::gemm_phase(F.lds, g, SC, E);
                    EpiMerge EM{(const unsigned char*)GT, MB, GC}; const Gemm gm{512, 1536, 512};
                    RectSched SM{64, 4, 0, G, c, 3, ~0ull, (const char*)QA, (size_t)((const char*)QBN - (const char*)QA), (size_t)((const char*)YC - (const char*)QA), (const char*)(ws + O_WBR), (size_t)256 * 512 * 2, (size_t)256 * 1536 * 2, (size_t)512 * 2};
                    pg8::gemm_phase(F.lds, gm, SM, EM);
                } else pg8::gemm_phase(F.lds, g, S8, E);
            } break;
            case 5: if (SUB_ON(5) && !(L1 && G == 256)) {
                for (int rep_ = 0; rep_ < REP(512); ++rep_) { EpiMerge E{(const unsigned char*)GT, MB, GC}; const Gemm g{512, 1536, 512};
                RectSched S{nMt, 4, 0, G, c, 3, ~0ull, (const char*)QA, (size_t)((const char*)QBN - (const char*)QA), (size_t)((const char*)YC - (const char*)QA), (const char*)(ws + O_WBR), (size_t)256 * 512 * 2, (size_t)256 * 1536 * 2, (size_t)512 * 2};
                pg8::gemm_phase(F.lds, g, S, E); }
                if (!L1 && G == 256 && c >= 32) { F.cv_rank = c - 32; F.cv_n = 224; convert_weights_main(F, kp, 1, 1); }
            } break;
            case 6: if (SUB_ON(6)) {
                EpiRes E{xin_lat, xin_ctx, outp, XC, mod_l + 2048}; const Gemm g{1024, 1024, 1024};
                RectSched S{nMt, 4, 0, G, c, 1, ~0ull, (const char*)MB, 0, 0, (const char*)(ws + O_WOUT), (size_t)256 * 1024 * 2, (size_t)256 * 1024 * 2, 0};
                pg8::gemm_phase(F.lds, g, S, E);
                if (!L1 && G == 256 && c >= 32) { F.cv_rank = c - 32; F.cv_n = 224; convert_weights_ffn(F, kp, 0); }
            } break;
            case 7: if (SUB_ON(7)) {
                if (L1 || G != 256) convert_weights_ffn(F, kp, l);
                if (!L1 && G == 256) convert_weights_main(F, kp, 1, 2);
                for (int rep_ = 0; rep_ < REP(2048); ++rep_) norm_pass(F, outp, XC, HB, kin(kp, 7) + l * 1024, mod_l, 3072, L1 ? ML : MT);
            } break;
            case 8: if (SUB_ON(8)) {
                EpiSwiglu E{ACT}; const Gemm g{1024, 1024, 1024};
                if (L1 || G != 256) {
                    RectSched S{nMt, 22, 0, G, c, 1, ~0ull, (const char*)HB, 0, 0, (const char*)(ws + O_WFI), (size_t)256 * 1024 * 2, (size_t)256 * 1024 * 2, 0};
                    pg8::gemm_phase(F.lds, g, S, E);
                } else {
                    const RectSched Slat{64, 22, 0, G, c, 1, ~0ull, (const char*)HB, 0, 0, (const char*)(ws + O_WFI), (size_t)256 * 1024 * 2, (size_t)256 * 1024 * 2, 0};
                    { RectSched Sc{8, 22, 64, G, c, 1, ~0ull, (const char*)HB, 0, 0, (const char*)(ws + O_WFI), (size_t)256 * 1024 * 2, (size_t)256 * 1024 * 2, 0};
                      struct ASched { RectSched sc; WinSched sl; int G, c; __device__ __forceinline__ bool next(int i, Unit& u) const { const long L = (long)i * G + c; if (L < 176) return sc.at(L, 0, u); if (L < 512) return sl.s.at(L - 176, 0, u); return false; } } SA{Sc, WinSched{Slat, 0, 336, G, c}, G, c};
                      pg8::gemm_phase(F.lds, g, SA, E); }
                    GRID_SYNC(false);
                    { FfnBSched SB{RectSched{8, 4, 64, G, c, 1, ~0ull, (const char*)ACT, 0, 0, (const char*)(ws + O_WFO), (size_t)256 * FFH * 2, (size_t)256 * FFH * 2, 0}, Slat, 32, 32 + 1072, 336, G, c};
                      FfnBEpi EB{E, EpiRes{outp, XC, outp, XC, mod_l + 5120}};
                      pg8::gemm_phase(F.lds, g, SB, EB); }
                }
            } break;
            case 9: if (SUB_ON(9)) {
                EpiRes E{outp, XC, outp, XC, mod_l + 5120}; const Gemm g{FFH, FFH, FFH};
                RectSched S{(L1 || G == 256) ? 64 : 72, 4, 0, G, c, 1, ~0ull, (const char*)ACT, 0, 0, (const char*)(ws + O_WFO), (size_t)256 * FFH * 2, (size_t)256 * FFH * 2, 0};
                pg8::gemm_phase(F.lds, g, S, E);
            } break;
            }
        }
        if (ph + 1 < args.ph_hi || DIAG_TS >= 0) { GRID_SYNC(ph == 0); }
        if (DIAG_TS >= 0 && ph == DIAG_TS) ts1 = __builtin_amdgcn_s_memrealtime();
        if (TIME_PH >= 0 && ph == TIME_PH && !rep_done) { rep_done = true; --ph; }
    }
    if (DIAG_TS >= 0 && blockIdx.x == 0 && threadIdx.x == 0) { float* o = kout((KP)__builtin_amdgcn_kernarg_segment_ptr()); o[0] = (float)(ts1 - ts0) * 0.01f; }
}

extern "C" void kernel_launch(void* const* d_in, const int* in_sizes, int n_in, void* d_out, int out_size, void* d_ws, size_t ws_size, hipStream_t stream) {
    static int grid = 0;
    if (grid == 0) {
        if (n_in != 26 || out_size != ML * DM || ws_size < O_END) { fprintf(stderr, "kernel_launch: unexpected shapes (n_in %d out %d ws %zu)\n", n_in, out_size, ws_size); grid = -1; return; }
        int dev = 0, cus = 0, per_cu = 0;
        hipGetDevice(&dev); hipDeviceGetAttribute(&cus, hipDeviceAttributeMultiprocessorCount, dev);
        if (hipFuncSetAttribute((const void*)fwd_kernel, hipFuncAttributeMaxDynamicSharedMemorySize, LDS_BYTES) != hipSuccess) { fprintf(stderr, "kernel_launch: hipFuncSetAttribute failed\n"); grid = -1; return; }
        hipOccupancyMaxActiveBlocksPerMultiprocessor(&per_cu, (const void*)fwd_kernel, NTHR, LDS_BYTES);
        if (per_cu < 1) { fprintf(stderr, "kernel_launch: occupancy query says %d blocks/CU\n", per_cu); per_cu = 1; }
        (void)hipGetLastError();
        grid = cus;
        if (grid > 256) grid = 256;
    }
    if (grid < 0) return;
    (void)hipMemsetAsync((char*)d_ws + O_CTL, 0, CTL_ZERO_BYTES, stream);
    Args a{};
    for (int i = 0; i < 26; ++i) a.in[i] = (const float*)d_in[i];
    a.out = (float*)d_out; a.ws = (unsigned char*)d_ws;
#if MK_MULTI
    for (int ph = 0; ph < NPHASE; ++ph) { a.ph_lo = ph; a.ph_hi = ph + 1; hipLaunchKernelGGL(fwd_kernel, dim3(grid), dim3(NTHR), LDS_BYTES, stream, a); }
#else
    a.ph_lo = 0; a.ph_hi = NPHASE;
    void* kargs[] = {&a};
    hipError_t e = hipLaunchCooperativeKernel((const void*)fwd_kernel, dim3(grid), dim3(NTHR), kargs, LDS_BYTES, stream);
    if (e != hipSuccess) fprintf(stderr, "cooperative launch failed: %s (grid %d)\n", hipGetErrorString(e), grid);
#endif
}
```
